# Optimizing an MI355X kernel written in HIP

```python
import math
import jax, jax.numpy as jnp
from jax import lax
import numpy as np

D_MODEL = 1024
BATCH = 2
SEQ = 16384
DEPTH = 4

N_MIXERS = 3
N_A = (DEPTH + 2) // 3
N_B = (DEPTH + 1) // 3
N_C = DEPTH // 3

DEEPNORM_ALPHA = (2.0 * DEPTH) ** 0.25
DEEPNORM_BETA = (8.0 * DEPTH) ** -0.25
LN_EPS = 1e-5
RMS_EPS = 1e-6

D_FF = 2816

GMLP_CHUNK = 128
GMLP_WIDTH = D_MODEL
GMLP_GROUPS = 8
GMLP_GROUP_DIM = GMLP_WIDTH // GMLP_GROUPS

HGRN_EXPAND = 128
HGRN_HEADS = D_MODEL // HGRN_EXPAND
HGRN_DK = HGRN_EXPAND
HGRN_DV = D_MODEL // HGRN_HEADS
HGRN_WIDTH = HGRN_HEADS * HGRN_DK
HGRN_CHUNK = 64

ATTN_WINDOW = 128
ATTN_BLOCK = 128
ATTN_HEAD_DIM = 64
ATTN_Q_HEADS = D_MODEL // ATTN_HEAD_DIM
ATTN_KV_HEADS = 2
ATTN_GROUP = ATTN_Q_HEADS // ATTN_KV_HEADS
ATTN_QKV_WIDTH = (ATTN_Q_HEADS + 2 * ATTN_KV_HEADS) * ATTN_HEAD_DIM

kernel_name = 'hybrid_gmlp_hgrn2_swa_sink_deepnorm_macaron'


def layer_norm(x, g, b):
    xf = x.astype(jnp.float32)
    mu = jnp.mean(xf, axis=-1, keepdims=True)
    var = jnp.mean(jnp.square(xf - mu), axis=-1, keepdims=True)
    y = (xf - mu) * lax.rsqrt(var + LN_EPS)
    return (y * g.astype(jnp.float32) + b.astype(jnp.float32)).astype(x.dtype)


def rms_norm(x, g):
    xf = x.astype(jnp.float32)
    y = xf * lax.rsqrt(jnp.mean(jnp.square(xf), axis=-1, keepdims=True) + RMS_EPS)
    return y * g.astype(jnp.float32)


def swiglu(x, w_gate_up, w_down):
    gate, up = jnp.split(x @ w_gate_up, 2, axis=-1)
    return (jax.nn.silu(gate) * up) @ w_down


def chunked_gmlp(x, w_in, ln_g, ln_b, w_s, b_s, w_out):
    B, S, _ = x.shape
    nc = S // GMLP_CHUNK
    z = jax.nn.gelu(x @ w_in, approximate=False)
    u, v = jnp.split(z, 2, axis=-1)
    v = layer_norm(v, ln_g, ln_b)
    v = v.reshape(B, nc, GMLP_CHUNK, GMLP_GROUPS, GMLP_GROUP_DIM)
    causal = jnp.tril(jnp.ones((GMLP_CHUNK, GMLP_CHUNK), dtype=bool))
    w = jnp.where(causal[None], w_s, jnp.zeros_like(w_s))
    mixed = jnp.einsum('gts,bcsgd->bctgd', w, v) + jnp.transpose(b_s)[:, :, None]
    return (u * mixed.reshape(B, S, GMLP_WIDTH)) @ w_out


def hgrn2(x, w_in, lower_bound, norm_g, w_out):
    B, S, _ = x.shape
    H, K, V, C = HGRN_HEADS, HGRN_DK, HGRN_DV, HGRN_CHUNK
    nc = S // C
    q, f, i, g = jnp.split(x @ w_in, 4, axis=-1)
    q = jax.nn.silu(q.astype(jnp.float32))
    f = lower_bound + (1.0 - lower_bound) * jax.nn.sigmoid(f.astype(jnp.float32))
    k = 1.0 - f
    log_f = jnp.log(f)

    def to_chunks(t, d):
        return t.reshape(B, nc, C, H, d).transpose(1, 0, 3, 2, 4)

    qc = to_chunks(q, K)
    kc = to_chunks(k, K)
    vc = to_chunks(i.astype(jnp.float32), V)
    gcum = jnp.cumsum(to_chunks(log_f, K), axis=-2)
    mask = jnp.tril(jnp.ones((C, C), dtype=bool))[:, :, None]

    def step(state, inp):
        q_, k_, v_, gc_ = inp
        diff = gc_[..., :, None, :] - gc_[..., None, :, :]
        decay = jnp.exp(jnp.where(mask, diff, -jnp.inf))
        scores = jnp.einsum('bhtk,bhtsk,bhsk->bhts', q_, decay, k_)
        o = jnp.einsum('bhts,bhsv->bhtv', scores, v_) + jnp.einsum('bhtk,bhkv->bhtv', q_ * jnp.exp(gc_), state)
        g_last = gc_[..., -1:, :]
        k_dec = k_ * jnp.exp(g_last - gc_)
        state = jnp.exp(g_last[..., 0, :])[..., None] * state + jnp.einsum('bhsk,bhsv->bhkv', k_dec, v_)
        return state, o

    state0 = jnp.zeros((B, H, K, V), jnp.float32)
    _, o = lax.scan(step, state0, (qc, kc, vc, gcum))
    o = o.transpose(1, 0, 3, 2, 4).reshape(B, S, H, V)
    o = rms_norm(o, norm_g).reshape(B, S, H * V)
    o = (o * jax.nn.silu(g.astype(jnp.float32))).astype(x.dtype)
    return o @ w_out


def sliding_window_attention(x, w_qkv, b_qkv, sinks, w_o, b_o):
    B, S, _ = x.shape
    nb = S // ATTN_BLOCK
    L, HD, HKV, G = ATTN_BLOCK, ATTN_HEAD_DIM, ATTN_KV_HEADS, ATTN_GROUP
    qkv = x @ w_qkv + b_qkv
    q, k, v = jnp.split(qkv, [ATTN_Q_HEADS * HD, ATTN_Q_HEADS * HD + HKV * HD], axis=-1)
    q = q.reshape(B, nb, L, HKV, G, HD) * (HD ** -0.5)
    k = k.reshape(B, nb, L, HKV, HD)
    v = v.reshape(B, nb, L, HKV, HD)

    def with_prev(t):
        prev = jnp.concatenate([jnp.zeros_like(t[:, :1]), t[:, :-1]], axis=1)
        return jnp.concatenate([prev, t], axis=2)

    k2, v2 = with_prev(k), with_prev(v)
    scores = jnp.einsum('bnqhgd,bnkhd->bnhgqk', q, k2).astype(jnp.float32)
    q_pos = jnp.arange(L)[:, None] + L
    k_pos = jnp.arange(2 * L)[None, :]
    rel = q_pos - k_pos
    in_band = (rel >= 0) & (rel < ATTN_WINDOW)
    real_key = (jnp.arange(nb)[:, None, None] > 0) | (k_pos[None] >= L)
    mask = in_band[None] & real_key
    scores = jnp.where(mask[None, :, None, None], scores, -jnp.inf)
    sink = jnp.broadcast_to(sinks.astype(jnp.float32).reshape(1, 1, HKV, G, 1, 1), scores.shape[:-1] + (1,))
    probs = jax.nn.softmax(jnp.concatenate([scores, sink], axis=-1), axis=-1)[..., :-1]
    out = jnp.einsum('bnhgqk,bnkhd->bnqhgd', probs.astype(v2.dtype), v2)
    return out.reshape(B, S, ATTN_Q_HEADS * HD) @ w_o + b_o


def setup_inputs(seed: int = 0) -> dict:
    key = jax.random.key(seed)
    ks = jax.random.split(key, 24)

    def nrm(k, shape, scale):
        return jax.random.normal(k, shape, jnp.float32) * scale

    beta = DEEPNORM_BETA
    return {
        'x': nrm(ks[0], (BATCH, SEQ, D_MODEL), 1.0),
        'ffn_w_gate_up': nrm(ks[1], (DEPTH, 2, D_MODEL, 2 * D_FF), D_MODEL ** -0.5),
        'ffn_w_down': nrm(ks[2], (DEPTH, 2, D_FF, D_MODEL), beta * D_FF ** -0.5),
        'ln_gain': 1.0 + nrm(ks[3], (DEPTH, 3, D_MODEL), 0.01),
        'ln_bias': nrm(ks[4], (DEPTH, 3, D_MODEL), 0.01),
        'gmlp_w_in': nrm(ks[5], (N_A, D_MODEL, 2 * GMLP_WIDTH), D_MODEL ** -0.5),
        'gmlp_ln_gain': 1.0 + nrm(ks[6], (N_A, GMLP_WIDTH), 0.01),
        'gmlp_ln_bias': nrm(ks[7], (N_A, GMLP_WIDTH), 0.01),
        'gmlp_w_spatial': nrm(ks[8], (N_A, GMLP_GROUPS, GMLP_CHUNK, GMLP_CHUNK), GMLP_CHUNK ** -0.5),
        'gmlp_b_spatial': 1.0 + nrm(ks[9], (N_A, GMLP_GROUPS, GMLP_CHUNK), 0.01),
        'gmlp_w_out': nrm(ks[10], (N_A, GMLP_WIDTH, D_MODEL), beta * GMLP_WIDTH ** -0.5),
        'hgrn_w_in': nrm(ks[11], (N_B, D_MODEL, 4 * HGRN_WIDTH), D_MODEL ** -0.5),
        'hgrn_lb_logits': nrm(ks[12], (DEPTH, HGRN_WIDTH), 0.1),
        'hgrn_norm_gain': 1.0 + nrm(ks[13], (N_B, HGRN_DV), 0.01),
        'hgrn_w_out': nrm(ks[14], (N_B, HGRN_HEADS * HGRN_DV, D_MODEL), beta * (HGRN_HEADS * HGRN_DV) ** -0.5),
        'attn_w_qkv': nrm(ks[15], (N_C, D_MODEL, ATTN_QKV_WIDTH), D_MODEL ** -0.5),
        'attn_b_qkv': nrm(ks[16], (N_C, ATTN_QKV_WIDTH), 0.01),
        'attn_sinks': nrm(ks[17], (N_C, ATTN_Q_HEADS), 1.0),
        'attn_w_o': nrm(ks[18], (N_C, ATTN_Q_HEADS * ATTN_HEAD_DIM, D_MODEL), beta * (ATTN_Q_HEADS * ATTN_HEAD_DIM) ** -0.5),
        'attn_b_o': nrm(ks[19], (N_C, D_MODEL), 0.01),
    }


def reference(x, ffn_w_gate_up, ffn_w_down, ln_gain, ln_bias,
              gmlp_w_in, gmlp_ln_gain, gmlp_ln_bias, gmlp_w_spatial, gmlp_b_spatial, gmlp_w_out,
              hgrn_w_in, hgrn_lb_logits, hgrn_norm_gain, hgrn_w_out,
              attn_w_qkv, attn_b_qkv, attn_sinks, attn_w_o, attn_b_o):
    lb_cum = jnp.cumsum(jax.nn.softmax(hgrn_lb_logits.astype(jnp.float32), axis=0), axis=0)
    lower_bounds = lb_cum - lb_cum[:1]
    alpha = DEEPNORM_ALPHA
    h = x
    for layer in range(DEPTH):
        kind = layer % N_MIXERS
        slot = layer // N_MIXERS
        h = layer_norm(alpha * h + 0.5 * swiglu(h, ffn_w_gate_up[layer, 0], ffn_w_down[layer, 0]),
                       ln_gain[layer, 0], ln_bias[layer, 0])
        if kind == 0:
            mix = chunked_gmlp(h, gmlp_w_in[slot], gmlp_ln_gain[slot], gmlp_ln_bias[slot],
                               gmlp_w_spatial[slot], gmlp_b_spatial[slot], gmlp_w_out[slot])
        elif kind == 1:
            mix = hgrn2(h, hgrn_w_in[slot], lower_bounds[layer], hgrn_norm_gain[slot], hgrn_w_out[slot])
        else:
            mix = sliding_window_attention(h, attn_w_qkv[slot], attn_b_qkv[slot], attn_sinks[slot],
                                           attn_w_o[slot], attn_b_o[slot])
        h = layer_norm(alpha * h + mix, ln_gain[layer, 1], ln_bias[layer, 1])
        h = layer_norm(alpha * h + 0.5 * swiglu(h, ffn_w_gate_up[layer, 1], ffn_w_down[layer, 1]),
                       ln_gain[layer, 2], ln_bias[layer, 2])
    return h
```

```cpp
#include <hip/hip_runtime.h>
#include <hip/hip_cooperative_groups.h>
#include <stdint.h>
#include <stdio.h>
namespace cg = cooperative_groups;

#ifndef COOP
#define COOP 0
#endif

typedef unsigned short bf16_t;
typedef __attribute__((ext_vector_type(8))) __bf16 bfrag;
typedef __attribute__((ext_vector_type(16))) float f32x16;

constexpr int T_TOK = 32768;
constexpr int NPANEL = 256;
constexpr float ALPHA = 1.6817928305074290f;
constexpr int LDS_BYTES = 102400;

constexpr size_t SZ_WGU = (size_t)8 * 5632 * 1024 * 2;
constexpr size_t SZ_WD = (size_t)8 * 1024 * 2816 * 2;
constexpr size_t SZ_WGI = (size_t)2 * 2048 * 1024 * 2;
constexpr size_t SZ_WGO = (size_t)2 * 1024 * 1024 * 2;
constexpr size_t SZ_WSP = (size_t)2 * 8 * 128 * 128 * 2;
constexpr size_t SZ_WHI = (size_t)4096 * 1024 * 2;
constexpr size_t SZ_WHO = (size_t)1024 * 1024 * 2;
constexpr size_t SZ_WQKV = (size_t)1536 * 1024 * 2;
constexpr size_t SZ_WAO = (size_t)1024 * 1024 * 2;
constexpr size_t SZ_LB = 4096;
constexpr size_t SZ_H = (size_t)T_TOK * 1024 * 4;
constexpr size_t SZ_HB = (size_t)T_TOK * 1024 * 2;
constexpr size_t SZ_ACT = (size_t)T_TOK * 2816 * 2;
constexpr size_t SZ_SG = (size_t)T_TOK * 1024 * 2;
constexpr size_t SZ_DS = (size_t)NPANEL * 8 * 128 * 128 * 2;
constexpr size_t SZ_DEC = (size_t)NPANEL * 8 * 128 * 4;
constexpr size_t SZ_KB = (size_t)T_TOK * 128 * 2;

constexpr size_t OFF_WGU = 0;
constexpr size_t OFF_WD = OFF_WGU + SZ_WGU;
constexpr size_t OFF_WGI = OFF_WD + SZ_WD;
constexpr size_t OFF_WGO = OFF_WGI + SZ_WGI;
constexpr size_t OFF_WSP = OFF_WGO + SZ_WGO;
constexpr size_t OFF_WHI = OFF_WSP + SZ_WSP;
constexpr size_t OFF_WHO = OFF_WHI + SZ_WHI;
constexpr size_t OFF_WQKV = OFF_WHO + SZ_WHO;
constexpr size_t OFF_WAO = OFF_WQKV + SZ_WQKV;
constexpr size_t OFF_LB = OFF_WAO + SZ_WAO;
constexpr size_t OFF_H = OFF_LB + SZ_LB;
constexpr size_t OFF_HB = OFF_H + SZ_H;
constexpr size_t OFF_ACT = OFF_HB + SZ_HB;
constexpr size_t OFF_SG = OFF_ACT + SZ_ACT;
constexpr size_t OFF_DS = OFF_SG + SZ_SG;
constexpr size_t OFF_DEC = OFF_DS + SZ_DS;
constexpr size_t OFF_KB = OFF_DEC + SZ_DEC;
constexpr size_t OFF_VB = OFF_KB + SZ_KB;
constexpr size_t OFF_BAR = OFF_VB + SZ_KB;
constexpr size_t WS_END = OFF_BAR + 256;

struct Params {
  const float* in[20];
  float* out;
  unsigned char* ws;
  int ph_lo, ph_hi;
};

struct Ctx {
  const float* const* in;
  float* out;
  unsigned char* ws;
  __device__ __forceinline__ bf16_t* WGU() const { return (bf16_t*)(ws + OFF_WGU); }
  __device__ __forceinline__ bf16_t* WD() const { return (bf16_t*)(ws + OFF_WD); }
  __device__ __forceinline__ bf16_t* WGI() const { return (bf16_t*)(ws + OFF_WGI); }
  __device__ __forceinline__ bf16_t* WGO() const { return (bf16_t*)(ws + OFF_WGO); }
  __device__ __forceinline__ bf16_t* WSP() const { return (bf16_t*)(ws + OFF_WSP); }
  __device__ __forceinline__ bf16_t* WHI() const { return (bf16_t*)(ws + OFF_WHI); }
  __device__ __forceinline__ bf16_t* WHO() const { return (bf16_t*)(ws + OFF_WHO); }
  __device__ __forceinline__ bf16_t* WQKV() const { return (bf16_t*)(ws + OFF_WQKV); }
  __device__ __forceinline__ bf16_t* WAO() const { return (bf16_t*)(ws + OFF_WAO); }
  __device__ __forceinline__ float* LB() const { return (float*)(ws + OFF_LB); }
  __device__ __forceinline__ float* H() const { return (float*)(ws + OFF_H); }
  __device__ __forceinline__ bf16_t* HB() const { return (bf16_t*)(ws + OFF_HB); }
  __device__ __forceinline__ bf16_t* ACT() const { return (bf16_t*)(ws + OFF_ACT); }
  __device__ __forceinline__ bf16_t* SG() const { return (bf16_t*)(ws + OFF_SG); }
  __device__ __forceinline__ bf16_t* DS() const { return (bf16_t*)(ws + OFF_DS); }
  __device__ __forceinline__ float* DEC() const { return (float*)(ws + OFF_DEC); }
  __device__ __forceinline__ bf16_t* KB() const { return (bf16_t*)(ws + OFF_KB); }
  __device__ __forceinline__ bf16_t* VB() const { return (bf16_t*)(ws + OFF_VB); }
};

__device__ __forceinline__ bf16_t f2bf(float f) {
  uint32_t u = __float_as_uint(f);
  u += 0x7fffu + ((u >> 16) & 1u);
  return (bf16_t)(u >> 16);
}
__device__ __forceinline__ float bf2f(bf16_t b) { return __uint_as_float(((uint32_t)b) << 16); }
__device__ __forceinline__ uint32_t pack2(float a, float b) { return (uint32_t)f2bf(a) | ((uint32_t)f2bf(b) << 16); }
__device__ __forceinline__ float wave_sum(float v) {
  v += __shfl_xor(v, 32, 64); v += __shfl_xor(v, 16, 64); v += __shfl_xor(v, 8, 64);
  v += __shfl_xor(v, 4, 64); v += __shfl_xor(v, 2, 64); v += __shfl_xor(v, 1, 64);
  return v;
}
__device__ __forceinline__ float silu_f(float x) { return x * __frcp_rn(1.f + __expf(-x)); }
#define ROWMAP(reg, lane) ((((reg)&3)) + 8 * ((reg) >> 2) + 4 * ((lane) >> 5))
#define MFMA(a, b, c) __builtin_amdgcn_mfma_f32_32x32x16_bf16((a), (b), (c), 0, 0, 0)

__device__ __forceinline__ int opaque_tid() {
  int t = threadIdx.x;
  asm volatile("" : "+v"(t));
  return t;
}

__device__ __forceinline__ unsigned long long opaque_u64(unsigned long long v) {
  unsigned lo = (unsigned)v, hi = (unsigned)(v >> 32);
  asm volatile("" : "+v"(lo), "+v"(hi));
  lo = __builtin_amdgcn_readfirstlane(lo);
  hi = __builtin_amdgcn_readfirstlane(hi);
  return ((unsigned long long)hi << 32) | lo;
}

__device__ __forceinline__ f32x16 zero16() {
  f32x16 z;
#pragma unroll
  for (int i = 0; i < 16; ++i) z[i] = 0.f;
  return z;
}

constexpr int G_ROW = 40;
constexpr int G_STAGE = 640 * G_ROW;

template <class Epi>
__device__ __forceinline__ void gemm_panel(const bf16_t* __restrict__ A, const int lda, const bf16_t* __restrict__ Wb,
                                           const int K, const int nN, const Epi epi, bf16_t* smem) {
  const int tid = opaque_tid(), lane = tid & 63;
  const int w = __builtin_amdgcn_readfirstlane(tid >> 6);
  const int wm = w & 1, wn = w >> 1;
  const int nk = K >> 5;
  const int total = nN * nk;
  const int l31 = lane & 31, h8 = (lane >> 5) * 8;
  const bf16_t* a_ptr = A + (size_t)(tid >> 2) * lda + (tid & 3) * 8;
  const int st_off = (tid >> 2) * G_ROW + (tid & 3) * 8;
  f32x16 acc[2][4];
#pragma unroll
  for (int i = 0; i < 2; ++i)
#pragma unroll
    for (int j = 0; j < 4; ++j) acc[i][j] = zero16();
  uint4 ra, rb0, rb1, rb2, rb3;
  {
    ra = *(const uint4*)(a_ptr);
    const uint4* bp = (const uint4*)Wb;
    rb0 = bp[tid]; rb1 = bp[tid + 512]; rb2 = bp[tid + 1024]; rb3 = bp[tid + 1536];
    __syncthreads();
    bf16_t* st = smem;
    *(uint4*)(st + st_off) = ra;
    *(uint4*)(st + 128 * G_ROW + st_off) = rb0;
    *(uint4*)(st + 256 * G_ROW + st_off) = rb1;
    *(uint4*)(st + 384 * G_ROW + st_off) = rb2;
    *(uint4*)(st + 512 * G_ROW + st_off) = rb3;
    __syncthreads();
  }
  int ks = 0, nt = 0;
  for (int it = 0; it < total; ++it) {
    const int cur = it & 1;
    const bool has_next = (it + 1 < total);
    int ks_n = ks + 1;
    if (ks_n == nk) ks_n = 0;
    if (has_next) {
      ra = *(const uint4*)(a_ptr + ks_n * 32);
      const uint4* bp = (const uint4*)(Wb + (size_t)(it + 1) * 16384);
      rb0 = bp[tid]; rb1 = bp[tid + 512]; rb2 = bp[tid + 1024]; rb3 = bp[tid + 1536];
    }
    const bf16_t* sa = smem + cur * G_STAGE;
#pragma unroll
    for (int kk = 0; kk < 2; ++kk) {
      const bfrag a0 = *(const bfrag*)(sa + (wm * 64 + l31) * G_ROW + kk * 16 + h8);
      const bfrag a1 = *(const bfrag*)(sa + (wm * 64 + 32 + l31) * G_ROW + kk * 16 + h8);
#pragma unroll
      for (int ni = 0; ni < 4; ++ni) {
        const bfrag b = *(const bfrag*)(sa + (128 + wn * 128 + ni * 32 + l31) * G_ROW + kk * 16 + h8);
        acc[0][ni] = MFMA(a0, b, acc[0][ni]);
        acc[1][ni] = MFMA(a1, b, acc[1][ni]);
      }
      if (kk == 0) __builtin_amdgcn_sched_barrier(0);
    }
    if (ks == nk - 1) {
      epi(acc, nt, wm, wn, lane);
#pragma unroll
      for (int i = 0; i < 2; ++i)
#pragma unroll
        for (int j = 0; j < 4; ++j) acc[i][j] = zero16();
      ++nt;
    }
    if (has_next) {
      bf16_t* st = smem + (cur ^ 1) * G_STAGE;
      *(uint4*)(st + st_off) = ra;
      *(uint4*)(st + 128 * G_ROW + st_off) = rb0;
      *(uint4*)(st + 256 * G_ROW + st_off) = rb1;
      *(uint4*)(st + 384 * G_ROW + st_off) = rb2;
      *(uint4*)(st + 512 * G_ROW + st_off) = rb3;
    }
    __syncthreads();
    ks = ks_n;
  }
}

struct EpiSwiglu {
  bf16_t* act;
  __device__ __forceinline__ void operator()(f32x16 (&acc)[2][4], int nt, int wm, int wn, int lane_in) const {
    int lane = lane_in;
    asm volatile("" : "+v"(lane));
    const int l31 = lane & 31;
#pragma unroll
    for (int mi = 0; mi < 2; ++mi)
#pragma unroll
      for (int n2 = 0; n2 < 2; ++n2)
#pragma unroll
        for (int r = 0; r < 16; ++r) {
          const int row = wm * 64 + mi * 32 + ROWMAP(r, lane);
          const int col = (nt * 4 + wn) * 64 + n2 * 32 + l31;
          const float g = acc[mi][n2][r], u = acc[mi][n2 + 2][r];
          act[(size_t)row * 2816 + col] = f2bf(silu_f(g) * u);
        }
  }
};
struct EpiResLN {
  float* Hp;
  float alpha, c;
  const float* bias;
  __device__ __forceinline__ void operator()(f32x16 (&acc)[2][4], int nt, int wm, int wn, int lane_in) const {
    int lane = lane_in;
    asm volatile("" : "+v"(lane));
    const int l31 = lane & 31;
#pragma unroll
    for (int ni = 0; ni < 4; ++ni) {
      const int col = nt * 512 + wn * 128 + ni * 32 + l31;
      const float bv = bias ? bias[col] : 0.f;
#pragma unroll
      for (int mi = 0; mi < 2; ++mi)
#pragma unroll
        for (int r = 0; r < 16; ++r) {
          const int row = wm * 64 + mi * 32 + ROWMAP(r, lane);
          float* ptr = Hp + (size_t)row * 1024 + col;
          *ptr = alpha * (*ptr) + c * (acc[mi][ni][r] + bv);
        }
      __builtin_amdgcn_sched_barrier(0);
    }
  }
};
struct EpiGelu {
  bf16_t* Z;
  __device__ __forceinline__ void operator()(f32x16 (&acc)[2][4], int nt, int wm, int wn, int lane_in) const {
    int lane = lane_in;
    asm volatile("" : "+v"(lane));
    const int l31 = lane & 31;
#pragma unroll
    for (int ni = 0; ni < 4; ++ni) {
      const int col = nt * 512 + wn * 128 + ni * 32 + l31;
#pragma unroll
      for (int mi = 0; mi < 2; ++mi)
#pragma unroll
        for (int r = 0; r < 16; ++r) {
          const int row = wm * 64 + mi * 32 + ROWMAP(r, lane);
          const float x = acc[mi][ni][r];
          Z[(size_t)row * 2048 + col] = f2bf(0.5f * x * (1.f + erff(x * 0.70710678118654752f)));
        }
    }
  }
};
struct EpiHgrn {
  bf16_t* Qp;
  bf16_t* Vp;
  float* LFp;
  bf16_t* SGp;
  const float* lb;
  __device__ __forceinline__ void operator()(f32x16 (&acc)[2][4], int nt, int wm, int wn, int lane_in) const {
    int lane = lane_in;
    asm volatile("" : "+v"(lane));
    const int l31 = lane & 31;
    const int sec = nt >> 1;
    const int cb = (nt & 1) * 512 + wn * 128 + l31;
    const int rb = wm * 64 + 4 * (lane >> 5);
    if (sec == 0 || sec == 3) {
      bf16_t* dst = (sec == 0) ? Qp : SGp;
#pragma unroll
      for (int ni = 0; ni < 4; ++ni)
#pragma unroll
        for (int mi = 0; mi < 2; ++mi)
#pragma unroll
          for (int r = 0; r < 16; ++r) {
            const int row = rb + mi * 32 + (r & 3) + 8 * (r >> 2);
            dst[(size_t)row * 1024 + cb + ni * 32] = f2bf(silu_f(acc[mi][ni][r]));
          }
    } else if (sec == 1) {
#pragma unroll
      for (int ni = 0; ni < 4; ++ni) {
        const float lbv = lb[cb + ni * 32];
#pragma unroll
        for (int mi = 0; mi < 2; ++mi)
#pragma unroll
          for (int r = 0; r < 16; ++r) {
            const int row = rb + mi * 32 + (r & 3) + 8 * (r >> 2);
            const float f = lbv + (1.f - lbv) * __frcp_rn(1.f + __expf(-acc[mi][ni][r]));
            LFp[(size_t)row * 1024 + cb + ni * 32] = __logf(f);
          }
      }
    } else {
#pragma unroll
      for (int ni = 0; ni < 4; ++ni)
#pragma unroll
        for (int mi = 0; mi < 2; ++mi)
#pragma unroll
          for (int r = 0; r < 16; ++r) {
            const int row = rb + mi * 32 + (r & 3) + 8 * (r >> 2);
            Vp[(size_t)row * 1024 + cb + ni * 32] = f2bf(acc[mi][ni][r]);
          }
    }
  }
};
struct EpiQkv {
  bf16_t* Qp;
  bf16_t* Kp;
  bf16_t* Vp;
  const float* bias;
  __device__ __forceinline__ void operator()(f32x16 (&acc)[2][4], int nt, int wm, int wn, int lane_in) const {
    int lane = lane_in;
    asm volatile("" : "+v"(lane));
    const int l31 = lane & 31;
#pragma unroll
    for (int ni = 0; ni < 4; ++ni) {
      const int col = nt * 512 + wn * 128 + ni * 32 + l31;
      if (col < 1280) {
        const float bv = bias[col];
#pragma unroll
        for (int mi = 0; mi < 2; ++mi)
#pragma unroll
          for (int r = 0; r < 16; ++r) {
            const int row = wm * 64 + mi * 32 + ROWMAP(r, lane);
            const float x = acc[mi][ni][r] + bv;
            if (col < 1024) Qp[(size_t)row * 1024 + col] = f2bf(x * 0.125f);
            else if (col < 1152) Kp[(size_t)row * 128 + (col - 1024)] = f2bf(x);
            else Vp[(size_t)row * 128 + (col - 1152)] = f2bf(x);
          }
      }
    }
  }
};

__device__ __forceinline__ void ln_panel(const float* Hp, float* outp, bf16_t* HBp, const float* g, const float* b) {
  const int tid = opaque_tid(), lane = tid & 63;
  const int w = __builtin_amdgcn_readfirstlane(tid >> 6);
  float4 gv[4], bv[4];
#pragma unroll
  for (int j = 0; j < 4; ++j) {
    gv[j] = *(const float4*)(g + j * 256 + lane * 4);
    bv[j] = *(const float4*)(b + j * 256 + lane * 4);
  }
  for (int r = w; r < 128; r += 8) {
    float4 x[4];
    float s = 0.f;
#pragma unroll
    for (int j = 0; j < 4; ++j) {
      x[j] = *(const float4*)(Hp + (size_t)r * 1024 + j * 256 + lane * 4);
      s += x[j].x + x[j].y + x[j].z + x[j].w;
    }
    s = wave_sum(s);
    const float mean = s * (1.f / 1024.f);
    float v = 0.f;
#pragma unroll
    for (int j = 0; j < 4; ++j) {
      x[j].x -= mean; x[j].y -= mean; x[j].z -= mean; x[j].w -= mean;
      v += x[j].x * x[j].x + x[j].y * x[j].y + x[j].z * x[j].z + x[j].w * x[j].w;
    }
    v = wave_sum(v);
    const float rstd = 1.0f / sqrtf(v * (1.f / 1024.f) + 1e-5f);
#pragma unroll
    for (int j = 0; j < 4; ++j) {
      float4 y;
      y.x = x[j].x * rstd * gv[j].x + bv[j].x;
      y.y = x[j].y * rstd * gv[j].y + bv[j].y;
      y.z = x[j].z * rstd * gv[j].z + bv[j].z;
      y.w = x[j].w * rstd * gv[j].w + bv[j].w;
      *(float4*)(outp + (size_t)r * 1024 + j * 256 + lane * 4) = y;
      uint2 pk;
      pk.x = pack2(y.x, y.y);
      pk.y = pack2(y.z, y.w);
      *(uint2*)(HBp + (size_t)r * 1024 + j * 256 + lane * 4) = pk;
    }
  }
  __syncthreads();
}

__device__ __forceinline__ void ffn_panel(const Ctx& C, int p, int layer, int j, bool final_out, bf16_t* smem) {
  const int wi = layer * 2 + j;
  bf16_t* HBp = C.HB() + (size_t)p * 128 * 1024;
  bf16_t* ACTp = C.ACT() + (size_t)p * 128 * 2816;
  float* Hp = C.H() + (size_t)p * 128 * 1024;
  EpiSwiglu e1{ACTp};
  gemm_panel(HBp, 1024, C.WGU() + (size_t)wi * 5632 * 1024, 1024, 11, e1, smem);
  EpiResLN e2{Hp, ALPHA, 0.5f, nullptr};
  gemm_panel(ACTp, 2816, C.WD() + (size_t)wi * 1024 * 2816, 2816, 2, e2, smem);
  const int li = (layer * 3 + (j == 0 ? 0 : 2)) * 1024;
  float* outp = final_out ? (C.out + (size_t)p * 128 * 1024) : Hp;
  ln_panel(Hp, outp, HBp, C.in[3] + li, C.in[4] + li);
}

__device__ __forceinline__ void gmlp_panel(const Ctx& C, int p, int layer, int slot, bf16_t* smem) {
  const int tid = opaque_tid(), lane = tid & 63;
  const int w = __builtin_amdgcn_readfirstlane(tid >> 6);
  const int l31 = lane & 31, h8 = (lane >> 5) * 8;
  bf16_t* HBp = C.HB() + (size_t)p * 128 * 1024;
  bf16_t* Zp = C.ACT() + (size_t)p * 128 * 2816;
  float* Hp = C.H() + (size_t)p * 128 * 1024;
  {
    EpiGelu e{Zp};
    gemm_panel(HBp, 1024, C.WGI() + (size_t)slot * 2048 * 1024, 1024, 4, e, smem);
  }
  bf16_t* As = smem;
  bf16_t* Bs = smem + 128 * 136;
  float* st = (float*)(smem + 2 * 128 * 136);
  for (int r = w; r < 128; r += 8) {
    const uint4 q0 = *(const uint4*)(Zp + (size_t)r * 2048 + 1024 + lane * 16);
    const uint4 q1 = *(const uint4*)(Zp + (size_t)r * 2048 + 1024 + lane * 16 + 8);
    const uint32_t u[8] = {q0.x, q0.y, q0.z, q0.w, q1.x, q1.y, q1.z, q1.w};
    float x[16];
    float s = 0.f;
#pragma unroll
    for (int e = 0; e < 8; ++e) {
      x[2 * e] = __uint_as_float(u[e] << 16);
      x[2 * e + 1] = __uint_as_float(u[e] & 0xffff0000u);
      s += x[2 * e] + x[2 * e + 1];
    }
    s = wave_sum(s);
    const float mean = s * (1.f / 1024.f);
    float v = 0.f;
#pragma unroll
    for (int e = 0; e < 16; ++e) { const float d = x[e] - mean; v += d * d; }
    v = wave_sum(v);
    if (lane == 0) { st[r * 2] = mean; st[r * 2 + 1] = 1.0f / sqrtf(v * (1.f / 1024.f) + 1e-5f); }
  }
  __syncthreads();
  const float* lng = C.in[6] + slot * 1024;
  const float* lnb = C.in[7] + slot * 1024;
  const float* bsp = C.in[9] + slot * 1024;
  const bf16_t* Wsp = C.WSP() + (size_t)slot * 8 * 16384;
  const int nd = w & 3, mt0 = (w >> 2) * 2;
  for (int g = 0; g < 8; ++g) {
#pragma unroll
    for (int i = 0; i < 4; ++i) {
      const int c = tid + 512 * i;
      *(uint4*)(As + (c >> 4) * 136 + (c & 15) * 8) = *(const uint4*)(Wsp + (size_t)g * 16384 + c * 8);
    }
    {
      const int s = tid >> 2, dq = tid & 3;
      const float mean = st[s * 2], rstd = st[s * 2 + 1];
      const bf16_t* src = Zp + (size_t)s * 2048 + 1024 + g * 128 + dq * 32;
#pragma unroll
      for (int q = 0; q < 4; ++q) {
        const uint4 v4 = *(const uint4*)(src + q * 8);
        const uint32_t u[4] = {v4.x, v4.y, v4.z, v4.w};
#pragma unroll
        for (int e = 0; e < 4; ++e) {
          const int d0 = dq * 32 + q * 8 + e * 2;
          const int ch = g * 128 + d0;
          const float x0 = __uint_as_float(u[e] << 16), x1 = __uint_as_float(u[e] & 0xffff0000u);
          Bs[d0 * 136 + s] = f2bf((x0 - mean) * rstd * lng[ch] + lnb[ch]);
          Bs[(d0 + 1) * 136 + s] = f2bf((x1 - mean) * rstd * lng[ch + 1] + lnb[ch + 1]);
        }
      }
    }
    __syncthreads();
    f32x16 acc[2];
    acc[0] = zero16(); acc[1] = zero16();
#pragma unroll
    for (int k16 = 0; k16 < 8; ++k16) {
      const bfrag b = *(const bfrag*)(Bs + (nd * 32 + l31) * 136 + k16 * 16 + h8);
#pragma unroll
      for (int mi = 0; mi < 2; ++mi) {
        const bfrag a = *(const bfrag*)(As + ((mt0 + mi) * 32 + l31) * 136 + k16 * 16 + h8);
        acc[mi] = MFMA(a, b, acc[mi]);
      }
    }
#pragma unroll
    for (int mi = 0; mi < 2; ++mi)
#pragma unroll
      for (int r = 0; r < 16; ++r) {
        const int t = (mt0 + mi) * 32 + ROWMAP(r, lane);
        const int ch = g * 128 + nd * 32 + l31;
        const float mixed = acc[mi][r] + bsp[g * 128 + t];
        const float u = bf2f(Zp[(size_t)t * 2048 + ch]);
        HBp[(size_t)t * 1024 + ch] = f2bf(u * mixed);
      }
    __syncthreads();
  }
  {
    EpiResLN e2{Hp, ALPHA, 1.0f, nullptr};
    gemm_panel(HBp, 1024, C.WGO() + (size_t)slot * 1024 * 1024, 1024, 2, e2, smem);
  }
  const int li = (layer * 3 + 1) * 1024;
  ln_panel(Hp, Hp, HBp, C.in[3] + li, C.in[4] + li);
}

template <bool OUT>
__device__ __forceinline__ void hgrn_rec(const Ctx& C, int p, bf16_t* smem) {
  const int tid = opaque_tid(), lane = tid & 63;
  const int w = __builtin_amdgcn_readfirstlane(tid >> 6);
  const int l31 = lane & 31, h8 = (lane >> 5) * 8;
  bf16_t* ST = smem;
  bf16_t* Qh = smem + 17408;
  bf16_t* Kh = smem + 21760;
  bf16_t* KhT = smem + 26112;
  bf16_t* vT = smem + 31232;
  bf16_t* Ps = smem + 36352;
  float* seg = (float*)(smem + 37632);
  float* dec = seg + 512;
  float* oF = dec + 128;
  const size_t row0 = (size_t)p * 128;
  const bf16_t* Qp = C.ACT() + (size_t)p * 128 * 2816;
  const bf16_t* Vp = Qp + 128 * 1024;
  const float* LFp = C.out + row0 * 1024;
  const bf16_t* SGp = C.SG() + row0 * 1024;
  bf16_t* HBp = C.HB() + row0 * 1024;
  const float* ng = C.in[13];
  const int jt = w >> 1, kt0 = (w & 1) * 2;
  const int kq = tid & 127, tq = tid >> 7;
  for (int h = 0; h < 8; ++h) {
    f32x16 accS[2];
    bf16_t* SBh = C.DS() + ((size_t)(p * 8 + h)) * 16384;
    if (OUT) {
      __syncthreads();
#pragma unroll
      for (int i = 0; i < 4; ++i) {
        const int c = tid + 512 * i;
        *(uint4*)(ST + (c >> 4) * 136 + (c & 15) * 8) = *(const uint4*)(SBh + c * 8);
      }
      __syncthreads();
#pragma unroll
      for (int c2 = 0; c2 < 2; ++c2)
#pragma unroll
        for (int r = 0; r < 16; ++r)
          accS[c2][r] = bf2f(ST[(jt * 32 + ROWMAP(r, lane)) * 136 + (kt0 + c2) * 32 + l31]);
    } else {
      accS[0] = zero16(); accS[1] = zero16();
    }
    float dsum = 0.f;
    for (int i = 0; i < 4; ++i) {
      float l[8], cs[8];
      const size_t gbase = (size_t)(i * 32 + tq * 8) * 1024 + h * 128 + kq;
#pragma unroll
      for (int e = 0; e < 8; ++e) l[e] = LFp[gbase + (size_t)e * 1024];
      cs[0] = l[0];
#pragma unroll
      for (int e = 1; e < 8; ++e) cs[e] = cs[e - 1] + l[e];
      seg[tq * 128 + kq] = cs[7];
#pragma unroll
      for (int e = 0; e < 8; ++e) vT[kq * 40 + tq * 8 + e] = Vp[gbase + (size_t)e * 1024];
      __syncthreads();
      float off = 0.f, tot = 0.f;
#pragma unroll
      for (int q = 0; q < 4; ++q) {
        const float s = seg[q * 128 + kq];
        if (q < tq) off += s;
        tot += s;
      }
#pragma unroll
      for (int e = 0; e < 8; ++e) {
        const float gc = cs[e] + off;
        const float f = __expf(l[e]);
        const float kh = (1.f - f) * __expf(-gc);
        const bf16_t khb = f2bf(kh);
        const int t = tq * 8 + e;
        KhT[kq * 40 + t] = khb;
        if (OUT) {
          Kh[t * 136 + kq] = khb;
          const float qv = bf2f(Qp[gbase + (size_t)e * 1024]);
          Qh[t * 136 + kq] = f2bf(qv * __expf(gc));
        }
      }
      if (tq == 0) { dec[kq] = __expf(tot); dsum += tot; }
      __syncthreads();
      f32x16 accO = zero16();
      if (OUT) {
        if (w == 0) {
          f32x16 accP = zero16();
#pragma unroll
          for (int k16 = 0; k16 < 8; ++k16) {
            const bfrag a = *(const bfrag*)(Qh + l31 * 136 + k16 * 16 + h8);
            const bfrag b = *(const bfrag*)(Kh + l31 * 136 + k16 * 16 + h8);
            accP = MFMA(a, b, accP);
          }
#pragma unroll
          for (int r = 0; r < 16; ++r) {
            const int t = ROWMAP(r, lane);
            Ps[t * 40 + l31] = (l31 <= t) ? f2bf(accP[r]) : (bf16_t)0;
          }
        } else if (w <= 4) {
          const int nt = w - 1;
#pragma unroll
          for (int k16 = 0; k16 < 8; ++k16) {
            const bfrag a = *(const bfrag*)(Qh + l31 * 136 + k16 * 16 + h8);
            const bfrag b = *(const bfrag*)(ST + (nt * 32 + l31) * 136 + k16 * 16 + h8);
            accO = MFMA(a, b, accO);
          }
        }
        __syncthreads();
        if (w >= 1 && w <= 4) {
          const int nt = w - 1;
#pragma unroll
          for (int k16 = 0; k16 < 2; ++k16) {
            const bfrag a = *(const bfrag*)(Ps + l31 * 40 + k16 * 16 + h8);
            const bfrag b = *(const bfrag*)(vT + (nt * 32 + l31) * 40 + k16 * 16 + h8);
            accO = MFMA(a, b, accO);
          }
#pragma unroll
          for (int r = 0; r < 16; ++r) oF[ROWMAP(r, lane) * 132 + nt * 32 + l31] = accO[r];
        }
      }
#pragma unroll
      for (int c2 = 0; c2 < 2; ++c2) {
#pragma unroll
        for (int k16 = 0; k16 < 2; ++k16) {
          const bfrag a = *(const bfrag*)(vT + (jt * 32 + l31) * 40 + k16 * 16 + h8);
          const bfrag b = *(const bfrag*)(KhT + ((kt0 + c2) * 32 + l31) * 40 + k16 * 16 + h8);
          accS[c2] = MFMA(a, b, accS[c2]);
        }
        const float dk = dec[(kt0 + c2) * 32 + l31];
#pragma unroll
        for (int r = 0; r < 16; ++r) accS[c2][r] *= dk;
        if (OUT) {
#pragma unroll
          for (int r = 0; r < 16; ++r)
            ST[(jt * 32 + ROWMAP(r, lane)) * 136 + (kt0 + c2) * 32 + l31] = f2bf(accS[c2][r]);
        }
      }
      __syncthreads();
      if (OUT) {
        const int t = tid >> 4, part = tid & 15;
        float x[8];
        float ss = 0.f;
#pragma unroll
        for (int e = 0; e < 8; ++e) { x[e] = oF[t * 132 + part * 8 + e]; ss += x[e] * x[e]; }
        ss += __shfl_xor(ss, 1, 64); ss += __shfl_xor(ss, 2, 64); ss += __shfl_xor(ss, 4, 64); ss += __shfl_xor(ss, 8, 64);
        const float rr = 1.0f / sqrtf(ss * (1.f / 128.f) + 1e-6f);
        const size_t gro = (size_t)(i * 32 + t) * 1024 + h * 128 + part * 8;
        const uint4 sg4 = *(const uint4*)(SGp + gro);
        const uint32_t su[4] = {sg4.x, sg4.y, sg4.z, sg4.w};
        uint32_t ov[4];
#pragma unroll
        for (int e = 0; e < 4; ++e) {
          const float g0 = ng[part * 8 + 2 * e], g1 = ng[part * 8 + 2 * e + 1];
          const float s0 = __uint_as_float(su[e] << 16), s1 = __uint_as_float(su[e] & 0xffff0000u);
          ov[e] = pack2(x[2 * e] * rr * g0 * s0, x[2 * e + 1] * rr * g1 * s1);
        }
        uint4 o4; o4.x = ov[0]; o4.y = ov[1]; o4.z = ov[2]; o4.w = ov[3];
        *(uint4*)(HBp + gro) = o4;
      }
    }
    if (!OUT) {
#pragma unroll
      for (int c2 = 0; c2 < 2; ++c2)
#pragma unroll
        for (int r = 0; r < 16; ++r)
          SBh[(jt * 32 + ROWMAP(r, lane)) * 128 + (kt0 + c2) * 32 + l31] = f2bf(accS[c2][r]);
      if (tq == 0) C.DEC()[(size_t)(p * 8 + h) * 128 + kq] = __expf(dsum);
    }
  }
  __syncthreads();
}

__device__ __forceinline__ void hgrn_scan(const Ctx& C) {
  for (int gid = blockIdx.x * 512 + threadIdx.x; gid < 131072; gid += gridDim.x * 512) {
    const int kp = gid & 63, j = (gid >> 6) & 127, h = (gid >> 13) & 7, b = gid >> 16;
    float s0 = 0.f, s1 = 0.f;
    for (int c0 = 0; c0 < 128; c0 += 8) {
      uint32_t d[8];
      float2 dc[8];
#pragma unroll
      for (int e = 0; e < 8; ++e) {
        const size_t ph = (size_t)((b * 128 + c0 + e) * 8 + h);
        d[e] = *(const uint32_t*)(C.DS() + ph * 16384 + j * 128 + kp * 2);
        dc[e] = *(const float2*)(C.DEC() + ph * 128 + kp * 2);
      }
#pragma unroll
      for (int e = 0; e < 8; ++e) {
        const size_t ph = (size_t)((b * 128 + c0 + e) * 8 + h);
        *(uint32_t*)(C.DS() + ph * 16384 + j * 128 + kp * 2) = pack2(s0, s1);
        s0 = dc[e].x * s0 + __uint_as_float(d[e] << 16);
        s1 = dc[e].y * s1 + __uint_as_float(d[e] & 0xffff0000u);
      }
    }
  }
}

__device__ __forceinline__ void attn_panel(const Ctx& C, int p, bf16_t* smem) {
  const int tid = opaque_tid(), lane = tid & 63;
  const int w = __builtin_amdgcn_readfirstlane(tid >> 6);
  const int l31 = lane & 31, h8 = (lane >> 5) * 8;
  bf16_t* K2 = smem;
  bf16_t* VT = smem + 18432;
  bf16_t* Pw = smem + 35328 + w * 1280;
  const int blk = p & 127;
  const size_t row0 = (size_t)p * 128;
  const bf16_t* Qp = C.ACT() + (size_t)p * 128 * 2816;
  bf16_t* HBp = C.HB() + row0 * 1024;
  const int qt = w & 3;
  for (int hk = 0; hk < 2; ++hk) {
    __syncthreads();
#pragma unroll
    for (int i = 0; i < 4; ++i) {
      const int c = tid + 512 * i;
      const int r = c >> 3, ch = c & 7;
      uint4 kv = make_uint4(0, 0, 0, 0), vv = make_uint4(0, 0, 0, 0);
      if (blk > 0 || r >= 128) {
        const size_t tok = row0 + r - 128;
        kv = *(const uint4*)(C.KB() + tok * 128 + hk * 64 + ch * 8);
        vv = *(const uint4*)(C.VB() + tok * 128 + hk * 64 + ch * 8);
      }
      *(uint4*)(K2 + r * 72 + ch * 8) = kv;
      const uint32_t vu[4] = {vv.x, vv.y, vv.z, vv.w};
#pragma unroll
      for (int e = 0; e < 4; ++e) {
        VT[(ch * 8 + 2 * e) * 264 + r] = (bf16_t)(vu[e] & 0xffffu);
        VT[(ch * 8 + 2 * e + 1) * 264 + r] = (bf16_t)(vu[e] >> 16);
      }
    }
    __syncthreads();
    for (int u = 0; u < 4; ++u) {
      const int hq = hk * 8 + (w >> 2) * 4 + u;
      const float sink = C.in[17][hq];
      bfrag aq[4];
#pragma unroll
      for (int k16 = 0; k16 < 4; ++k16)
        aq[k16] = *(const bfrag*)(Qp + (size_t)(qt * 32 + l31) * 1024 + hq * 64 + k16 * 16 + h8);
      f32x16 s[5];
#pragma unroll
      for (int c = 0; c < 5; ++c) {
        s[c] = zero16();
#pragma unroll
        for (int k16 = 0; k16 < 4; ++k16) {
          const bfrag b = *(const bfrag*)(K2 + ((qt + c) * 32 + l31) * 72 + k16 * 16 + h8);
          s[c] = MFMA(aq[k16], b, s[c]);
        }
      }
      float linv[16];
#pragma unroll
      for (int r = 0; r < 16; ++r) {
        const int qi = qt * 32 + ROWMAP(r, lane);
        float m = -1e30f;
#pragma unroll
        for (int c = 0; c < 5; ++c) {
          const int kp = (qt + c) * 32 + l31;
          const bool valid = (kp > qi) && (kp <= qi + 128) && (blk > 0 || kp >= 128);
          const float v = valid ? s[c][r] : -1e30f;
          s[c][r] = v;
          m = fmaxf(m, v);
        }
        m = fmaxf(m, __shfl_xor(m, 16, 64)); m = fmaxf(m, __shfl_xor(m, 8, 64)); m = fmaxf(m, __shfl_xor(m, 4, 64));
        m = fmaxf(m, __shfl_xor(m, 2, 64)); m = fmaxf(m, __shfl_xor(m, 1, 64));
        m = fmaxf(m, sink);
        float sum = 0.f;
#pragma unroll
        for (int c = 0; c < 5; ++c) {
          const float pv = (s[c][r] > -1e29f) ? __expf(s[c][r] - m) : 0.f;
          s[c][r] = pv;
          sum += pv;
        }
        sum += __shfl_xor(sum, 16, 64); sum += __shfl_xor(sum, 8, 64); sum += __shfl_xor(sum, 4, 64);
        sum += __shfl_xor(sum, 2, 64); sum += __shfl_xor(sum, 1, 64);
        sum += __expf(sink - m);
        linv[r] = 1.f / sum;
      }
      f32x16 o[2];
      o[0] = zero16(); o[1] = zero16();
#pragma unroll
      for (int c = 0; c < 5; ++c) {
#pragma unroll
        for (int r = 0; r < 16; ++r) Pw[ROWMAP(r, lane) * 40 + l31] = f2bf(s[c][r]);
        __syncthreads();
#pragma unroll
        for (int k16 = 0; k16 < 2; ++k16) {
          const bfrag a = *(const bfrag*)(Pw + l31 * 40 + k16 * 16 + h8);
#pragma unroll
          for (int dt = 0; dt < 2; ++dt) {
            const bfrag b = *(const bfrag*)(VT + (dt * 32 + l31) * 264 + (qt + c) * 32 + k16 * 16 + h8);
            o[dt] = MFMA(a, b, o[dt]);
          }
        }
        __syncthreads();
      }
#pragma unroll
      for (int dt = 0; dt < 2; ++dt)
#pragma unroll
        for (int r = 0; r < 16; ++r)
          HBp[(size_t)(qt * 32 + ROWMAP(r, lane)) * 1024 + hq * 64 + dt * 32 + l31] = f2bf(o[dt][r] * linv[r]);
    }
  }
  __syncthreads();
}

__device__ __forceinline__ void conv_weights(const float* __restrict__ src, bf16_t* __restrict__ dst, int nmat, int K,
                                             int Nsrc, int Ndst, int mode) {
  const int nk = K >> 5, nNt = Ndst >> 9;
  const int upm = nk * nNt;
  const int tid = threadIdx.x;
  for (int u = blockIdx.x; u < nmat * upm; u += gridDim.x) {
    const int m = u / upm, r = u - m * upm;
    const int nt = r / nk, ks = r - nt * nk;
    const int np = nt * 512 + tid;
    int sc;
    if (mode == 1) {
      const int b = np >> 7, rr = np & 127;
      sc = (rr < 64) ? (b * 64 + rr) : (2816 + b * 64 + rr - 64);
    } else {
      sc = (np < Nsrc) ? np : -1;
    }
    const float* s = src + (size_t)m * K * Nsrc + (size_t)(ks * 32) * Nsrc + (sc < 0 ? 0 : sc);
    uint32_t pk[16];
#pragma unroll
    for (int kk = 0; kk < 16; ++kk) {
      float v0 = s[(size_t)(2 * kk) * Nsrc], v1 = s[(size_t)(2 * kk + 1) * Nsrc];
      if (sc < 0) { v0 = 0.f; v1 = 0.f; }
      pk[kk] = pack2(v0, v1);
    }
    uint4* d = (uint4*)(dst + (size_t)m * K * Ndst + (size_t)(nt * nk + ks) * 16384 + tid * 32);
    d[0] = make_uint4(pk[0], pk[1], pk[2], pk[3]);
    d[1] = make_uint4(pk[4], pk[5], pk[6], pk[7]);
    d[2] = make_uint4(pk[8], pk[9], pk[10], pk[11]);
    d[3] = make_uint4(pk[12], pk[13], pk[14], pk[15]);
  }
}

__device__ __forceinline__ void phase0(const Ctx& C) {
  conv_weights(C.in[1], C.WGU(), 8, 1024, 5632, 5632, 1);
  conv_weights(C.in[2], C.WD(), 8, 2816, 1024, 1024, 0);
  conv_weights(C.in[5], C.WGI(), 2, 1024, 2048, 2048, 0);
  conv_weights(C.in[10], C.WGO(), 2, 1024, 1024, 1024, 0);
  conv_weights(C.in[11], C.WHI(), 1, 1024, 4096, 4096, 0);
  conv_weights(C.in[14], C.WHO(), 1, 1024, 1024, 1024, 0);
  conv_weights(C.in[15], C.WQKV(), 1, 1024, 1280, 1536, 0);
  conv_weights(C.in[18], C.WAO(), 1, 1024, 1024, 1024, 0);
  const size_t gtid = (size_t)blockIdx.x * 512 + threadIdx.x;
  const size_t gsz = (size_t)gridDim.x * 512;
  for (size_t i = gtid; i < (size_t)T_TOK * 1024 / 4; i += gsz) {
    const float4 v = ((const float4*)C.in[0])[i];
    ((float4*)C.H())[i] = v;
    uint2 pk;
    pk.x = pack2(v.x, v.y);
    pk.y = pack2(v.z, v.w);
    ((uint2*)C.HB())[i] = pk;
  }
  for (size_t i = gtid; i < (size_t)2 * 8 * 128 * 128; i += gsz) {
    const int s = (int)(i & 127), t = (int)((i >> 7) & 127);
    C.WSP()[i] = (s <= t) ? f2bf(C.in[8][i]) : (bf16_t)0;
  }
  for (size_t i = gtid; i < 1024; i += gsz) {
    const float* lp = C.in[12];
    const float a0 = lp[i], a1 = lp[1024 + i], a2 = lp[2048 + i], a3 = lp[3072 + i];
    const float m = fmaxf(fmaxf(a0, a1), fmaxf(a2, a3));
    const float e0 = expf(a0 - m), e1 = expf(a1 - m), e2 = expf(a2 - m), e3 = expf(a3 - m);
    C.LB()[i] = e1 / (e0 + e1 + e2 + e3);
  }
}

enum { OP_FFN = 0, OP_GMLP = 1, OP_HIN = 2, OP_HOUT = 3, OP_QKV = 4, OP_ATTN = 5 };

__device__ __forceinline__ void run_ops(const Ctx& C0, int op_lo, int op_hi, bf16_t* smem) {
  for (int p0 = blockIdx.x; p0 < NPANEL; p0 += gridDim.x) {
    for (int op = op_lo; op < op_hi; ++op) {
      const Ctx& C = C0;
      const int p = p0;
      bf16_t* HBp = C.HB() + (size_t)p * 128 * 1024;
      float* Hp = C.H() + (size_t)p * 128 * 1024;
      bf16_t* ACTp = C.ACT() + (size_t)p * 128 * 2816;
      int kind = OP_FFN, layer = 0, j = 0;
      switch (op) {
        case 0: kind = OP_FFN; layer = 0; j = 0; break;
        case 1: kind = OP_GMLP; layer = 0; j = 0; break;
        case 2: kind = OP_FFN; layer = 0; j = 1; break;
        case 3: kind = OP_FFN; layer = 1; j = 0; break;
        case 4: kind = OP_HIN; layer = 1; break;
        case 5: kind = OP_HOUT; layer = 1; break;
        case 6: kind = OP_FFN; layer = 1; j = 1; break;
        case 7: kind = OP_FFN; layer = 2; j = 0; break;
        case 8: kind = OP_QKV; layer = 2; break;
        case 9: kind = OP_ATTN; layer = 2; break;
        case 10: kind = OP_FFN; layer = 2; j = 1; break;
        case 11: kind = OP_FFN; layer = 3; j = 0; break;
        case 12: kind = OP_GMLP; layer = 3; j = 1; break;
        default: kind = OP_FFN; layer = 3; j = 1; break;
      }
      if (kind == OP_FFN) {
        ffn_panel(C, p, layer, j, op == 13, smem);
      } else if (kind == OP_GMLP) {
        gmlp_panel(C, p, layer, j, smem);
      } else if (kind == OP_HIN) {
        EpiHgrn e{ACTp, ACTp + 128 * 1024, C.out + (size_t)p * 128 * 1024, C.SG() + (size_t)p * 128 * 1024, C.LB()};
        gemm_panel(HBp, 1024, C.WHI(), 1024, 8, e, smem);
        hgrn_rec<false>(C, p, smem);
      } else if (kind == OP_HOUT) {
        hgrn_rec<true>(C, p, smem);
        EpiResLN e2{Hp, ALPHA, 1.0f, nullptr};
        gemm_panel(HBp, 1024, C.WHO(), 1024, 2, e2, smem);
        const int li = (1 * 3 + 1) * 1024;
        ln_panel(Hp, Hp, HBp, C.in[3] + li, C.in[4] + li);
      } else if (kind == OP_QKV) {
        EpiQkv e{ACTp, C.KB() + (size_t)p * 128 * 128, C.VB() + (size_t)p * 128 * 128, C.in[16]};
        gemm_panel(HBp, 1024, C.WQKV(), 1024, 3, e, smem);
      } else {
        attn_panel(C, p, smem);
        EpiResLN e2{Hp, ALPHA, 1.0f, C.in[19]};
        gemm_panel(HBp, 1024, C.WAO(), 1024, 2, e2, smem);
        const int li = (2 * 3 + 1) * 1024;
        ln_panel(Hp, Hp, HBp, C.in[3] + li, C.in[4] + li);
      }
    }
  }
}

#if COOP
__device__ __forceinline__ void grid_barrier(unsigned* bar, unsigned target) {
  __syncthreads();
  if (threadIdx.x == 0) {
    __threadfence();
    __hip_atomic_fetch_add(bar, 1u, __ATOMIC_RELEASE, __HIP_MEMORY_SCOPE_AGENT);
    while (__hip_atomic_load(bar, __ATOMIC_ACQUIRE, __HIP_MEMORY_SCOPE_AGENT) < target) __builtin_amdgcn_s_sleep(8);
    __threadfence();
  }
  __syncthreads();
}

__global__ void __launch_bounds__(512) mega(Params P) {
  extern __shared__ __attribute__((aligned(16))) unsigned char lds_raw[];
  bf16_t* smem = (bf16_t*)lds_raw;
  Ctx C;
  C.in = P.in;
  C.out = P.out;
  C.ws = P.ws;
  const int lo = P.ph_lo, hi = P.ph_hi;
#if COOP
  if (lo < 0) cg::this_grid().sync();
  unsigned* bar = (unsigned*)(P.ws + OFF_BAR);
#define GSYNC(k) do { if (lo <= (k) && (k) + 1 < hi) grid_barrier(bar, (unsigned)((k) + 1) * gridDim.x); } while (0)
#else
#define GSYNC(k) do { } while (0)
#endif
  if (lo <= 0 && 0 < hi) phase0(C);
  GSYNC(0);
  if (lo <= 1 && 1 < hi) run_ops(C, 0, 5, smem);
  GSYNC(1);
  if (lo <= 2 && 2 < hi) hgrn_scan(C);
  GSYNC(2);
  if (lo <= 3 && 3 < hi) run_ops(C, 5, 9, smem);
  GSYNC(3);
  if (lo <= 4 && 4 < hi) run_ops(C, 9, 14, smem);
}

#endif

#if !COOP
__device__ __forceinline__ Ctx make_ctx(const Params& P) { Ctx C; C.in = P.in; C.out = P.out; C.ws = P.ws; return C; }
#define OPK(name, ...) __global__ void __launch_bounds__(512) name(Params P) { \
    extern __shared__ __attribute__((aligned(16))) unsigned char lds_raw[]; bf16_t* smem = (bf16_t*)lds_raw; \
    Ctx C = make_ctx(P); const int p = blockIdx.x; const int layer = P.ph_lo, j = P.ph_hi; (void)p; (void)layer; (void)j; (void)smem; __VA_ARGS__; }
OPK(k_p0, phase0(C))
OPK(k_ffn, ffn_panel(C, p, layer, j & 1, (j >> 1) != 0, smem))
OPK(k_gmlp, gmlp_panel(C, p, layer, j, smem))
OPK(k_hin, { bf16_t* ACTp = C.ACT() + (size_t)p * 128 * 2816; EpiHgrn e{ACTp, ACTp + 128 * 1024, C.out + (size_t)p * 128 * 1024, C.SG() + (size_t)p * 128 * 1024, C.LB()}; gemm_panel(C.HB() + (size_t)p * 128 * 1024, 1024, C.WHI(), 1024, 8, e, smem); hgrn_rec<false>(C, p, smem); })
OPK(k_scan, hgrn_scan(C))
OPK(k_hout, { hgrn_rec<true>(C, p, smem); float* Hp = C.H() + (size_t)p * 128 * 1024; bf16_t* HBp = C.HB() + (size_t)p * 128 * 1024; EpiResLN e2{Hp, ALPHA, 1.0f, nullptr}; gemm_panel(HBp, 1024, C.WHO(), 1024, 2, e2, smem); ln_panel(Hp, Hp, HBp, C.in[3] + 4 * 1024, C.in[4] + 4 * 1024); })
OPK(k_qkv, { bf16_t* ACTp = C.ACT() + (size_t)p * 128 * 2816; EpiQkv e{ACTp, C.KB() + (size_t)p * 128 * 128, C.VB() + (size_t)p * 128 * 128, C.in[16]}; gemm_panel(C.HB() + (size_t)p * 128 * 1024, 1024, C.WQKV(), 1024, 3, e, smem); })
OPK(k_attn, { attn_panel(C, p, smem); float* Hp = C.H() + (size_t)p * 128 * 1024; bf16_t* HBp = C.HB() + (size_t)p * 128 * 1024; EpiResLN e2{Hp, ALPHA, 1.0f, C.in[19]}; gemm_panel(HBp, 1024, C.WAO(), 1024, 2, e2, smem); ln_panel(Hp, Hp, HBp, C.in[3] + 7 * 1024, C.in[4] + 7 * 1024); })
#endif

extern "C" void kernel_launch(void* const* d_in, const int* in_sizes, int n_in, void* d_out, int out_size, void* d_ws,
                              size_t ws_size, hipStream_t stream) {
  static int grid_blocks = 0;
  if (grid_blocks == 0) {
    if (n_in != 20 || ws_size < WS_END) {
      fprintf(stderr, "kernel_launch: unexpected n_in %d or ws_size %zu (need %zu)\n", n_in, ws_size, (size_t)WS_END);
      grid_blocks = -1;
      return;
    }
    int dev = 0, cus = 0, per_cu = 0;
    hipGetDevice(&dev);
    hipDeviceGetAttribute(&cus, hipDeviceAttributeMultiprocessorCount, dev);
#if COOP
    if (hipFuncSetAttribute((const void*)mega, hipFuncAttributeMaxDynamicSharedMemorySize, LDS_BYTES) != hipSuccess)
      fprintf(stderr, "kernel_launch: hipFuncSetAttribute failed\n");
    hipOccupancyMaxActiveBlocksPerMultiprocessor(&per_cu, (const void*)mega, 512, LDS_BYTES);
#else
    const void* ks[] = {(const void*)k_p0, (const void*)k_ffn, (const void*)k_gmlp, (const void*)k_hin, (const void*)k_scan, (const void*)k_hout, (const void*)k_qkv, (const void*)k_attn};
    for (int i = 0; i < 8; ++i) (void)hipFuncSetAttribute(ks[i], hipFuncAttributeMaxDynamicSharedMemorySize, LDS_BYTES);
    per_cu = 1;
#endif
    (void)hipGetLastError();
    if (per_cu < 1) per_cu = 1;
    grid_blocks = cus * per_cu;
    if (grid_blocks > NPANEL) grid_blocks = NPANEL;
    if (grid_blocks < 1) grid_blocks = NPANEL;
  }
  if (grid_blocks < 0) return;
  Params P{};
  for (int i = 0; i < 20; ++i) P.in[i] = (const float*)d_in[i];
  P.out = (float*)d_out;
  P.ws = (unsigned char*)d_ws;
#if COOP
  P.ph_lo = 0; P.ph_hi = 5;
  (void)hipMemsetAsync((unsigned char*)d_ws + OFF_BAR, 0, 256, stream);
  void* args[] = {&P};
  hipError_t e = hipLaunchCooperativeKernel((const void*)mega, dim3(grid_blocks), dim3(512), args, LDS_BYTES, stream);
  if (e != hipSuccess) fprintf(stderr, "cooperative launch failed: %s (grid %d)\n", hipGetErrorString(e), grid_blocks);
#else
#define LAUNCH(k, a, b) do { P.ph_lo = (a); P.ph_hi = (b); hipLaunchKernelGGL(k, dim3(NPANEL), dim3(512), LDS_BYTES, stream, P); } while (0)
  LAUNCH(k_p0, 0, 0);
  LAUNCH(k_ffn, 0, 0); LAUNCH(k_gmlp, 0, 0); LAUNCH(k_ffn, 0, 1);
  LAUNCH(k_ffn, 1, 0); LAUNCH(k_hin, 0, 0); LAUNCH(k_scan, 0, 0); LAUNCH(k_hout, 0, 0); LAUNCH(k_ffn, 1, 1);
  LAUNCH(k_ffn, 2, 0); LAUNCH(k_qkv, 0, 0); LAUNCH(k_attn, 0, 0); LAUNCH(k_ffn, 2, 1);
  LAUNCH(k_ffn, 3, 0); LAUNCH(k_gmlp, 3, 1); LAUNCH(k_ffn, 3, 3);
#endif
}
```

```cpp
#include <hip/hip_runtime.h>
#include <hip/hip_cooperative_groups.h>
#include <stdint.h>
#include <stdio.h>
namespace cg = cooperative_groups;

#ifndef COOP
#define COOP 1
#endif

typedef unsigned short bf16_t;
typedef __attribute__((ext_vector_type(8))) __bf16 bfrag;
typedef __attribute__((ext_vector_type(16))) float f32x16;

constexpr int T_TOK = 32768;
constexpr int NPANEL = 256;
constexpr float ALPHA = 1.6817928305074290f;
constexpr int LDS_BYTES = 122880;

constexpr size_t SZ_WGU = (size_t)8 * 5632 * 1024 * 2;
constexpr size_t SZ_WD = (size_t)8 * 1024 * 2816 * 2;
constexpr size_t SZ_WGI = (size_t)2 * 2048 * 1024 * 2;
constexpr size_t SZ_WGO = (size_t)2 * 1024 * 1024 * 2;
constexpr size_t SZ_WSP = (size_t)2 * 8 * 128 * 128 * 2;
constexpr size_t SZ_WHI = (size_t)4096 * 1024 * 2;
constexpr size_t SZ_WHO = (size_t)1024 * 1024 * 2;
constexpr size_t SZ_WQKV = (size_t)1536 * 1024 * 2;
constexpr size_t SZ_WAO = (size_t)1024 * 1024 * 2;
constexpr size_t SZ_LB = 4096;
constexpr size_t SZ_H = (size_t)T_TOK * 1024 * 4;
constexpr size_t SZ_HB = (size_t)T_TOK * 1024 * 2;
constexpr size_t SZ_ACT = (size_t)T_TOK * 2816 * 2;
constexpr size_t SZ_SG = (size_t)T_TOK * 1024 * 2;
constexpr size_t SZ_DS = (size_t)NPANEL * 8 * 128 * 128 * 2;
constexpr size_t SZ_DEC = (size_t)NPANEL * 8 * 128 * 4;
constexpr size_t SZ_KB = (size_t)T_TOK * 128 * 2;

constexpr size_t OFF_WGU = 0;
constexpr size_t OFF_WD = OFF_WGU + SZ_WGU;
constexpr size_t OFF_WGI = OFF_WD + SZ_WD;
constexpr size_t OFF_WGO = OFF_WGI + SZ_WGI;
constexpr size_t OFF_WSP = OFF_WGO + SZ_WGO;
constexpr size_t OFF_WHI = OFF_WSP + SZ_WSP;
constexpr size_t OFF_WHO = OFF_WHI + SZ_WHI;
constexpr size_t OFF_WQKV = OFF_WHO + SZ_WHO;
constexpr size_t OFF_WAO = OFF_WQKV + SZ_WQKV;
constexpr size_t OFF_LB = OFF_WAO + SZ_WAO;
constexpr size_t OFF_H = OFF_LB + SZ_LB;
constexpr size_t OFF_HB = OFF_H + SZ_H;
constexpr size_t OFF_ACT = OFF_HB + SZ_HB;
constexpr size_t OFF_SG = OFF_ACT + SZ_ACT;
constexpr size_t OFF_DS = OFF_SG + SZ_SG;
constexpr size_t OFF_DEC = OFF_DS + SZ_DS;
constexpr size_t OFF_KB = OFF_DEC + SZ_DEC;
constexpr size_t OFF_VB = OFF_KB + SZ_KB;
constexpr size_t OFF_BAR = OFF_VB + SZ_KB;
constexpr size_t WS_END = OFF_BAR + 256;

struct Params {
  const float* in[20];
  float* out;
  unsigned char* ws;
  int ph_lo, ph_hi;
};

struct Ctx {
  const float* const* in;
  float* out;
  unsigned char* ws;
  __device__ __forceinline__ bf16_t* WGU() const { return (bf16_t*)(ws + OFF_WGU); }
  __device__ __forceinline__ bf16_t* WD() const { return (bf16_t*)(ws + OFF_WD); }
  __device__ __forceinline__ bf16_t* WGI() const { return (bf16_t*)(ws + OFF_WGI); }
  __device__ __forceinline__ bf16_t* WGO() const { return (bf16_t*)(ws + OFF_WGO); }
  __device__ __forceinline__ bf16_t* WSP() const { return (bf16_t*)(ws + OFF_WSP); }
  __device__ __forceinline__ bf16_t* WHI() const { return (bf16_t*)(ws + OFF_WHI); }
  __device__ __forceinline__ bf16_t* WHO() const { return (bf16_t*)(ws + OFF_WHO); }
  __device__ __forceinline__ bf16_t* WQKV() const { return (bf16_t*)(ws + OFF_WQKV); }
  __device__ __forceinline__ bf16_t* WAO() const { return (bf16_t*)(ws + OFF_WAO); }
  __device__ __forceinline__ float* LB() const { return (float*)(ws + OFF_LB); }
  __device__ __forceinline__ float* H() const { return (float*)(ws + OFF_H); }
  __device__ __forceinline__ bf16_t* HB() const { return (bf16_t*)(ws + OFF_HB); }
  __device__ __forceinline__ bf16_t* ACT() const { return (bf16_t*)(ws + OFF_ACT); }
  __device__ __forceinline__ bf16_t* SG() const { return (bf16_t*)(ws + OFF_SG); }
  __device__ __forceinline__ bf16_t* DS() const { return (bf16_t*)(ws + OFF_DS); }
  __device__ __forceinline__ float* DEC() const { return (float*)(ws + OFF_DEC); }
  __device__ __forceinline__ bf16_t* KB() const { return (bf16_t*)(ws + OFF_KB); }
  __device__ __forceinline__ bf16_t* VB() const { return (bf16_t*)(ws + OFF_VB); }
};

__device__ __forceinline__ bf16_t f2bf(float f) {
  uint32_t u = __float_as_uint(f);
  u += 0x7fffu + ((u >> 16) & 1u);
  return (bf16_t)(u >> 16);
}
__device__ __forceinline__ float bf2f(bf16_t b) { return __uint_as_float(((uint32_t)b) << 16); }
__device__ __forceinline__ uint32_t pack2(float a, float b) { return (uint32_t)f2bf(a) | ((uint32_t)f2bf(b) << 16); }
__device__ __forceinline__ float wave_sum(float v) {
  v += __shfl_xor(v, 32, 64); v += __shfl_xor(v, 16, 64); v += __shfl_xor(v, 8, 64);
  v += __shfl_xor(v, 4, 64); v += __shfl_xor(v, 2, 64); v += __shfl_xor(v, 1, 64);
  return v;
}
__device__ __forceinline__ float silu_f(float x) { return x * __frcp_rn(1.f + __expf(-x)); }
#define ROWMAP(reg, lane) ((((reg)&3)) + 8 * ((reg) >> 2) + 4 * ((lane) >> 5))
#define MFMA(a, b, c) __builtin_amdgcn_mfma_f32_32x32x16_bf16((a), (b), (c), 0, 0, 0)

__device__ __forceinline__ int opaque_tid() {
  int t = threadIdx.x;
  asm volatile("" : "+v"(t));
  return t;
}

__device__ __forceinline__ unsigned long long opaque_u64(unsigned long long v) {
  unsigned lo = (unsigned)v, hi = (unsigned)(v >> 32);
  asm volatile("" : "+v"(lo), "+v"(hi));
  lo = __builtin_amdgcn_readfirstlane(lo);
  hi = __builtin_amdgcn_readfirstlane(hi);
  return ((unsigned long long)hi << 32) | lo;
}

__device__ __forceinline__ f32x16 zero16() {
  f32x16 z;
#pragma unroll
  for (int i = 0; i < 16; ++i) z[i] = 0.f;
  return z;
}

constexpr int G_STAGE_B = 40960;

__device__ __forceinline__ void glds16(const bf16_t* g, char* l) {
  __builtin_amdgcn_global_load_lds((const unsigned*)g, (unsigned*)l, 16, 0, 0);
}

template <class Epi>
__device__ __forceinline__ void gemm_panel(const bf16_t* __restrict__ A, const int lda, const bf16_t* __restrict__ Wb,
                                           const int K, const int nN, const Epi epi, bf16_t* smem) {
  const int tid = opaque_tid(), lane = tid & 63;
  const int w = __builtin_amdgcn_readfirstlane(tid >> 6);
  const int wm = w & 1, wn = w >> 1;
  const int nk = K >> 5;
  const int total = nN * nk;
  const int l31 = lane & 31, h = lane >> 5;
  const int grow = lane >> 2;
  const int gch = (lane & 3) ^ ((lane >> 4) & 3);
  const bf16_t* a_src = A + (size_t)(w * 16 + grow) * lda + gch * 8;
  const bf16_t* b_src = Wb + (size_t)(w * 16 + grow) * 32 + gch * 8;
  char* lds = (char*)smem;
  const int pos0 = h ^ ((l31 >> 2) & 3);
  const int offk0 = l31 * 64 + pos0 * 16;
  const int offk1 = l31 * 64 + (pos0 ^ 2) * 16;
  f32x16 acc[2][4];
#pragma unroll
  for (int i = 0; i < 2; ++i)
#pragma unroll
    for (int j = 0; j < 4; ++j) acc[i][j] = zero16();
  __syncthreads();
  {
    char* st = lds + w * 1024;
    glds16(a_src, st);
#pragma unroll
    for (int i = 0; i < 4; ++i) glds16(b_src + i * 4096, st + 8192 + i * 8192);
    st += G_STAGE_B;
    glds16(a_src + (nk > 1 ? 32 : 0), st);
#pragma unroll
    for (int i = 0; i < 4; ++i) glds16(b_src + 16384 + i * 4096, st + 8192 + i * 8192);
  }
  int ks = 0, nt = 0, stage = 0;
  int ks2 = 2 % nk, stage2 = 2;
  bool drain = false;
  for (int it = 0; it < total; ++it) {
    if (it + 1 < total && !drain) asm volatile("s_waitcnt vmcnt(5)" ::: "memory");
    else asm volatile("s_waitcnt vmcnt(0)" ::: "memory");
    drain = false;
    asm volatile("s_waitcnt lgkmcnt(0)" ::: "memory");
    __builtin_amdgcn_s_barrier();
    asm volatile("" ::: "memory");
    if (it + 2 < total) {
      char* st = lds + stage2 * G_STAGE_B + w * 1024;
      glds16(a_src + ks2 * 32, st);
      const bf16_t* bs = b_src + (size_t)(it + 2) * 16384;
#pragma unroll
      for (int i = 0; i < 4; ++i) glds16(bs + i * 4096, st + 8192 + i * 8192);
    }
    const char* sa = lds + stage * G_STAGE_B + wm * 4096;
    const char* sb = lds + stage * G_STAGE_B + 8192 + wn * 8192;
#pragma unroll
    for (int kk = 0; kk < 2; ++kk) {
      const int ok = kk ? offk1 : offk0;
      const bfrag a0 = *(const bfrag*)(sa + ok);
      const bfrag a1 = *(const bfrag*)(sa + 2048 + ok);
#pragma unroll
      for (int ni = 0; ni < 4; ++ni) {
        const bfrag b = *(const bfrag*)(sb + ni * 2048 + ok);
        acc[0][ni] = MFMA(a0, b, acc[0][ni]);
        acc[1][ni] = MFMA(a1, b, acc[1][ni]);
      }
    }
    if (ks == nk - 1) {
      epi(acc, nt, wm, wn, lane);
#pragma unroll
      for (int i = 0; i < 2; ++i)
#pragma unroll
        for (int j = 0; j < 4; ++j) acc[i][j] = zero16();
      ++nt;
      drain = true;
    }
    ++ks; if (ks == nk) ks = 0;
    ++ks2; if (ks2 == nk) ks2 = 0;
    ++stage; if (stage == 3) stage = 0;
    ++stage2; if (stage2 == 3) stage2 = 0;
  }
  __syncthreads();
}

struct EpiSwiglu {
  bf16_t* act;
  __device__ __forceinline__ void operator()(f32x16 (&acc)[2][4], int nt, int wm, int wn, int lane_in) const {
    int lane = lane_in;
    asm volatile("" : "+v"(lane));
    const int l31 = lane & 31;
#pragma unroll
    for (int mi = 0; mi < 2; ++mi)
#pragma unroll
      for (int n2 = 0; n2 < 2; ++n2)
#pragma unroll
        for (int r = 0; r < 16; ++r) {
          const int row = wm * 64 + mi * 32 + ROWMAP(r, lane);
          const int col = (nt * 4 + wn) * 64 + n2 * 32 + l31;
          const float g = acc[mi][n2][r], u = acc[mi][n2 + 2][r];
          act[(size_t)row * 2816 + col] = f2bf(silu_f(g) * u);
        }
  }
};
struct EpiResLN {
  float* Hp;
  float alpha, c;
  const float* bias;
  __device__ __forceinline__ void operator()(f32x16 (&acc)[2][4], int nt, int wm, int wn, int lane_in) const {
    int lane = lane_in;
    asm volatile("" : "+v"(lane));
    const int l31 = lane & 31;
    float* base = Hp + (size_t)(wm * 64 + 4 * (lane >> 5)) * 1024 + nt * 512 + wn * 128 + l31;
#pragma unroll
    for (int ni = 0; ni < 4; ++ni) {
      const float bv = bias ? bias[nt * 512 + wn * 128 + ni * 32 + l31] : 0.f;
#pragma unroll
      for (int mi = 0; mi < 2; ++mi) {
        float hv[16];
#pragma unroll
        for (int r = 0; r < 16; ++r) hv[r] = base[(size_t)(mi * 32 + (r & 3) + 8 * (r >> 2)) * 1024 + ni * 32];
#pragma unroll
        for (int r = 0; r < 16; ++r)
          base[(size_t)(mi * 32 + (r & 3) + 8 * (r >> 2)) * 1024 + ni * 32] = alpha * hv[r] + c * (acc[mi][ni][r] + bv);
        __builtin_amdgcn_sched_barrier(0);
      }
    }
  }
};
struct EpiGelu {
  bf16_t* Z;
  __device__ __forceinline__ void operator()(f32x16 (&acc)[2][4], int nt, int wm, int wn, int lane_in) const {
    int lane = lane_in;
    asm volatile("" : "+v"(lane));
    const int l31 = lane & 31;
#pragma unroll
    for (int ni = 0; ni < 4; ++ni) {
      const int col = nt * 512 + wn * 128 + ni * 32 + l31;
#pragma unroll
      for (int mi = 0; mi < 2; ++mi)
#pragma unroll
        for (int r = 0; r < 16; ++r) {
          const int row = wm * 64 + mi * 32 + ROWMAP(r, lane);
          const float x = acc[mi][ni][r];
          Z[(size_t)row * 2048 + col] = f2bf(0.5f * x * (1.f + erff(x * 0.70710678118654752f)));
        }
    }
  }
};
struct EpiHgrn {
  bf16_t* Qp;
  bf16_t* Vp;
  float* LFp;
  bf16_t* SGp;
  const float* lb;
  __device__ __forceinline__ void operator()(f32x16 (&acc)[2][4], int nt, int wm, int wn, int lane_in) const {
    int lane = lane_in;
    asm volatile("" : "+v"(lane));
    const int l31 = lane & 31;
    const int sec = nt >> 1;
    const int cb = (nt & 1) * 512 + wn * 128 + l31;
    const int rb = wm * 64 + 4 * (lane >> 5);
    if (sec == 0 || sec == 3) {
      bf16_t* dst = (sec == 0) ? Qp : SGp;
#pragma unroll
      for (int ni = 0; ni < 4; ++ni)
#pragma unroll
        for (int mi = 0; mi < 2; ++mi)
#pragma unroll
          for (int r = 0; r < 16; ++r) {
            const int row = rb + mi * 32 + (r & 3) + 8 * (r >> 2);
            dst[(size_t)row * 1024 + cb + ni * 32] = f2bf(silu_f(acc[mi][ni][r]));
          }
    } else if (sec == 1) {
#pragma unroll
      for (int ni = 0; ni < 4; ++ni) {
        const float lbv = lb[cb + ni * 32];
#pragma unroll
        for (int mi = 0; mi < 2; ++mi)
#pragma unroll
          for (int r = 0; r < 16; ++r) {
            const int row = rb + mi * 32 + (r & 3) + 8 * (r >> 2);
            const float f = lbv + (1.f - lbv) * __frcp_rn(1.f + __expf(-acc[mi][ni][r]));
            LFp[(size_t)row * 1024 + cb + ni * 32] = __logf(f);
          }
      }
    } else {
#pragma unroll
      for (int ni = 0; ni < 4; ++ni)
#pragma unroll
        for (int mi = 0; mi < 2; ++mi)
#pragma unroll
          for (int r = 0; r < 16; ++r) {
            const int row = rb + mi * 32 + (r & 3) + 8 * (r >> 2);
            Vp[(size_t)row * 1024 + cb + ni * 32] = f2bf(acc[mi][ni][r]);
          }
    }
  }
};
struct EpiQkv {
  bf16_t* Qp;
  bf16_t* Kp;
  bf16_t* Vp;
  const float* bias;
  __device__ __forceinline__ void operator()(f32x16 (&acc)[2][4], int nt, int wm, int wn, int lane_in) const {
    int lane = lane_in;
    asm volatile("" : "+v"(lane));
    const int l31 = lane & 31;
#pragma unroll
    for (int ni = 0; ni < 4; ++ni) {
      const int col = nt * 512 + wn * 128 + ni * 32 + l31;
      if (col < 1280) {
        const float bv = bias[col];
#pragma unroll
        for (int mi = 0; mi < 2; ++mi)
#pragma unroll
          for (int r = 0; r < 16; ++r) {
            const int row = wm * 64 + mi * 32 + ROWMAP(r, lane);
            const float x = acc[mi][ni][r] + bv;
            if (col < 1024) Qp[(size_t)row * 1024 + col] = f2bf(x * 0.125f);
            else if (col < 1152) Kp[(size_t)row * 128 + (col - 1024)] = f2bf(x);
            else Vp[(size_t)row * 128 + (col - 1152)] = f2bf(x);
          }
      }
    }
  }
};

__device__ __forceinline__ void ln_panel(const float* Hp, float* outp, bf16_t* HBp, const float* g, const float* b) {
  const int tid = opaque_tid(), lane = tid & 63;
  const int w = __builtin_amdgcn_readfirstlane(tid >> 6);
  float4 gv[4], bv[4];
#pragma unroll
  for (int j = 0; j < 4; ++j) {
    gv[j] = *(const float4*)(g + j * 256 + lane * 4);
    bv[j] = *(const float4*)(b + j * 256 + lane * 4);
  }
  for (int r = w; r < 128; r += 8) {
    float4 x[4];
    float s = 0.f;
#pragma unroll
    for (int j = 0; j < 4; ++j) {
      x[j] = *(const float4*)(Hp + (size_t)r * 1024 + j * 256 + lane * 4);
      s += x[j].x + x[j].y + x[j].z + x[j].w;
    }
    s = wave_sum(s);
    const float mean = s * (1.f / 1024.f);
    float v = 0.f;
#pragma unroll
    for (int j = 0; j < 4; ++j) {
      x[j].x -= mean; x[j].y -= mean; x[j].z -= mean; x[j].w -= mean;
      v += x[j].x * x[j].x + x[j].y * x[j].y + x[j].z * x[j].z + x[j].w * x[j].w;
    }
    v = wave_sum(v);
    const float rstd = 1.0f / sqrtf(v * (1.f / 1024.f) + 1e-5f);
#pragma unroll
    for (int j = 0; j < 4; ++j) {
      float4 y;
      y.x = x[j].x * rstd * gv[j].x + bv[j].x;
      y.y = x[j].y * rstd * gv[j].y + bv[j].y;
      y.z = x[j].z * rstd * gv[j].z + bv[j].z;
      y.w = x[j].w * rstd * gv[j].w + bv[j].w;
      *(float4*)(outp + (size_t)r * 1024 + j * 256 + lane * 4) = y;
      uint2 pk;
      pk.x = pack2(y.x, y.y);
      pk.y = pack2(y.z, y.w);
      *(uint2*)(HBp + (size_t)r * 1024 + j * 256 + lane * 4) = pk;
    }
  }
  __syncthreads();
}

__device__ __forceinline__ void ffn_panel(const Ctx& C, int p, int layer, int j, bool final_out, bf16_t* smem) {
  const int wi = layer * 2 + j;
  bf16_t* HBp = C.HB() + (size_t)p * 128 * 1024;
  bf16_t* ACTp = C.ACT() + (size_t)p * 128 * 2816;
  float* Hp = C.H() + (size_t)p * 128 * 1024;
  EpiSwiglu e1{ACTp};
  gemm_panel(HBp, 1024, C.WGU() + (size_t)wi * 5632 * 1024, 1024, 11, e1, smem);
  EpiResLN e2{Hp, ALPHA, 0.5f, nullptr};
  gemm_panel(ACTp, 2816, C.WD() + (size_t)wi * 1024 * 2816, 2816, 2, e2, smem);
  const int li = (layer * 3 + (j == 0 ? 0 : 2)) * 1024;
  float* outp = final_out ? (C.out + (size_t)p * 128 * 1024) : Hp;
  ln_panel(Hp, outp, HBp, C.in[3] + li, C.in[4] + li);
}

__device__ __forceinline__ void gmlp_panel(const Ctx& C, int p, int layer, int slot, bf16_t* smem) {
  const int tid = opaque_tid(), lane = tid & 63;
  const int w = __builtin_amdgcn_readfirstlane(tid >> 6);
  const int l31 = lane & 31, h8 = (lane >> 5) * 8;
  bf16_t* HBp = C.HB() + (size_t)p * 128 * 1024;
  bf16_t* Zp = C.ACT() + (size_t)p * 128 * 2816;
  float* Hp = C.H() + (size_t)p * 128 * 1024;
  {
    EpiGelu e{Zp};
    gemm_panel(HBp, 1024, C.WGI() + (size_t)slot * 2048 * 1024, 1024, 4, e, smem);
  }
  bf16_t* As = smem;
  bf16_t* Bs = smem + 128 * 136;
  float* st = (float*)(smem + 2 * 128 * 136);
  for (int r = w; r < 128; r += 8) {
    const uint4 q0 = *(const uint4*)(Zp + (size_t)r * 2048 + 1024 + lane * 16);
    const uint4 q1 = *(const uint4*)(Zp + (size_t)r * 2048 + 1024 + lane * 16 + 8);
    const uint32_t u[8] = {q0.x, q0.y, q0.z, q0.w, q1.x, q1.y, q1.z, q1.w};
    float x[16];
    float s = 0.f;
#pragma unroll
    for (int e = 0; e < 8; ++e) {
      x[2 * e] = __uint_as_float(u[e] << 16);
      x[2 * e + 1] = __uint_as_float(u[e] & 0xffff0000u);
      s += x[2 * e] + x[2 * e + 1];
    }
    s = wave_sum(s);
    const float mean = s * (1.f / 1024.f);
    float v = 0.f;
#pragma unroll
    for (int e = 0; e < 16; ++e) { const float d = x[e] - mean; v += d * d; }
    v = wave_sum(v);
    if (lane == 0) { st[r * 2] = mean; st[r * 2 + 1] = 1.0f / sqrtf(v * (1.f / 1024.f) + 1e-5f); }
  }
  __syncthreads();
  const float* lng = C.in[6] + slot * 1024;
  const float* lnb = C.in[7] + slot * 1024;
  const float* bsp = C.in[9] + slot * 1024;
  const bf16_t* Wsp = C.WSP() + (size_t)slot * 8 * 16384;
  const int nd = w & 3, mt0 = (w >> 2) * 2;
  for (int g = 0; g < 8; ++g) {
#pragma unroll
    for (int i = 0; i < 4; ++i) {
      const int c = tid + 512 * i;
      *(uint4*)(As + (c >> 4) * 136 + (c & 15) * 8) = *(const uint4*)(Wsp + (size_t)g * 16384 + c * 8);
    }
    {
      const int s = tid >> 2, dq = tid & 3;
      const float mean = st[s * 2], rstd = st[s * 2 + 1];
      const bf16_t* src = Zp + (size_t)s * 2048 + 1024 + g * 128 + dq * 32;
#pragma unroll
      for (int q = 0; q < 4; ++q) {
        const uint4 v4 = *(const uint4*)(src + q * 8);
        const uint32_t u[4] = {v4.x, v4.y, v4.z, v4.w};
#pragma unroll
        for (int e = 0; e < 4; ++e) {
          const int d0 = dq * 32 + q * 8 + e * 2;
          const int ch = g * 128 + d0;
          const float x0 = __uint_as_float(u[e] << 16), x1 = __uint_as_float(u[e] & 0xffff0000u);
          Bs[d0 * 136 + s] = f2bf((x0 - mean) * rstd * lng[ch] + lnb[ch]);
          Bs[(d0 + 1) * 136 + s] = f2bf((x1 - mean) * rstd * lng[ch + 1] + lnb[ch + 1]);
        }
      }
    }
    __syncthreads();
    f32x16 acc[2];
    acc[0] = zero16(); acc[1] = zero16();
#pragma unroll
    for (int k16 = 0; k16 < 8; ++k16) {
      const bfrag b = *(const bfrag*)(Bs + (nd * 32 + l31) * 136 + k16 * 16 + h8);
#pragma unroll
      for (int mi = 0; mi < 2; ++mi) {
        const bfrag a = *(const bfrag*)(As + ((mt0 + mi) * 32 + l31) * 136 + k16 * 16 + h8);
        acc[mi] = MFMA(a, b, acc[mi]);
      }
    }
#pragma unroll
    for (int mi = 0; mi < 2; ++mi)
#pragma unroll
      for (int r = 0; r < 16; ++r) {
        const int t = (mt0 + mi) * 32 + ROWMAP(r, lane);
        const int ch = g * 128 + nd * 32 + l31;
        const float mixed = acc[mi][r] + bsp[g * 128 + t];
        const float u = bf2f(Zp[(size_t)t * 2048 + ch]);
        HBp[(size_t)t * 1024 + ch] = f2bf(u * mixed);
      }
    __syncthreads();
  }
  {
    EpiResLN e2{Hp, ALPHA, 1.0f, nullptr};
    gemm_panel(HBp, 1024, C.WGO() + (size_t)slot * 1024 * 1024, 1024, 2, e2, smem);
  }
  const int li = (layer * 3 + 1) * 1024;
  ln_panel(Hp, Hp, HBp, C.in[3] + li, C.in[4] + li);
}

template <bool OUT>
__device__ __forceinline__ void hgrn_rec(const Ctx& C, int p, bf16_t* smem) {
  const int tid = opaque_tid(), lane = tid & 63;
  const int w = __builtin_amdgcn_readfirstlane(tid >> 6);
  const int l31 = lane & 31, h8 = (lane >> 5) * 8;
  bf16_t* ST = smem;
  bf16_t* Qh = smem + 17408;
  bf16_t* Kh = smem + 21760;
  bf16_t* KhT = smem + 26112;
  bf16_t* vT = smem + 31232;
  bf16_t* Ps = smem + 36352;
  float* seg = (float*)(smem + 37632);
  float* dec = seg + 512;
  float* oF = dec + 128;
  const size_t row0 = (size_t)p * 128;
  const bf16_t* Qp = C.ACT() + (size_t)p * 128 * 2816;
  const bf16_t* Vp = Qp + 128 * 1024;
  const float* LFp = C.out + row0 * 1024;
  const bf16_t* SGp = C.SG() + row0 * 1024;
  bf16_t* HBp = C.HB() + row0 * 1024;
  const float* ng = C.in[13];
  const int jt = w >> 1, kt0 = (w & 1) * 2;
  const int kq = tid & 127, tq = tid >> 7;
  for (int h = 0; h < 8; ++h) {
    f32x16 accS[2];
    bf16_t* SBh = C.DS() + ((size_t)(p * 8 + h)) * 16384;
    if (OUT) {
      __syncthreads();
#pragma unroll
      for (int i = 0; i < 4; ++i) {
        const int c = tid + 512 * i;
        *(uint4*)(ST + (c >> 4) * 136 + (c & 15) * 8) = *(const uint4*)(SBh + c * 8);
      }
      __syncthreads();
#pragma unroll
      for (int c2 = 0; c2 < 2; ++c2)
#pragma unroll
        for (int r = 0; r < 16; ++r)
          accS[c2][r] = bf2f(ST[(jt * 32 + ROWMAP(r, lane)) * 136 + (kt0 + c2) * 32 + l31]);
    } else {
      accS[0] = zero16(); accS[1] = zero16();
    }
    float dsum = 0.f;
    for (int i = 0; i < 4; ++i) {
      float l[8], cs[8];
      const size_t gbase = (size_t)(i * 32 + tq * 8) * 1024 + h * 128 + kq;
#pragma unroll
      for (int e = 0; e < 8; ++e) l[e] = LFp[gbase + (size_t)e * 1024];
      cs[0] = l[0];
#pragma unroll
      for (int e = 1; e < 8; ++e) cs[e] = cs[e - 1] + l[e];
      seg[tq * 128 + kq] = cs[7];
#pragma unroll
      for (int e = 0; e < 8; ++e) vT[kq * 40 + tq * 8 + e] = Vp[gbase + (size_t)e * 1024];
      __syncthreads();
      float off = 0.f, tot = 0.f;
#pragma unroll
      for (int q = 0; q < 4; ++q) {
        const float s = seg[q * 128 + kq];
        if (q < tq) off += s;
        tot += s;
      }
#pragma unroll
      for (int e = 0; e < 8; ++e) {
        const float gc = cs[e] + off;
        const float f = __expf(l[e]);
        const float kh = (1.f - f) * __expf(-gc);
        const bf16_t khb = f2bf(kh);
        const int t = tq * 8 + e;
        KhT[kq * 40 + t] = khb;
        if (OUT) {
          Kh[t * 136 + kq] = khb;
          const float qv = bf2f(Qp[gbase + (size_t)e * 1024]);
          Qh[t * 136 + kq] = f2bf(qv * __expf(gc));
        }
      }
      if (tq == 0) { dec[kq] = __expf(tot); dsum += tot; }
      __syncthreads();
      f32x16 accO = zero16();
      if (OUT) {
        if (w == 0) {
          f32x16 accP = zero16();
#pragma unroll
          for (int k16 = 0; k16 < 8; ++k16) {
            const bfrag a = *(const bfrag*)(Qh + l31 * 136 + k16 * 16 + h8);
            const bfrag b = *(const bfrag*)(Kh + l31 * 136 + k16 * 16 + h8);
            accP = MFMA(a, b, accP);
          }
#pragma unroll
          for (int r = 0; r < 16; ++r) {
            const int t = ROWMAP(r, lane);
            Ps[t * 40 + l31] = (l31 <= t) ? f2bf(accP[r]) : (bf16_t)0;
          }
        } else if (w <= 4) {
          const int nt = w - 1;
#pragma unroll
          for (int k16 = 0; k16 < 8; ++k16) {
            const bfrag a = *(const bfrag*)(Qh + l31 * 136 + k16 * 16 + h8);
            const bfrag b = *(const bfrag*)(ST + (nt * 32 + l31) * 136 + k16 * 16 + h8);
            accO = MFMA(a, b, accO);
          }
        }
        __syncthreads();
        if (w >= 1 && w <= 4) {
          const int nt = w - 1;
#pragma unroll
          for (int k16 = 0; k16 < 2; ++k16) {
            const bfrag a = *(const bfrag*)(Ps + l31 * 40 + k16 * 16 + h8);
            const bfrag b = *(const bfrag*)(vT + (nt * 32 + l31) * 40 + k16 * 16 + h8);
            accO = MFMA(a, b, accO);
          }
#pragma unroll
          for (int r = 0; r < 16; ++r) oF[ROWMAP(r, lane) * 132 + nt * 32 + l31] = accO[r];
        }
      }
#pragma unroll
      for (int c2 = 0; c2 < 2; ++c2) {
#pragma unroll
        for (int k16 = 0; k16 < 2; ++k16) {
          const bfrag a = *(const bfrag*)(vT + (jt * 32 + l31) * 40 + k16 * 16 + h8);
          const bfrag b = *(const bfrag*)(KhT + ((kt0 + c2) * 32 + l31) * 40 + k16 * 16 + h8);
          accS[c2] = MFMA(a, b, accS[c2]);
        }
        const float dk = dec[(kt0 + c2) * 32 + l31];
#pragma unroll
        for (int r = 0; r < 16; ++r) accS[c2][r] *= dk;
        if (OUT) {
#pragma unroll
          for (int r = 0; r < 16; ++r)
            ST[(jt * 32 + ROWMAP(r, lane)) * 136 + (kt0 + c2) * 32 + l31] = f2bf(accS[c2][r]);
        }
      }
      __syncthreads();
      if (OUT) {
        const int t = tid >> 4, part = tid & 15;
        float x[8];
        float ss = 0.f;
#pragma unroll
        for (int e = 0; e < 8; ++e) { x[e] = oF[t * 132 + part * 8 + e]; ss += x[e] * x[e]; }
        ss += __shfl_xor(ss, 1, 64); ss += __shfl_xor(ss, 2, 64); ss += __shfl_xor(ss, 4, 64); ss += __shfl_xor(ss, 8, 64);
        const float rr = 1.0f / sqrtf(ss * (1.f / 128.f) + 1e-6f);
        const size_t gro = (size_t)(i * 32 + t) * 1024 + h * 128 + part * 8;
        const uint4 sg4 = *(const uint4*)(SGp + gro);
        const uint32_t su[4] = {sg4.x, sg4.y, sg4.z, sg4.w};
        uint32_t ov[4];
#pragma unroll
        for (int e = 0; e < 4; ++e) {
          const float g0 = ng[part * 8 + 2 * e], g1 = ng[part * 8 + 2 * e + 1];
          const float s0 = __uint_as_float(su[e] << 16), s1 = __uint_as_float(su[e] & 0xffff0000u);
          ov[e] = pack2(x[2 * e] * rr * g0 * s0, x[2 * e + 1] * rr * g1 * s1);
        }
        uint4 o4; o4.x = ov[0]; o4.y = ov[1]; o4.z = ov[2]; o4.w = ov[3];
        *(uint4*)(HBp + gro) = o4;
      }
    }
    if (!OUT) {
#pragma unroll
      for (int c2 = 0; c2 < 2; ++c2)
#pragma unroll
        for (int r = 0; r < 16; ++r)
          SBh[(jt * 32 + ROWMAP(r, lane)) * 128 + (kt0 + c2) * 32 + l31] = f2bf(accS[c2][r]);
      if (tq == 0) C.DEC()[(size_t)(p * 8 + h) * 128 + kq] = __expf(dsum);
    }
  }
  __syncthreads();
}

__device__ __forceinline__ void hgrn_scan(const Ctx& C) {
  for (int gid = blockIdx.x * 512 + threadIdx.x; gid < 131072; gid += gridDim.x * 512) {
    const int kp = gid & 63, j = (gid >> 6) & 127, h = (gid >> 13) & 7, b = gid >> 16;
    float s0 = 0.f, s1 = 0.f;
    for (int c0 = 0; c0 < 128; c0 += 8) {
      uint32_t d[8];
      float2 dc[8];
#pragma unroll
      for (int e = 0; e < 8; ++e) {
        const size_t ph = (size_t)((b * 128 + c0 + e) * 8 + h);
        d[e] = *(const uint32_t*)(C.DS() + ph * 16384 + j * 128 + kp * 2);
        dc[e] = *(const float2*)(C.DEC() + ph * 128 + kp * 2);
      }
#pragma unroll
      for (int e = 0; e < 8; ++e) {
        const size_t ph = (size_t)((b * 128 + c0 + e) * 8 + h);
        *(uint32_t*)(C.DS() + ph * 16384 + j * 128 + kp * 2) = pack2(s0, s1);
        s0 = dc[e].x * s0 + __uint_as_float(d[e] << 16);
        s1 = dc[e].y * s1 + __uint_as_float(d[e] & 0xffff0000u);
      }
    }
  }
}

__device__ __forceinline__ void attn_panel(const Ctx& C, int p, bf16_t* smem) {
  const int tid = opaque_tid(), lane = tid & 63;
  const int w = __builtin_amdgcn_readfirstlane(tid >> 6);
  const int l31 = lane & 31, h8 = (lane >> 5) * 8;
  bf16_t* K2 = smem;
  bf16_t* VT = smem + 18432;
  bf16_t* Pw = smem + 35328 + w * 1280;
  const int blk = p & 127;
  const size_t row0 = (size_t)p * 128;
  const bf16_t* Qp = C.ACT() + (size_t)p * 128 * 2816;
  bf16_t* HBp = C.HB() + row0 * 1024;
  const int qt = w & 3;
  for (int hk = 0; hk < 2; ++hk) {
    __syncthreads();
#pragma unroll
    for (int i = 0; i < 4; ++i) {
      const int c = tid + 512 * i;
      const int r = c >> 3, ch = c & 7;
      uint4 kv = make_uint4(0, 0, 0, 0), vv = make_uint4(0, 0, 0, 0);
      if (blk > 0 || r >= 128) {
        const size_t tok = row0 + r - 128;
        kv = *(const uint4*)(C.KB() + tok * 128 + hk * 64 + ch * 8);
        vv = *(const uint4*)(C.VB() + tok * 128 + hk * 64 + ch * 8);
      }
      *(uint4*)(K2 + r * 72 + ch * 8) = kv;
      const uint32_t vu[4] = {vv.x, vv.y, vv.z, vv.w};
#pragma unroll
      for (int e = 0; e < 4; ++e) {
        VT[(ch * 8 + 2 * e) * 264 + r] = (bf16_t)(vu[e] & 0xffffu);
        VT[(ch * 8 + 2 * e + 1) * 264 + r] = (bf16_t)(vu[e] >> 16);
      }
    }
    __syncthreads();
    for (int u = 0; u < 4; ++u) {
      const int hq = hk * 8 + (w >> 2) * 4 + u;
      const float sink = C.in[17][hq];
      bfrag aq[4];
#pragma unroll
      for (int k16 = 0; k16 < 4; ++k16)
        aq[k16] = *(const bfrag*)(Qp + (size_t)(qt * 32 + l31) * 1024 + hq * 64 + k16 * 16 + h8);
      f32x16 s[5];
#pragma unroll
      for (int c = 0; c < 5; ++c) {
        s[c] = zero16();
#pragma unroll
        for (int k16 = 0; k16 < 4; ++k16) {
          const bfrag b = *(const bfrag*)(K2 + ((qt + c) * 32 + l31) * 72 + k16 * 16 + h8);
          s[c] = MFMA(aq[k16], b, s[c]);
        }
      }
      float linv[16];
#pragma unroll
      for (int r = 0; r < 16; ++r) {
        const int qi = qt * 32 + ROWMAP(r, lane);
        float m = -1e30f;
#pragma unroll
        for (int c = 0; c < 5; ++c) {
          const int kp = (qt + c) * 32 + l31;
          const bool valid = (kp > qi) && (kp <= qi + 128) && (blk > 0 || kp >= 128);
          const float v = valid ? s[c][r] : -1e30f;
          s[c][r] = v;
          m = fmaxf(m, v);
        }
        m = fmaxf(m, __shfl_xor(m, 16, 64)); m = fmaxf(m, __shfl_xor(m, 8, 64)); m = fmaxf(m, __shfl_xor(m, 4, 64));
        m = fmaxf(m, __shfl_xor(m, 2, 64)); m = fmaxf(m, __shfl_xor(m, 1, 64));
        m = fmaxf(m, sink);
        float sum = 0.f;
#pragma unroll
        for (int c = 0; c < 5; ++c) {
          const float pv = (s[c][r] > -1e29f) ? __expf(s[c][r] - m) : 0.f;
          s[c][r] = pv;
          sum += pv;
        }
        sum += __shfl_xor(sum, 16, 64); sum += __shfl_xor(sum, 8, 64); sum += __shfl_xor(sum, 4, 64);
        sum += __shfl_xor(sum, 2, 64); sum += __shfl_xor(sum, 1, 64);
        sum += __expf(sink - m);
        linv[r] = 1.f / sum;
      }
      f32x16 o[2];
      o[0] = zero16(); o[1] = zero16();
#pragma unroll
      for (int c = 0; c < 5; ++c) {
#pragma unroll
        for (int r = 0; r < 16; ++r) Pw[ROWMAP(r, lane) * 40 + l31] = f2bf(s[c][r]);
        __syncthreads();
#pragma unroll
        for (int k16 = 0; k16 < 2; ++k16) {
          const bfrag a = *(const bfrag*)(Pw + l31 * 40 + k16 * 16 + h8);
#pragma unroll
          for (int dt = 0; dt < 2; ++dt) {
            const bfrag b = *(const bfrag*)(VT + (dt * 32 + l31) * 264 + (qt + c) * 32 + k16 * 16 + h8);
            o[dt] = MFMA(a, b, o[dt]);
          }
        }
        __syncthreads();
      }
#pragma unroll
      for (int dt = 0; dt < 2; ++dt)
#pragma unroll
        for (int r = 0; r < 16; ++r)
          HBp[(size_t)(qt * 32 + ROWMAP(r, lane)) * 1024 + hq * 64 + dt * 32 + l31] = f2bf(o[dt][r] * linv[r]);
    }
  }
  __syncthreads();
}

__device__ __forceinline__ void conv_weights(const float* __restrict__ src, bf16_t* __restrict__ dst, int nmat, int K,
                                             int Nsrc, int Ndst, int mode) {
  const int nk = K >> 5, nNt = Ndst >> 9;
  const int upm = nk * nNt;
  const int tid = threadIdx.x;
  for (int u = blockIdx.x; u < nmat * upm; u += gridDim.x) {
    const int m = u / upm, r = u - m * upm;
    const int nt = r / nk, ks = r - nt * nk;
    const int np = nt * 512 + tid;
    int sc;
    if (mode == 1) {
      const int b = np >> 7, rr = np & 127;
      sc = (rr < 64) ? (b * 64 + rr) : (2816 + b * 64 + rr - 64);
    } else {
      sc = (np < Nsrc) ? np : -1;
    }
    const float* s = src + (size_t)m * K * Nsrc + (size_t)(ks * 32) * Nsrc + (sc < 0 ? 0 : sc);
    uint32_t pk[16];
#pragma unroll
    for (int kk = 0; kk < 16; ++kk) {
      float v0 = s[(size_t)(2 * kk) * Nsrc], v1 = s[(size_t)(2 * kk + 1) * Nsrc];
      if (sc < 0) { v0 = 0.f; v1 = 0.f; }
      pk[kk] = pack2(v0, v1);
    }
    uint4* d = (uint4*)(dst + (size_t)m * K * Ndst + (size_t)(nt * nk + ks) * 16384 + tid * 32);
    d[0] = make_uint4(pk[0], pk[1], pk[2], pk[3]);
    d[1] = make_uint4(pk[4], pk[5], pk[6], pk[7]);
    d[2] = make_uint4(pk[8], pk[9], pk[10], pk[11]);
    d[3] = make_uint4(pk[12], pk[13], pk[14], pk[15]);
  }
}

__device__ __forceinline__ void phase0(const Ctx& C) {
  conv_weights(C.in[1], C.WGU(), 8, 1024, 5632, 5632, 1);
  conv_weights(C.in[2], C.WD(), 8, 2816, 1024, 1024, 0);
  conv_weights(C.in[5], C.WGI(), 2, 1024, 2048, 2048, 0);
  conv_weights(C.in[10], C.WGO(), 2, 1024, 1024, 1024, 0);
  conv_weights(C.in[11], C.WHI(), 1, 1024, 4096, 4096, 0);
  conv_weights(C.in[14], C.WHO(), 1, 1024, 1024, 1024, 0);
  conv_weights(C.in[15], C.WQKV(), 1, 1024, 1280, 1536, 0);
  conv_weights(C.in[18], C.WAO(), 1, 1024, 1024, 1024, 0);
  const size_t gtid = (size_t)blockIdx.x * 512 + threadIdx.x;
  const size_t gsz = (size_t)gridDim.x * 512;
  for (size_t i = gtid; i < (size_t)T_TOK * 1024 / 4; i += gsz) {
    const float4 v = ((const float4*)C.in[0])[i];
    ((float4*)C.H())[i] = v;
    uint2 pk;
    pk.x = pack2(v.x, v.y);
    pk.y = pack2(v.z, v.w);
    ((uint2*)C.HB())[i] = pk;
  }
  for (size_t i = gtid; i < (size_t)2 * 8 * 128 * 128; i += gsz) {
    const int s = (int)(i & 127), t = (int)((i >> 7) & 127);
    C.WSP()[i] = (s <= t) ? f2bf(C.in[8][i]) : (bf16_t)0;
  }
  for (size_t i = gtid; i < 1024; i += gsz) {
    const float* lp = C.in[12];
    const float a0 = lp[i], a1 = lp[1024 + i], a2 = lp[2048 + i], a3 = lp[3072 + i];
    const float m = fmaxf(fmaxf(a0, a1), fmaxf(a2, a3));
    const float e0 = expf(a0 - m), e1 = expf(a1 - m), e2 = expf(a2 - m), e3 = expf(a3 - m);
    C.LB()[i] = e1 / (e0 + e1 + e2 + e3);
  }
}

enum { OP_FFN = 0, OP_GMLP = 1, OP_HIN = 2, OP_HOUT = 3, OP_QKV = 4, OP_ATTN = 5 };

__device__ __forceinline__ void run_ops(const Ctx& C0, int op_lo, int op_hi, bf16_t* smem) {
  for (int p0 = blockIdx.x; p0 < NPANEL; p0 += gridDim.x) {
    for (int op = op_lo; op < op_hi; ++op) {
      const Ctx& C = C0;
      const int p = p0;
      bf16_t* HBp = C.HB() + (size_t)p * 128 * 1024;
      float* Hp = C.H() + (size_t)p * 128 * 1024;
      bf16_t* ACTp = C.ACT() + (size_t)p * 128 * 2816;
      int kind = OP_FFN, layer = 0, j = 0;
      switch (op) {
        case 0: kind = OP_FFN; layer = 0; j = 0; break;
        case 1: kind = OP_GMLP; layer = 0; j = 0; break;
        case 2: kind = OP_FFN; layer = 0; j = 1; break;
        case 3: kind = OP_FFN; layer = 1; j = 0; break;
        case 4: kind = OP_HIN; layer = 1; break;
        case 5: kind = OP_HOUT; layer = 1; break;
        case 6: kind = OP_FFN; layer = 1; j = 1; break;
        case 7: kind = OP_FFN; layer = 2; j = 0; break;
        case 8: kind = OP_QKV; layer = 2; break;
        case 9: kind = OP_ATTN; layer = 2; break;
        case 10: kind = OP_FFN; layer = 2; j = 1; break;
        case 11: kind = OP_FFN; layer = 3; j = 0; break;
        case 12: kind = OP_GMLP; layer = 3; j = 1; break;
        default: kind = OP_FFN; layer = 3; j = 1; break;
      }
      if (kind == OP_FFN) {
        ffn_panel(C, p, layer, j, op == 13, smem);
      } else if (kind == OP_GMLP) {
        gmlp_panel(C, p, layer, j, smem);
      } else if (kind == OP_HIN) {
        EpiHgrn e{ACTp, ACTp + 128 * 1024, C.out + (size_t)p * 128 * 1024, C.SG() + (size_t)p * 128 * 1024, C.LB()};
        gemm_panel(HBp, 1024, C.WHI(), 1024, 8, e, smem);
        hgrn_rec<false>(C, p, smem);
      } else if (kind == OP_HOUT) {
        hgrn_rec<true>(C, p, smem);
        EpiResLN e2{Hp, ALPHA, 1.0f, nullptr};
        gemm_panel(HBp, 1024, C.WHO(), 1024, 2, e2, smem);
        const int li = (1 * 3 + 1) * 1024;
        ln_panel(Hp, Hp, HBp, C.in[3] + li, C.in[4] + li);
      } else if (kind == OP_QKV) {
        EpiQkv e{ACTp, C.KB() + (size_t)p * 128 * 128, C.VB() + (size_t)p * 128 * 128, C.in[16]};
        gemm_panel(HBp, 1024, C.WQKV(), 1024, 3, e, smem);
      } else {
        attn_panel(C, p, smem);
        EpiResLN e2{Hp, ALPHA, 1.0f, C.in[19]};
        gemm_panel(HBp, 1024, C.WAO(), 1024, 2, e2, smem);
        const int li = (2 * 3 + 1) * 1024;
        ln_panel(Hp, Hp, HBp, C.in[3] + li, C.in[4] + li);
      }
    }
  }
}

#if COOP
__device__ __forceinline__ void grid_barrier(unsigned* bar, unsigned target) {
  __syncthreads();
  if (threadIdx.x == 0) {
    __threadfence();
    __hip_atomic_fetch_add(bar, 1u, __ATOMIC_RELEASE, __HIP_MEMORY_SCOPE_AGENT);
    while (__hip_atomic_load(bar, __ATOMIC_ACQUIRE, __HIP_MEMORY_SCOPE_AGENT) < target) __builtin_amdgcn_s_sleep(8);
    __threadfence();
  }
  __syncthreads();
}

__global__ void __launch_bounds__(512) mega(Params P) {
  extern __shared__ __attribute__((aligned(16))) unsigned char lds_raw[];
  bf16_t* smem = (bf16_t*)lds_raw;
  Ctx C;
  C.in = P.in;
  C.out = P.out;
  C.ws = P.ws;
  const int lo = P.ph_lo, hi = P.ph_hi;
#if COOP
  if (lo < 0) cg::this_grid().sync();
  unsigned* bar = (unsigned*)(P.ws + OFF_BAR);
#define GSYNC(k) do { if (lo <= (k) && (k) + 1 < hi) grid_barrier(bar, (unsigned)((k) + 1) * gridDim.x); } while (0)
#else
#define GSYNC(k) do { } while (0)
#endif
  if (lo <= 0 && 0 < hi) phase0(C);
  GSYNC(0);
  if (lo <= 1 && 1 < hi) run_ops(C, 0, 5, smem);
  GSYNC(1);
  if (lo <= 2 && 2 < hi) hgrn_scan(C);
  GSYNC(2);
  if (lo <= 3 && 3 < hi) run_ops(C, 5, 9, smem);
  GSYNC(3);
  if (lo <= 4 && 4 < hi) run_ops(C, 9, 14, smem);
}

#endif

#if !COOP
__device__ __forceinline__ Ctx make_ctx(const Params& P) { Ctx C; C.in = P.in; C.out = P.out; C.ws = P.ws; return C; }
#define OPK(name, ...) __global__ void __launch_bounds__(512) name(Params P) { \
    extern __shared__ __attribute__((aligned(16))) unsigned char lds_raw[]; bf16_t* smem = (bf16_t*)lds_raw; \
    Ctx C = make_ctx(P); const int p = blockIdx.x; const int layer = P.ph_lo, j = P.ph_hi; (void)p; (void)layer; (void)j; (void)smem; __VA_ARGS__; }
OPK(k_p0, phase0(C))
OPK(k_ffn, ffn_panel(C, p, layer, j & 1, (j >> 1) != 0, smem))
OPK(k_gmlp, gmlp_panel(C, p, layer, j, smem))
OPK(k_hin, { bf16_t* ACTp = C.ACT() + (size_t)p * 128 * 2816; EpiHgrn e{ACTp, ACTp + 128 * 1024, C.out + (size_t)p * 128 * 1024, C.SG() + (size_t)p * 128 * 1024, C.LB()}; gemm_panel(C.HB() + (size_t)p * 128 * 1024, 1024, C.WHI(), 1024, 8, e, smem); hgrn_rec<false>(C, p, smem); })
OPK(k_scan, hgrn_scan(C))
OPK(k_hout, { hgrn_rec<true>(C, p, smem); float* Hp = C.H() + (size_t)p * 128 * 1024; bf16_t* HBp = C.HB() + (size_t)p * 128 * 1024; EpiResLN e2{Hp, ALPHA, 1.0f, nullptr}; gemm_panel(HBp, 1024, C.WHO(), 1024, 2, e2, smem); ln_panel(Hp, Hp, HBp, C.in[3] + 4 * 1024, C.in[4] + 4 * 1024); })
OPK(k_qkv, { bf16_t* ACTp = C.ACT() + (size_t)p * 128 * 2816; EpiQkv e{ACTp, C.KB() + (size_t)p * 128 * 128, C.VB() + (size_t)p * 128 * 128, C.in[16]}; gemm_panel(C.HB() + (size_t)p * 128 * 1024, 1024, C.WQKV(), 1024, 3, e, smem); })
OPK(k_attn, { attn_panel(C, p, smem); float* Hp = C.H() + (size_t)p * 128 * 1024; bf16_t* HBp = C.HB() + (size_t)p * 128 * 1024; EpiResLN e2{Hp, ALPHA, 1.0f, C.in[19]}; gemm_panel(HBp, 1024, C.WAO(), 1024, 2, e2, smem); ln_panel(Hp, Hp, HBp, C.in[3] + 7 * 1024, C.in[4] + 7 * 1024); })
#endif

extern "C" void kernel_launch(void* const* d_in, const int* in_sizes, int n_in, void* d_out, int out_size, void* d_ws,
                              size_t ws_size, hipStream_t stream) {
  static int grid_blocks = 0;
  if (grid_blocks == 0) {
    if (n_in != 20 || ws_size < WS_END) {
      fprintf(stderr, "kernel_launch: unexpected n_in %d or ws_size %zu (need %zu)\n", n_in, ws_size, (size_t)WS_END);
      grid_blocks = -1;
      return;
    }
    int dev = 0, cus = 0, per_cu = 0;
    hipGetDevice(&dev);
    hipDeviceGetAttribute(&cus, hipDeviceAttributeMultiprocessorCount, dev);
#if COOP
    if (hipFuncSetAttribute((const void*)mega, hipFuncAttributeMaxDynamicSharedMemorySize, LDS_BYTES) != hipSuccess)
      fprintf(stderr, "kernel_launch: hipFuncSetAttribute failed\n");
    hipOccupancyMaxActiveBlocksPerMultiprocessor(&per_cu, (const void*)mega, 512, LDS_BYTES);
#else
    const void* ks[] = {(const void*)k_p0, (const void*)k_ffn, (const void*)k_gmlp, (const void*)k_hin, (const void*)k_scan, (const void*)k_hout, (const void*)k_qkv, (const void*)k_attn};
    for (int i = 0; i < 8; ++i) (void)hipFuncSetAttribute(ks[i], hipFuncAttributeMaxDynamicSharedMemorySize, LDS_BYTES);
    per_cu = 1;
#endif
    (void)hipGetLastError();
    if (per_cu < 1) per_cu = 1;
    grid_blocks = cus * per_cu;
    if (grid_blocks > NPANEL) grid_blocks = NPANEL;
    if (grid_blocks < 1) grid_blocks = NPANEL;
  }
  if (grid_blocks < 0) return;
  Params P{};
  for (int i = 0; i < 20; ++i) P.in[i] = (const float*)d_in[i];
  P.out = (float*)d_out;
  P.ws = (unsigned char*)d_ws;
#if COOP
  P.ph_lo = 0; P.ph_hi = 5;
  (void)hipMemsetAsync((unsigned char*)d_ws + OFF_BAR, 0, 256, stream);
  void* args[] = {&P};
  hipError_t e = hipLaunchCooperativeKernel((const void*)mega, dim3(grid_blocks), dim3(512), args, LDS_BYTES, stream);
  if (e != hipSuccess) fprintf(stderr, "cooperative launch failed: %s (grid %d)\n", hipGetErrorString(e), grid_blocks);
#else
#define LAUNCH(k, a, b) do { P.ph_lo = (a); P.ph_hi = (b); hipLaunchKernelGGL(k, dim3(NPANEL), dim3(512), LDS_BYTES, stream, P); } while (0)
  LAUNCH(k_p0, 0, 0);
  LAUNCH(k_ffn, 0, 0); LAUNCH(k_gmlp, 0, 0); LAUNCH(k_ffn, 0, 1);
  LAUNCH(k_ffn, 1, 0); LAUNCH(k_hin, 0, 0); LAUNCH(k_scan, 0, 0); LAUNCH(k_hout, 0, 0); LAUNCH(k_ffn, 1, 1);
  LAUNCH(k_ffn, 2, 0); LAUNCH(k_qkv, 0, 0); LAUNCH(k_attn, 0, 0); LAUNCH(k_ffn, 2, 1);
  LAUNCH(k_ffn, 3, 0); LAUNCH(k_gmlp, 3, 1); LAUNCH(k_ffn, 3, 3);
#endif
}
```

```cpp
#include <hip/hip_runtime.h>
#include <hip/hip_cooperative_groups.h>
#include <stdint.h>
#include <stdio.h>
namespace cg = cooperative_groups;

#ifndef COOP
#define COOP 1
#endif

typedef unsigned short bf16_t;
typedef __attribute__((ext_vector_type(8))) __bf16 bfrag;
typedef __attribute__((ext_vector_type(16))) float f32x16;

constexpr int T_TOK = 32768;
constexpr int NPANEL = 256;
constexpr float ALPHA = 1.6817928305074290f;
constexpr int LDS_BYTES = 122880;

constexpr size_t SZ_WGU = (size_t)8 * 5632 * 1024 * 2;
constexpr size_t SZ_WD = (size_t)8 * 1024 * 2816 * 2;
constexpr size_t SZ_WGI = (size_t)2 * 2048 * 1024 * 2;
constexpr size_t SZ_WGO = (size_t)2 * 1024 * 1024 * 2;
constexpr size_t SZ_WSP = (size_t)2 * 8 * 128 * 128 * 2;
constexpr size_t SZ_WHI = (size_t)4096 * 1024 * 2;
constexpr size_t SZ_WHO = (size_t)1024 * 1024 * 2;
constexpr size_t SZ_WQKV = (size_t)1536 * 1024 * 2;
constexpr size_t SZ_WAO = (size_t)1024 * 1024 * 2;
constexpr size_t SZ_LB = 4096;
constexpr size_t SZ_H = (size_t)T_TOK * 1024 * 4;
constexpr size_t SZ_HB = (size_t)T_TOK * 1024 * 2;
constexpr size_t SZ_ACT = (size_t)T_TOK * 2816 * 2;
constexpr size_t SZ_SG = (size_t)T_TOK * 1024 * 2;
constexpr size_t SZ_DS = (size_t)NPANEL * 8 * 128 * 128 * 2;
constexpr size_t SZ_DEC = (size_t)NPANEL * 8 * 128 * 4;
constexpr size_t SZ_KB = (size_t)T_TOK * 128 * 2;

constexpr size_t OFF_WGU = 0;
constexpr size_t OFF_WD = OFF_WGU + SZ_WGU;
constexpr size_t OFF_WGI = OFF_WD + SZ_WD;
constexpr size_t OFF_WGO = OFF_WGI + SZ_WGI;
constexpr size_t OFF_WSP = OFF_WGO + SZ_WGO;
constexpr size_t OFF_WHI = OFF_WSP + SZ_WSP;
constexpr size_t OFF_WHO = OFF_WHI + SZ_WHI;
constexpr size_t OFF_WQKV = OFF_WHO + SZ_WHO;
constexpr size_t OFF_WAO = OFF_WQKV + SZ_WQKV;
constexpr size_t OFF_LB = OFF_WAO + SZ_WAO;
constexpr size_t OFF_H = OFF_LB + SZ_LB;
constexpr size_t OFF_HB = OFF_H + SZ_H;
constexpr size_t OFF_ACT = OFF_HB + SZ_HB;
constexpr size_t OFF_SG = OFF_ACT + SZ_ACT;
constexpr size_t OFF_DS = OFF_SG + SZ_SG;
constexpr size_t OFF_DEC = OFF_DS + SZ_DS;
constexpr size_t OFF_KB = OFF_DEC + SZ_DEC;
constexpr size_t OFF_VB = OFF_KB + SZ_KB;
constexpr size_t OFF_BAR = OFF_VB + SZ_KB;
constexpr size_t WS_END = OFF_BAR + 256;

struct Params {
  const float* in[20];
  float* out;
  unsigned char* ws;
  int ph_lo, ph_hi;
};

struct Ctx {
  const float* const* in;
  float* out;
  unsigned char* ws;
  __device__ __forceinline__ bf16_t* WGU() const { return (bf16_t*)(ws + OFF_WGU); }
  __device__ __forceinline__ bf16_t* WD() const { return (bf16_t*)(ws + OFF_WD); }
  __device__ __forceinline__ bf16_t* WGI() const { return (bf16_t*)(ws + OFF_WGI); }
  __device__ __forceinline__ bf16_t* WGO() const { return (bf16_t*)(ws + OFF_WGO); }
  __device__ __forceinline__ bf16_t* WSP() const { return (bf16_t*)(ws + OFF_WSP); }
  __device__ __forceinline__ bf16_t* WHI() const { return (bf16_t*)(ws + OFF_WHI); }
  __device__ __forceinline__ bf16_t* WHO() const { return (bf16_t*)(ws + OFF_WHO); }
  __device__ __forceinline__ bf16_t* WQKV() const { return (bf16_t*)(ws + OFF_WQKV); }
  __device__ __forceinline__ bf16_t* WAO() const { return (bf16_t*)(ws + OFF_WAO); }
  __device__ __forceinline__ float* LB() const { return (float*)(ws + OFF_LB); }
  __device__ __forceinline__ float* H() const { return (float*)(ws + OFF_H); }
  __device__ __forceinline__ bf16_t* HB() const { return (bf16_t*)(ws + OFF_HB); }
  __device__ __forceinline__ bf16_t* ACT() const { return (bf16_t*)(ws + OFF_ACT); }
  __device__ __forceinline__ bf16_t* SG() const { return (bf16_t*)(ws + OFF_SG); }
  __device__ __forceinline__ bf16_t* DS() const { return (bf16_t*)(ws + OFF_DS); }
  __device__ __forceinline__ float* DEC() const { return (float*)(ws + OFF_DEC); }
  __device__ __forceinline__ bf16_t* KB() const { return (bf16_t*)(ws + OFF_KB); }
  __device__ __forceinline__ bf16_t* VB() const { return (bf16_t*)(ws + OFF_VB); }
};

__device__ __forceinline__ bf16_t f2bf(float f) {
  uint32_t u = __float_as_uint(f);
  u += 0x7fffu + ((u >> 16) & 1u);
  return (bf16_t)(u >> 16);
}
__device__ __forceinline__ float bf2f(bf16_t b) { return __uint_as_float(((uint32_t)b) << 16); }
__device__ __forceinline__ uint32_t pack2(float a, float b) { return (uint32_t)f2bf(a) | ((uint32_t)f2bf(b) << 16); }
__device__ __forceinline__ float wave_sum(float v) {
  v += __shfl_xor(v, 32, 64); v += __shfl_xor(v, 16, 64); v += __shfl_xor(v, 8, 64);
  v += __shfl_xor(v, 4, 64); v += __shfl_xor(v, 2, 64); v += __shfl_xor(v, 1, 64);
  return v;
}
__device__ __forceinline__ float silu_f(float x) { return x * __frcp_rn(1.f + __expf(-x)); }
#define ROWMAP(reg, lane) ((((reg)&3)) + 8 * ((reg) >> 2) + 4 * ((lane) >> 5))
#define MFMA(a, b, c) __builtin_amdgcn_mfma_f32_32x32x16_bf16((a), (b), (c), 0, 0, 0)

__device__ __forceinline__ int opaque_tid() {
  int t = threadIdx.x;
  asm volatile("" : "+v"(t));
  return t;
}

__device__ __forceinline__ unsigned long long opaque_u64(unsigned long long v) {
  unsigned lo = (unsigned)v, hi = (unsigned)(v >> 32);
  asm volatile("" : "+v"(lo), "+v"(hi));
  lo = __builtin_amdgcn_readfirstlane(lo);
  hi = __builtin_amdgcn_readfirstlane(hi);
  return ((unsigned long long)hi << 32) | lo;
}

__device__ __forceinline__ f32x16 zero16() {
  f32x16 z;
#pragma unroll
  for (int i = 0; i < 16; ++i) z[i] = 0.f;
  return z;
}

constexpr int G_STAGE_B = 40960;

__device__ __forceinline__ void glds16(const bf16_t* g, const char* l) {
  __builtin_amdgcn_global_load_lds((const unsigned*)g, (unsigned*)const_cast<char*>(l), 16, 0, 0);
}

#define RDFRAGS(F, stg, ok)                                                              \
  do {                                                                                   \
    const char* sa_ = lds + (stg) * G_STAGE_B + wm * 4096 + (ok);                         \
    const char* sb_ = lds + (stg) * G_STAGE_B + 8192 + wn * 8192 + (ok);                  \
    F[0] = *(const bfrag*)(sa_);                                                         \
    F[1] = *(const bfrag*)(sa_ + 2048);                                                  \
    F[2] = *(const bfrag*)(sb_);                                                         \
    F[3] = *(const bfrag*)(sb_ + 2048);                                                  \
    F[4] = *(const bfrag*)(sb_ + 4096);                                                  \
    F[5] = *(const bfrag*)(sb_ + 6144);                                                  \
  } while (0)
#define DOMFMA(F)                                                                        \
  do {                                                                                   \
    _Pragma("unroll") for (int ni_ = 0; ni_ < 4; ++ni_) {                                \
      acc[0][ni_] = MFMA(F[0], F[2 + ni_], acc[0][ni_]);                                 \
      acc[1][ni_] = MFMA(F[1], F[2 + ni_], acc[1][ni_]);                                 \
    }                                                                                    \
  } while (0)
#define ISSUE_SLAB(stg, ntv, krv)                                                        \
  do {                                                                                   \
    const char* st_ = lds + (stg) * G_STAGE_B + w * 1024;                                    \
    glds16(a_src + (krv) * 32, st_);                                                     \
    const bf16_t* bs_ = b_src + (size_t)((ntv) * nk + (krv)) * 16384;                    \
    _Pragma("unroll") for (int i_ = 0; i_ < 4; ++i_) glds16(bs_ + i_ * 4096, st_ + 8192 + i_ * 8192); \
  } while (0)

template <class Epi>
__device__ __forceinline__ void gemm_panel(const bf16_t* __restrict__ A, const int lda, const bf16_t* __restrict__ Wb,
                                           const int K, const int nN, const Epi epi, bf16_t* smem) {
  const int tid = opaque_tid(), lane = tid & 63;
  const int w = __builtin_amdgcn_readfirstlane(tid >> 6);
  const int wm = w & 1, wn = w >> 1;
  const int nk = K >> 5;
  const int total = nN * nk;
  const int l31 = lane & 31, h = lane >> 5;
  const int grow = lane >> 2;
  const int gch = (lane & 3) ^ ((lane >> 4) & 3);
  const bf16_t* a_src = A + (size_t)(w * 16 + grow) * lda + gch * 8;
  const bf16_t* b_src = Wb + (size_t)(w * 16 + grow) * 32 + gch * 8;
  const char* lds = (const char*)smem;
  const int pos0 = h ^ ((l31 >> 2) & 3);
  const int offk0 = l31 * 64 + pos0 * 16;
  const int offk1 = l31 * 64 + (pos0 ^ 2) * 16;
  f32x16 acc[2][4];
#pragma unroll
  for (int i = 0; i < 2; ++i)
#pragma unroll
    for (int j = 0; j < 4; ++j) acc[i][j] = zero16();
  const int rot = (int)(((blockIdx.x >> 3) & 31) * nk) >> 5;
  int kr3 = rot, nt3 = 0, cnt3 = 0;
  __syncthreads();
#pragma unroll
  for (int s3 = 0; s3 < 3; ++s3) {
    ISSUE_SLAB(s3, nt3, kr3);
    ++kr3; if (kr3 == nk) kr3 = 0;
    ++cnt3; if (cnt3 == nk) { cnt3 = 0; ++nt3; }
  }
  asm volatile("s_waitcnt vmcnt(10)" ::: "memory");
  asm volatile("s_waitcnt lgkmcnt(0)" ::: "memory");
  __builtin_amdgcn_s_barrier();
  asm volatile("" ::: "memory");
  bfrag F0[6], F1[6];
  RDFRAGS(F0, 0, offk0);
  int ks = 0, nt = 0, stage = 0, stage_n = 1;
  for (int it = 0; it < total; ++it) {
    RDFRAGS(F1, stage, offk1);
    DOMFMA(F0);
    __builtin_amdgcn_sched_group_barrier(0x100, 2, 0);
    __builtin_amdgcn_sched_group_barrier(0x008, 1, 0);
    __builtin_amdgcn_sched_group_barrier(0x100, 2, 0);
    __builtin_amdgcn_sched_group_barrier(0x008, 1, 0);
    __builtin_amdgcn_sched_group_barrier(0x100, 2, 0);
    __builtin_amdgcn_sched_group_barrier(0x008, 6, 0);
    __builtin_amdgcn_sched_barrier(0);
    asm volatile("s_waitcnt vmcnt(5)" ::: "memory");
    asm volatile("s_waitcnt lgkmcnt(0)" ::: "memory");
    __builtin_amdgcn_s_barrier();
    asm volatile("" ::: "memory");
    __builtin_amdgcn_sched_barrier(0);
    ISSUE_SLAB(stage, nt3, kr3);
    RDFRAGS(F0, stage_n, offk0);
    DOMFMA(F1);
    __builtin_amdgcn_sched_group_barrier(0x008, 1, 1);
    __builtin_amdgcn_sched_group_barrier(0x020, 1, 1);
    __builtin_amdgcn_sched_group_barrier(0x100, 2, 1);
    __builtin_amdgcn_sched_group_barrier(0x008, 1, 1);
    __builtin_amdgcn_sched_group_barrier(0x020, 1, 1);
    __builtin_amdgcn_sched_group_barrier(0x100, 2, 1);
    __builtin_amdgcn_sched_group_barrier(0x008, 1, 1);
    __builtin_amdgcn_sched_group_barrier(0x020, 1, 1);
    __builtin_amdgcn_sched_group_barrier(0x100, 2, 1);
    __builtin_amdgcn_sched_group_barrier(0x008, 1, 1);
    __builtin_amdgcn_sched_group_barrier(0x020, 1, 1);
    __builtin_amdgcn_sched_group_barrier(0x008, 1, 1);
    __builtin_amdgcn_sched_group_barrier(0x020, 1, 1);
    __builtin_amdgcn_sched_group_barrier(0x008, 3, 1);
    __builtin_amdgcn_sched_barrier(0);
    ++kr3; if (kr3 == nk) kr3 = 0;
    ++cnt3; if (cnt3 == nk) { cnt3 = 0; ++nt3; }
    if (ks == nk - 1) {
      epi(acc, nt, wm, wn, lane);
#pragma unroll
      for (int i = 0; i < 2; ++i)
#pragma unroll
        for (int j = 0; j < 4; ++j) acc[i][j] = zero16();
      ++nt;
      asm volatile("s_waitcnt vmcnt(0)" ::: "memory");
      RDFRAGS(F0, stage_n, offk0);
    }
    ++ks; if (ks == nk) ks = 0;
    stage = stage_n;
    ++stage_n; if (stage_n == 3) stage_n = 0;
  }
  asm volatile("s_waitcnt vmcnt(0)" ::: "memory");
  __syncthreads();
}

struct EpiSwiglu {
  bf16_t* act;
  __device__ __forceinline__ void operator()(f32x16 (&acc)[2][4], int nt, int wm, int wn, int lane_in) const {
    int lane = lane_in;
    asm volatile("" : "+v"(lane));
    const int l31 = lane & 31;
#pragma unroll
    for (int mi = 0; mi < 2; ++mi)
#pragma unroll
      for (int n2 = 0; n2 < 2; ++n2)
#pragma unroll
        for (int r = 0; r < 16; ++r) {
          const int row = wm * 64 + mi * 32 + ROWMAP(r, lane);
          const int col = (nt * 4 + wn) * 64 + n2 * 32 + l31;
          const float g = acc[mi][n2][r], u = acc[mi][n2 + 2][r];
          act[(size_t)row * 2816 + col] = f2bf(silu_f(g) * u);
        }
  }
};
struct EpiResLN {
  float* Hp;
  float alpha, c;
  const float* bias;
  __device__ __forceinline__ void operator()(f32x16 (&acc)[2][4], int nt, int wm, int wn, int lane_in) const {
    int lane = lane_in;
    asm volatile("" : "+v"(lane));
    const int l31 = lane & 31;
    float* base = Hp + (size_t)(wm * 64 + 4 * (lane >> 5)) * 1024 + nt * 512 + wn * 128 + l31;
#pragma unroll
    for (int ni = 0; ni < 4; ++ni) {
      const float bv = bias ? bias[nt * 512 + wn * 128 + ni * 32 + l31] : 0.f;
#pragma unroll
      for (int mi = 0; mi < 2; ++mi) {
        float hv[16];
#pragma unroll
        for (int r = 0; r < 16; ++r) hv[r] = base[(size_t)(mi * 32 + (r & 3) + 8 * (r >> 2)) * 1024 + ni * 32];
#pragma unroll
        for (int r = 0; r < 16; ++r)
          base[(size_t)(mi * 32 + (r & 3) + 8 * (r >> 2)) * 1024 + ni * 32] = alpha * hv[r] + c * (acc[mi][ni][r] + bv);
        __builtin_amdgcn_sched_barrier(0);
      }
    }
  }
};
struct EpiGelu {
  bf16_t* Z;
  __device__ __forceinline__ void operator()(f32x16 (&acc)[2][4], int nt, int wm, int wn, int lane_in) const {
    int lane = lane_in;
    asm volatile("" : "+v"(lane));
    const int l31 = lane & 31;
#pragma unroll
    for (int ni = 0; ni < 4; ++ni) {
      const int col = nt * 512 + wn * 128 + ni * 32 + l31;
#pragma unroll
      for (int mi = 0; mi < 2; ++mi)
#pragma unroll
        for (int r = 0; r < 16; ++r) {
          const int row = wm * 64 + mi * 32 + ROWMAP(r, lane);
          const float x = acc[mi][ni][r];
          Z[(size_t)row * 2048 + col] = f2bf(0.5f * x * (1.f + erff(x * 0.70710678118654752f)));
        }
    }
  }
};
struct EpiHgrn {
  bf16_t* Qp;
  bf16_t* Vp;
  float* LFp;
  bf16_t* SGp;
  const float* lb;
  __device__ __forceinline__ void operator()(f32x16 (&acc)[2][4], int nt, int wm, int wn, int lane_in) const {
    int lane = lane_in;
    asm volatile("" : "+v"(lane));
    const int l31 = lane & 31;
    const int sec = nt >> 1;
    const int cb = (nt & 1) * 512 + wn * 128 + l31;
    const int rb = wm * 64 + 4 * (lane >> 5);
    if (sec == 0 || sec == 3) {
      bf16_t* dst = (sec == 0) ? Qp : SGp;
#pragma unroll
      for (int ni = 0; ni < 4; ++ni)
#pragma unroll
        for (int mi = 0; mi < 2; ++mi)
#pragma unroll
          for (int r = 0; r < 16; ++r) {
            const int row = rb + mi * 32 + (r & 3) + 8 * (r >> 2);
            dst[(size_t)row * 1024 + cb + ni * 32] = f2bf(silu_f(acc[mi][ni][r]));
          }
    } else if (sec == 1) {
#pragma unroll
      for (int ni = 0; ni < 4; ++ni) {
        const float lbv = lb[cb + ni * 32];
#pragma unroll
        for (int mi = 0; mi < 2; ++mi)
#pragma unroll
          for (int r = 0; r < 16; ++r) {
            const int row = rb + mi * 32 + (r & 3) + 8 * (r >> 2);
            const float f = lbv + (1.f - lbv) * __frcp_rn(1.f + __expf(-acc[mi][ni][r]));
            LFp[(size_t)row * 1024 + cb + ni * 32] = __logf(f);
          }
      }
    } else {
#pragma unroll
      for (int ni = 0; ni < 4; ++ni)
#pragma unroll
        for (int mi = 0; mi < 2; ++mi)
#pragma unroll
          for (int r = 0; r < 16; ++r) {
            const int row = rb + mi * 32 + (r & 3) + 8 * (r >> 2);
            Vp[(size_t)row * 1024 + cb + ni * 32] = f2bf(acc[mi][ni][r]);
          }
    }
  }
};
struct EpiQkv {
  bf16_t* Qp;
  bf16_t* Kp;
  bf16_t* Vp;
  const float* bias;
  __device__ __forceinline__ void operator()(f32x16 (&acc)[2][4], int nt, int wm, int wn, int lane_in) const {
    int lane = lane_in;
    asm volatile("" : "+v"(lane));
    const int l31 = lane & 31;
#pragma unroll
    for (int ni = 0; ni < 4; ++ni) {
      const int col = nt * 512 + wn * 128 + ni * 32 + l31;
      if (col < 1280) {
        const float bv = bias[col];
#pragma unroll
        for (int mi = 0; mi < 2; ++mi)
#pragma unroll
          for (int r = 0; r < 16; ++r) {
            const int row = wm * 64 + mi * 32 + ROWMAP(r, lane);
            const float x = acc[mi][ni][r] + bv;
            if (col < 1024) Qp[(size_t)row * 1024 + col] = f2bf(x * 0.125f);
            else if (col < 1152) Kp[(size_t)row * 128 + (col - 1024)] = f2bf(x);
            else Vp[(size_t)row * 128 + (col - 1152)] = f2bf(x);
          }
      }
    }
  }
};

__device__ __forceinline__ void ln_panel(const float* Hp, float* outp, bf16_t* HBp, const float* g, const float* b) {
  const int tid = opaque_tid(), lane = tid & 63;
  const int w = __builtin_amdgcn_readfirstlane(tid >> 6);
  float4 gv[4], bv[4];
#pragma unroll
  for (int j = 0; j < 4; ++j) {
    gv[j] = *(const float4*)(g + j * 256 + lane * 4);
    bv[j] = *(const float4*)(b + j * 256 + lane * 4);
  }
  for (int r = w; r < 128; r += 8) {
    float4 x[4];
    float s = 0.f;
#pragma unroll
    for (int j = 0; j < 4; ++j) {
      x[j] = *(const float4*)(Hp + (size_t)r * 1024 + j * 256 + lane * 4);
      s += x[j].x + x[j].y + x[j].z + x[j].w;
    }
    s = wave_sum(s);
    const float mean = s * (1.f / 1024.f);
    float v = 0.f;
#pragma unroll
    for (int j = 0; j < 4; ++j) {
      x[j].x -= mean; x[j].y -= mean; x[j].z -= mean; x[j].w -= mean;
      v += x[j].x * x[j].x + x[j].y * x[j].y + x[j].z * x[j].z + x[j].w * x[j].w;
    }
    v = wave_sum(v);
    const float rstd = 1.0f / sqrtf(v * (1.f / 1024.f) + 1e-5f);
#pragma unroll
    for (int j = 0; j < 4; ++j) {
      float4 y;
      y.x = x[j].x * rstd * gv[j].x + bv[j].x;
      y.y = x[j].y * rstd * gv[j].y + bv[j].y;
      y.z = x[j].z * rstd * gv[j].z + bv[j].z;
      y.w = x[j].w * rstd * gv[j].w + bv[j].w;
      *(float4*)(outp + (size_t)r * 1024 + j * 256 + lane * 4) = y;
      uint2 pk;
      pk.x = pack2(y.x, y.y);
      pk.y = pack2(y.z, y.w);
      *(uint2*)(HBp + (size_t)r * 1024 + j * 256 + lane * 4) = pk;
    }
  }
  __syncthreads();
}

__device__ __forceinline__ void ffn_panel(const Ctx& C, int p, int layer, int j, bool final_out, bf16_t* smem) {
  const int wi = layer * 2 + j;
  bf16_t* HBp = C.HB() + (size_t)p * 128 * 1024;
  bf16_t* ACTp = C.ACT() + (size_t)p * 128 * 2816;
  float* Hp = C.H() + (size_t)p * 128 * 1024;
  EpiSwiglu e1{ACTp};
  gemm_panel(HBp, 1024, C.WGU() + (size_t)wi * 5632 * 1024, 1024, 11, e1, smem);
  EpiResLN e2{Hp, ALPHA, 0.5f, nullptr};
  gemm_panel(ACTp, 2816, C.WD() + (size_t)wi * 1024 * 2816, 2816, 2, e2, smem);
  const int li = (layer * 3 + (j == 0 ? 0 : 2)) * 1024;
  float* outp = final_out ? (C.out + (size_t)p * 128 * 1024) : Hp;
  ln_panel(Hp, outp, HBp, C.in[3] + li, C.in[4] + li);
}

__device__ __forceinline__ void gmlp_panel(const Ctx& C, int p, int layer, int slot, bf16_t* smem) {
  const int tid = opaque_tid(), lane = tid & 63;
  const int w = __builtin_amdgcn_readfirstlane(tid >> 6);
  const int l31 = lane & 31, h8 = (lane >> 5) * 8;
  bf16_t* HBp = C.HB() + (size_t)p * 128 * 1024;
  bf16_t* Zp = C.ACT() + (size_t)p * 128 * 2816;
  float* Hp = C.H() + (size_t)p * 128 * 1024;
  {
    EpiGelu e{Zp};
    gemm_panel(HBp, 1024, C.WGI() + (size_t)slot * 2048 * 1024, 1024, 4, e, smem);
  }
  bf16_t* As = smem;
  bf16_t* Bs = smem + 128 * 136;
  float* st = (float*)(smem + 2 * 128 * 136);
  for (int r = w; r < 128; r += 8) {
    const uint4 q0 = *(const uint4*)(Zp + (size_t)r * 2048 + 1024 + lane * 16);
    const uint4 q1 = *(const uint4*)(Zp + (size_t)r * 2048 + 1024 + lane * 16 + 8);
    const uint32_t u[8] = {q0.x, q0.y, q0.z, q0.w, q1.x, q1.y, q1.z, q1.w};
    float x[16];
    float s = 0.f;
#pragma unroll
    for (int e = 0; e < 8; ++e) {
      x[2 * e] = __uint_as_float(u[e] << 16);
      x[2 * e + 1] = __uint_as_float(u[e] & 0xffff0000u);
      s += x[2 * e] + x[2 * e + 1];
    }
    s = wave_sum(s);
    const float mean = s * (1.f / 1024.f);
    float v = 0.f;
#pragma unroll
    for (int e = 0; e < 16; ++e) { const float d = x[e] - mean; v += d * d; }
    v = wave_sum(v);
    if (lane == 0) { st[r * 2] = mean; st[r * 2 + 1] = 1.0f / sqrtf(v * (1.f / 1024.f) + 1e-5f); }
  }
  __syncthreads();
  const float* lng = C.in[6] + slot * 1024;
  const float* lnb = C.in[7] + slot * 1024;
  const float* bsp = C.in[9] + slot * 1024;
  const bf16_t* Wsp = C.WSP() + (size_t)slot * 8 * 16384;
  const int nd = w & 3, mt0 = (w >> 2) * 2;
  for (int g = 0; g < 8; ++g) {
#pragma unroll
    for (int i = 0; i < 4; ++i) {
      const int c = tid + 512 * i;
      *(uint4*)(As + (c >> 4) * 136 + (c & 15) * 8) = *(const uint4*)(Wsp + (size_t)g * 16384 + c * 8);
    }
    {
      const int s = tid >> 2, dq = tid & 3;
      const float mean = st[s * 2], rstd = st[s * 2 + 1];
      const bf16_t* src = Zp + (size_t)s * 2048 + 1024 + g * 128 + dq * 32;
#pragma unroll
      for (int q = 0; q < 4; ++q) {
        const uint4 v4 = *(const uint4*)(src + q * 8);
        const uint32_t u[4] = {v4.x, v4.y, v4.z, v4.w};
#pragma unroll
        for (int e = 0; e < 4; ++e) {
          const int d0 = dq * 32 + q * 8 + e * 2;
          const int ch = g * 128 + d0;
          const float x0 = __uint_as_float(u[e] << 16), x1 = __uint_as_float(u[e] & 0xffff0000u);
          Bs[d0 * 136 + s] = f2bf((x0 - mean) * rstd * lng[ch] + lnb[ch]);
          Bs[(d0 + 1) * 136 + s] = f2bf((x1 - mean) * rstd * lng[ch + 1] + lnb[ch + 1]);
        }
      }
    }
    __syncthreads();
    f32x16 acc[2];
    acc[0] = zero16(); acc[1] = zero16();
#pragma unroll
    for (int k16 = 0; k16 < 8; ++k16) {
      const bfrag b = *(const bfrag*)(Bs + (nd * 32 + l31) * 136 + k16 * 16 + h8);
#pragma unroll
      for (int mi = 0; mi < 2; ++mi) {
        const bfrag a = *(const bfrag*)(As + ((mt0 + mi) * 32 + l31) * 136 + k16 * 16 + h8);
        acc[mi] = MFMA(a, b, acc[mi]);
      }
    }
#pragma unroll
    for (int mi = 0; mi < 2; ++mi)
#pragma unroll
      for (int r = 0; r < 16; ++r) {
        const int t = (mt0 + mi) * 32 + ROWMAP(r, lane);
        const int ch = g * 128 + nd * 32 + l31;
        const float mixed = acc[mi][r] + bsp[g * 128 + t];
        const float u = bf2f(Zp[(size_t)t * 2048 + ch]);
        HBp[(size_t)t * 1024 + ch] = f2bf(u * mixed);
      }
    __syncthreads();
  }
  {
    EpiResLN e2{Hp, ALPHA, 1.0f, nullptr};
    gemm_panel(HBp, 1024, C.WGO() + (size_t)slot * 1024 * 1024, 1024, 2, e2, smem);
  }
  const int li = (layer * 3 + 1) * 1024;
  ln_panel(Hp, Hp, HBp, C.in[3] + li, C.in[4] + li);
}

template <bool OUT>
__device__ __forceinline__ void hgrn_rec(const Ctx& C, int p, bf16_t* smem) {
  const int tid = opaque_tid(), lane = tid & 63;
  const int w = __builtin_amdgcn_readfirstlane(tid >> 6);
  const int l31 = lane & 31, h8 = (lane >> 5) * 8;
  bf16_t* ST = smem;
  bf16_t* Qh = smem + 17408;
  bf16_t* Kh = smem + 21760;
  bf16_t* KhT = smem + 26112;
  bf16_t* vT = smem + 31232;
  bf16_t* Ps = smem + 36352;
  float* seg = (float*)(smem + 37632);
  float* dec = seg + 512;
  float* oF = dec + 128;
  const size_t row0 = (size_t)p * 128;
  const bf16_t* Qp = C.ACT() + (size_t)p * 128 * 2816;
  const bf16_t* Vp = Qp + 128 * 1024;
  const float* LFp = C.out + row0 * 1024;
  const bf16_t* SGp = C.SG() + row0 * 1024;
  bf16_t* HBp = C.HB() + row0 * 1024;
  const float* ng = C.in[13];
  const int jt = w >> 1, kt0 = (w & 1) * 2;
  const int kq = tid & 127, tq = tid >> 7;
  for (int h = 0; h < 8; ++h) {
    f32x16 accS[2];
    bf16_t* SBh = C.DS() + ((size_t)(p * 8 + h)) * 16384;
    if (OUT) {
      __syncthreads();
#pragma unroll
      for (int i = 0; i < 4; ++i) {
        const int c = tid + 512 * i;
        *(uint4*)(ST + (c >> 4) * 136 + (c & 15) * 8) = *(const uint4*)(SBh + c * 8);
      }
      __syncthreads();
#pragma unroll
      for (int c2 = 0; c2 < 2; ++c2)
#pragma unroll
        for (int r = 0; r < 16; ++r)
          accS[c2][r] = bf2f(ST[(jt * 32 + ROWMAP(r, lane)) * 136 + (kt0 + c2) * 32 + l31]);
    } else {
      accS[0] = zero16(); accS[1] = zero16();
    }
    float dsum = 0.f;
    for (int i = 0; i < 4; ++i) {
      float l[8], cs[8];
      const size_t gbase = (size_t)(i * 32 + tq * 8) * 1024 + h * 128 + kq;
#pragma unroll
      for (int e = 0; e < 8; ++e) l[e] = LFp[gbase + (size_t)e * 1024];
      cs[0] = l[0];
#pragma unroll
      for (int e = 1; e < 8; ++e) cs[e] = cs[e - 1] + l[e];
      seg[tq * 128 + kq] = cs[7];
#pragma unroll
      for (int e = 0; e < 8; ++e) vT[kq * 40 + tq * 8 + e] = Vp[gbase + (size_t)e * 1024];
      __syncthreads();
      float off = 0.f, tot = 0.f;
#pragma unroll
      for (int q = 0; q < 4; ++q) {
        const float s = seg[q * 128 + kq];
        if (q < tq) off += s;
        tot += s;
      }
#pragma unroll
      for (int e = 0; e < 8; ++e) {
        const float gc = cs[e] + off;
        const float f = __expf(l[e]);
        const float kh = (1.f - f) * __expf(-gc);
        const bf16_t khb = f2bf(kh);
        const int t = tq * 8 + e;
        KhT[kq * 40 + t] = khb;
        if (OUT) {
          Kh[t * 136 + kq] = khb;
          const float qv = bf2f(Qp[gbase + (size_t)e * 1024]);
          Qh[t * 136 + kq] = f2bf(qv * __expf(gc));
        }
      }
      if (tq == 0) { dec[kq] = __expf(tot); dsum += tot; }
      __syncthreads();
      f32x16 accO = zero16();
      if (OUT) {
        if (w == 0) {
          f32x16 accP = zero16();
#pragma unroll
          for (int k16 = 0; k16 < 8; ++k16) {
            const bfrag a = *(const bfrag*)(Qh + l31 * 136 + k16 * 16 + h8);
            const bfrag b = *(const bfrag*)(Kh + l31 * 136 + k16 * 16 + h8);
            accP = MFMA(a, b, accP);
          }
#pragma unroll
          for (int r = 0; r < 16; ++r) {
            const int t = ROWMAP(r, lane);
            Ps[t * 40 + l31] = (l31 <= t) ? f2bf(accP[r]) : (bf16_t)0;
          }
        } else if (w <= 4) {
          const int nt = w - 1;
#pragma unroll
          for (int k16 = 0; k16 < 8; ++k16) {
            const bfrag a = *(const bfrag*)(Qh + l31 * 136 + k16 * 16 + h8);
            const bfrag b = *(const bfrag*)(ST + (nt * 32 + l31) * 136 + k16 * 16 + h8);
            accO = MFMA(a, b, accO);
          }
        }
        __syncthreads();
        if (w >= 1 && w <= 4) {
          const int nt = w - 1;
#pragma unroll
          for (int k16 = 0; k16 < 2; ++k16) {
            const bfrag a = *(const bfrag*)(Ps + l31 * 40 + k16 * 16 + h8);
            const bfrag b = *(const bfrag*)(vT + (nt * 32 + l31) * 40 + k16 * 16 + h8);
            accO = MFMA(a, b, accO);
          }
#pragma unroll
          for (int r = 0; r < 16; ++r) oF[ROWMAP(r, lane) * 132 + nt * 32 + l31] = accO[r];
        }
      }
#pragma unroll
      for (int c2 = 0; c2 < 2; ++c2) {
#pragma unroll
        for (int k16 = 0; k16 < 2; ++k16) {
          const bfrag a = *(const bfrag*)(vT + (jt * 32 + l31) * 40 + k16 * 16 + h8);
          const bfrag b = *(const bfrag*)(KhT + ((kt0 + c2) * 32 + l31) * 40 + k16 * 16 + h8);
          accS[c2] = MFMA(a, b, accS[c2]);
        }
        const float dk = dec[(kt0 + c2) * 32 + l31];
#pragma unroll
        for (int r = 0; r < 16; ++r) accS[c2][r] *= dk;
        if (OUT) {
#pragma unroll
          for (int r = 0; r < 16; ++r)
            ST[(jt * 32 + ROWMAP(r, lane)) * 136 + (kt0 + c2) * 32 + l31] = f2bf(accS[c2][r]);
        }
      }
      __syncthreads();
      if (OUT) {
        const int t = tid >> 4, part = tid & 15;
        float x[8];
        float ss = 0.f;
#pragma unroll
        for (int e = 0; e < 8; ++e) { x[e] = oF[t * 132 + part * 8 + e]; ss += x[e] * x[e]; }
        ss += __shfl_xor(ss, 1, 64); ss += __shfl_xor(ss, 2, 64); ss += __shfl_xor(ss, 4, 64); ss += __shfl_xor(ss, 8, 64);
        const float rr = 1.0f / sqrtf(ss * (1.f / 128.f) + 1e-6f);
        const size_t gro = (size_t)(i * 32 + t) * 1024 + h * 128 + part * 8;
        const uint4 sg4 = *(const uint4*)(SGp + gro);
        const uint32_t su[4] = {sg4.x, sg4.y, sg4.z, sg4.w};
        uint32_t ov[4];
#pragma unroll
        for (int e = 0; e < 4; ++e) {
          const float g0 = ng[part * 8 + 2 * e], g1 = ng[part * 8 + 2 * e + 1];
          const float s0 = __uint_as_float(su[e] << 16), s1 = __uint_as_float(su[e] & 0xffff0000u);
          ov[e] = pack2(x[2 * e] * rr * g0 * s0, x[2 * e + 1] * rr * g1 * s1);
        }
        uint4 o4; o4.x = ov[0]; o4.y = ov[1]; o4.z = ov[2]; o4.w = ov[3];
        *(uint4*)(HBp + gro) = o4;
      }
    }
    if (!OUT) {
#pragma unroll
      for (int c2 = 0; c2 < 2; ++c2)
#pragma unroll
        for (int r = 0; r < 16; ++r)
          SBh[(jt * 32 + ROWMAP(r, lane)) * 128 + (kt0 + c2) * 32 + l31] = f2bf(accS[c2][r]);
      if (tq == 0) C.DEC()[(size_t)(p * 8 + h) * 128 + kq] = __expf(dsum);
    }
  }
  __syncthreads();
}

__device__ __forceinline__ void hgrn_scan(const Ctx& C) {
  for (int gid = blockIdx.x * 512 + threadIdx.x; gid < 131072; gid += gridDim.x * 512) {
    const int kp = gid & 63, j = (gid >> 6) & 127, h = (gid >> 13) & 7, b = gid >> 16;
    float s0 = 0.f, s1 = 0.f;
    for (int c0 = 0; c0 < 128; c0 += 8) {
      uint32_t d[8];
      float2 dc[8];
#pragma unroll
      for (int e = 0; e < 8; ++e) {
        const size_t ph = (size_t)((b * 128 + c0 + e) * 8 + h);
        d[e] = *(const uint32_t*)(C.DS() + ph * 16384 + j * 128 + kp * 2);
        dc[e] = *(const float2*)(C.DEC() + ph * 128 + kp * 2);
      }
#pragma unroll
      for (int e = 0; e < 8; ++e) {
        const size_t ph = (size_t)((b * 128 + c0 + e) * 8 + h);
        *(uint32_t*)(C.DS() + ph * 16384 + j * 128 + kp * 2) = pack2(s0, s1);
        s0 = dc[e].x * s0 + __uint_as_float(d[e] << 16);
        s1 = dc[e].y * s1 + __uint_as_float(d[e] & 0xffff0000u);
      }
    }
  }
}

__device__ __forceinline__ void attn_panel(const Ctx& C, int p, bf16_t* smem) {
  const int tid = opaque_tid(), lane = tid & 63;
  const int w = __builtin_amdgcn_readfirstlane(tid >> 6);
  const int l31 = lane & 31, h8 = (lane >> 5) * 8;
  bf16_t* K2 = smem;
  bf16_t* VT = smem + 18432;
  bf16_t* Pw = smem + 35328 + w * 1280;
  const int blk = p & 127;
  const size_t row0 = (size_t)p * 128;
  const bf16_t* Qp = C.ACT() + (size_t)p * 128 * 2816;
  bf16_t* HBp = C.HB() + row0 * 1024;
  const int qt = w & 3;
  for (int hk = 0; hk < 2; ++hk) {
    __syncthreads();
#pragma unroll
    for (int i = 0; i < 4; ++i) {
      const int c = tid + 512 * i;
      const int r = c >> 3, ch = c & 7;
      uint4 kv = make_uint4(0, 0, 0, 0), vv = make_uint4(0, 0, 0, 0);
      if (blk > 0 || r >= 128) {
        const size_t tok = row0 + r - 128;
        kv = *(const uint4*)(C.KB() + tok * 128 + hk * 64 + ch * 8);
        vv = *(const uint4*)(C.VB() + tok * 128 + hk * 64 + ch * 8);
      }
      *(uint4*)(K2 + r * 72 + ch * 8) = kv;
      const uint32_t vu[4] = {vv.x, vv.y, vv.z, vv.w};
#pragma unroll
      for (int e = 0; e < 4; ++e) {
        VT[(ch * 8 + 2 * e) * 264 + r] = (bf16_t)(vu[e] & 0xffffu);
        VT[(ch * 8 + 2 * e + 1) * 264 + r] = (bf16_t)(vu[e] >> 16);
      }
    }
    __syncthreads();
    for (int u = 0; u < 4; ++u) {
      const int hq = hk * 8 + (w >> 2) * 4 + u;
      const float sink = C.in[17][hq];
      bfrag aq[4];
#pragma unroll
      for (int k16 = 0; k16 < 4; ++k16)
        aq[k16] = *(const bfrag*)(Qp + (size_t)(qt * 32 + l31) * 1024 + hq * 64 + k16 * 16 + h8);
      f32x16 s[5];
#pragma unroll
      for (int c = 0; c < 5; ++c) {
        s[c] = zero16();
#pragma unroll
        for (int k16 = 0; k16 < 4; ++k16) {
          const bfrag b = *(const bfrag*)(K2 + ((qt + c) * 32 + l31) * 72 + k16 * 16 + h8);
          s[c] = MFMA(aq[k16], b, s[c]);
        }
      }
      float linv[16];
#pragma unroll
      for (int r = 0; r < 16; ++r) {
        const int qi = qt * 32 + ROWMAP(r, lane);
        float m = -1e30f;
#pragma unroll
        for (int c = 0; c < 5; ++c) {
          const int kp = (qt + c) * 32 + l31;
          const bool valid = (kp > qi) && (kp <= qi + 128) && (blk > 0 || kp >= 128);
          const float v = valid ? s[c][r] : -1e30f;
          s[c][r] = v;
          m = fmaxf(m, v);
        }
        m = fmaxf(m, __shfl_xor(m, 16, 64)); m = fmaxf(m, __shfl_xor(m, 8, 64)); m = fmaxf(m, __shfl_xor(m, 4, 64));
        m = fmaxf(m, __shfl_xor(m, 2, 64)); m = fmaxf(m, __shfl_xor(m, 1, 64));
        m = fmaxf(m, sink);
        float sum = 0.f;
#pragma unroll
        for (int c = 0; c < 5; ++c) {
          const float pv = (s[c][r] > -1e29f) ? __expf(s[c][r] - m) : 0.f;
          s[c][r] = pv;
          sum += pv;
        }
        sum += __shfl_xor(sum, 16, 64); sum += __shfl_xor(sum, 8, 64); sum += __shfl_xor(sum, 4, 64);
        sum += __shfl_xor(sum, 2, 64); sum += __shfl_xor(sum, 1, 64);
        sum += __expf(sink - m);
        linv[r] = 1.f / sum;
      }
      f32x16 o[2];
      o[0] = zero16(); o[1] = zero16();
#pragma unroll
      for (int c = 0; c < 5; ++c) {
#pragma unroll
        for (int r = 0; r < 16; ++r) Pw[ROWMAP(r, lane) * 40 + l31] = f2bf(s[c][r]);
        __syncthreads();
#pragma unroll
        for (int k16 = 0; k16 < 2; ++k16) {
          const bfrag a = *(const bfrag*)(Pw + l31 * 40 + k16 * 16 + h8);
#pragma unroll
          for (int dt = 0; dt < 2; ++dt) {
            const bfrag b = *(const bfrag*)(VT + (dt * 32 + l31) * 264 + (qt + c) * 32 + k16 * 16 + h8);
            o[dt] = MFMA(a, b, o[dt]);
          }
        }
        __syncthreads();
      }
#pragma unroll
      for (int dt = 0; dt < 2; ++dt)
#pragma unroll
        for (int r = 0; r < 16; ++r)
          HBp[(size_t)(qt * 32 + ROWMAP(r, lane)) * 1024 + hq * 64 + dt * 32 + l31] = f2bf(o[dt][r] * linv[r]);
    }
  }
  __syncthreads();
}

__device__ __forceinline__ void conv_weights(const float* __restrict__ src, bf16_t* __restrict__ dst, int nmat, int K,
                                             int Nsrc, int Ndst, int mode) {
  const int nk = K >> 5, nNt = Ndst >> 9;
  const int upm = nk * nNt;
  const int tid = threadIdx.x;
  for (int u = blockIdx.x; u < nmat * upm; u += gridDim.x) {
    const int m = u / upm, r = u - m * upm;
    const int nt = r / nk, ks = r - nt * nk;
    const int np = nt * 512 + tid;
    int sc;
    if (mode == 1) {
      const int b = np >> 7, rr = np & 127;
      sc = (rr < 64) ? (b * 64 + rr) : (2816 + b * 64 + rr - 64);
    } else {
      sc = (np < Nsrc) ? np : -1;
    }
    const float* s = src + (size_t)m * K * Nsrc + (size_t)(ks * 32) * Nsrc + (sc < 0 ? 0 : sc);
    uint32_t pk[16];
#pragma unroll
    for (int kk = 0; kk < 16; ++kk) {
      float v0 = s[(size_t)(2 * kk) * Nsrc], v1 = s[(size_t)(2 * kk + 1) * Nsrc];
      if (sc < 0) { v0 = 0.f; v1 = 0.f; }
      pk[kk] = pack2(v0, v1);
    }
    uint4* d = (uint4*)(dst + (size_t)m * K * Ndst + (size_t)(nt * nk + ks) * 16384 + tid * 32);
    d[0] = make_uint4(pk[0], pk[1], pk[2], pk[3]);
    d[1] = make_uint4(pk[4], pk[5], pk[6], pk[7]);
    d[2] = make_uint4(pk[8], pk[9], pk[10], pk[11]);
    d[3] = make_uint4(pk[12], pk[13], pk[14], pk[15]);
  }
}

__device__ __forceinline__ void phase0(const Ctx& C) {
  conv_weights(C.in[1], C.WGU(), 8, 1024, 5632, 5632, 1);
  conv_weights(C.in[2], C.WD(), 8, 2816, 1024, 1024, 0);
  conv_weights(C.in[5], C.WGI(), 2, 1024, 2048, 2048, 0);
  conv_weights(C.in[10], C.WGO(), 2, 1024, 1024, 1024, 0);
  conv_weights(C.in[11], C.WHI(), 1, 1024, 4096, 4096, 0);
  conv_weights(C.in[14], C.WHO(), 1, 1024, 1024, 1024, 0);
  conv_weights(C.in[15], C.WQKV(), 1, 1024, 1280, 1536, 0);
  conv_weights(C.in[18], C.WAO(), 1, 1024, 1024, 1024, 0);
  const size_t gtid = (size_t)blockIdx.x * 512 + threadIdx.x;
  const size_t gsz = (size_t)gridDim.x * 512;
  for (size_t i = gtid; i < (size_t)T_TOK * 1024 / 4; i += gsz) {
    const float4 v = ((const float4*)C.in[0])[i];
    ((float4*)C.H())[i] = v;
    uint2 pk;
    pk.x = pack2(v.x, v.y);
    pk.y = pack2(v.z, v.w);
    ((uint2*)C.HB())[i] = pk;
  }
  for (size_t i = gtid; i < (size_t)2 * 8 * 128 * 128; i += gsz) {
    const int s = (int)(i & 127), t = (int)((i >> 7) & 127);
    C.WSP()[i] = (s <= t) ? f2bf(C.in[8][i]) : (bf16_t)0;
  }
  for (size_t i = gtid; i < 1024; i += gsz) {
    const float* lp = C.in[12];
    const float a0 = lp[i], a1 = lp[1024 + i], a2 = lp[2048 + i], a3 = lp[3072 + i];
    const float m = fmaxf(fmaxf(a0, a1), fmaxf(a2, a3));
    const float e0 = expf(a0 - m), e1 = expf(a1 - m), e2 = expf(a2 - m), e3 = expf(a3 - m);
    C.LB()[i] = e1 / (e0 + e1 + e2 + e3);
  }
}

enum { OP_FFN = 0, OP_GMLP = 1, OP_HIN = 2, OP_HOUT = 3, OP_QKV = 4, OP_ATTN = 5 };

__device__ __forceinline__ void run_ops(const Ctx& C0, int op_lo, int op_hi, bf16_t* smem) {
  for (int p0 = blockIdx.x; p0 < NPANEL; p0 += gridDim.x) {
    for (int op = op_lo; op < op_hi; ++op) {
      const Ctx& C = C0;
      const int p = p0;
      bf16_t* HBp = C.HB() + (size_t)p * 128 * 1024;
      float* Hp = C.H() + (size_t)p * 128 * 1024;
      bf16_t* ACTp = C.ACT() + (size_t)p * 128 * 2816;
      int kind = OP_FFN, layer = 0, j = 0;
      switch (op) {
        case 0: kind = OP_FFN; layer = 0; j = 0; break;
        case 1: kind = OP_GMLP; layer = 0; j = 0; break;
        case 2: kind = OP_FFN; layer = 0; j = 1; break;
        case 3: kind = OP_FFN; layer = 1; j = 0; break;
        case 4: kind = OP_HIN; layer = 1; break;
        case 5: kind = OP_HOUT; layer = 1; break;
        case 6: kind = OP_FFN; layer = 1; j = 1; break;
        case 7: kind = OP_FFN; layer = 2; j = 0; break;
        case 8: kind = OP_QKV; layer = 2; break;
        case 9: kind = OP_ATTN; layer = 2; break;
        case 10: kind = OP_FFN; layer = 2; j = 1; break;
        case 11: kind = OP_FFN; layer = 3; j = 0; break;
        case 12: kind = OP_GMLP; layer = 3; j = 1; break;
        default: kind = OP_FFN; layer = 3; j = 1; break;
      }
      if (kind == OP_FFN) {
        ffn_panel(C, p, layer, j, op == 13, smem);
      } else if (kind == OP_GMLP) {
        gmlp_panel(C, p, layer, j, smem);
      } else if (kind == OP_HIN) {
        EpiHgrn e{ACTp, ACTp + 128 * 1024, C.out + (size_t)p * 128 * 1024, C.SG() + (size_t)p * 128 * 1024, C.LB()};
        gemm_panel(HBp, 1024, C.WHI(), 1024, 8, e, smem);
        hgrn_rec<false>(C, p, smem);
      } else if (kind == OP_HOUT) {
        hgrn_rec<true>(C, p, smem);
        EpiResLN e2{Hp, ALPHA, 1.0f, nullptr};
        gemm_panel(HBp, 1024, C.WHO(), 1024, 2, e2, smem);
        const int li = (1 * 3 + 1) * 1024;
        ln_panel(Hp, Hp, HBp, C.in[3] + li, C.in[4] + li);
      } else if (kind == OP_QKV) {
        EpiQkv e{ACTp, C.KB() + (size_t)p * 128 * 128, C.VB() + (size_t)p * 128 * 128, C.in[16]};
        gemm_panel(HBp, 1024, C.WQKV(), 1024, 3, e, smem);
      } else {
        attn_panel(C, p, smem);
        EpiResLN e2{Hp, ALPHA, 1.0f, C.in[19]};
        gemm_panel(HBp, 1024, C.WAO(), 1024, 2, e2, smem);
        const int li = (2 * 3 + 1) * 1024;
        ln_panel(Hp, Hp, HBp, C.in[3] + li, C.in[4] + li);
      }
    }
  }
}

#if COOP
__device__ __forceinline__ void grid_barrier(unsigned* bar, unsigned target) {
  __syncthreads();
  if (threadIdx.x == 0) {
    __threadfence();
    __hip_atomic_fetch_add(bar, 1u, __ATOMIC_RELEASE, __HIP_MEMORY_SCOPE_AGENT);
    while (__hip_atomic_load(bar, __ATOMIC_ACQUIRE, __HIP_MEMORY_SCOPE_AGENT) < target) __builtin_amdgcn_s_sleep(8);
    __threadfence();
  }
  __syncthreads();
}

__global__ void __launch_bounds__(512) mega(Params P) {
  extern __shared__ __attribute__((aligned(16))) unsigned char lds_raw[];
  bf16_t* smem = (bf16_t*)lds_raw;
  Ctx C;
  C.in = P.in;
  C.out = P.out;
  C.ws = P.ws;
  const int lo = P.ph_lo, hi = P.ph_hi;
#if COOP
  if (lo < 0) cg::this_grid().sync();
  unsigned* bar = (unsigned*)(P.ws + OFF_BAR);
#define GSYNC(k) do { if (lo <= (k) && (k) + 1 < hi) grid_barrier(bar, (unsigned)((k) + 1) * gridDim.x); } while (0)
#else
#define GSYNC(k) do { } while (0)
#endif
  if (lo <= 0 && 0 < hi) phase0(C);
  GSYNC(0);
  if (lo <= 1 && 1 < hi) run_ops(C, 0, 5, smem);
  GSYNC(1);
  if (lo <= 2 && 2 < hi) hgrn_scan(C);
  GSYNC(2);
  if (lo <= 3 && 3 < hi) run_ops(C, 5, 9, smem);
  GSYNC(3);
  if (lo <= 4 && 4 < hi) run_ops(C, 9, 14, smem);
}

#endif

#if !COOP
__device__ __forceinline__ Ctx make_ctx(const Params& P) { Ctx C; C.in = P.in; C.out = P.out; C.ws = P.ws; return C; }
#define OPK(name, ...) __global__ void __launch_bounds__(512) name(Params P) { \
    extern __shared__ __attribute__((aligned(16))) unsigned char lds_raw[]; bf16_t* smem = (bf16_t*)lds_raw; \
    Ctx C = make_ctx(P); const int p = blockIdx.x; const int layer = P.ph_lo, j = P.ph_hi; (void)p; (void)layer; (void)j; (void)smem; __VA_ARGS__; }
OPK(k_p0, phase0(C))
OPK(k_ffn, ffn_panel(C, p, layer, j & 1, (j >> 1) != 0, smem))
OPK(k_gmlp, gmlp_panel(C, p, layer, j, smem))
OPK(k_hin, { bf16_t* ACTp = C.ACT() + (size_t)p * 128 * 2816; EpiHgrn e{ACTp, ACTp + 128 * 1024, C.out + (size_t)p * 128 * 1024, C.SG() + (size_t)p * 128 * 1024, C.LB()}; gemm_panel(C.HB() + (size_t)p * 128 * 1024, 1024, C.WHI(), 1024, 8, e, smem); hgrn_rec<false>(C, p, smem); })
OPK(k_scan, hgrn_scan(C))
OPK(k_hout, { hgrn_rec<true>(C, p, smem); float* Hp = C.H() + (size_t)p * 128 * 1024; bf16_t* HBp = C.HB() + (size_t)p * 128 * 1024; EpiResLN e2{Hp, ALPHA, 1.0f, nullptr}; gemm_panel(HBp, 1024, C.WHO(), 1024, 2, e2, smem); ln_panel(Hp, Hp, HBp, C.in[3] + 4 * 1024, C.in[4] + 4 * 1024); })
OPK(k_qkv, { bf16_t* ACTp = C.ACT() + (size_t)p * 128 * 2816; EpiQkv e{ACTp, C.KB() + (size_t)p * 128 * 128, C.VB() + (size_t)p * 128 * 128, C.in[16]}; gemm_panel(C.HB() + (size_t)p * 128 * 1024, 1024, C.WQKV(), 1024, 3, e, smem); })
OPK(k_attn, { attn_panel(C, p, smem); float* Hp = C.H() + (size_t)p * 128 * 1024; bf16_t* HBp = C.HB() + (size_t)p * 128 * 1024; EpiResLN e2{Hp, ALPHA, 1.0f, C.in[19]}; gemm_panel(HBp, 1024, C.WAO(), 1024, 2, e2, smem); ln_panel(Hp, Hp, HBp, C.in[3] + 7 * 1024, C.in[4] + 7 * 1024); })
#endif

extern "C" void kernel_launch(void* const* d_in, const int* in_sizes, int n_in, void* d_out, int out_size, void* d_ws,
                              size_t ws_size, hipStream_t stream) {
  static int grid_blocks = 0;
  if (grid_blocks == 0) {
    if (n_in != 20 || ws_size < WS_END) {
      fprintf(stderr, "kernel_launch: unexpected n_in %d or ws_size %zu (need %zu)\n", n_in, ws_size, (size_t)WS_END);
      grid_blocks = -1;
      return;
    }
    int dev = 0, cus = 0, per_cu = 0;
    hipGetDevice(&dev);
    hipDeviceGetAttribute(&cus, hipDeviceAttributeMultiprocessorCount, dev);
#if COOP
    if (hipFuncSetAttribute((const void*)mega, hipFuncAttributeMaxDynamicSharedMemorySize, LDS_BYTES) != hipSuccess)
      fprintf(stderr, "kernel_launch: hipFuncSetAttribute failed\n");
    hipOccupancyMaxActiveBlocksPerMultiprocessor(&per_cu, (const void*)mega, 512, LDS_BYTES);
#else
    const void* ks[] = {(const void*)k_p0, (const void*)k_ffn, (const void*)k_gmlp, (const void*)k_hin, (const void*)k_scan, (const void*)k_hout, (const void*)k_qkv, (const void*)k_attn};
    for (int i = 0; i < 8; ++i) (void)hipFuncSetAttribute(ks[i], hipFuncAttributeMaxDynamicSharedMemorySize, LDS_BYTES);
    per_cu = 1;
#endif
    (void)hipGetLastError();
    if (per_cu < 1) per_cu = 1;
    grid_blocks = cus * per_cu;
    if (grid_blocks > NPANEL) grid_blocks = NPANEL;
    if (grid_blocks < 1) grid_blocks = NPANEL;
  }
  if (grid_blocks < 0) return;
  Params P{};
  for (int i = 0; i < 20; ++i) P.in[i] = (const float*)d_in[i];
  P.out = (float*)d_out;
  P.ws = (unsigned char*)d_ws;
#if COOP
  P.ph_lo = 0; P.ph_hi = 5;
  (void)hipMemsetAsync((unsigned char*)d_ws + OFF_BAR, 0, 256, stream);
  void* args[] = {&P};
  hipError_t e = hipLaunchCooperativeKernel((const void*)mega, dim3(grid_blocks), dim3(512), args, LDS_BYTES, stream);
  if (e != hipSuccess) fprintf(stderr, "cooperative launch failed: %s (grid %d)\n", hipGetErrorString(e), grid_blocks);
#else
#define LAUNCH(k, a, b) do { P.ph_lo = (a); P.ph_hi = (b); hipLaunchKernelGGL(k, dim3(NPANEL), dim3(512), LDS_BYTES, stream, P); } while (0)
  LAUNCH(k_p0, 0, 0);
  LAUNCH(k_ffn, 0, 0); LAUNCH(k_gmlp, 0, 0); LAUNCH(k_ffn, 0, 1);
  LAUNCH(k_ffn, 1, 0); LAUNCH(k_hin, 0, 0); LAUNCH(k_scan, 0, 0); LAUNCH(k_hout, 0, 0); LAUNCH(k_ffn, 1, 1);
  LAUNCH(k_ffn, 2, 0); LAUNCH(k_qkv, 0, 0); LAUNCH(k_attn, 0, 0); LAUNCH(k_ffn, 2, 1);
  LAUNCH(k_ffn, 3, 0); LAUNCH(k_gmlp, 3, 1); LAUNCH(k_ffn, 3, 3);
#endif
}
```

```cpp
#include <hip/hip_runtime.h>
#include <hip/hip_cooperative_groups.h>
#include <stdint.h>
#include <stdio.h>
namespace cg = cooperative_groups;

#ifndef COOP
#define COOP 1
#endif

typedef unsigned short bf16_t;
typedef __attribute__((ext_vector_type(8))) __bf16 bfrag;
typedef __attribute__((ext_vector_type(16))) float f32x16;

constexpr int T_TOK = 32768;
constexpr int NPANEL = 256;
constexpr float ALPHA = 1.6817928305074290f;
constexpr int LDS_BYTES = 122880;

constexpr size_t SZ_WGU = (size_t)8 * 5632 * 1024 * 2;
constexpr size_t SZ_WD = (size_t)8 * 1024 * 2816 * 2;
constexpr size_t SZ_WGI = (size_t)2 * 2048 * 1024 * 2;
constexpr size_t SZ_WGO = (size_t)2 * 1024 * 1024 * 2;
constexpr size_t SZ_WSP = (size_t)2 * 8 * 128 * 128 * 2;
constexpr size_t SZ_WHI = (size_t)4096 * 1024 * 2;
constexpr size_t SZ_WHO = (size_t)1024 * 1024 * 2;
constexpr size_t SZ_WQKV = (size_t)1536 * 1024 * 2;
constexpr size_t SZ_WAO = (size_t)1024 * 1024 * 2;
constexpr size_t SZ_LB = 4096;
constexpr size_t SZ_H = (size_t)T_TOK * 1024 * 4;
constexpr size_t SZ_HB = (size_t)T_TOK * 1024 * 2;
constexpr size_t SZ_ACT = (size_t)T_TOK * 2816 * 2;
constexpr size_t SZ_SG = (size_t)T_TOK * 1024 * 2;
constexpr size_t SZ_DS = (size_t)NPANEL * 8 * 128 * 128 * 2;
constexpr size_t SZ_DEC = (size_t)NPANEL * 8 * 128 * 4;
constexpr size_t SZ_KB = (size_t)T_TOK * 128 * 2;

constexpr size_t OFF_WGU = 0;
constexpr size_t OFF_WD = OFF_WGU + SZ_WGU;
constexpr size_t OFF_WGI = OFF_WD + SZ_WD;
constexpr size_t OFF_WGO = OFF_WGI + SZ_WGI;
constexpr size_t OFF_WSP = OFF_WGO + SZ_WGO;
constexpr size_t OFF_WHI = OFF_WSP + SZ_WSP;
constexpr size_t OFF_WHO = OFF_WHI + SZ_WHI;
constexpr size_t OFF_WQKV = OFF_WHO + SZ_WHO;
constexpr size_t OFF_WAO = OFF_WQKV + SZ_WQKV;
constexpr size_t OFF_LB = OFF_WAO + SZ_WAO;
constexpr size_t OFF_H = OFF_LB + SZ_LB;
constexpr size_t OFF_HB = OFF_H + SZ_H;
constexpr size_t OFF_ACT = OFF_HB + SZ_HB;
constexpr size_t OFF_SG = OFF_ACT + SZ_ACT;
constexpr size_t OFF_DS = OFF_SG + SZ_SG;
constexpr size_t OFF_DEC = OFF_DS + SZ_DS;
constexpr size_t OFF_KB = OFF_DEC + SZ_DEC;
constexpr size_t OFF_VB = OFF_KB + SZ_KB;
constexpr size_t OFF_BAR = OFF_VB + SZ_KB;
constexpr size_t WS_END = OFF_BAR + 256;

struct Params {
  const float* in[20];
  float* out;
  unsigned char* ws;
  int ph_lo, ph_hi;
};

struct Ctx {
  const float* const* in;
  float* out;
  unsigned char* ws;
  __device__ __forceinline__ bf16_t* WGU() const { return (bf16_t*)(ws + OFF_WGU); }
  __device__ __forceinline__ bf16_t* WD() const { return (bf16_t*)(ws + OFF_WD); }
  __device__ __forceinline__ bf16_t* WGI() const { return (bf16_t*)(ws + OFF_WGI); }
  __device__ __forceinline__ bf16_t* WGO() const { return (bf16_t*)(ws + OFF_WGO); }
  __device__ __forceinline__ bf16_t* WSP() const { return (bf16_t*)(ws + OFF_WSP); }
  __device__ __forceinline__ bf16_t* WHI() const { return (bf16_t*)(ws + OFF_WHI); }
  __device__ __forceinline__ bf16_t* WHO() const { return (bf16_t*)(ws + OFF_WHO); }
  __device__ __forceinline__ bf16_t* WQKV() const { return (bf16_t*)(ws + OFF_WQKV); }
  __device__ __forceinline__ bf16_t* WAO() const { return (bf16_t*)(ws + OFF_WAO); }
  __device__ __forceinline__ float* LB() const { return (float*)(ws + OFF_LB); }
  __device__ __forceinline__ float* H() const { return (float*)(ws + OFF_H); }
  __device__ __forceinline__ bf16_t* HB() const { return (bf16_t*)(ws + OFF_HB); }
  __device__ __forceinline__ bf16_t* ACT() const { return (bf16_t*)(ws + OFF_ACT); }
  __device__ __forceinline__ bf16_t* SG() const { return (bf16_t*)(ws + OFF_SG); }
  __device__ __forceinline__ bf16_t* DS() const { return (bf16_t*)(ws + OFF_DS); }
  __device__ __forceinline__ float* DEC() const { return (float*)(ws + OFF_DEC); }
  __device__ __forceinline__ bf16_t* KB() const { return (bf16_t*)(ws + OFF_KB); }
  __device__ __forceinline__ bf16_t* VB() const { return (bf16_t*)(ws + OFF_VB); }
};

typedef __attribute__((ext_vector_type(2))) float f32x2_t;
typedef __attribute__((ext_vector_type(2))) __bf16 bf16x2_t;
__device__ __forceinline__ uint32_t pack2(float a, float b) {
  f32x2_t v = {a, b};
  bf16x2_t r = __builtin_convertvector(v, bf16x2_t);
  return __builtin_bit_cast(uint32_t, r);
}
__device__ __forceinline__ bf16_t f2bf(float f) { return (bf16_t)(pack2(f, 0.f) & 0xffffu); }
__device__ __forceinline__ float bf2f(bf16_t b) { return __uint_as_float(((uint32_t)b) << 16); }
__device__ __forceinline__ float wave_sum(float v) {
  v += __shfl_xor(v, 32, 64); v += __shfl_xor(v, 16, 64); v += __shfl_xor(v, 8, 64);
  v += __shfl_xor(v, 4, 64); v += __shfl_xor(v, 2, 64); v += __shfl_xor(v, 1, 64);
  return v;
}
__device__ __forceinline__ float silu_f(float x) { return x * __frcp_rn(1.f + __expf(-x)); }
#define ROWMAP(reg, lane) ((((reg)&3)) + 8 * ((reg) >> 2) + 4 * ((lane) >> 5))
#define MFMA(a, b, c) __builtin_amdgcn_mfma_f32_32x32x16_bf16((a), (b), (c), 0, 0, 0)

__device__ __forceinline__ int opaque_tid() {
  int t = threadIdx.x;
  asm volatile("" : "+v"(t));
  return t;
}

__device__ __forceinline__ unsigned long long opaque_u64(unsigned long long v) {
  unsigned lo = (unsigned)v, hi = (unsigned)(v >> 32);
  asm volatile("" : "+v"(lo), "+v"(hi));
  lo = __builtin_amdgcn_readfirstlane(lo);
  hi = __builtin_amdgcn_readfirstlane(hi);
  return ((unsigned long long)hi << 32) | lo;
}

__device__ __forceinline__ f32x16 zero16() {
  f32x16 z;
#pragma unroll
  for (int i = 0; i < 16; ++i) z[i] = 0.f;
  return z;
}

constexpr int G_STAGE_B = 40960;

__device__ __forceinline__ void glds16(const bf16_t* g, const char* l) {
  __builtin_amdgcn_global_load_lds((const unsigned*)g, (unsigned*)const_cast<char*>(l), 16, 0, 0);
}

#define RDFRAGS(F, stg, ok)                                                              \
  do {                                                                                   \
    const char* sa_ = lds + (stg) * G_STAGE_B + wm * 4096 + (ok);                         \
    const char* sb_ = lds + (stg) * G_STAGE_B + 8192 + wn * 8192 + (ok);                  \
    F[0] = *(const bfrag*)(sa_);                                                         \
    F[1] = *(const bfrag*)(sa_ + 2048);                                                  \
    F[2] = *(const bfrag*)(sb_);                                                         \
    F[3] = *(const bfrag*)(sb_ + 2048);                                                  \
    F[4] = *(const bfrag*)(sb_ + 4096);                                                  \
    F[5] = *(const bfrag*)(sb_ + 6144);                                                  \
  } while (0)
#define DOMFMA(F)                                                                        \
  do {                                                                                   \
    _Pragma("unroll") for (int ni_ = 0; ni_ < 4; ++ni_) {                                \
      acc[0][ni_] = MFMA(F[0], F[2 + ni_], acc[0][ni_]);                                 \
      acc[1][ni_] = MFMA(F[1], F[2 + ni_], acc[1][ni_]);                                 \
    }                                                                                    \
  } while (0)
#define ISSUE_SLAB(stg, ntv, krv)                                                        \
  do {                                                                                   \
    const char* st_ = lds + (stg) * G_STAGE_B + w * 1024;                                    \
    glds16(a_src + (krv) * 32, st_);                                                     \
    const bf16_t* bs_ = b_src + (size_t)((ntv) * nk + (krv)) * 16384;                    \
    _Pragma("unroll") for (int i_ = 0; i_ < 4; ++i_) glds16(bs_ + i_ * 4096, st_ + 8192 + i_ * 8192); \
  } while (0)

template <class Epi>
__device__ __forceinline__ void gemm_panel(const bf16_t* __restrict__ A, const int lda, const bf16_t* __restrict__ Wb,
                                           const int K, const int nN, const Epi epi, bf16_t* smem) {
  const int tid = opaque_tid(), lane = tid & 63;
  const int w = __builtin_amdgcn_readfirstlane(tid >> 6);
  const int wm = w & 1, wn = w >> 1;
  const int nk = K >> 5;
  const int total = nN * nk;
  const int l31 = lane & 31, h = lane >> 5;
  const int grow = lane >> 2;
  const int gch = (lane & 3) ^ ((lane >> 4) & 3);
  const bf16_t* a_src = A + (size_t)(w * 16 + grow) * lda + gch * 8;
  const bf16_t* b_src = Wb + (size_t)(w * 16 + grow) * 32 + gch * 8;
  const char* lds = (const char*)smem;
  const int pos0 = h ^ ((l31 >> 2) & 3);
  const int offk0 = l31 * 64 + pos0 * 16;
  const int offk1 = l31 * 64 + (pos0 ^ 2) * 16;
  f32x16 acc[2][4];
#pragma unroll
  for (int i = 0; i < 2; ++i)
#pragma unroll
    for (int j = 0; j < 4; ++j) acc[i][j] = zero16();
  const int rot = (int)(((blockIdx.x >> 3) & 31) * nk) >> 5;
  int kr3 = rot, nt3 = 0, cnt3 = 0;
  __syncthreads();
#pragma unroll
  for (int s3 = 0; s3 < 3; ++s3) {
    ISSUE_SLAB(s3, nt3, kr3);
    ++kr3; if (kr3 == nk) kr3 = 0;
    ++cnt3; if (cnt3 == nk) { cnt3 = 0; ++nt3; }
  }
  asm volatile("s_waitcnt vmcnt(10)" ::: "memory");
  asm volatile("s_waitcnt lgkmcnt(0)" ::: "memory");
  __builtin_amdgcn_s_barrier();
  asm volatile("" ::: "memory");
  bfrag F0[6], F1[6];
  RDFRAGS(F0, 0, offk0);
  int ks = 0, nt = 0, stage = 0, stage_n = 1, stage_p = 2;
  const bool late = (w >= 4);
  for (int it = 0; it < total; ++it) {
    if (late && it > 0) {
      ISSUE_SLAB(stage_p, nt3, kr3);
      ++kr3; if (kr3 == nk) kr3 = 0;
      ++cnt3; if (cnt3 == nk) { cnt3 = 0; ++nt3; }
    }
    RDFRAGS(F1, stage, offk1);
    DOMFMA(F0);
    __builtin_amdgcn_sched_group_barrier(0x100, 2, 0);
    __builtin_amdgcn_sched_group_barrier(0x008, 1, 0);
    __builtin_amdgcn_sched_group_barrier(0x100, 2, 0);
    __builtin_amdgcn_sched_group_barrier(0x008, 1, 0);
    __builtin_amdgcn_sched_group_barrier(0x100, 2, 0);
    __builtin_amdgcn_sched_group_barrier(0x008, 6, 0);
    __builtin_amdgcn_sched_barrier(0);
    asm volatile("s_waitcnt vmcnt(5)" ::: "memory");
    asm volatile("s_waitcnt lgkmcnt(0)" ::: "memory");
    __builtin_amdgcn_s_barrier();
    asm volatile("" ::: "memory");
    __builtin_amdgcn_sched_barrier(0);
    if (!late) {
      ISSUE_SLAB(stage, nt3, kr3);
      ++kr3; if (kr3 == nk) kr3 = 0;
      ++cnt3; if (cnt3 == nk) { cnt3 = 0; ++nt3; }
    }
    RDFRAGS(F0, stage_n, offk0);
    DOMFMA(F1);
    __builtin_amdgcn_sched_group_barrier(0x100, 2, 1);
    __builtin_amdgcn_sched_group_barrier(0x008, 1, 1);
    __builtin_amdgcn_sched_group_barrier(0x100, 2, 1);
    __builtin_amdgcn_sched_group_barrier(0x008, 1, 1);
    __builtin_amdgcn_sched_group_barrier(0x100, 2, 1);
    __builtin_amdgcn_sched_group_barrier(0x008, 6, 1);
    __builtin_amdgcn_sched_barrier(0);
    if (ks == nk - 1) {
      epi(acc, nt, wm, wn, lane);
#pragma unroll
      for (int i = 0; i < 2; ++i)
#pragma unroll
        for (int j = 0; j < 4; ++j) acc[i][j] = zero16();
      ++nt;
      asm volatile("s_waitcnt vmcnt(0)" ::: "memory");
      RDFRAGS(F0, stage_n, offk0);
    }
    ++ks; if (ks == nk) ks = 0;
    stage_p = stage;
    stage = stage_n;
    ++stage_n; if (stage_n == 3) stage_n = 0;
  }
  asm volatile("s_waitcnt vmcnt(0)" ::: "memory");
  __syncthreads();
}

struct EpiSwiglu {
  bf16_t* act;
  __device__ __forceinline__ void operator()(f32x16 (&acc)[2][4], int nt, int wm, int wn, int lane_in) const {
    int lane = lane_in;
    asm volatile("" : "+v"(lane));
    const int l31 = lane & 31;
#pragma unroll
    for (int mi = 0; mi < 2; ++mi)
#pragma unroll
      for (int n2 = 0; n2 < 2; ++n2)
#pragma unroll
        for (int r = 0; r < 16; ++r) {
          const int row = wm * 64 + mi * 32 + ROWMAP(r, lane);
          const int col = (nt * 4 + wn) * 64 + n2 * 32 + l31;
          const float g = acc[mi][n2][r], u = acc[mi][n2 + 2][r];
          act[(size_t)row * 2816 + col] = f2bf(silu_f(g) * u);
        }
  }
};
struct EpiResLN {
  float* Hp;
  float alpha, c;
  const float* bias;
  __device__ __forceinline__ void operator()(f32x16 (&acc)[2][4], int nt, int wm, int wn, int lane_in) const {
    int lane = lane_in;
    asm volatile("" : "+v"(lane));
    const int l31 = lane & 31;
    float* base = Hp + (size_t)(wm * 64 + 4 * (lane >> 5)) * 1024 + nt * 512 + wn * 128 + l31;
#pragma unroll
    for (int ni = 0; ni < 4; ++ni) {
      const float bv = bias ? bias[nt * 512 + wn * 128 + ni * 32 + l31] : 0.f;
#pragma unroll
      for (int mi = 0; mi < 2; ++mi) {
        float hv[16];
#pragma unroll
        for (int r = 0; r < 16; ++r) hv[r] = base[(size_t)(mi * 32 + (r & 3) + 8 * (r >> 2)) * 1024 + ni * 32];
#pragma unroll
        for (int r = 0; r < 16; ++r)
          base[(size_t)(mi * 32 + (r & 3) + 8 * (r >> 2)) * 1024 + ni * 32] = alpha * hv[r] + c * (acc[mi][ni][r] + bv);
        __builtin_amdgcn_sched_barrier(0);
      }
    }
  }
};
struct EpiGelu {
  bf16_t* Z;
  __device__ __forceinline__ void operator()(f32x16 (&acc)[2][4], int nt, int wm, int wn, int lane_in) const {
    int lane = lane_in;
    asm volatile("" : "+v"(lane));
    const int l31 = lane & 31;
#pragma unroll
    for (int ni = 0; ni < 4; ++ni) {
      const int col = nt * 512 + wn * 128 + ni * 32 + l31;
#pragma unroll
      for (int mi = 0; mi < 2; ++mi)
#pragma unroll
        for (int r = 0; r < 16; ++r) {
          const int row = wm * 64 + mi * 32 + ROWMAP(r, lane);
          const float x = acc[mi][ni][r];
          Z[(size_t)row * 2048 + col] = f2bf(0.5f * x * (1.f + erff(x * 0.70710678118654752f)));
        }
    }
  }
};
struct EpiHgrn {
  bf16_t* Qp;
  bf16_t* Vp;
  float* LFp;
  bf16_t* SGp;
  const float* lb;
  __device__ __forceinline__ void operator()(f32x16 (&acc)[2][4], int nt, int wm, int wn, int lane_in) const {
    int lane = lane_in;
    asm volatile("" : "+v"(lane));
    const int l31 = lane & 31;
    const int sec = nt >> 1;
    const int cb = (nt & 1) * 512 + wn * 128 + l31;
    const int rb = wm * 64 + 4 * (lane >> 5);
    if (sec == 0 || sec == 3) {
      bf16_t* dst = (sec == 0) ? Qp : SGp;
#pragma unroll
      for (int ni = 0; ni < 4; ++ni)
#pragma unroll
        for (int mi = 0; mi < 2; ++mi)
#pragma unroll
          for (int r = 0; r < 16; ++r) {
            const int row = rb + mi * 32 + (r & 3) + 8 * (r >> 2);
            dst[(size_t)row * 1024 + cb + ni * 32] = f2bf(silu_f(acc[mi][ni][r]));
          }
    } else if (sec == 1) {
#pragma unroll
      for (int ni = 0; ni < 4; ++ni) {
        const float lbv = lb[cb + ni * 32];
#pragma unroll
        for (int mi = 0; mi < 2; ++mi)
#pragma unroll
          for (int r = 0; r < 16; ++r) {
            const int row = rb + mi * 32 + (r & 3) + 8 * (r >> 2);
            const float f = lbv + (1.f - lbv) * __frcp_rn(1.f + __expf(-acc[mi][ni][r]));
            LFp[(size_t)row * 1024 + cb + ni * 32] = __logf(f);
          }
      }
    } else {
#pragma unroll
      for (int ni = 0; ni < 4; ++ni)
#pragma unroll
        for (int mi = 0; mi < 2; ++mi)
#pragma unroll
          for (int r = 0; r < 16; ++r) {
            const int row = rb + mi * 32 + (r & 3) + 8 * (r >> 2);
            Vp[(size_t)row * 1024 + cb + ni * 32] = f2bf(acc[mi][ni][r]);
          }
    }
  }
};
struct EpiQkv {
  bf16_t* Qp;
  bf16_t* Kp;
  bf16_t* Vp;
  const float* bias;
  __device__ __forceinline__ void operator()(f32x16 (&acc)[2][4], int nt, int wm, int wn, int lane_in) const {
    int lane = lane_in;
    asm volatile("" : "+v"(lane));
    const int l31 = lane & 31;
#pragma unroll
    for (int ni = 0; ni < 4; ++ni) {
      const int col = nt * 512 + wn * 128 + ni * 32 + l31;
      if (col < 1280) {
        const float bv = bias[col];
#pragma unroll
        for (int mi = 0; mi < 2; ++mi)
#pragma unroll
          for (int r = 0; r < 16; ++r) {
            const int row = wm * 64 + mi * 32 + ROWMAP(r, lane);
            const float x = acc[mi][ni][r] + bv;
            if (col < 1024) Qp[(size_t)row * 1024 + col] = f2bf(x * 0.125f);
            else if (col < 1152) Kp[(size_t)row * 128 + (col - 1024)] = f2bf(x);
            else Vp[(size_t)row * 128 + (col - 1152)] = f2bf(x);
          }
      }
    }
  }
};

__device__ __forceinline__ void ln_panel(const float* Hp, float* outp, bf16_t* HBp, const float* g, const float* b) {
  const int tid = opaque_tid(), lane = tid & 63;
  const int w = __builtin_amdgcn_readfirstlane(tid >> 6);
  float4 gv[4], bv[4];
#pragma unroll
  for (int j = 0; j < 4; ++j) {
    gv[j] = *(const float4*)(g + j * 256 + lane * 4);
    bv[j] = *(const float4*)(b + j * 256 + lane * 4);
  }
  for (int r = w; r < 128; r += 8) {
    float4 x[4];
    float s = 0.f;
#pragma unroll
    for (int j = 0; j < 4; ++j) {
      x[j] = *(const float4*)(Hp + (size_t)r * 1024 + j * 256 + lane * 4);
      s += x[j].x + x[j].y + x[j].z + x[j].w;
    }
    s = wave_sum(s);
    const float mean = s * (1.f / 1024.f);
    float v = 0.f;
#pragma unroll
    for (int j = 0; j < 4; ++j) {
      x[j].x -= mean; x[j].y -= mean; x[j].z -= mean; x[j].w -= mean;
      v += x[j].x * x[j].x + x[j].y * x[j].y + x[j].z * x[j].z + x[j].w * x[j].w;
    }
    v = wave_sum(v);
    const float rstd = 1.0f / sqrtf(v * (1.f / 1024.f) + 1e-5f);
#pragma unroll
    for (int j = 0; j < 4; ++j) {
      float4 y;
      y.x = x[j].x * rstd * gv[j].x + bv[j].x;
      y.y = x[j].y * rstd * gv[j].y + bv[j].y;
      y.z = x[j].z * rstd * gv[j].z + bv[j].z;
      y.w = x[j].w * rstd * gv[j].w + bv[j].w;
      *(float4*)(outp + (size_t)r * 1024 + j * 256 + lane * 4) = y;
      uint2 pk;
      pk.x = pack2(y.x, y.y);
      pk.y = pack2(y.z, y.w);
      *(uint2*)(HBp + (size_t)r * 1024 + j * 256 + lane * 4) = pk;
    }
  }
  __syncthreads();
}

__device__ __forceinline__ void ffn_panel(const Ctx& C, int p, int layer, int j, bool final_out, bf16_t* smem) {
  const int wi = layer * 2 + j;
  bf16_t* HBp = C.HB() + (size_t)p * 128 * 1024;
  bf16_t* ACTp = C.ACT() + (size_t)p * 128 * 2816;
  float* Hp = C.H() + (size_t)p * 128 * 1024;
  EpiSwiglu e1{ACTp};
  gemm_panel(HBp, 1024, C.WGU() + (size_t)wi * 5632 * 1024, 1024, 11, e1, smem);
  EpiResLN e2{Hp, ALPHA, 0.5f, nullptr};
  gemm_panel(ACTp, 2816, C.WD() + (size_t)wi * 1024 * 2816, 2816, 2, e2, smem);
  const int li = (layer * 3 + (j == 0 ? 0 : 2)) * 1024;
  float* outp = final_out ? (C.out + (size_t)p * 128 * 1024) : Hp;
  ln_panel(Hp, outp, HBp, C.in[3] + li, C.in[4] + li);
}

__device__ __forceinline__ void gmlp_panel(const Ctx& C, int p, int layer, int slot, bf16_t* smem) {
  const int tid = opaque_tid(), lane = tid & 63;
  const int w = __builtin_amdgcn_readfirstlane(tid >> 6);
  const int l31 = lane & 31, h8 = (lane >> 5) * 8;
  bf16_t* HBp = C.HB() + (size_t)p * 128 * 1024;
  bf16_t* Zp = C.ACT() + (size_t)p * 128 * 2816;
  float* Hp = C.H() + (size_t)p * 128 * 1024;
  {
    EpiGelu e{Zp};
    gemm_panel(HBp, 1024, C.WGI() + (size_t)slot * 2048 * 1024, 1024, 4, e, smem);
  }
  bf16_t* As = smem;
  bf16_t* Bs = smem + 128 * 136;
  float* st = (float*)(smem + 2 * 128 * 136);
  for (int r = w; r < 128; r += 8) {
    const uint4 q0 = *(const uint4*)(Zp + (size_t)r * 2048 + 1024 + lane * 16);
    const uint4 q1 = *(const uint4*)(Zp + (size_t)r * 2048 + 1024 + lane * 16 + 8);
    const uint32_t u[8] = {q0.x, q0.y, q0.z, q0.w, q1.x, q1.y, q1.z, q1.w};
    float x[16];
    float s = 0.f;
#pragma unroll
    for (int e = 0; e < 8; ++e) {
      x[2 * e] = __uint_as_float(u[e] << 16);
      x[2 * e + 1] = __uint_as_float(u[e] & 0xffff0000u);
      s += x[2 * e] + x[2 * e + 1];
    }
    s = wave_sum(s);
    const float mean = s * (1.f / 1024.f);
    float v = 0.f;
#pragma unroll
    for (int e = 0; e < 16; ++e) { const float d = x[e] - mean; v += d * d; }
    v = wave_sum(v);
    if (lane == 0) { st[r * 2] = mean; st[r * 2 + 1] = 1.0f / sqrtf(v * (1.f / 1024.f) + 1e-5f); }
  }
  __syncthreads();
  const float* lng = C.in[6] + slot * 1024;
  const float* lnb = C.in[7] + slot * 1024;
  const float* bsp = C.in[9] + slot * 1024;
  const bf16_t* Wsp = C.WSP() + (size_t)slot * 8 * 16384;
  const int nd = w & 3, mt0 = (w >> 2) * 2;
  for (int g = 0; g < 8; ++g) {
#pragma unroll
    for (int i = 0; i < 4; ++i) {
      const int c = tid + 512 * i;
      *(uint4*)(As + (c >> 4) * 136 + (c & 15) * 8) = *(const uint4*)(Wsp + (size_t)g * 16384 + c * 8);
    }
    {
      const int s = tid >> 2, dq = tid & 3;
      const float mean = st[s * 2], rstd = st[s * 2 + 1];
      const bf16_t* src = Zp + (size_t)s * 2048 + 1024 + g * 128 + dq * 32;
#pragma unroll
      for (int q = 0; q < 4; ++q) {
        const uint4 v4 = *(const uint4*)(src + q * 8);
        const uint32_t u[4] = {v4.x, v4.y, v4.z, v4.w};
#pragma unroll
        for (int e = 0; e < 4; ++e) {
          const int d0 = dq * 32 + q * 8 + e * 2;
          const int ch = g * 128 + d0;
          const float x0 = __uint_as_float(u[e] << 16), x1 = __uint_as_float(u[e] & 0xffff0000u);
          Bs[d0 * 136 + s] = f2bf((x0 - mean) * rstd * lng[ch] + lnb[ch]);
          Bs[(d0 + 1) * 136 + s] = f2bf((x1 - mean) * rstd * lng[ch + 1] + lnb[ch + 1]);
        }
      }
    }
    __syncthreads();
    f32x16 acc[2];
    acc[0] = zero16(); acc[1] = zero16();
#pragma unroll
    for (int k16 = 0; k16 < 8; ++k16) {
      const bfrag b = *(const bfrag*)(Bs + (nd * 32 + l31) * 136 + k16 * 16 + h8);
#pragma unroll
      for (int mi = 0; mi < 2; ++mi) {
        const bfrag a = *(const bfrag*)(As + ((mt0 + mi) * 32 + l31) * 136 + k16 * 16 + h8);
        acc[mi] = MFMA(a, b, acc[mi]);
      }
    }
#pragma unroll
    for (int mi = 0; mi < 2; ++mi)
#pragma unroll
      for (int r = 0; r < 16; ++r) {
        const int t = (mt0 + mi) * 32 + ROWMAP(r, lane);
        const int ch = g * 128 + nd * 32 + l31;
        const float mixed = acc[mi][r] + bsp[g * 128 + t];
        const float u = bf2f(Zp[(size_t)t * 2048 + ch]);
        HBp[(size_t)t * 1024 + ch] = f2bf(u * mixed);
      }
    __syncthreads();
  }
  {
    EpiResLN e2{Hp, ALPHA, 1.0f, nullptr};
    gemm_panel(HBp, 1024, C.WGO() + (size_t)slot * 1024 * 1024, 1024, 2, e2, smem);
  }
  const int li = (layer * 3 + 1) * 1024;
  ln_panel(Hp, Hp, HBp, C.in[3] + li, C.in[4] + li);
}

template <bool OUT>
__device__ __forceinline__ void hgrn_rec(const Ctx& C, int p, bf16_t* smem) {
  const int tid = opaque_tid(), lane = tid & 63;
  const int w = __builtin_amdgcn_readfirstlane(tid >> 6);
  const int l31 = lane & 31, h8 = (lane >> 5) * 8;
  bf16_t* ST = smem;
  bf16_t* Qh = smem + 17408;
  bf16_t* Kh = smem + 21760;
  bf16_t* KhT = smem + 26112;
  bf16_t* vT = smem + 31232;
  bf16_t* Ps = smem + 36352;
  float* seg = (float*)(smem + 37632);
  float* dec = seg + 512;
  float* oF = dec + 128;
  const size_t row0 = (size_t)p * 128;
  const bf16_t* Qp = C.ACT() + (size_t)p * 128 * 2816;
  const bf16_t* Vp = Qp + 128 * 1024;
  const float* LFp = C.out + row0 * 1024;
  const bf16_t* SGp = C.SG() + row0 * 1024;
  bf16_t* HBp = C.HB() + row0 * 1024;
  const float* ng = C.in[13];
  const int jt = w >> 1, kt0 = (w & 1) * 2;
  const int kq = tid & 127, tq = tid >> 7;
  for (int h = 0; h < 8; ++h) {
    f32x16 accS[2];
    bf16_t* SBh = C.DS() + ((size_t)(p * 8 + h)) * 16384;
    if (OUT) {
      __syncthreads();
#pragma unroll
      for (int i = 0; i < 4; ++i) {
        const int c = tid + 512 * i;
        *(uint4*)(ST + (c >> 4) * 136 + (c & 15) * 8) = *(const uint4*)(SBh + c * 8);
      }
      __syncthreads();
#pragma unroll
      for (int c2 = 0; c2 < 2; ++c2)
#pragma unroll
        for (int r = 0; r < 16; ++r)
          accS[c2][r] = bf2f(ST[(jt * 32 + ROWMAP(r, lane)) * 136 + (kt0 + c2) * 32 + l31]);
    } else {
      accS[0] = zero16(); accS[1] = zero16();
    }
    float dsum = 0.f;
    for (int i = 0; i < 4; ++i) {
      float l[8], cs[8];
      const size_t gbase = (size_t)(i * 32 + tq * 8) * 1024 + h * 128 + kq;
#pragma unroll
      for (int e = 0; e < 8; ++e) l[e] = LFp[gbase + (size_t)e * 1024];
      cs[0] = l[0];
#pragma unroll
      for (int e = 1; e < 8; ++e) cs[e] = cs[e - 1] + l[e];
      seg[tq * 128 + kq] = cs[7];
#pragma unroll
      for (int e = 0; e < 8; ++e) vT[kq * 40 + tq * 8 + e] = Vp[gbase + (size_t)e * 1024];
      __syncthreads();
      float off = 0.f, tot = 0.f;
#pragma unroll
      for (int q = 0; q < 4; ++q) {
        const float s = seg[q * 128 + kq];
        if (q < tq) off += s;
        tot += s;
      }
#pragma unroll
      for (int e = 0; e < 8; ++e) {
        const float gc = cs[e] + off;
        const float f = __expf(l[e]);
        const float kh = (1.f - f) * __expf(-gc);
        const bf16_t khb = f2bf(kh);
        const int t = tq * 8 + e;
        KhT[kq * 40 + t] = khb;
        if (OUT) {
          Kh[t * 136 + kq] = khb;
          const float qv = bf2f(Qp[gbase + (size_t)e * 1024]);
          Qh[t * 136 + kq] = f2bf(qv * __expf(gc));
        }
      }
      if (tq == 0) { dec[kq] = __expf(tot); dsum += tot; }
      __syncthreads();
      f32x16 accO = zero16();
      if (OUT) {
        if (w == 0) {
          f32x16 accP = zero16();
#pragma unroll
          for (int k16 = 0; k16 < 8; ++k16) {
            const bfrag a = *(const bfrag*)(Qh + l31 * 136 + k16 * 16 + h8);
            const bfrag b = *(const bfrag*)(Kh + l31 * 136 + k16 * 16 + h8);
            accP = MFMA(a, b, accP);
          }
#pragma unroll
          for (int r = 0; r < 16; ++r) {
            const int t = ROWMAP(r, lane);
            Ps[t * 40 + l31] = (l31 <= t) ? f2bf(accP[r]) : (bf16_t)0;
          }
        } else if (w <= 4) {
          const int nt = w - 1;
#pragma unroll
          for (int k16 = 0; k16 < 8; ++k16) {
            const bfrag a = *(const bfrag*)(Qh + l31 * 136 + k16 * 16 + h8);
            const bfrag b = *(const bfrag*)(ST + (nt * 32 + l31) * 136 + k16 * 16 + h8);
            accO = MFMA(a, b, accO);
          }
        }
        __syncthreads();
        if (w >= 1 && w <= 4) {
          const int nt = w - 1;
#pragma unroll
          for (int k16 = 0; k16 < 2; ++k16) {
            const bfrag a = *(const bfrag*)(Ps + l31 * 40 + k16 * 16 + h8);
            const bfrag b = *(const bfrag*)(vT + (nt * 32 + l31) * 40 + k16 * 16 + h8);
            accO = MFMA(a, b, accO);
          }
#pragma unroll
          for (int r = 0; r < 16; ++r) oF[ROWMAP(r, lane) * 132 + nt * 32 + l31] = accO[r];
        }
      }
#pragma unroll
      for (int c2 = 0; c2 < 2; ++c2) {
#pragma unroll
        for (int k16 = 0; k16 < 2; ++k16) {
          const bfrag a = *(const bfrag*)(vT + (jt * 32 + l31) * 40 + k16 * 16 + h8);
          const bfrag b = *(const bfrag*)(KhT + ((kt0 + c2) * 32 + l31) * 40 + k16 * 16 + h8);
          accS[c2] = MFMA(a, b, accS[c2]);
        }
        const float dk = dec[(kt0 + c2) * 32 + l31];
#pragma unroll
        for (int r = 0; r < 16; ++r) accS[c2][r] *= dk;
        if (OUT) {
#pragma unroll
          for (int r = 0; r < 16; ++r)
            ST[(jt * 32 + ROWMAP(r, lane)) * 136 + (kt0 + c2) * 32 + l31] = f2bf(accS[c2][r]);
        }
      }
      __syncthreads();
      if (OUT) {
        const int t = tid >> 4, part = tid & 15;
        float x[8];
        float ss = 0.f;
#pragma unroll
        for (int e = 0; e < 8; ++e) { x[e] = oF[t * 132 + part * 8 + e]; ss += x[e] * x[e]; }
        ss += __shfl_xor(ss, 1, 64); ss += __shfl_xor(ss, 2, 64); ss += __shfl_xor(ss, 4, 64); ss += __shfl_xor(ss, 8, 64);
        const float rr = 1.0f / sqrtf(ss * (1.f / 128.f) + 1e-6f);
        const size_t gro = (size_t)(i * 32 + t) * 1024 + h * 128 + part * 8;
        const uint4 sg4 = *(const uint4*)(SGp + gro);
        const uint32_t su[4] = {sg4.x, sg4.y, sg4.z, sg4.w};
        uint32_t ov[4];
#pragma unroll
        for (int e = 0; e < 4; ++e) {
          const float g0 = ng[part * 8 + 2 * e], g1 = ng[part * 8 + 2 * e + 1];
          const float s0 = __uint_as_float(su[e] << 16), s1 = __uint_as_float(su[e] & 0xffff0000u);
          ov[e] = pack2(x[2 * e] * rr * g0 * s0, x[2 * e + 1] * rr * g1 * s1);
        }
        uint4 o4; o4.x = ov[0]; o4.y = ov[1]; o4.z = ov[2]; o4.w = ov[3];
        *(uint4*)(HBp + gro) = o4;
      }
    }
    if (!OUT) {
#pragma unroll
      for (int c2 = 0; c2 < 2; ++c2)
#pragma unroll
        for (int r = 0; r < 16; ++r)
          SBh[(jt * 32 + ROWMAP(r, lane)) * 128 + (kt0 + c2) * 32 + l31] = f2bf(accS[c2][r]);
      if (tq == 0) C.DEC()[(size_t)(p * 8 + h) * 128 + kq] = __expf(dsum);
    }
  }
  __syncthreads();
}

__device__ __forceinline__ void hgrn_scan(const Ctx& C) {
  for (int gid = blockIdx.x * 512 + threadIdx.x; gid < 131072; gid += gridDim.x * 512) {
    const int kp = gid & 63, j = (gid >> 6) & 127, h = (gid >> 13) & 7, b = gid >> 16;
    float s0 = 0.f, s1 = 0.f;
    for (int c0 = 0; c0 < 128; c0 += 8) {
      uint32_t d[8];
      float2 dc[8];
#pragma unroll
      for (int e = 0; e < 8; ++e) {
        const size_t ph = (size_t)((b * 128 + c0 + e) * 8 + h);
        d[e] = *(const uint32_t*)(C.DS() + ph * 16384 + j * 128 + kp * 2);
        dc[e] = *(const float2*)(C.DEC() + ph * 128 + kp * 2);
      }
#pragma unroll
      for (int e = 0; e < 8; ++e) {
        const size_t ph = (size_t)((b * 128 + c0 + e) * 8 + h);
        *(uint32_t*)(C.DS() + ph * 16384 + j * 128 + kp * 2) = pack2(s0, s1);
        s0 = dc[e].x * s0 + __uint_as_float(d[e] << 16);
        s1 = dc[e].y * s1 + __uint_as_float(d[e] & 0xffff0000u);
      }
    }
  }
}

__device__ __forceinline__ void attn_panel(const Ctx& C, int p, bf16_t* smem) {
  const int tid = opaque_tid(), lane = tid & 63;
  const int w = __builtin_amdgcn_readfirstlane(tid >> 6);
  const int l31 = lane & 31, h8 = (lane >> 5) * 8;
  bf16_t* K2 = smem;
  bf16_t* VT = smem + 18432;
  bf16_t* Pw = smem + 35328 + w * 1280;
  const int blk = p & 127;
  const size_t row0 = (size_t)p * 128;
  const bf16_t* Qp = C.ACT() + (size_t)p * 128 * 2816;
  bf16_t* HBp = C.HB() + row0 * 1024;
  const int qt = w & 3;
  for (int hk = 0; hk < 2; ++hk) {
    __syncthreads();
#pragma unroll
    for (int i = 0; i < 4; ++i) {
      const int c = tid + 512 * i;
      const int r = c >> 3, ch = c & 7;
      uint4 kv = make_uint4(0, 0, 0, 0), vv = make_uint4(0, 0, 0, 0);
      if (blk > 0 || r >= 128) {
        const size_t tok = row0 + r - 128;
        kv = *(const uint4*)(C.KB() + tok * 128 + hk * 64 + ch * 8);
        vv = *(const uint4*)(C.VB() + tok * 128 + hk * 64 + ch * 8);
      }
      *(uint4*)(K2 + r * 72 + ch * 8) = kv;
      const uint32_t vu[4] = {vv.x, vv.y, vv.z, vv.w};
#pragma unroll
      for (int e = 0; e < 4; ++e) {
        VT[(ch * 8 + 2 * e) * 264 + r] = (bf16_t)(vu[e] & 0xffffu);
        VT[(ch * 8 + 2 * e + 1) * 264 + r] = (bf16_t)(vu[e] >> 16);
      }
    }
    __syncthreads();
    for (int u = 0; u < 4; ++u) {
      const int hq = hk * 8 + (w >> 2) * 4 + u;
      const float sink = C.in[17][hq];
      bfrag aq[4];
#pragma unroll
      for (int k16 = 0; k16 < 4; ++k16)
        aq[k16] = *(const bfrag*)(Qp + (size_t)(qt * 32 + l31) * 1024 + hq * 64 + k16 * 16 + h8);
      f32x16 s[5];
#pragma unroll
      for (int c = 0; c < 5; ++c) {
        s[c] = zero16();
#pragma unroll
        for (int k16 = 0; k16 < 4; ++k16) {
          const bfrag b = *(const bfrag*)(K2 + ((qt + c) * 32 + l31) * 72 + k16 * 16 + h8);
          s[c] = MFMA(aq[k16], b, s[c]);
        }
      }
      float linv[16];
#pragma unroll
      for (int r = 0; r < 16; ++r) {
        const int qi = qt * 32 + ROWMAP(r, lane);
        float m = -1e30f;
#pragma unroll
        for (int c = 0; c < 5; ++c) {
          const int kp = (qt + c) * 32 + l31;
          const bool valid = (kp > qi) && (kp <= qi + 128) && (blk > 0 || kp >= 128);
          const float v = valid ? s[c][r] : -1e30f;
          s[c][r] = v;
          m = fmaxf(m, v);
        }
        m = fmaxf(m, __shfl_xor(m, 16, 64)); m = fmaxf(m, __shfl_xor(m, 8, 64)); m = fmaxf(m, __shfl_xor(m, 4, 64));
        m = fmaxf(m, __shfl_xor(m, 2, 64)); m = fmaxf(m, __shfl_xor(m, 1, 64));
        m = fmaxf(m, sink);
        float sum = 0.f;
#pragma unroll
        for (int c = 0; c < 5; ++c) {
          const float pv = (s[c][r] > -1e29f) ? __expf(s[c][r] - m) : 0.f;
          s[c][r] = pv;
          sum += pv;
        }
        sum += __shfl_xor(sum, 16, 64); sum += __shfl_xor(sum, 8, 64); sum += __shfl_xor(sum, 4, 64);
        sum += __shfl_xor(sum, 2, 64); sum += __shfl_xor(sum, 1, 64);
        sum += __expf(sink - m);
        linv[r] = 1.f / sum;
      }
      f32x16 o[2];
      o[0] = zero16(); o[1] = zero16();
#pragma unroll
      for (int c = 0; c < 5; ++c) {
#pragma unroll
        for (int r = 0; r < 16; ++r) Pw[ROWMAP(r, lane) * 40 + l31] = f2bf(s[c][r]);
        __syncthreads();
#pragma unroll
        for (int k16 = 0; k16 < 2; ++k16) {
          const bfrag a = *(const bfrag*)(Pw + l31 * 40 + k16 * 16 + h8);
#pragma unroll
          for (int dt = 0; dt < 2; ++dt) {
            const bfrag b = *(const bfrag*)(VT + (dt * 32 + l31) * 264 + (qt + c) * 32 + k16 * 16 + h8);
            o[dt] = MFMA(a, b, o[dt]);
          }
        }
        __syncthreads();
      }
#pragma unroll
      for (int dt = 0; dt < 2; ++dt)
#pragma unroll
        for (int r = 0; r < 16; ++r)
          HBp[(size_t)(qt * 32 + ROWMAP(r, lane)) * 1024 + hq * 64 + dt * 32 + l31] = f2bf(o[dt][r] * linv[r]);
    }
  }
  __syncthreads();
}

__device__ __forceinline__ void conv_weights(const float* __restrict__ src, bf16_t* __restrict__ dst, int nmat, int K,
                                             int Nsrc, int Ndst, int mode) {
  const int nk = K >> 5, nNt = Ndst >> 9;
  const int upm = nk * nNt;
  const int tid = threadIdx.x;
  for (int u = blockIdx.x; u < nmat * upm; u += gridDim.x) {
    const int m = u / upm, r = u - m * upm;
    const int nt = r / nk, ks = r - nt * nk;
    const int np = nt * 512 + tid;
    int sc;
    if (mode == 1) {
      const int b = np >> 7, rr = np & 127;
      sc = (rr < 64) ? (b * 64 + rr) : (2816 + b * 64 + rr - 64);
    } else {
      sc = (np < Nsrc) ? np : -1;
    }
    const float* s = src + (size_t)m * K * Nsrc + (size_t)(ks * 32) * Nsrc + (sc < 0 ? 0 : sc);
    uint32_t pk[16];
#pragma unroll
    for (int kk = 0; kk < 16; ++kk) {
      float v0 = s[(size_t)(2 * kk) * Nsrc], v1 = s[(size_t)(2 * kk + 1) * Nsrc];
      if (sc < 0) { v0 = 0.f; v1 = 0.f; }
      pk[kk] = pack2(v0, v1);
    }
    uint4* d = (uint4*)(dst + (size_t)m * K * Ndst + (size_t)(nt * nk + ks) * 16384 + tid * 32);
    d[0] = make_uint4(pk[0], pk[1], pk[2], pk[3]);
    d[1] = make_uint4(pk[4], pk[5], pk[6], pk[7]);
    d[2] = make_uint4(pk[8], pk[9], pk[10], pk[11]);
    d[3] = make_uint4(pk[12], pk[13], pk[14], pk[15]);
  }
}

__device__ __forceinline__ void phase0(const Ctx& C) {
  conv_weights(C.in[1], C.WGU(), 8, 1024, 5632, 5632, 1);
  conv_weights(C.in[2], C.WD(), 8, 2816, 1024, 1024, 0);
  conv_weights(C.in[5], C.WGI(), 2, 1024, 2048, 2048, 0);
  conv_weights(C.in[10], C.WGO(), 2, 1024, 1024, 1024, 0);
  conv_weights(C.in[11], C.WHI(), 1, 1024, 4096, 4096, 0);
  conv_weights(C.in[14], C.WHO(), 1, 1024, 1024, 1024, 0);
  conv_weights(C.in[15], C.WQKV(), 1, 1024, 1280, 1536, 0);
  conv_weights(C.in[18], C.WAO(), 1, 1024, 1024, 1024, 0);
  const size_t gtid = (size_t)blockIdx.x * 512 + threadIdx.x;
  const size_t gsz = (size_t)gridDim.x * 512;
  for (size_t i = gtid; i < (size_t)T_TOK * 1024 / 4; i += gsz) {
    const float4 v = ((const float4*)C.in[0])[i];
    ((float4*)C.H())[i] = v;
    uint2 pk;
    pk.x = pack2(v.x, v.y);
    pk.y = pack2(v.z, v.w);
    ((uint2*)C.HB())[i] = pk;
  }
  for (size_t i = gtid; i < (size_t)2 * 8 * 128 * 128; i += gsz) {
    const int s = (int)(i & 127), t = (int)((i >> 7) & 127);
    C.WSP()[i] = (s <= t) ? f2bf(C.in[8][i]) : (bf16_t)0;
  }
  for (size_t i = gtid; i < 1024; i += gsz) {
    const float* lp = C.in[12];
    const float a0 = lp[i], a1 = lp[1024 + i], a2 = lp[2048 + i], a3 = lp[3072 + i];
    const float m = fmaxf(fmaxf(a0, a1), fmaxf(a2, a3));
    const float e0 = expf(a0 - m), e1 = expf(a1 - m), e2 = expf(a2 - m), e3 = expf(a3 - m);
    C.LB()[i] = e1 / (e0 + e1 + e2 + e3);
  }
}

enum { OP_FFN = 0, OP_GMLP = 1, OP_HIN = 2, OP_HOUT = 3, OP_QKV = 4, OP_ATTN = 5 };

__device__ __forceinline__ void run_ops(const Ctx& C0, int op_lo, int op_hi, bf16_t* smem) {
  for (int p0 = blockIdx.x; p0 < NPANEL; p0 += gridDim.x) {
    for (int op = op_lo; op < op_hi; ++op) {
      const Ctx& C = C0;
      const int p = p0;
      bf16_t* HBp = C.HB() + (size_t)p * 128 * 1024;
      float* Hp = C.H() + (size_t)p * 128 * 1024;
      bf16_t* ACTp = C.ACT() + (size_t)p * 128 * 2816;
      int kind = OP_FFN, layer = 0, j = 0;
      switch (op) {
        case 0: kind = OP_FFN; layer = 0; j = 0; break;
        case 1: kind = OP_GMLP; layer = 0; j = 0; break;
        case 2: kind = OP_FFN; layer = 0; j = 1; break;
        case 3: kind = OP_FFN; layer = 1; j = 0; break;
        case 4: kind = OP_HIN; layer = 1; break;
        case 5: kind = OP_HOUT; layer = 1; break;
        case 6: kind = OP_FFN; layer = 1; j = 1; break;
        case 7: kind = OP_FFN; layer = 2; j = 0; break;
        case 8: kind = OP_QKV; layer = 2; break;
        case 9: kind = OP_ATTN; layer = 2; break;
        case 10: kind = OP_FFN; layer = 2; j = 1; break;
        case 11: kind = OP_FFN; layer = 3; j = 0; break;
        case 12: kind = OP_GMLP; layer = 3; j = 1; break;
        default: kind = OP_FFN; layer = 3; j = 1; break;
      }
      if (kind == OP_FFN) {
        ffn_panel(C, p, layer, j, op == 13, smem);
      } else if (kind == OP_GMLP) {
        gmlp_panel(C, p, layer, j, smem);
      } else if (kind == OP_HIN) {
        EpiHgrn e{ACTp, ACTp + 128 * 1024, C.out + (size_t)p * 128 * 1024, C.SG() + (size_t)p * 128 * 1024, C.LB()};
        gemm_panel(HBp, 1024, C.WHI(), 1024, 8, e, smem);
        hgrn_rec<false>(C, p, smem);
      } else if (kind == OP_HOUT) {
        hgrn_rec<true>(C, p, smem);
        EpiResLN e2{Hp, ALPHA, 1.0f, nullptr};
        gemm_panel(HBp, 1024, C.WHO(), 1024, 2, e2, smem);
        const int li = (1 * 3 + 1) * 1024;
        ln_panel(Hp, Hp, HBp, C.in[3] + li, C.in[4] + li);
      } else if (kind == OP_QKV) {
        EpiQkv e{ACTp, C.KB() + (size_t)p * 128 * 128, C.VB() + (size_t)p * 128 * 128, C.in[16]};
        gemm_panel(HBp, 1024, C.WQKV(), 1024, 3, e, smem);
      } else {
        attn_panel(C, p, smem);
        EpiResLN e2{Hp, ALPHA, 1.0f, C.in[19]};
        gemm_panel(HBp, 1024, C.WAO(), 1024, 2, e2, smem);
        const int li = (2 * 3 + 1) * 1024;
        ln_panel(Hp, Hp, HBp, C.in[3] + li, C.in[4] + li);
      }
    }
  }
}

#if COOP
__device__ __forceinline__ void grid_barrier(unsigned* bar, unsigned target) {
  __syncthreads();
  if (threadIdx.x == 0) {
    __threadfence();
    __hip_atomic_fetch_add(bar, 1u, __ATOMIC_RELEASE, __HIP_MEMORY_SCOPE_AGENT);
    while (__hip_atomic_load(bar, __ATOMIC_ACQUIRE, __HIP_MEMORY_SCOPE_AGENT) < target) __builtin_amdgcn_s_sleep(8);
    __threadfence();
  }
  __syncthreads();
}

__global__ void __launch_bounds__(512) mega(Params P) {
  extern __shared__ __attribute__((aligned(16))) unsigned char lds_raw[];
  bf16_t* smem = (bf16_t*)lds_raw;
  Ctx C;
  C.in = P.in;
  C.out = P.out;
  C.ws = P.ws;
  const int lo = P.ph_lo, hi = P.ph_hi;
#if COOP
  if (lo < 0) cg::this_grid().sync();
  unsigned* bar = (unsigned*)(P.ws + OFF_BAR);
#define GSYNC(k) do { if (lo <= (k) && (k) + 1 < hi) grid_barrier(bar, (unsigned)((k) + 1) * gridDim.x); } while (0)
#else
#define GSYNC(k) do { } while (0)
#endif
  if (lo <= 0 && 0 < hi) phase0(C);
  GSYNC(0);
  if (lo <= 1 && 1 < hi) run_ops(C, 0, 5, smem);
  GSYNC(1);
  if (lo <= 2 && 2 < hi) hgrn_scan(C);
  GSYNC(2);
  if (lo <= 3 && 3 < hi) run_ops(C, 5, 9, smem);
  GSYNC(3);
  if (lo <= 4 && 4 < hi) run_ops(C, 9, 14, smem);
}

#endif

#if !COOP
__device__ __forceinline__ Ctx make_ctx(const Params& P) { Ctx C; C.in = P.in; C.out = P.out; C.ws = P.ws; return C; }
#define OPK(name, ...) __global__ void __launch_bounds__(512) name(Params P) { \
    extern __shared__ __attribute__((aligned(16))) unsigned char lds_raw[]; bf16_t* smem = (bf16_t*)lds_raw; \
    Ctx C = make_ctx(P); const int p = blockIdx.x; const int layer = P.ph_lo, j = P.ph_hi; (void)p; (void)layer; (void)j; (void)smem; __VA_ARGS__; }
OPK(k_p0, phase0(C))
OPK(k_ffn, ffn_panel(C, p, layer, j & 1, (j >> 1) != 0, smem))
OPK(k_gmlp, gmlp_panel(C, p, layer, j, smem))
OPK(k_hin, { bf16_t* ACTp = C.ACT() + (size_t)p * 128 * 2816; EpiHgrn e{ACTp, ACTp + 128 * 1024, C.out + (size_t)p * 128 * 1024, C.SG() + (size_t)p * 128 * 1024, C.LB()}; gemm_panel(C.HB() + (size_t)p * 128 * 1024, 1024, C.WHI(), 1024, 8, e, smem); hgrn_rec<false>(C, p, smem); })
OPK(k_scan, hgrn_scan(C))
OPK(k_hout, { hgrn_rec<true>(C, p, smem); float* Hp = C.H() + (size_t)p * 128 * 1024; bf16_t* HBp = C.HB() + (size_t)p * 128 * 1024; EpiResLN e2{Hp, ALPHA, 1.0f, nullptr}; gemm_panel(HBp, 1024, C.WHO(), 1024, 2, e2, smem); ln_panel(Hp, Hp, HBp, C.in[3] + 4 * 1024, C.in[4] + 4 * 1024); })
OPK(k_qkv, { bf16_t* ACTp = C.ACT() + (size_t)p * 128 * 2816; EpiQkv e{ACTp, C.KB() + (size_t)p * 128 * 128, C.VB() + (size_t)p * 128 * 128, C.in[16]}; gemm_panel(C.HB() + (size_t)p * 128 * 1024, 1024, C.WQKV(), 1024, 3, e, smem); })
OPK(k_attn, { attn_panel(C, p, smem); float* Hp = C.H() + (size_t)p * 128 * 1024; bf16_t* HBp = C.HB() + (size_t)p * 128 * 1024; EpiResLN e2{Hp, ALPHA, 1.0f, C.in[19]}; gemm_panel(HBp, 1024, C.WAO(), 1024, 2, e2, smem); ln_panel(Hp, Hp, HBp, C.in[3] + 7 * 1024, C.in[4] + 7 * 1024); })
#endif

extern "C" void kernel_launch(void* const* d_in, const int* in_sizes, int n_in, void* d_out, int out_size, void* d_ws,
                              size_t ws_size, hipStream_t stream) {
  static int grid_blocks = 0;
  if (grid_blocks == 0) {
    if (n_in != 20 || ws_size < WS_END) {
      fprintf(stderr, "kernel_launch: unexpected n_in %d or ws_size %zu (need %zu)\n", n_in, ws_size, (size_t)WS_END);
      grid_blocks = -1;
      return;
    }
    int dev = 0, cus = 0, per_cu = 0;
    hipGetDevice(&dev);
    hipDeviceGetAttribute(&cus, hipDeviceAttributeMultiprocessorCount, dev);
#if COOP
    if (hipFuncSetAttribute((const void*)mega, hipFuncAttributeMaxDynamicSharedMemorySize, LDS_BYTES) != hipSuccess)
      fprintf(stderr, "kernel_launch: hipFuncSetAttribute failed\n");
    hipOccupancyMaxActiveBlocksPerMultiprocessor(&per_cu, (const void*)mega, 512, LDS_BYTES);
#else
    const void* ks[] = {(const void*)k_p0, (const void*)k_ffn, (const void*)k_gmlp, (const void*)k_hin, (const void*)k_scan, (const void*)k_hout, (const void*)k_qkv, (const void*)k_attn};
    for (int i = 0; i < 8; ++i) (void)hipFuncSetAttribute(ks[i], hipFuncAttributeMaxDynamicSharedMemorySize, LDS_BYTES);
    per_cu = 1;
#endif
    (void)hipGetLastError();
    if (per_cu < 1) per_cu = 1;
    grid_blocks = cus * per_cu;
    if (grid_blocks > NPANEL) grid_blocks = NPANEL;
    if (grid_blocks < 1) grid_blocks = NPANEL;
  }
  if (grid_blocks < 0) return;
  Params P{};
  for (int i = 0; i < 20; ++i) P.in[i] = (const float*)d_in[i];
  P.out = (float*)d_out;
  P.ws = (unsigned char*)d_ws;
#if COOP
  P.ph_lo = 0; P.ph_hi = 5;
  (void)hipMemsetAsync((unsigned char*)d_ws + OFF_BAR, 0, 256, stream);
  void* args[] = {&P};
  hipError_t e = hipLaunchCooperativeKernel((const void*)mega, dim3(grid_blocks), dim3(512), args, LDS_BYTES, stream);
  if (e != hipSuccess) fprintf(stderr, "cooperative launch failed: %s (grid %d)\n", hipGetErrorString(e), grid_blocks);
#else
#define LAUNCH(k, a, b) do { P.ph_lo = (a); P.ph_hi = (b); hipLaunchKernelGGL(k, dim3(NPANEL), dim3(512), LDS_BYTES, stream, P); } while (0)
  LAUNCH(k_p0, 0, 0);
  LAUNCH(k_ffn, 0, 0); LAUNCH(k_gmlp, 0, 0); LAUNCH(k_ffn, 0, 1);
  LAUNCH(k_ffn, 1, 0); LAUNCH(k_hin, 0, 0); LAUNCH(k_scan, 0, 0); LAUNCH(k_hout, 0, 0); LAUNCH(k_ffn, 1, 1);
  LAUNCH(k_ffn, 2, 0); LAUNCH(k_qkv, 0, 0); LAUNCH(k_attn, 0, 0); LAUNCH(k_ffn, 2, 1);
  LAUNCH(k_ffn, 3, 0); LAUNCH(k_gmlp, 3, 1); LAUNCH(k_ffn, 3, 3);
#endif
}
```

```cpp
#include <hip/hip_runtime.h>
#include <hip/hip_cooperative_groups.h>
#include <stdint.h>
#include <stdio.h>
namespace cg = cooperative_groups;

#ifndef COOP
#define COOP 1
#endif

typedef unsigned short bf16_t;
typedef __attribute__((ext_vector_type(8))) __bf16 bfrag;
typedef __attribute__((ext_vector_type(16))) float f32x16;

constexpr int T_TOK = 32768;
constexpr int NPANEL = 256;
constexpr float ALPHA = 1.6817928305074290f;
constexpr int LDS_BYTES = 122880;

constexpr size_t SZ_WGU = (size_t)8 * 5632 * 1024 * 2;
constexpr size_t SZ_WD = (size_t)8 * 1024 * 2816 * 2;
constexpr size_t SZ_WGI = (size_t)2 * 2048 * 1024 * 2;
constexpr size_t SZ_WGO = (size_t)2 * 1024 * 1024 * 2;
constexpr size_t SZ_WSP = (size_t)2 * 8 * 128 * 128 * 2;
constexpr size_t SZ_WHI = (size_t)4096 * 1024 * 2;
constexpr size_t SZ_WHO = (size_t)1024 * 1024 * 2;
constexpr size_t SZ_WQKV = (size_t)1536 * 1024 * 2;
constexpr size_t SZ_WAO = (size_t)1024 * 1024 * 2;
constexpr size_t SZ_LB = 4096;
constexpr size_t SZ_H = (size_t)T_TOK * 1024 * 4;
constexpr size_t SZ_HB = (size_t)T_TOK * 1024 * 2;
constexpr size_t SZ_ACT = (size_t)T_TOK * 2816 * 2;
constexpr size_t SZ_SG = (size_t)T_TOK * 1024 * 2;
constexpr size_t SZ_DS = (size_t)NPANEL * 8 * 128 * 128 * 2;
constexpr size_t SZ_DEC = (size_t)NPANEL * 8 * 128 * 4;
constexpr size_t SZ_KB = (size_t)T_TOK * 128 * 2;

constexpr size_t OFF_WGU = 0;
constexpr size_t OFF_WD = OFF_WGU + SZ_WGU;
constexpr size_t OFF_WGI = OFF_WD + SZ_WD;
constexpr size_t OFF_WGO = OFF_WGI + SZ_WGI;
constexpr size_t OFF_WSP = OFF_WGO + SZ_WGO;
constexpr size_t OFF_WHI = OFF_WSP + SZ_WSP;
constexpr size_t OFF_WHO = OFF_WHI + SZ_WHI;
constexpr size_t OFF_WQKV = OFF_WHO + SZ_WHO;
constexpr size_t OFF_WAO = OFF_WQKV + SZ_WQKV;
constexpr size_t OFF_LB = OFF_WAO + SZ_WAO;
constexpr size_t OFF_H = OFF_LB + SZ_LB;
constexpr size_t OFF_HB = OFF_H + SZ_H;
constexpr size_t OFF_ACT = OFF_HB + SZ_HB;
constexpr size_t OFF_SG = OFF_ACT + SZ_ACT;
constexpr size_t OFF_DS = OFF_SG + SZ_SG;
constexpr size_t OFF_DEC = OFF_DS + SZ_DS;
constexpr size_t OFF_KB = OFF_DEC + SZ_DEC;
constexpr size_t OFF_VB = OFF_KB + SZ_KB;
constexpr size_t OFF_BAR = OFF_VB + SZ_KB;
constexpr size_t WS_END = OFF_BAR + 256;

struct Params {
  const float* in[20];
  float* out;
  unsigned char* ws;
  int ph_lo, ph_hi;
};

struct Ctx {
  const float* const* in;
  float* out;
  unsigned char* ws;
  __device__ __forceinline__ bf16_t* WGU() const { return (bf16_t*)(ws + OFF_WGU); }
  __device__ __forceinline__ bf16_t* WD() const { return (bf16_t*)(ws + OFF_WD); }
  __device__ __forceinline__ bf16_t* WGI() const { return (bf16_t*)(ws + OFF_WGI); }
  __device__ __forceinline__ bf16_t* WGO() const { return (bf16_t*)(ws + OFF_WGO); }
  __device__ __forceinline__ bf16_t* WSP() const { return (bf16_t*)(ws + OFF_WSP); }
  __device__ __forceinline__ bf16_t* WHI() const { return (bf16_t*)(ws + OFF_WHI); }
  __device__ __forceinline__ bf16_t* WHO() const { return (bf16_t*)(ws + OFF_WHO); }
  __device__ __forceinline__ bf16_t* WQKV() const { return (bf16_t*)(ws + OFF_WQKV); }
  __device__ __forceinline__ bf16_t* WAO() const { return (bf16_t*)(ws + OFF_WAO); }
  __device__ __forceinline__ float* LB() const { return (float*)(ws + OFF_LB); }
  __device__ __forceinline__ float* H() const { return (float*)(ws + OFF_H); }
  __device__ __forceinline__ bf16_t* HB() const { return (bf16_t*)(ws + OFF_HB); }
  __device__ __forceinline__ bf16_t* ACT() const { return (bf16_t*)(ws + OFF_ACT); }
  __device__ __forceinline__ bf16_t* SG() const { return (bf16_t*)(ws + OFF_SG); }
  __device__ __forceinline__ bf16_t* DS() const { return (bf16_t*)(ws + OFF_DS); }
  __device__ __forceinline__ float* DEC() const { return (float*)(ws + OFF_DEC); }
  __device__ __forceinline__ bf16_t* KB() const { return (bf16_t*)(ws + OFF_KB); }
  __device__ __forceinline__ bf16_t* VB() const { return (bf16_t*)(ws + OFF_VB); }
};

typedef __attribute__((ext_vector_type(2))) float f32x2_t;
typedef __attribute__((ext_vector_type(2))) __bf16 bf16x2_t;
__device__ __forceinline__ uint32_t pack2(float a, float b) {
  f32x2_t v = {a, b};
  bf16x2_t r = __builtin_convertvector(v, bf16x2_t);
  return __builtin_bit_cast(uint32_t, r);
}
__device__ __forceinline__ bf16_t f2bf(float f) { return (bf16_t)(pack2(f, 0.f) & 0xffffu); }
__device__ __forceinline__ float bf2f(bf16_t b) { return __uint_as_float(((uint32_t)b) << 16); }
__device__ __forceinline__ float wave_sum(float v) {
  v += __shfl_xor(v, 32, 64); v += __shfl_xor(v, 16, 64); v += __shfl_xor(v, 8, 64);
  v += __shfl_xor(v, 4, 64); v += __shfl_xor(v, 2, 64); v += __shfl_xor(v, 1, 64);
  return v;
}
__device__ __forceinline__ float silu_f(float x) { return x * __frcp_rn(1.f + __expf(-x)); }
#define ROWMAP(reg, lane) ((((reg)&3)) + 8 * ((reg) >> 2) + 4 * ((lane) >> 5))
#define MFMA(a, b, c) __builtin_amdgcn_mfma_f32_32x32x16_bf16((a), (b), (c), 0, 0, 0)

__device__ __forceinline__ int opaque_tid() {
  int t = threadIdx.x;
  asm volatile("" : "+v"(t));
  return t;
}

__device__ __forceinline__ unsigned long long opaque_u64(unsigned long long v) {
  unsigned lo = (unsigned)v, hi = (unsigned)(v >> 32);
  asm volatile("" : "+v"(lo), "+v"(hi));
  lo = __builtin_amdgcn_readfirstlane(lo);
  hi = __builtin_amdgcn_readfirstlane(hi);
  return ((unsigned long long)hi << 32) | lo;
}

__device__ __forceinline__ f32x16 zero16() {
  f32x16 z;
#pragma unroll
  for (int i = 0; i < 16; ++i) z[i] = 0.f;
  return z;
}

constexpr int G_STAGE_B = 40960;

__device__ __forceinline__ void glds16(const bf16_t* g, const char* l) {
  __builtin_amdgcn_global_load_lds((const unsigned*)g, (unsigned*)const_cast<char*>(l), 16, 0, 0);
}

#define RDFRAGS(F, stg, ok)                                                              \
  do {                                                                                   \
    const char* sa_ = lds + (stg) * G_STAGE_B + wm * 4096 + (ok);                         \
    const char* sb_ = lds + (stg) * G_STAGE_B + 8192 + wn * 8192 + (ok);                  \
    F[0] = *(const bfrag*)(sa_);                                                         \
    F[1] = *(const bfrag*)(sa_ + 2048);                                                  \
    F[2] = *(const bfrag*)(sb_);                                                         \
    F[3] = *(const bfrag*)(sb_ + 2048);                                                  \
    F[4] = *(const bfrag*)(sb_ + 4096);                                                  \
    F[5] = *(const bfrag*)(sb_ + 6144);                                                  \
  } while (0)
#define DOMFMA(F)                                                                        \
  do {                                                                                   \
    _Pragma("unroll") for (int ni_ = 0; ni_ < 4; ++ni_) {                                \
      acc[0][ni_] = MFMA(F[0], F[2 + ni_], acc[0][ni_]);                                 \
      acc[1][ni_] = MFMA(F[1], F[2 + ni_], acc[1][ni_]);                                 \
    }                                                                                    \
  } while (0)
#define ISSUE_SLAB(stg, ntv, krv)                                                        \
  do {                                                                                   \
    const char* st_ = lds + (stg) * G_STAGE_B + w * 1024;                                    \
    glds16(a_src + (krv) * 32, st_);                                                     \
    const bf16_t* bs_ = b_src + (size_t)((ntv) * nk + (krv)) * 16384;                    \
    _Pragma("unroll") for (int i_ = 0; i_ < 4; ++i_) glds16(bs_ + i_ * 4096, st_ + 8192 + i_ * 8192); \
  } while (0)

#define ISSUE_SLAB_LO(stg, ntv, krv)    \
  do {                                                                                   \
    const char* st_ = lds + (stg) * G_STAGE_B + w * 1024;                                \
    glds16(a_src + (krv) * 32, st_);                                                     \
    const bf16_t* bs_ = b_src + (size_t)((ntv) * nk + (krv)) * 16384;                    \
    glds16(bs_, st_ + 8192);                                                             \
    glds16(bs_ + 4096, st_ + 8192 + 8192);                                               \
  } while (0)
#define ISSUE_SLAB_HI(stg, ntv, krv)                        \
  do {                                                                                   \
    const char* st_ = lds + (stg) * G_STAGE_B + w * 1024;                                \
    const bf16_t* bs_ = b_src + (size_t)((ntv) * nk + (krv)) * 16384;                    \
    glds16(bs_ + 2 * 4096, st_ + 8192 + 2 * 8192);                                       \
    glds16(bs_ + 3 * 4096, st_ + 8192 + 3 * 8192);                                       \
  } while (0)

template <class Epi>
__device__ __forceinline__ void gemm_panel(const bf16_t* __restrict__ A, const int lda, const bf16_t* __restrict__ Wb,
                                           const int K, const int nN, const Epi epi, bf16_t* smem) {
  const int tid = opaque_tid(), lane = tid & 63;
  const int w = __builtin_amdgcn_readfirstlane(tid >> 6);
  const int wm = w & 1, wn = w >> 1;
  const int nk = K >> 5;
  const int total = nN * nk;
  const int l31 = lane & 31, h = lane >> 5;
  const int grow = lane >> 2;
  const int gch = (lane & 3) ^ ((lane >> 4) & 3);
  const bf16_t* a_src = A + (size_t)(w * 16 + grow) * lda + gch * 8;
  const bf16_t* b_src = Wb + (size_t)(w * 16 + grow) * 32 + gch * 8;
  const char* lds = (const char*)smem;
  const int pos0 = h ^ ((l31 >> 2) & 3);
  const int offk0 = l31 * 64 + pos0 * 16;
  const int offk1 = l31 * 64 + (pos0 ^ 2) * 16;
  f32x16 acc[2][4];
#pragma unroll
  for (int i = 0; i < 2; ++i)
#pragma unroll
    for (int j = 0; j < 4; ++j) acc[i][j] = zero16();
  const int rot = (int)(((blockIdx.x >> 3) & 31) * nk) >> 5;
  int kr3 = rot, nt3 = 0, cnt3 = 0;
  __syncthreads();
#pragma unroll
  for (int s3 = 0; s3 < 3; ++s3) {
    ISSUE_SLAB(s3, nt3, kr3);
    ++kr3; if (kr3 == nk) kr3 = 0;
    ++cnt3; if (cnt3 == nk) { cnt3 = 0; ++nt3; }
  }
  asm volatile("s_waitcnt vmcnt(10)" ::: "memory");
  asm volatile("s_waitcnt lgkmcnt(0)" ::: "memory");
  __builtin_amdgcn_s_barrier();
  asm volatile("" ::: "memory");
  bfrag F0[6], F1[6];
  RDFRAGS(F0, 0, offk0);
  int ks = 0, nt = 0, stage = 0, stage_n = 1, stage_p = 2;
  int kr3p = 0, nt3p = 0;
  for (int it = 0; it < total; ++it) {
    if (it > 0) ISSUE_SLAB_HI(stage_p, nt3p, kr3p);
    RDFRAGS(F1, stage, offk1);
    DOMFMA(F0);
    __builtin_amdgcn_sched_group_barrier(0x100, 2, 0);
    __builtin_amdgcn_sched_group_barrier(0x008, 1, 0);
    __builtin_amdgcn_sched_group_barrier(0x100, 2, 0);
    __builtin_amdgcn_sched_group_barrier(0x008, 1, 0);
    __builtin_amdgcn_sched_group_barrier(0x100, 2, 0);
    __builtin_amdgcn_sched_group_barrier(0x008, 1, 0);
    __builtin_amdgcn_sched_group_barrier(0x020, 1, 0);
    __builtin_amdgcn_sched_group_barrier(0x008, 2, 0);
    __builtin_amdgcn_sched_group_barrier(0x020, 1, 0);
    __builtin_amdgcn_sched_group_barrier(0x008, 3, 0);
    __builtin_amdgcn_sched_barrier(0);
    asm volatile("s_waitcnt vmcnt(5)" ::: "memory");
    asm volatile("s_waitcnt lgkmcnt(0)" ::: "memory");
    __builtin_amdgcn_s_barrier();
    asm volatile("" ::: "memory");
    __builtin_amdgcn_sched_barrier(0);
    ISSUE_SLAB_LO(stage, nt3, kr3);
    kr3p = kr3; nt3p = nt3;
    ++kr3; if (kr3 == nk) kr3 = 0;
    ++cnt3; if (cnt3 == nk) { cnt3 = 0; ++nt3; }
    RDFRAGS(F0, stage_n, offk0);
    DOMFMA(F1);
    __builtin_amdgcn_sched_group_barrier(0x008, 1, 1);
    __builtin_amdgcn_sched_group_barrier(0x020, 1, 1);
    __builtin_amdgcn_sched_group_barrier(0x100, 2, 1);
    __builtin_amdgcn_sched_group_barrier(0x008, 2, 1);
    __builtin_amdgcn_sched_group_barrier(0x020, 1, 1);
    __builtin_amdgcn_sched_group_barrier(0x100, 2, 1);
    __builtin_amdgcn_sched_group_barrier(0x008, 2, 1);
    __builtin_amdgcn_sched_group_barrier(0x020, 1, 1);
    __builtin_amdgcn_sched_group_barrier(0x100, 2, 1);
    __builtin_amdgcn_sched_group_barrier(0x008, 3, 1);
    __builtin_amdgcn_sched_barrier(0);
    if (ks == nk - 1) {
      epi(acc, nt, wm, wn, lane);
#pragma unroll
      for (int i = 0; i < 2; ++i)
#pragma unroll
        for (int j = 0; j < 4; ++j) acc[i][j] = zero16();
      ++nt;
      asm volatile("s_waitcnt vmcnt(0)" ::: "memory");
      RDFRAGS(F0, stage_n, offk0);
    }
    ++ks; if (ks == nk) ks = 0;
    stage_p = stage;
    stage = stage_n;
    ++stage_n; if (stage_n == 3) stage_n = 0;
  }
  asm volatile("s_waitcnt vmcnt(0)" ::: "memory");
  __syncthreads();
}

struct EpiSwiglu {
  bf16_t* act;
  __device__ __forceinline__ void operator()(f32x16 (&acc)[2][4], int nt, int wm, int wn, int lane_in) const {
    int lane = lane_in;
    asm volatile("" : "+v"(lane));
    const int l31 = lane & 31;
#pragma unroll
    for (int mi = 0; mi < 2; ++mi)
#pragma unroll
      for (int n2 = 0; n2 < 2; ++n2)
#pragma unroll
        for (int r = 0; r < 16; ++r) {
          const int row = wm * 64 + mi * 32 + ROWMAP(r, lane);
          const int col = (nt * 4 + wn) * 64 + n2 * 32 + l31;
          const float g = acc[mi][n2][r], u = acc[mi][n2 + 2][r];
          act[(size_t)row * 2816 + col] = f2bf(silu_f(g) * u);
        }
  }
};
struct EpiResLN {
  float* Hp;
  float alpha, c;
  const float* bias;
  __device__ __forceinline__ void operator()(f32x16 (&acc)[2][4], int nt, int wm, int wn, int lane_in) const {
    int lane = lane_in;
    asm volatile("" : "+v"(lane));
    const int l31 = lane & 31;
    float* base = Hp + (size_t)(wm * 64 + 4 * (lane >> 5)) * 1024 + nt * 512 + wn * 128 + l31;
#pragma unroll
    for (int ni = 0; ni < 4; ++ni) {
      const float bv = bias ? bias[nt * 512 + wn * 128 + ni * 32 + l31] : 0.f;
#pragma unroll
      for (int mi = 0; mi < 2; ++mi) {
        float hv[16];
#pragma unroll
        for (int r = 0; r < 16; ++r) hv[r] = base[(size_t)(mi * 32 + (r & 3) + 8 * (r >> 2)) * 1024 + ni * 32];
#pragma unroll
        for (int r = 0; r < 16; ++r)
          base[(size_t)(mi * 32 + (r & 3) + 8 * (r >> 2)) * 1024 + ni * 32] = alpha * hv[r] + c * (acc[mi][ni][r] + bv);
        __builtin_amdgcn_sched_barrier(0);
      }
    }
  }
};
struct EpiGelu {
  bf16_t* Z;
  __device__ __forceinline__ void operator()(f32x16 (&acc)[2][4], int nt, int wm, int wn, int lane_in) const {
    int lane = lane_in;
    asm volatile("" : "+v"(lane));
    const int l31 = lane & 31;
#pragma unroll
    for (int ni = 0; ni < 4; ++ni) {
      const int col = nt * 512 + wn * 128 + ni * 32 + l31;
#pragma unroll
      for (int mi = 0; mi < 2; ++mi)
#pragma unroll
        for (int r = 0; r < 16; ++r) {
          const int row = wm * 64 + mi * 32 + ROWMAP(r, lane);
          const float x = acc[mi][ni][r];
          Z[(size_t)row * 2048 + col] = f2bf(0.5f * x * (1.f + erff(x * 0.70710678118654752f)));
        }
    }
  }
};
struct EpiHgrn {
  bf16_t* Qp;
  bf16_t* Vp;
  float* LFp;
  bf16_t* SGp;
  const float* lb;
  __device__ __forceinline__ void operator()(f32x16 (&acc)[2][4], int nt, int wm, int wn, int lane_in) const {
    int lane = lane_in;
    asm volatile("" : "+v"(lane));
    const int l31 = lane & 31;
    const int sec = nt >> 1;
    const int cb = (nt & 1) * 512 + wn * 128 + l31;
    const int rb = wm * 64 + 4 * (lane >> 5);
    if (sec == 0 || sec == 3) {
      bf16_t* dst = (sec == 0) ? Qp : SGp;
#pragma unroll
      for (int ni = 0; ni < 4; ++ni)
#pragma unroll
        for (int mi = 0; mi < 2; ++mi)
#pragma unroll
          for (int r = 0; r < 16; ++r) {
            const int row = rb + mi * 32 + (r & 3) + 8 * (r >> 2);
            dst[(size_t)row * 1024 + cb + ni * 32] = f2bf(silu_f(acc[mi][ni][r]));
          }
    } else if (sec == 1) {
#pragma unroll
      for (int ni = 0; ni < 4; ++ni) {
        const float lbv = lb[cb + ni * 32];
#pragma unroll
        for (int mi = 0; mi < 2; ++mi)
#pragma unroll
          for (int r = 0; r < 16; ++r) {
            const int row = rb + mi * 32 + (r & 3) + 8 * (r >> 2);
            const float f = lbv + (1.f - lbv) * __frcp_rn(1.f + __expf(-acc[mi][ni][r]));
            LFp[(size_t)row * 1024 + cb + ni * 32] = __logf(f);
          }
      }
    } else {
#pragma unroll
      for (int ni = 0; ni < 4; ++ni)
#pragma unroll
        for (int mi = 0; mi < 2; ++mi)
#pragma unroll
          for (int r = 0; r < 16; ++r) {
            const int row = rb + mi * 32 + (r & 3) + 8 * (r >> 2);
            Vp[(size_t)row * 1024 + cb + ni * 32] = f2bf(acc[mi][ni][r]);
          }
    }
  }
};
struct EpiQkv {
  bf16_t* Qp;
  bf16_t* Kp;
  bf16_t* Vp;
  const float* bias;
  __device__ __forceinline__ void operator()(f32x16 (&acc)[2][4], int nt, int wm, int wn, int lane_in) const {
    int lane = lane_in;
    asm volatile("" : "+v"(lane));
    const int l31 = lane & 31;
#pragma unroll
    for (int ni = 0; ni < 4; ++ni) {
      const int col = nt * 512 + wn * 128 + ni * 32 + l31;
      if (col < 1280) {
        const float bv = bias[col];
#pragma unroll
        for (int mi = 0; mi < 2; ++mi)
#pragma unroll
          for (int r = 0; r < 16; ++r) {
            const int row = wm * 64 + mi * 32 + ROWMAP(r, lane);
            const float x = acc[mi][ni][r] + bv;
            if (col < 1024) Qp[(size_t)row * 1024 + col] = f2bf(x * 0.125f);
            else if (col < 1152) Kp[(size_t)row * 128 + (col - 1024)] = f2bf(x);
            else Vp[(size_t)row * 128 + (col - 1152)] = f2bf(x);
          }
      }
    }
  }
};

__device__ __forceinline__ void ln_panel(const float* Hp, float* outp, bf16_t* HBp, const float* g, const float* b) {
  const int tid = opaque_tid(), lane = tid & 63;
  const int w = __builtin_amdgcn_readfirstlane(tid >> 6);
  float4 gv[4], bv[4];
#pragma unroll
  for (int j = 0; j < 4; ++j) {
    gv[j] = *(const float4*)(g + j * 256 + lane * 4);
    bv[j] = *(const float4*)(b + j * 256 + lane * 4);
  }
  for (int r = w; r < 128; r += 8) {
    float4 x[4];
    float s = 0.f;
#pragma unroll
    for (int j = 0; j < 4; ++j) {
      x[j] = *(const float4*)(Hp + (size_t)r * 1024 + j * 256 + lane * 4);
      s += x[j].x + x[j].y + x[j].z + x[j].w;
    }
    s = wave_sum(s);
    const float mean = s * (1.f / 1024.f);
    float v = 0.f;
#pragma unroll
    for (int j = 0; j < 4; ++j) {
      x[j].x -= mean; x[j].y -= mean; x[j].z -= mean; x[j].w -= mean;
      v += x[j].x * x[j].x + x[j].y * x[j].y + x[j].z * x[j].z + x[j].w * x[j].w;
    }
    v = wave_sum(v);
    const float rstd = 1.0f / sqrtf(v * (1.f / 1024.f) + 1e-5f);
#pragma unroll
    for (int j = 0; j < 4; ++j) {
      float4 y;
      y.x = x[j].x * rstd * gv[j].x + bv[j].x;
      y.y = x[j].y * rstd * gv[j].y + bv[j].y;
      y.z = x[j].z * rstd * gv[j].z + bv[j].z;
      y.w = x[j].w * rstd * gv[j].w + bv[j].w;
      *(float4*)(outp + (size_t)r * 1024 + j * 256 + lane * 4) = y;
      uint2 pk;
      pk.x = pack2(y.x, y.y);
      pk.y = pack2(y.z, y.w);
      *(uint2*)(HBp + (size_t)r * 1024 + j * 256 + lane * 4) = pk;
    }
  }
  __syncthreads();
}

__device__ __forceinline__ void ffn_panel(const Ctx& C, int p, int layer, int j, bool final_out, bf16_t* smem) {
  const int wi = layer * 2 + j;
  bf16_t* HBp = C.HB() + (size_t)p * 128 * 1024;
  bf16_t* ACTp = C.ACT() + (size_t)p * 128 * 2816;
  float* Hp = C.H() + (size_t)p * 128 * 1024;
  EpiSwiglu e1{ACTp};
  gemm_panel(HBp, 1024, C.WGU() + (size_t)wi * 5632 * 1024, 1024, 11, e1, smem);
  EpiResLN e2{Hp, ALPHA, 0.5f, nullptr};
  gemm_panel(ACTp, 2816, C.WD() + (size_t)wi * 1024 * 2816, 2816, 2, e2, smem);
  const int li = (layer * 3 + (j == 0 ? 0 : 2)) * 1024;
  float* outp = final_out ? (C.out + (size_t)p * 128 * 1024) : Hp;
  ln_panel(Hp, outp, HBp, C.in[3] + li, C.in[4] + li);
}

__device__ __forceinline__ void gmlp_panel(const Ctx& C, int p, int layer, int slot, bf16_t* smem) {
  const int tid = opaque_tid(), lane = tid & 63;
  const int w = __builtin_amdgcn_readfirstlane(tid >> 6);
  const int l31 = lane & 31, h8 = (lane >> 5) * 8;
  bf16_t* HBp = C.HB() + (size_t)p * 128 * 1024;
  bf16_t* Zp = C.ACT() + (size_t)p * 128 * 2816;
  float* Hp = C.H() + (size_t)p * 128 * 1024;
  {
    EpiGelu e{Zp};
    gemm_panel(HBp, 1024, C.WGI() + (size_t)slot * 2048 * 1024, 1024, 4, e, smem);
  }
  bf16_t* As = smem;
  bf16_t* Bs = smem + 128 * 136;
  float* st = (float*)(smem + 2 * 128 * 136);
  for (int r = w; r < 128; r += 8) {
    const uint4 q0 = *(const uint4*)(Zp + (size_t)r * 2048 + 1024 + lane * 16);
    const uint4 q1 = *(const uint4*)(Zp + (size_t)r * 2048 + 1024 + lane * 16 + 8);
    const uint32_t u[8] = {q0.x, q0.y, q0.z, q0.w, q1.x, q1.y, q1.z, q1.w};
    float x[16];
    float s = 0.f;
#pragma unroll
    for (int e = 0; e < 8; ++e) {
      x[2 * e] = __uint_as_float(u[e] << 16);
      x[2 * e + 1] = __uint_as_float(u[e] & 0xffff0000u);
      s += x[2 * e] + x[2 * e + 1];
    }
    s = wave_sum(s);
    const float mean = s * (1.f / 1024.f);
    float v = 0.f;
#pragma unroll
    for (int e = 0; e < 16; ++e) { const float d = x[e] - mean; v += d * d; }
    v = wave_sum(v);
    if (lane == 0) { st[r * 2] = mean; st[r * 2 + 1] = 1.0f / sqrtf(v * (1.f / 1024.f) + 1e-5f); }
  }
  __syncthreads();
  const float* lng = C.in[6] + slot * 1024;
  const float* lnb = C.in[7] + slot * 1024;
  const float* bsp = C.in[9] + slot * 1024;
  const bf16_t* Wsp = C.WSP() + (size_t)slot * 8 * 16384;
  const int nd = w & 3, mt0 = (w >> 2) * 2;
  for (int g = 0; g < 8; ++g) {
#pragma unroll
    for (int i = 0; i < 4; ++i) {
      const int c = tid + 512 * i;
      *(uint4*)(As + (c >> 4) * 136 + (c & 15) * 8) = *(const uint4*)(Wsp + (size_t)g * 16384 + c * 8);
    }
    {
      const int s = tid >> 2, dq = tid & 3;
      const float mean = st[s * 2], rstd = st[s * 2 + 1];
      const bf16_t* src = Zp + (size_t)s * 2048 + 1024 + g * 128 + dq * 32;
#pragma unroll
      for (int q = 0; q < 4; ++q) {
        const uint4 v4 = *(const uint4*)(src + q * 8);
        const uint32_t u[4] = {v4.x, v4.y, v4.z, v4.w};
#pragma unroll
        for (int e = 0; e < 4; ++e) {
          const int d0 = dq * 32 + q * 8 + e * 2;
          const int ch = g * 128 + d0;
          const float x0 = __uint_as_float(u[e] << 16), x1 = __uint_as_float(u[e] & 0xffff0000u);
          Bs[d0 * 136 + s] = f2bf((x0 - mean) * rstd * lng[ch] + lnb[ch]);
          Bs[(d0 + 1) * 136 + s] = f2bf((x1 - mean) * rstd * lng[ch + 1] + lnb[ch + 1]);
        }
      }
    }
    __syncthreads();
    f32x16 acc[2];
    acc[0] = zero16(); acc[1] = zero16();
#pragma unroll
    for (int k16 = 0; k16 < 8; ++k16) {
      const bfrag b = *(const bfrag*)(Bs + (nd * 32 + l31) * 136 + k16 * 16 + h8);
#pragma unroll
      for (int mi = 0; mi < 2; ++mi) {
        const bfrag a = *(const bfrag*)(As + ((mt0 + mi) * 32 + l31) * 136 + k16 * 16 + h8);
        acc[mi] = MFMA(a, b, acc[mi]);
      }
    }
#pragma unroll
    for (int mi = 0; mi < 2; ++mi)
#pragma unroll
      for (int r = 0; r < 16; ++r) {
        const int t = (mt0 + mi) * 32 + ROWMAP(r, lane);
        const int ch = g * 128 + nd * 32 + l31;
        const float mixed = acc[mi][r] + bsp[g * 128 + t];
        const float u = bf2f(Zp[(size_t)t * 2048 + ch]);
        HBp[(size_t)t * 1024 + ch] = f2bf(u * mixed);
      }
    __syncthreads();
  }
  {
    EpiResLN e2{Hp, ALPHA, 1.0f, nullptr};
    gemm_panel(HBp, 1024, C.WGO() + (size_t)slot * 1024 * 1024, 1024, 2, e2, smem);
  }
  const int li = (layer * 3 + 1) * 1024;
  ln_panel(Hp, Hp, HBp, C.in[3] + li, C.in[4] + li);
}

template <bool OUT>
__device__ __forceinline__ void hgrn_rec(const Ctx& C, int p, bf16_t* smem) {
  const int tid = opaque_tid(), lane = tid & 63;
  const int w = __builtin_amdgcn_readfirstlane(tid >> 6);
  const int l31 = lane & 31, h8 = (lane >> 5) * 8;
  bf16_t* ST = smem;
  bf16_t* Qh = smem + 17408;
  bf16_t* Kh = smem + 21760;
  bf16_t* KhT = smem + 26112;
  bf16_t* vT = smem + 31232;
  bf16_t* Ps = smem + 36352;
  float* seg = (float*)(smem + 37632);
  float* dec = seg + 512;
  float* oF = dec + 128;
  const size_t row0 = (size_t)p * 128;
  const bf16_t* Qp = C.ACT() + (size_t)p * 128 * 2816;
  const bf16_t* Vp = Qp + 128 * 1024;
  const float* LFp = C.out + row0 * 1024;
  const bf16_t* SGp = C.SG() + row0 * 1024;
  bf16_t* HBp = C.HB() + row0 * 1024;
  const float* ng = C.in[13];
  const int jt = w >> 1, kt0 = (w & 1) * 2;
  const int kq = tid & 127, tq = tid >> 7;
  for (int h = 0; h < 8; ++h) {
    f32x16 accS[2];
    bf16_t* SBh = C.DS() + ((size_t)(p * 8 + h)) * 16384;
    if (OUT) {
      __syncthreads();
#pragma unroll
      for (int i = 0; i < 4; ++i) {
        const int c = tid + 512 * i;
        *(uint4*)(ST + (c >> 4) * 136 + (c & 15) * 8) = *(const uint4*)(SBh + c * 8);
      }
      __syncthreads();
#pragma unroll
      for (int c2 = 0; c2 < 2; ++c2)
#pragma unroll
        for (int r = 0; r < 16; ++r)
          accS[c2][r] = bf2f(ST[(jt * 32 + ROWMAP(r, lane)) * 136 + (kt0 + c2) * 32 + l31]);
    } else {
      accS[0] = zero16(); accS[1] = zero16();
    }
    float dsum = 0.f;
    for (int i = 0; i < 4; ++i) {
      float l[8], cs[8];
      const size_t gbase = (size_t)(i * 32 + tq * 8) * 1024 + h * 128 + kq;
#pragma unroll
      for (int e = 0; e < 8; ++e) l[e] = LFp[gbase + (size_t)e * 1024];
      cs[0] = l[0];
#pragma unroll
      for (int e = 1; e < 8; ++e) cs[e] = cs[e - 1] + l[e];
      seg[tq * 128 + kq] = cs[7];
#pragma unroll
      for (int e = 0; e < 8; ++e) vT[kq * 40 + tq * 8 + e] = Vp[gbase + (size_t)e * 1024];
      __syncthreads();
      float off = 0.f, tot = 0.f;
#pragma unroll
      for (int q = 0; q < 4; ++q) {
        const float s = seg[q * 128 + kq];
        if (q < tq) off += s;
        tot += s;
      }
#pragma unroll
      for (int e = 0; e < 8; ++e) {
        const float gc = cs[e] + off;
        const float f = __expf(l[e]);
        const float kh = (1.f - f) * __expf(-gc);
        const bf16_t khb = f2bf(kh);
        const int t = tq * 8 + e;
        KhT[kq * 40 + t] = khb;
        if (OUT) {
          Kh[t * 136 + kq] = khb;
          const float qv = bf2f(Qp[gbase + (size_t)e * 1024]);
          Qh[t * 136 + kq] = f2bf(qv * __expf(gc));
        }
      }
      if (tq == 0) { dec[kq] = __expf(tot); dsum += tot; }
      __syncthreads();
      f32x16 accO = zero16();
      if (OUT) {
        if (w == 0) {
          f32x16 accP = zero16();
#pragma unroll
          for (int k16 = 0; k16 < 8; ++k16) {
            const bfrag a = *(const bfrag*)(Qh + l31 * 136 + k16 * 16 + h8);
            const bfrag b = *(const bfrag*)(Kh + l31 * 136 + k16 * 16 + h8);
            accP = MFMA(a, b, accP);
          }
#pragma unroll
          for (int r = 0; r < 16; ++r) {
            const int t = ROWMAP(r, lane);
            Ps[t * 40 + l31] = (l31 <= t) ? f2bf(accP[r]) : (bf16_t)0;
          }
        } else if (w <= 4) {
          const int nt = w - 1;
#pragma unroll
          for (int k16 = 0; k16 < 8; ++k16) {
            const bfrag a = *(const bfrag*)(Qh + l31 * 136 + k16 * 16 + h8);
            const bfrag b = *(const bfrag*)(ST + (nt * 32 + l31) * 136 + k16 * 16 + h8);
            accO = MFMA(a, b, accO);
          }
        }
        __syncthreads();
        if (w >= 1 && w <= 4) {
          const int nt = w - 1;
#pragma unroll
          for (int k16 = 0; k16 < 2; ++k16) {
            const bfrag a = *(const bfrag*)(Ps + l31 * 40 + k16 * 16 + h8);
            const bfrag b = *(const bfrag*)(vT + (nt * 32 + l31) * 40 + k16 * 16 + h8);
            accO = MFMA(a, b, accO);
          }
#pragma unroll
          for (int r = 0; r < 16; ++r) oF[ROWMAP(r, lane) * 132 + nt * 32 + l31] = accO[r];
        }
      }
#pragma unroll
      for (int c2 = 0; c2 < 2; ++c2) {
#pragma unroll
        for (int k16 = 0; k16 < 2; ++k16) {
          const bfrag a = *(const bfrag*)(vT + (jt * 32 + l31) * 40 + k16 * 16 + h8);
          const bfrag b = *(const bfrag*)(KhT + ((kt0 + c2) * 32 + l31) * 40 + k16 * 16 + h8);
          accS[c2] = MFMA(a, b, accS[c2]);
        }
        const float dk = dec[(kt0 + c2) * 32 + l31];
#pragma unroll
        for (int r = 0; r < 16; ++r) accS[c2][r] *= dk;
        if (OUT) {
#pragma unroll
          for (int r = 0; r < 16; ++r)
            ST[(jt * 32 + ROWMAP(r, lane)) * 136 + (kt0 + c2) * 32 + l31] = f2bf(accS[c2][r]);
        }
      }
      __syncthreads();
      if (OUT) {
        const int t = tid >> 4, part = tid & 15;
        float x[8];
        float ss = 0.f;
#pragma unroll
        for (int e = 0; e < 8; ++e) { x[e] = oF[t * 132 + part * 8 + e]; ss += x[e] * x[e]; }
        ss += __shfl_xor(ss, 1, 64); ss += __shfl_xor(ss, 2, 64); ss += __shfl_xor(ss, 4, 64); ss += __shfl_xor(ss, 8, 64);
        const float rr = 1.0f / sqrtf(ss * (1.f / 128.f) + 1e-6f);
        const size_t gro = (size_t)(i * 32 + t) * 1024 + h * 128 + part * 8;
        const uint4 sg4 = *(const uint4*)(SGp + gro);
        const uint32_t su[4] = {sg4.x, sg4.y, sg4.z, sg4.w};
        uint32_t ov[4];
#pragma unroll
        for (int e = 0; e < 4; ++e) {
          const float g0 = ng[part * 8 + 2 * e], g1 = ng[part * 8 + 2 * e + 1];
          const float s0 = __uint_as_float(su[e] << 16), s1 = __uint_as_float(su[e] & 0xffff0000u);
          ov[e] = pack2(x[2 * e] * rr * g0 * s0, x[2 * e + 1] * rr * g1 * s1);
        }
        uint4 o4; o4.x = ov[0]; o4.y = ov[1]; o4.z = ov[2]; o4.w = ov[3];
        *(uint4*)(HBp + gro) = o4;
      }
    }
    if (!OUT) {
#pragma unroll
      for (int c2 = 0; c2 < 2; ++c2)
#pragma unroll
        for (int r = 0; r < 16; ++r)
          SBh[(jt * 32 + ROWMAP(r, lane)) * 128 + (kt0 + c2) * 32 + l31] = f2bf(accS[c2][r]);
      if (tq == 0) C.DEC()[(size_t)(p * 8 + h) * 128 + kq] = __expf(dsum);
    }
  }
  __syncthreads();
}

__device__ __forceinline__ void hgrn_scan(const Ctx& C) {
  for (int gid = blockIdx.x * 512 + threadIdx.x; gid < 131072; gid += gridDim.x * 512) {
    const int kp = gid & 63, j = (gid >> 6) & 127, h = (gid >> 13) & 7, b = gid >> 16;
    float s0 = 0.f, s1 = 0.f;
    for (int c0 = 0; c0 < 128; c0 += 8) {
      uint32_t d[8];
      float2 dc[8];
#pragma unroll
      for (int e = 0; e < 8; ++e) {
        const size_t ph = (size_t)((b * 128 + c0 + e) * 8 + h);
        d[e] = *(const uint32_t*)(C.DS() + ph * 16384 + j * 128 + kp * 2);
        dc[e] = *(const float2*)(C.DEC() + ph * 128 + kp * 2);
      }
#pragma unroll
      for (int e = 0; e < 8; ++e) {
        const size_t ph = (size_t)((b * 128 + c0 + e) * 8 + h);
        *(uint32_t*)(C.DS() + ph * 16384 + j * 128 + kp * 2) = pack2(s0, s1);
        s0 = dc[e].x * s0 + __uint_as_float(d[e] << 16);
        s1 = dc[e].y * s1 + __uint_as_float(d[e] & 0xffff0000u);
      }
    }
  }
}

__device__ __forceinline__ void attn_panel(const Ctx& C, int p, bf16_t* smem) {
  const int tid = opaque_tid(), lane = tid & 63;
  const int w = __builtin_amdgcn_readfirstlane(tid >> 6);
  const int l31 = lane & 31, h8 = (lane >> 5) * 8;
  bf16_t* K2 = smem;
  bf16_t* VT = smem + 18432;
  bf16_t* Pw = smem + 35328 + w * 1280;
  const int blk = p & 127;
  const size_t row0 = (size_t)p * 128;
  const bf16_t* Qp = C.ACT() + (size_t)p * 128 * 2816;
  bf16_t* HBp = C.HB() + row0 * 1024;
  const int qt = w & 3;
  for (int hk = 0; hk < 2; ++hk) {
    __syncthreads();
#pragma unroll
    for (int i = 0; i < 4; ++i) {
      const int c = tid + 512 * i;
      const int r = c >> 3, ch = c & 7;
      uint4 kv = make_uint4(0, 0, 0, 0), vv = make_uint4(0, 0, 0, 0);
      if (blk > 0 || r >= 128) {
        const size_t tok = row0 + r - 128;
        kv = *(const uint4*)(C.KB() + tok * 128 + hk * 64 + ch * 8);
        vv = *(const uint4*)(C.VB() + tok * 128 + hk * 64 + ch * 8);
      }
      *(uint4*)(K2 + r * 72 + ch * 8) = kv;
      const uint32_t vu[4] = {vv.x, vv.y, vv.z, vv.w};
#pragma unroll
      for (int e = 0; e < 4; ++e) {
        VT[(ch * 8 + 2 * e) * 264 + r] = (bf16_t)(vu[e] & 0xffffu);
        VT[(ch * 8 + 2 * e + 1) * 264 + r] = (bf16_t)(vu[e] >> 16);
      }
    }
    __syncthreads();
    for (int u = 0; u < 4; ++u) {
      const int hq = hk * 8 + (w >> 2) * 4 + u;
      const float sink = C.in[17][hq];
      bfrag aq[4];
#pragma unroll
      for (int k16 = 0; k16 < 4; ++k16)
        aq[k16] = *(const bfrag*)(Qp + (size_t)(qt * 32 + l31) * 1024 + hq * 64 + k16 * 16 + h8);
      f32x16 s[5];
#pragma unroll
      for (int c = 0; c < 5; ++c) {
        s[c] = zero16();
#pragma unroll
        for (int k16 = 0; k16 < 4; ++k16) {
          const bfrag b = *(const bfrag*)(K2 + ((qt + c) * 32 + l31) * 72 + k16 * 16 + h8);
          s[c] = MFMA(aq[k16], b, s[c]);
        }
      }
      float linv[16];
#pragma unroll
      for (int r = 0; r < 16; ++r) {
        const int qi = qt * 32 + ROWMAP(r, lane);
        float m = -1e30f;
#pragma unroll
        for (int c = 0; c < 5; ++c) {
          const int kp = (qt + c) * 32 + l31;
          const bool valid = (kp > qi) && (kp <= qi + 128) && (blk > 0 || kp >= 128);
          const float v = valid ? s[c][r] : -1e30f;
          s[c][r] = v;
          m = fmaxf(m, v);
        }
        m = fmaxf(m, __shfl_xor(m, 16, 64)); m = fmaxf(m, __shfl_xor(m, 8, 64)); m = fmaxf(m, __shfl_xor(m, 4, 64));
        m = fmaxf(m, __shfl_xor(m, 2, 64)); m = fmaxf(m, __shfl_xor(m, 1, 64));
        m = fmaxf(m, sink);
        float sum = 0.f;
#pragma unroll
        for (int c = 0; c < 5; ++c) {
          const float pv = (s[c][r] > -1e29f) ? __expf(s[c][r] - m) : 0.f;
          s[c][r] = pv;
          sum += pv;
        }
        sum += __shfl_xor(sum, 16, 64); sum += __shfl_xor(sum, 8, 64); sum += __shfl_xor(sum, 4, 64);
        sum += __shfl_xor(sum, 2, 64); sum += __shfl_xor(sum, 1, 64);
        sum += __expf(sink - m);
        linv[r] = 1.f / sum;
      }
      f32x16 o[2];
      o[0] = zero16(); o[1] = zero16();
#pragma unroll
      for (int c = 0; c < 5; ++c) {
#pragma unroll
        for (int r = 0; r < 16; ++r) Pw[ROWMAP(r, lane) * 40 + l31] = f2bf(s[c][r]);
        __syncthreads();
#pragma unroll
        for (int k16 = 0; k16 < 2; ++k16) {
          const bfrag a = *(const bfrag*)(Pw + l31 * 40 + k16 * 16 + h8);
#pragma unroll
          for (int dt = 0; dt < 2; ++dt) {
            const bfrag b = *(const bfrag*)(VT + (dt * 32 + l31) * 264 + (qt + c) * 32 + k16 * 16 + h8);
            o[dt] = MFMA(a, b, o[dt]);
          }
        }
        __syncthreads();
      }
#pragma unroll
      for (int dt = 0; dt < 2; ++dt)
#pragma unroll
        for (int r = 0; r < 16; ++r)
          HBp[(size_t)(qt * 32 + ROWMAP(r, lane)) * 1024 + hq * 64 + dt * 32 + l31] = f2bf(o[dt][r] * linv[r]);
    }
  }
  __syncthreads();
}

__device__ __forceinline__ void conv_weights(const float* __restrict__ src, bf16_t* __restrict__ dst, int nmat, int K,
                                             int Nsrc, int Ndst, int mode) {
  const int nk = K >> 5, nNt = Ndst >> 9;
  const int upm = nk * nNt;
  const int tid = threadIdx.x;
  for (int u = blockIdx.x; u < nmat * upm; u += gridDim.x) {
    const int m = u / upm, r = u - m * upm;
    const int nt = r / nk, ks = r - nt * nk;
    const int np = nt * 512 + tid;
    int sc;
    if (mode == 1) {
      const int b = np >> 7, rr = np & 127;
      sc = (rr < 64) ? (b * 64 + rr) : (2816 + b * 64 + rr - 64);
    } else {
      sc = (np < Nsrc) ? np : -1;
    }
    const float* s = src + (size_t)m * K * Nsrc + (size_t)(ks * 32) * Nsrc + (sc < 0 ? 0 : sc);
    uint32_t pk[16];
#pragma unroll
    for (int kk = 0; kk < 16; ++kk) {
      float v0 = s[(size_t)(2 * kk) * Nsrc], v1 = s[(size_t)(2 * kk + 1) * Nsrc];
      if (sc < 0) { v0 = 0.f; v1 = 0.f; }
      pk[kk] = pack2(v0, v1);
    }
    uint4* d = (uint4*)(dst + (size_t)m * K * Ndst + (size_t)(nt * nk + ks) * 16384 + tid * 32);
    d[0] = make_uint4(pk[0], pk[1], pk[2], pk[3]);
    d[1] = make_uint4(pk[4], pk[5], pk[6], pk[7]);
    d[2] = make_uint4(pk[8], pk[9], pk[10], pk[11]);
    d[3] = make_uint4(pk[12], pk[13], pk[14], pk[15]);
  }
}

__device__ __forceinline__ void phase0(const Ctx& C) {
  conv_weights(C.in[1], C.WGU(), 8, 1024, 5632, 5632, 1);
  conv_weights(C.in[2], C.WD(), 8, 2816, 1024, 1024, 0);
  conv_weights(C.in[5], C.WGI(), 2, 1024, 2048, 2048, 0);
  conv_weights(C.in[10], C.WGO(), 2, 1024, 1024, 1024, 0);
  conv_weights(C.in[11], C.WHI(), 1, 1024, 4096, 4096, 0);
  conv_weights(C.in[14], C.WHO(), 1, 1024, 1024, 1024, 0);
  conv_weights(C.in[15], C.WQKV(), 1, 1024, 1280, 1536, 0);
  conv_weights(C.in[18], C.WAO(), 1, 1024, 1024, 1024, 0);
  const size_t gtid = (size_t)blockIdx.x * 512 + threadIdx.x;
  const size_t gsz = (size_t)gridDim.x * 512;
  for (size_t i = gtid; i < (size_t)T_TOK * 1024 / 4; i += gsz) {
    const float4 v = ((const float4*)C.in[0])[i];
    ((float4*)C.H())[i] = v;
    uint2 pk;
    pk.x = pack2(v.x, v.y);
    pk.y = pack2(v.z, v.w);
    ((uint2*)C.HB())[i] = pk;
  }
  for (size_t i = gtid; i < (size_t)2 * 8 * 128 * 128; i += gsz) {
    const int s = (int)(i & 127), t = (int)((i >> 7) & 127);
    C.WSP()[i] = (s <= t) ? f2bf(C.in[8][i]) : (bf16_t)0;
  }
  for (size_t i = gtid; i < 1024; i += gsz) {
    const float* lp = C.in[12];
    const float a0 = lp[i], a1 = lp[1024 + i], a2 = lp[2048 + i], a3 = lp[3072 + i];
    const float m = fmaxf(fmaxf(a0, a1), fmaxf(a2, a3));
    const float e0 = expf(a0 - m), e1 = expf(a1 - m), e2 = expf(a2 - m), e3 = expf(a3 - m);
    C.LB()[i] = e1 / (e0 + e1 + e2 + e3);
  }
}

enum { OP_FFN = 0, OP_GMLP = 1, OP_HIN = 2, OP_HOUT = 3, OP_QKV = 4, OP_ATTN = 5 };

__device__ __forceinline__ void run_ops(const Ctx& C0, int op_lo, int op_hi, bf16_t* smem) {
  for (int p0 = blockIdx.x; p0 < NPANEL; p0 += gridDim.x) {
    for (int op = op_lo; op < op_hi; ++op) {
      const Ctx& C = C0;
      const int p = p0;
      bf16_t* HBp = C.HB() + (size_t)p * 128 * 1024;
      float* Hp = C.H() + (size_t)p * 128 * 1024;
      bf16_t* ACTp = C.ACT() + (size_t)p * 128 * 2816;
      int kind = OP_FFN, layer = 0, j = 0;
      switch (op) {
        case 0: kind = OP_FFN; layer = 0; j = 0; break;
        case 1: kind = OP_GMLP; layer = 0; j = 0; break;
        case 2: kind = OP_FFN; layer = 0; j = 1; break;
        case 3: kind = OP_FFN; layer = 1; j = 0; break;
        case 4: kind = OP_HIN; layer = 1; break;
        case 5: kind = OP_HOUT; layer = 1; break;
        case 6: kind = OP_FFN; layer = 1; j = 1; break;
        case 7: kind = OP_FFN; layer = 2; j = 0; break;
        case 8: kind = OP_QKV; layer = 2; break;
        case 9: kind = OP_ATTN; layer = 2; break;
        case 10: kind = OP_FFN; layer = 2; j = 1; break;
        case 11: kind = OP_FFN; layer = 3; j = 0; break;
        case 12: kind = OP_GMLP; layer = 3; j = 1; break;
        default: kind = OP_FFN; layer = 3; j = 1; break;
      }
      if (kind == OP_FFN) {
        ffn_panel(C, p, layer, j, op == 13, smem);
      } else if (kind == OP_GMLP) {
        gmlp_panel(C, p, layer, j, smem);
      } else if (kind == OP_HIN) {
        EpiHgrn e{ACTp, ACTp + 128 * 1024, C.out + (size_t)p * 128 * 1024, C.SG() + (size_t)p * 128 * 1024, C.LB()};
        gemm_panel(HBp, 1024, C.WHI(), 1024, 8, e, smem);
        hgrn_rec<false>(C, p, smem);
      } else if (kind == OP_HOUT) {
        hgrn_rec<true>(C, p, smem);
        EpiResLN e2{Hp, ALPHA, 1.0f, nullptr};
        gemm_panel(HBp, 1024, C.WHO(), 1024, 2, e2, smem);
        const int li = (1 * 3 + 1) * 1024;
        ln_panel(Hp, Hp, HBp, C.in[3] + li, C.in[4] + li);
      } else if (kind == OP_QKV) {
        EpiQkv e{ACTp, C.KB() + (size_t)p * 128 * 128, C.VB() + (size_t)p * 128 * 128, C.in[16]};
        gemm_panel(HBp, 1024, C.WQKV(), 1024, 3, e, smem);
      } else {
        attn_panel(C, p, smem);
        EpiResLN e2{Hp, ALPHA, 1.0f, C.in[19]};
        gemm_panel(HBp, 1024, C.WAO(), 1024, 2, e2, smem);
        const int li = (2 * 3 + 1) * 1024;
        ln_panel(Hp, Hp, HBp, C.in[3] + li, C.in[4] + li);
      }
    }
  }
}

#if COOP
__device__ __forceinline__ void grid_barrier(unsigned* bar, unsigned target) {
  __syncthreads();
  if (threadIdx.x == 0) {
    __threadfence();
    __hip_atomic_fetch_add(bar, 1u, __ATOMIC_RELEASE, __HIP_MEMORY_SCOPE_AGENT);
    while (__hip_atomic_load(bar, __ATOMIC_ACQUIRE, __HIP_MEMORY_SCOPE_AGENT) < target) __builtin_amdgcn_s_sleep(8);
    __threadfence();
  }
  __syncthreads();
}

__global__ void __launch_bounds__(512) mega(Params P) {
  extern __shared__ __attribute__((aligned(16))) unsigned char lds_raw[];
  bf16_t* smem = (bf16_t*)lds_raw;
  Ctx C;
  C.in = P.in;
  C.out = P.out;
  C.ws = P.ws;
  const int lo = P.ph_lo, hi = P.ph_hi;
#if COOP
  if (lo < 0) cg::this_grid().sync();
  unsigned* bar = (unsigned*)(P.ws + OFF_BAR);
#define GSYNC(k) do { if (lo <= (k) && (k) + 1 < hi) grid_barrier(bar, (unsigned)((k) + 1) * gridDim.x); } while (0)
#else
#define GSYNC(k) do { } while (0)
#endif
  if (lo <= 0 && 0 < hi) phase0(C);
  GSYNC(0);
  if (lo <= 1 && 1 < hi) run_ops(C, 0, 5, smem);
  GSYNC(1);
  if (lo <= 2 && 2 < hi) hgrn_scan(C);
  GSYNC(2);
  if (lo <= 3 && 3 < hi) run_ops(C, 5, 9, smem);
  GSYNC(3);
  if (lo <= 4 && 4 < hi) run_ops(C, 9, 14, smem);
}

#endif

#if !COOP
__device__ __forceinline__ Ctx make_ctx(const Params& P) { Ctx C; C.in = P.in; C.out = P.out; C.ws = P.ws; return C; }
#define OPK(name, ...) __global__ void __launch_bounds__(512) name(Params P) { \
    extern __shared__ __attribute__((aligned(16))) unsigned char lds_raw[]; bf16_t* smem = (bf16_t*)lds_raw; \
    Ctx C = make_ctx(P); const int p = blockIdx.x; const int layer = P.ph_lo, j = P.ph_hi; (void)p; (void)layer; (void)j; (void)smem; __VA_ARGS__; }
OPK(k_p0, phase0(C))
OPK(k_ffn, ffn_panel(C, p, layer, j & 1, (j >> 1) != 0, smem))
OPK(k_gmlp, gmlp_panel(C, p, layer, j, smem))
OPK(k_hin, { bf16_t* ACTp = C.ACT() + (size_t)p * 128 * 2816; EpiHgrn e{ACTp, ACTp + 128 * 1024, C.out + (size_t)p * 128 * 1024, C.SG() + (size_t)p * 128 * 1024, C.LB()}; gemm_panel(C.HB() + (size_t)p * 128 * 1024, 1024, C.WHI(), 1024, 8, e, smem); hgrn_rec<false>(C, p, smem); })
OPK(k_scan, hgrn_scan(C))
OPK(k_hout, { hgrn_rec<true>(C, p, smem); float* Hp = C.H() + (size_t)p * 128 * 1024; bf16_t* HBp = C.HB() + (size_t)p * 128 * 1024; EpiResLN e2{Hp, ALPHA, 1.0f, nullptr}; gemm_panel(HBp, 1024, C.WHO(), 1024, 2, e2, smem); ln_panel(Hp, Hp, HBp, C.in[3] + 4 * 1024, C.in[4] + 4 * 1024); })
OPK(k_qkv, { bf16_t* ACTp = C.ACT() + (size_t)p * 128 * 2816; EpiQkv e{ACTp, C.KB() + (size_t)p * 128 * 128, C.VB() + (size_t)p * 128 * 128, C.in[16]}; gemm_panel(C.HB() + (size_t)p * 128 * 1024, 1024, C.WQKV(), 1024, 3, e, smem); })
OPK(k_attn, { attn_panel(C, p, smem); float* Hp = C.H() + (size_t)p * 128 * 1024; bf16_t* HBp = C.HB() + (size_t)p * 128 * 1024; EpiResLN e2{Hp, ALPHA, 1.0f, C.in[19]}; gemm_panel(HBp, 1024, C.WAO(), 1024, 2, e2, smem); ln_panel(Hp, Hp, HBp, C.in[3] + 7 * 1024, C.in[4] + 7 * 1024); })
#endif

extern "C" void kernel_launch(void* const* d_in, const int* in_sizes, int n_in, void* d_out, int out_size, void* d_ws,
                              size_t ws_size, hipStream_t stream) {
  static int grid_blocks = 0;
  if (grid_blocks == 0) {
    if (n_in != 20 || ws_size < WS_END) {
      fprintf(stderr, "kernel_launch: unexpected n_in %d or ws_size %zu (need %zu)\n", n_in, ws_size, (size_t)WS_END);
      grid_blocks = -1;
      return;
    }
    int dev = 0, cus = 0, per_cu = 0;
    hipGetDevice(&dev);
    hipDeviceGetAttribute(&cus, hipDeviceAttributeMultiprocessorCount, dev);
#if COOP
    if (hipFuncSetAttribute((const void*)mega, hipFuncAttributeMaxDynamicSharedMemorySize, LDS_BYTES) != hipSuccess)
      fprintf(stderr, "kernel_launch: hipFuncSetAttribute failed\n");
    hipOccupancyMaxActiveBlocksPerMultiprocessor(&per_cu, (const void*)mega, 512, LDS_BYTES);
#else
    const void* ks[] = {(const void*)k_p0, (const void*)k_ffn, (const void*)k_gmlp, (const void*)k_hin, (const void*)k_scan, (const void*)k_hout, (const void*)k_qkv, (const void*)k_attn};
    for (int i = 0; i < 8; ++i) (void)hipFuncSetAttribute(ks[i], hipFuncAttributeMaxDynamicSharedMemorySize, LDS_BYTES);
    per_cu = 1;
#endif
    (void)hipGetLastError();
    if (per_cu < 1) per_cu = 1;
    grid_blocks = cus * per_cu;
    if (grid_blocks > NPANEL) grid_blocks = NPANEL;
    if (grid_blocks < 1) grid_blocks = NPANEL;
  }
  if (grid_blocks < 0) return;
  Params P{};
  for (int i = 0; i < 20; ++i) P.in[i] = (const float*)d_in[i];
  P.out = (float*)d_out;
  P.ws = (unsigned char*)d_ws;
#if COOP
  P.ph_lo = 0; P.ph_hi = 5;
  (void)hipMemsetAsync((unsigned char*)d_ws + OFF_BAR, 0, 256, stream);
  void* args[] = {&P};
  hipError_t e = hipLaunchCooperativeKernel((const void*)mega, dim3(grid_blocks), dim3(512), args, LDS_BYTES, stream);
  if (e != hipSuccess) fprintf(stderr, "cooperative launch failed: %s (grid %d)\n", hipGetErrorString(e), grid_blocks);
#else
#define LAUNCH(k, a, b) do { P.ph_lo = (a); P.ph_hi = (b); hipLaunchKernelGGL(k, dim3(NPANEL), dim3(512), LDS_BYTES, stream, P); } while (0)
  LAUNCH(k_p0, 0, 0);
  LAUNCH(k_ffn, 0, 0); LAUNCH(k_gmlp, 0, 0); LAUNCH(k_ffn, 0, 1);
  LAUNCH(k_ffn, 1, 0); LAUNCH(k_hin, 0, 0); LAUNCH(k_scan, 0, 0); LAUNCH(k_hout, 0, 0); LAUNCH(k_ffn, 1, 1);
  LAUNCH(k_ffn, 2, 0); LAUNCH(k_qkv, 0, 0); LAUNCH(k_attn, 0, 0); LAUNCH(k_ffn, 2, 1);
  LAUNCH(k_ffn, 3, 0); LAUNCH(k_gmlp, 3, 1); LAUNCH(k_ffn, 3, 3);
#endif
}
```

```cpp
#include <hip/hip_runtime.h>
#include <hip/hip_cooperative_groups.h>
#include <stdint.h>
#include <stdio.h>
namespace cg = cooperative_groups;

#ifndef COOP
#define COOP 1
#endif

typedef unsigned short bf16_t;
typedef __attribute__((ext_vector_type(8))) __bf16 bfrag;
typedef __attribute__((ext_vector_type(16))) float f32x16;

constexpr int T_TOK = 32768;
constexpr int NPANEL = 256;
constexpr float ALPHA = 1.6817928305074290f;
constexpr int LDS_BYTES = 122880;

constexpr size_t SZ_WGU = (size_t)8 * 5632 * 1024 * 2;
constexpr size_t SZ_WD = (size_t)8 * 1024 * 2816 * 2;
constexpr size_t SZ_WGI = (size_t)2 * 2048 * 1024 * 2;
constexpr size_t SZ_WGO = (size_t)2 * 1024 * 1024 * 2;
constexpr size_t SZ_WSP = (size_t)2 * 8 * 128 * 128 * 2;
constexpr size_t SZ_WHI = (size_t)4096 * 1024 * 2;
constexpr size_t SZ_WHO = (size_t)1024 * 1024 * 2;
constexpr size_t SZ_WQKV = (size_t)1536 * 1024 * 2;
constexpr size_t SZ_WAO = (size_t)1024 * 1024 * 2;
constexpr size_t SZ_LB = 4096;
constexpr size_t SZ_H = (size_t)T_TOK * 1024 * 4;
constexpr size_t SZ_HB = (size_t)T_TOK * 1024 * 2;
constexpr size_t SZ_ACT = (size_t)T_TOK * 2816 * 2;
constexpr size_t SZ_SG = (size_t)T_TOK * 1024 * 2;
constexpr size_t SZ_DS = (size_t)NPANEL * 8 * 128 * 128 * 2;
constexpr size_t SZ_DEC = (size_t)NPANEL * 8 * 128 * 4;
constexpr size_t SZ_KB = (size_t)T_TOK * 128 * 2;

constexpr size_t OFF_WGU = 0;
constexpr size_t OFF_WD = OFF_WGU + SZ_WGU;
constexpr size_t OFF_WGI = OFF_WD + SZ_WD;
constexpr size_t OFF_WGO = OFF_WGI + SZ_WGI;
constexpr size_t OFF_WSP = OFF_WGO + SZ_WGO;
constexpr size_t OFF_WHI = OFF_WSP + SZ_WSP;
constexpr size_t OFF_WHO = OFF_WHI + SZ_WHI;
constexpr size_t OFF_WQKV = OFF_WHO + SZ_WHO;
constexpr size_t OFF_WAO = OFF_WQKV + SZ_WQKV;
constexpr size_t OFF_LB = OFF_WAO + SZ_WAO;
constexpr size_t OFF_H = OFF_LB + SZ_LB;
constexpr size_t OFF_HB = OFF_H + SZ_H;
constexpr size_t OFF_ACT = OFF_HB + SZ_HB;
constexpr size_t OFF_SG = OFF_ACT + SZ_ACT;
constexpr size_t OFF_DS = OFF_SG + SZ_SG;
constexpr size_t OFF_DEC = OFF_DS + SZ_DS;
constexpr size_t OFF_KB = OFF_DEC + SZ_DEC;
constexpr size_t OFF_VB = OFF_KB + SZ_KB;
constexpr size_t OFF_BAR = OFF_VB + SZ_KB;
constexpr size_t WS_END = OFF_BAR + 256;

struct Params {
  const float* in[20];
  float* out;
  unsigned char* ws;
  int ph_lo, ph_hi;
};

struct Ctx {
  const float* const* in;
  float* out;
  unsigned char* ws;
  __device__ __forceinline__ bf16_t* WGU() const { return (bf16_t*)(ws + OFF_WGU); }
  __device__ __forceinline__ bf16_t* WD() const { return (bf16_t*)(ws + OFF_WD); }
  __device__ __forceinline__ bf16_t* WGI() const { return (bf16_t*)(ws + OFF_WGI); }
  __device__ __forceinline__ bf16_t* WGO() const { return (bf16_t*)(ws + OFF_WGO); }
  __device__ __forceinline__ bf16_t* WSP() const { return (bf16_t*)(ws + OFF_WSP); }
  __device__ __forceinline__ bf16_t* WHI() const { return (bf16_t*)(ws + OFF_WHI); }
  __device__ __forceinline__ bf16_t* WHO() const { return (bf16_t*)(ws + OFF_WHO); }
  __device__ __forceinline__ bf16_t* WQKV() const { return (bf16_t*)(ws + OFF_WQKV); }
  __device__ __forceinline__ bf16_t* WAO() const { return (bf16_t*)(ws + OFF_WAO); }
  __device__ __forceinline__ float* LB() const { return (float*)(ws + OFF_LB); }
  __device__ __forceinline__ float* H() const { return (float*)(ws + OFF_H); }
  __device__ __forceinline__ bf16_t* HB() const { return (bf16_t*)(ws + OFF_HB); }
  __device__ __forceinline__ bf16_t* ACT() const { return (bf16_t*)(ws + OFF_ACT); }
  __device__ __forceinline__ bf16_t* SG() const { return (bf16_t*)(ws + OFF_SG); }
  __device__ __forceinline__ bf16_t* DS() const { return (bf16_t*)(ws + OFF_DS); }
  __device__ __forceinline__ float* DEC() const { return (float*)(ws + OFF_DEC); }
  __device__ __forceinline__ bf16_t* KB() const { return (bf16_t*)(ws + OFF_KB); }
  __device__ __forceinline__ bf16_t* VB() const { return (bf16_t*)(ws + OFF_VB); }
};

typedef __attribute__((ext_vector_type(2))) float f32x2_t;
typedef __attribute__((ext_vector_type(2))) __bf16 bf16x2_t;
__device__ __forceinline__ uint32_t pack2(float a, float b) {
  f32x2_t v = {a, b};
  bf16x2_t r = __builtin_convertvector(v, bf16x2_t);
  return __builtin_bit_cast(uint32_t, r);
}
__device__ __forceinline__ bf16_t f2bf(float f) { return (bf16_t)(pack2(f, 0.f) & 0xffffu); }
__device__ __forceinline__ float bf2f(bf16_t b) { return __uint_as_float(((uint32_t)b) << 16); }
__device__ __forceinline__ float wave_sum(float v) {
  v += __shfl_xor(v, 32, 64); v += __shfl_xor(v, 16, 64); v += __shfl_xor(v, 8, 64);
  v += __shfl_xor(v, 4, 64); v += __shfl_xor(v, 2, 64); v += __shfl_xor(v, 1, 64);
  return v;
}
__device__ __forceinline__ float silu_f(float x) { return x * __frcp_rn(1.f + __expf(-x)); }
#define ROWMAP(reg, lane) ((((reg)&3)) + 8 * ((reg) >> 2) + 4 * ((lane) >> 5))
#define MFMA(a, b, c) __builtin_amdgcn_mfma_f32_32x32x16_bf16((a), (b), (c), 0, 0, 0)

__device__ __forceinline__ int opaque_tid() {
  int t = threadIdx.x;
  asm volatile("" : "+v"(t));
  return t;
}

__device__ __forceinline__ unsigned long long opaque_u64(unsigned long long v) {
  unsigned lo = (unsigned)v, hi = (unsigned)(v >> 32);
  asm volatile("" : "+v"(lo), "+v"(hi));
  lo = __builtin_amdgcn_readfirstlane(lo);
  hi = __builtin_amdgcn_readfirstlane(hi);
  return ((unsigned long long)hi << 32) | lo;
}

__device__ __forceinline__ f32x16 zero16() {
  f32x16 z;
#pragma unroll
  for (int i = 0; i < 16; ++i) z[i] = 0.f;
  return z;
}

constexpr int G_STAGE_B = 40960;

__device__ __forceinline__ void glds16(const bf16_t* g, const char* l) {
  __builtin_amdgcn_global_load_lds((const unsigned*)g, (unsigned*)const_cast<char*>(l), 16, 0, 0);
}

#define RDFRAGS(F, stg, ok)                                                              \
  do {                                                                                   \
    const char* sa_ = lds + (stg) * G_STAGE_B + wm * 4096 + (ok);                         \
    const char* sb_ = lds + (stg) * G_STAGE_B + 8192 + wn * 8192 + (ok);                  \
    F[0] = *(const bfrag*)(sa_);                                                         \
    F[1] = *(const bfrag*)(sa_ + 2048);                                                  \
    F[2] = *(const bfrag*)(sb_);                                                         \
    F[3] = *(const bfrag*)(sb_ + 2048);                                                  \
    F[4] = *(const bfrag*)(sb_ + 4096);                                                  \
    F[5] = *(const bfrag*)(sb_ + 6144);                                                  \
  } while (0)
#define DOMFMA(F)                                                                        \
  do {                                                                                   \
    _Pragma("unroll") for (int ni_ = 0; ni_ < 4; ++ni_) {                                \
      acc[0][ni_] = MFMA(F[0], F[2 + ni_], acc[0][ni_]);                                 \
      acc[1][ni_] = MFMA(F[1], F[2 + ni_], acc[1][ni_]);                                 \
    }                                                                                    \
  } while (0)
#define ISSUE_SLAB(stg, ntv, krv)                                                        \
  do {                                                                                   \
    const char* st_ = lds + (stg) * G_STAGE_B + w * 1024;                                    \
    glds16(a_src + (krv) * 32, st_);                                                     \
    const bf16_t* bs_ = b_src + (size_t)((ntv) * nk + (krv)) * 16384;                    \
    _Pragma("unroll") for (int i_ = 0; i_ < 4; ++i_) glds16(bs_ + i_ * 4096, st_ + 8192 + i_ * 8192); \
  } while (0)

#define ISSUE_SLAB_LO(stg, ntv, krv)    \
  do {                                                                                   \
    const char* st_ = lds + (stg) * G_STAGE_B + w * 1024;                                \
    glds16(a_src + (krv) * 32, st_);                                                     \
    const bf16_t* bs_ = b_src + (size_t)((ntv) * nk + (krv)) * 16384;                    \
    glds16(bs_, st_ + 8192);                                                             \
    glds16(bs_ + 4096, st_ + 8192 + 8192);                                               \
  } while (0)
#define ISSUE_SLAB_HI(stg, ntv, krv)                        \
  do {                                                                                   \
    const char* st_ = lds + (stg) * G_STAGE_B + w * 1024;                                \
    const bf16_t* bs_ = b_src + (size_t)((ntv) * nk + (krv)) * 16384;                    \
    glds16(bs_ + 2 * 4096, st_ + 8192 + 2 * 8192);                                       \
    glds16(bs_ + 3 * 4096, st_ + 8192 + 3 * 8192);                                       \
  } while (0)

template <class Epi>
__device__ __forceinline__ void gemm_panel(const bf16_t* __restrict__ A, const int lda, const bf16_t* __restrict__ Wb,
                                           const int K, const int nN, const Epi epi, bf16_t* smem) {
  const int tid = opaque_tid(), lane = tid & 63;
  const int w = __builtin_amdgcn_readfirstlane(tid >> 6);
  const int wm = w & 1, wn = w >> 1;
  const int nk = K >> 5;
  const int total = nN * nk;
  const int l31 = lane & 31, h = lane >> 5;
  const int grow = lane >> 2;
  const int gch = (lane & 3) ^ ((lane >> 4) & 3);
  const bf16_t* a_src = A + (size_t)(w * 16 + grow) * lda + gch * 8;
  const bf16_t* b_src = Wb + (size_t)(w * 16 + grow) * 32 + gch * 8;
  const char* lds = (const char*)smem;
  const int pos0 = h ^ ((l31 >> 2) & 3);
  const int offk0 = l31 * 64 + pos0 * 16;
  const int offk1 = l31 * 64 + (pos0 ^ 2) * 16;
  f32x16 acc[2][4];
#pragma unroll
  for (int i = 0; i < 2; ++i)
#pragma unroll
    for (int j = 0; j < 4; ++j) acc[i][j] = zero16();
  const int rot = (int)(((blockIdx.x >> 3) & 31) * nk) >> 5;
  int kr3 = rot, nt3 = 0, cnt3 = 0;
  __syncthreads();
#pragma unroll
  for (int s3 = 0; s3 < 3; ++s3) {
    ISSUE_SLAB(s3, nt3, kr3);
    ++kr3; if (kr3 == nk) kr3 = 0;
    ++cnt3; if (cnt3 == nk) { cnt3 = 0; ++nt3; }
  }
  asm volatile("s_waitcnt vmcnt(10)" ::: "memory");
  asm volatile("s_waitcnt lgkmcnt(0)" ::: "memory");
  __builtin_amdgcn_s_barrier();
  asm volatile("" ::: "memory");
  bfrag F0[6], F1[6];
  RDFRAGS(F0, 0, offk0);
  int ks = 0, nt = 0, stage = 0, stage_n = 1, stage_p = 2;
  int kr3p = 0, nt3p = 0;
  for (int it = 0; it < total; ++it) {
#define SB() __builtin_amdgcn_sched_barrier(0)
#define MM(F, mi_, ni_) acc[mi_][ni_] = MFMA(F[mi_], F[2 + (ni_)], acc[mi_][ni_])
    {
      const char* sa_ = lds + stage * G_STAGE_B + wm * 4096 + offk1;
      const char* sb_ = lds + stage * G_STAGE_B + 8192 + wn * 8192 + offk1;
      const char* stp_ = lds + stage_p * G_STAGE_B + w * 1024;
      const bf16_t* bsp_ = b_src + (size_t)(nt3p * nk + kr3p) * 16384;
      MM(F0, 0, 0); SB();
      F1[0] = *(const bfrag*)(sa_); F1[1] = *(const bfrag*)(sa_ + 2048); SB();
      MM(F0, 1, 0); SB();
      if (it > 0) glds16(bsp_ + 2 * 4096, stp_ + 8192 + 2 * 8192);
      SB();
      MM(F0, 0, 1); SB();
      F1[2] = *(const bfrag*)(sb_); F1[3] = *(const bfrag*)(sb_ + 2048); SB();
      MM(F0, 1, 1); SB();
      if (it > 0) glds16(bsp_ + 3 * 4096, stp_ + 8192 + 3 * 8192);
      SB();
      MM(F0, 0, 2); SB();
      F1[4] = *(const bfrag*)(sb_ + 4096); F1[5] = *(const bfrag*)(sb_ + 6144); SB();
      MM(F0, 1, 2); MM(F0, 0, 3); MM(F0, 1, 3); SB();
    }
    asm volatile("s_waitcnt vmcnt(5)" ::: "memory");
    asm volatile("s_waitcnt lgkmcnt(0)" ::: "memory");
    __builtin_amdgcn_s_barrier();
    asm volatile("" ::: "memory");
    SB();
    {
      const char* sa_ = lds + stage_n * G_STAGE_B + wm * 4096 + offk0;
      const char* sb_ = lds + stage_n * G_STAGE_B + 8192 + wn * 8192 + offk0;
      const char* st_ = lds + stage * G_STAGE_B + w * 1024;
      const bf16_t* bs_ = b_src + (size_t)(nt3 * nk + kr3) * 16384;
      MM(F1, 0, 0); SB();
      glds16(a_src + kr3 * 32, st_); SB();
      MM(F1, 1, 0); SB();
      F0[0] = *(const bfrag*)(sa_); F0[1] = *(const bfrag*)(sa_ + 2048); SB();
      MM(F1, 0, 1); SB();
      glds16(bs_, st_ + 8192); SB();
      MM(F1, 1, 1); SB();
      F0[2] = *(const bfrag*)(sb_); F0[3] = *(const bfrag*)(sb_ + 2048); SB();
      MM(F1, 0, 2); SB();
      glds16(bs_ + 4096, st_ + 8192 + 8192); SB();
      MM(F1, 1, 2); SB();
      F0[4] = *(const bfrag*)(sb_ + 4096); F0[5] = *(const bfrag*)(sb_ + 6144); SB();
      MM(F1, 0, 3); MM(F1, 1, 3); SB();
    }
    kr3p = kr3; nt3p = nt3;
    ++kr3; if (kr3 == nk) kr3 = 0;
    ++cnt3; if (cnt3 == nk) { cnt3 = 0; ++nt3; }
    if (ks == nk - 1) {
      epi(acc, nt, wm, wn, lane);
#pragma unroll
      for (int i = 0; i < 2; ++i)
#pragma unroll
        for (int j = 0; j < 4; ++j) acc[i][j] = zero16();
      ++nt;
      asm volatile("s_waitcnt vmcnt(0)" ::: "memory");
      RDFRAGS(F0, stage_n, offk0);
    }
    ++ks; if (ks == nk) ks = 0;
    stage_p = stage;
    stage = stage_n;
    ++stage_n; if (stage_n == 3) stage_n = 0;
  }
  asm volatile("s_waitcnt vmcnt(0)" ::: "memory");
  __syncthreads();
}

struct EpiSwiglu {
  bf16_t* act;
  __device__ __forceinline__ void operator()(f32x16 (&acc)[2][4], int nt, int wm, int wn, int lane_in) const {
    int lane = lane_in;
    asm volatile("" : "+v"(lane));
    const int l31 = lane & 31;
#pragma unroll
    for (int mi = 0; mi < 2; ++mi)
#pragma unroll
      for (int n2 = 0; n2 < 2; ++n2)
#pragma unroll
        for (int r = 0; r < 16; ++r) {
          const int row = wm * 64 + mi * 32 + ROWMAP(r, lane);
          const int col = (nt * 4 + wn) * 64 + n2 * 32 + l31;
          const float g = acc[mi][n2][r], u = acc[mi][n2 + 2][r];
          act[(size_t)row * 2816 + col] = f2bf(silu_f(g) * u);
        }
  }
};
struct EpiResLN {
  float* Hp;
  float alpha, c;
  const float* bias;
  __device__ __forceinline__ void operator()(f32x16 (&acc)[2][4], int nt, int wm, int wn, int lane_in) const {
    int lane = lane_in;
    asm volatile("" : "+v"(lane));
    const int l31 = lane & 31;
    float* base = Hp + (size_t)(wm * 64 + 4 * (lane >> 5)) * 1024 + nt * 512 + wn * 128 + l31;
#pragma unroll
    for (int ni = 0; ni < 4; ++ni) {
      const float bv = bias ? bias[nt * 512 + wn * 128 + ni * 32 + l31] : 0.f;
#pragma unroll
      for (int mi = 0; mi < 2; ++mi) {
        float hv[16];
#pragma unroll
        for (int r = 0; r < 16; ++r) hv[r] = base[(size_t)(mi * 32 + (r & 3) + 8 * (r >> 2)) * 1024 + ni * 32];
#pragma unroll
        for (int r = 0; r < 16; ++r)
          base[(size_t)(mi * 32 + (r & 3) + 8 * (r >> 2)) * 1024 + ni * 32] = alpha * hv[r] + c * (acc[mi][ni][r] + bv);
        __builtin_amdgcn_sched_barrier(0);
      }
    }
  }
};
struct EpiGelu {
  bf16_t* Z;
  __device__ __forceinline__ void operator()(f32x16 (&acc)[2][4], int nt, int wm, int wn, int lane_in) const {
    int lane = lane_in;
    asm volatile("" : "+v"(lane));
    const int l31 = lane & 31;
#pragma unroll
    for (int ni = 0; ni < 4; ++ni) {
      const int col = nt * 512 + wn * 128 + ni * 32 + l31;
#pragma unroll
      for (int mi = 0; mi < 2; ++mi)
#pragma unroll
        for (int r = 0; r < 16; ++r) {
          const int row = wm * 64 + mi * 32 + ROWMAP(r, lane);
          const float x = acc[mi][ni][r];
          Z[(size_t)row * 2048 + col] = f2bf(0.5f * x * (1.f + erff(x * 0.70710678118654752f)));
        }
    }
  }
};
struct EpiHgrn {
  bf16_t* Qp;
  bf16_t* Vp;
  float* LFp;
  bf16_t* SGp;
  const float* lb;
  __device__ __forceinline__ void operator()(f32x16 (&acc)[2][4], int nt, int wm, int wn, int lane_in) const {
    int lane = lane_in;
    asm volatile("" : "+v"(lane));
    const int l31 = lane & 31;
    const int sec = nt >> 1;
    const int cb = (nt & 1) * 512 + wn * 128 + l31;
    const int rb = wm * 64 + 4 * (lane >> 5);
    if (sec == 0 || sec == 3) {
      bf16_t* dst = (sec == 0) ? Qp : SGp;
#pragma unroll
      for (int ni = 0; ni < 4; ++ni)
#pragma unroll
        for (int mi = 0; mi < 2; ++mi)
#pragma unroll
          for (int r = 0; r < 16; ++r) {
            const int row = rb + mi * 32 + (r & 3) + 8 * (r >> 2);
            dst[(size_t)row * 1024 + cb + ni * 32] = f2bf(silu_f(acc[mi][ni][r]));
          }
    } else if (sec == 1) {
#pragma unroll
      for (int ni = 0; ni < 4; ++ni) {
        const float lbv = lb[cb + ni * 32];
#pragma unroll
        for (int mi = 0; mi < 2; ++mi)
#pragma unroll
          for (int r = 0; r < 16; ++r) {
            const int row = rb + mi * 32 + (r & 3) + 8 * (r >> 2);
            const float f = lbv + (1.f - lbv) * __frcp_rn(1.f + __expf(-acc[mi][ni][r]));
            LFp[(size_t)row * 1024 + cb + ni * 32] = __logf(f);
          }
      }
    } else {
#pragma unroll
      for (int ni = 0; ni < 4; ++ni)
#pragma unroll
        for (int mi = 0; mi < 2; ++mi)
#pragma unroll
          for (int r = 0; r < 16; ++r) {
            const int row = rb + mi * 32 + (r & 3) + 8 * (r >> 2);
            Vp[(size_t)row * 1024 + cb + ni * 32] = f2bf(acc[mi][ni][r]);
          }
    }
  }
};
struct EpiQkv {
  bf16_t* Qp;
  bf16_t* Kp;
  bf16_t* Vp;
  const float* bias;
  __device__ __forceinline__ void operator()(f32x16 (&acc)[2][4], int nt, int wm, int wn, int lane_in) const {
    int lane = lane_in;
    asm volatile("" : "+v"(lane));
    const int l31 = lane & 31;
#pragma unroll
    for (int ni = 0; ni < 4; ++ni) {
      const int col = nt * 512 + wn * 128 + ni * 32 + l31;
      if (col < 1280) {
        const float bv = bias[col];
#pragma unroll
        for (int mi = 0; mi < 2; ++mi)
#pragma unroll
          for (int r = 0; r < 16; ++r) {
            const int row = wm * 64 + mi * 32 + ROWMAP(r, lane);
            const float x = acc[mi][ni][r] + bv;
            if (col < 1024) Qp[(size_t)row * 1024 + col] = f2bf(x * 0.125f);
            else if (col < 1152) Kp[(size_t)row * 128 + (col - 1024)] = f2bf(x);
            else Vp[(size_t)row * 128 + (col - 1152)] = f2bf(x);
          }
      }
    }
  }
};

__device__ __forceinline__ void ln_panel(const float* Hp, float* outp, bf16_t* HBp, const float* g, const float* b) {
  const int tid = opaque_tid(), lane = tid & 63;
  const int w = __builtin_amdgcn_readfirstlane(tid >> 6);
  float4 gv[4], bv[4];
#pragma unroll
  for (int j = 0; j < 4; ++j) {
    gv[j] = *(const float4*)(g + j * 256 + lane * 4);
    bv[j] = *(const float4*)(b + j * 256 + lane * 4);
  }
  for (int r = w; r < 128; r += 8) {
    float4 x[4];
    float s = 0.f;
#pragma unroll
    for (int j = 0; j < 4; ++j) {
      x[j] = *(const float4*)(Hp + (size_t)r * 1024 + j * 256 + lane * 4);
      s += x[j].x + x[j].y + x[j].z + x[j].w;
    }
    s = wave_sum(s);
    const float mean = s * (1.f / 1024.f);
    float v = 0.f;
#pragma unroll
    for (int j = 0; j < 4; ++j) {
      x[j].x -= mean; x[j].y -= mean; x[j].z -= mean; x[j].w -= mean;
      v += x[j].x * x[j].x + x[j].y * x[j].y + x[j].z * x[j].z + x[j].w * x[j].w;
    }
    v = wave_sum(v);
    const float rstd = 1.0f / sqrtf(v * (1.f / 1024.f) + 1e-5f);
#pragma unroll
    for (int j = 0; j < 4; ++j) {
      float4 y;
      y.x = x[j].x * rstd * gv[j].x + bv[j].x;
      y.y = x[j].y * rstd * gv[j].y + bv[j].y;
      y.z = x[j].z * rstd * gv[j].z + bv[j].z;
      y.w = x[j].w * rstd * gv[j].w + bv[j].w;
      *(float4*)(outp + (size_t)r * 1024 + j * 256 + lane * 4) = y;
      uint2 pk;
      pk.x = pack2(y.x, y.y);
      pk.y = pack2(y.z, y.w);
      *(uint2*)(HBp + (size_t)r * 1024 + j * 256 + lane * 4) = pk;
    }
  }
  __syncthreads();
}

__device__ __forceinline__ void ffn_panel(const Ctx& C, int p, int layer, int j, bool final_out, bf16_t* smem) {
  const int wi = layer * 2 + j;
  bf16_t* HBp = C.HB() + (size_t)p * 128 * 1024;
  bf16_t* ACTp = C.ACT() + (size_t)p * 128 * 2816;
  float* Hp = C.H() + (size_t)p * 128 * 1024;
  EpiSwiglu e1{ACTp};
  gemm_panel(HBp, 1024, C.WGU() + (size_t)wi * 5632 * 1024, 1024, 11, e1, smem);
  EpiResLN e2{Hp, ALPHA, 0.5f, nullptr};
  gemm_panel(ACTp, 2816, C.WD() + (size_t)wi * 1024 * 2816, 2816, 2, e2, smem);
  const int li = (layer * 3 + (j == 0 ? 0 : 2)) * 1024;
  float* outp = final_out ? (C.out + (size_t)p * 128 * 1024) : Hp;
  ln_panel(Hp, outp, HBp, C.in[3] + li, C.in[4] + li);
}

__device__ __forceinline__ void gmlp_panel(const Ctx& C, int p, int layer, int slot, bf16_t* smem) {
  const int tid = opaque_tid(), lane = tid & 63;
  const int w = __builtin_amdgcn_readfirstlane(tid >> 6);
  const int l31 = lane & 31, h8 = (lane >> 5) * 8;
  bf16_t* HBp = C.HB() + (size_t)p * 128 * 1024;
  bf16_t* Zp = C.ACT() + (size_t)p * 128 * 2816;
  float* Hp = C.H() + (size_t)p * 128 * 1024;
  {
    EpiGelu e{Zp};
    gemm_panel(HBp, 1024, C.WGI() + (size_t)slot * 2048 * 1024, 1024, 4, e, smem);
  }
  bf16_t* As = smem;
  bf16_t* Bs = smem + 128 * 136;
  float* st = (float*)(smem + 2 * 128 * 136);
  for (int r = w; r < 128; r += 8) {
    const uint4 q0 = *(const uint4*)(Zp + (size_t)r * 2048 + 1024 + lane * 16);
    const uint4 q1 = *(const uint4*)(Zp + (size_t)r * 2048 + 1024 + lane * 16 + 8);
    const uint32_t u[8] = {q0.x, q0.y, q0.z, q0.w, q1.x, q1.y, q1.z, q1.w};
    float x[16];
    float s = 0.f;
#pragma unroll
    for (int e = 0; e < 8; ++e) {
      x[2 * e] = __uint_as_float(u[e] << 16);
      x[2 * e + 1] = __uint_as_float(u[e] & 0xffff0000u);
      s += x[2 * e] + x[2 * e + 1];
    }
    s = wave_sum(s);
    const float mean = s * (1.f / 1024.f);
    float v = 0.f;
#pragma unroll
    for (int e = 0; e < 16; ++e) { const float d = x[e] - mean; v += d * d; }
    v = wave_sum(v);
    if (lane == 0) { st[r * 2] = mean; st[r * 2 + 1] = 1.0f / sqrtf(v * (1.f / 1024.f) + 1e-5f); }
  }
  __syncthreads();
  const float* lng = C.in[6] + slot * 1024;
  const float* lnb = C.in[7] + slot * 1024;
  const float* bsp = C.in[9] + slot * 1024;
  const bf16_t* Wsp = C.WSP() + (size_t)slot * 8 * 16384;
  const int nd = w & 3, mt0 = (w >> 2) * 2;
  for (int g = 0; g < 8; ++g) {
#pragma unroll
    for (int i = 0; i < 4; ++i) {
      const int c = tid + 512 * i;
      *(uint4*)(As + (c >> 4) * 136 + (c & 15) * 8) = *(const uint4*)(Wsp + (size_t)g * 16384 + c * 8);
    }
    {
      const int s = tid >> 2, dq = tid & 3;
      const float mean = st[s * 2], rstd = st[s * 2 + 1];
      const bf16_t* src = Zp + (size_t)s * 2048 + 1024 + g * 128 + dq * 32;
#pragma unroll
      for (int q = 0; q < 4; ++q) {
        const uint4 v4 = *(const uint4*)(src + q * 8);
        const uint32_t u[4] = {v4.x, v4.y, v4.z, v4.w};
#pragma unroll
        for (int e = 0; e < 4; ++e) {
          const int d0 = dq * 32 + q * 8 + e * 2;
          const int ch = g * 128 + d0;
          const float x0 = __uint_as_float(u[e] << 16), x1 = __uint_as_float(u[e] & 0xffff0000u);
          Bs[d0 * 136 + s] = f2bf((x0 - mean) * rstd * lng[ch] + lnb[ch]);
          Bs[(d0 + 1) * 136 + s] = f2bf((x1 - mean) * rstd * lng[ch + 1] + lnb[ch + 1]);
        }
      }
    }
    __syncthreads();
    f32x16 acc[2];
    acc[0] = zero16(); acc[1] = zero16();
#pragma unroll
    for (int k16 = 0; k16 < 8; ++k16) {
      const bfrag b = *(const bfrag*)(Bs + (nd * 32 + l31) * 136 + k16 * 16 + h8);
#pragma unroll
      for (int mi = 0; mi < 2; ++mi) {
        const bfrag a = *(const bfrag*)(As + ((mt0 + mi) * 32 + l31) * 136 + k16 * 16 + h8);
        acc[mi] = MFMA(a, b, acc[mi]);
      }
    }
#pragma unroll
    for (int mi = 0; mi < 2; ++mi)
#pragma unroll
      for (int r = 0; r < 16; ++r) {
        const int t = (mt0 + mi) * 32 + ROWMAP(r, lane);
        const int ch = g * 128 + nd * 32 + l31;
        const float mixed = acc[mi][r] + bsp[g * 128 + t];
        const float u = bf2f(Zp[(size_t)t * 2048 + ch]);
        HBp[(size_t)t * 1024 + ch] = f2bf(u * mixed);
      }
    __syncthreads();
  }
  {
    EpiResLN e2{Hp, ALPHA, 1.0f, nullptr};
    gemm_panel(HBp, 1024, C.WGO() + (size_t)slot * 1024 * 1024, 1024, 2, e2, smem);
  }
  const int li = (layer * 3 + 1) * 1024;
  ln_panel(Hp, Hp, HBp, C.in[3] + li, C.in[4] + li);
}

template <bool OUT>
__device__ __forceinline__ void hgrn_rec(const Ctx& C, int p, bf16_t* smem) {
  const int tid = opaque_tid(), lane = tid & 63;
  const int w = __builtin_amdgcn_readfirstlane(tid >> 6);
  const int l31 = lane & 31, h8 = (lane >> 5) * 8;
  bf16_t* ST = smem;
  bf16_t* Qh = smem + 17408;
  bf16_t* Kh = smem + 21760;
  bf16_t* KhT = smem + 26112;
  bf16_t* vT = smem + 31232;
  bf16_t* Ps = smem + 36352;
  float* seg = (float*)(smem + 37632);
  float* dec = seg + 512;
  float* oF = dec + 128;
  const size_t row0 = (size_t)p * 128;
  const bf16_t* Qp = C.ACT() + (size_t)p * 128 * 2816;
  const bf16_t* Vp = Qp + 128 * 1024;
  const float* LFp = C.out + row0 * 1024;
  const bf16_t* SGp = C.SG() + row0 * 1024;
  bf16_t* HBp = C.HB() + row0 * 1024;
  const float* ng = C.in[13];
  const int jt = w >> 1, kt0 = (w & 1) * 2;
  const int kq = tid & 127, tq = tid >> 7;
  for (int h = 0; h < 8; ++h) {
    f32x16 accS[2];
    bf16_t* SBh = C.DS() + ((size_t)(p * 8 + h)) * 16384;
    if (OUT) {
      __syncthreads();
#pragma unroll
      for (int i = 0; i < 4; ++i) {
        const int c = tid + 512 * i;
        *(uint4*)(ST + (c >> 4) * 136 + (c & 15) * 8) = *(const uint4*)(SBh + c * 8);
      }
      __syncthreads();
#pragma unroll
      for (int c2 = 0; c2 < 2; ++c2)
#pragma unroll
        for (int r = 0; r < 16; ++r)
          accS[c2][r] = bf2f(ST[(jt * 32 + ROWMAP(r, lane)) * 136 + (kt0 + c2) * 32 + l31]);
    } else {
      accS[0] = zero16(); accS[1] = zero16();
    }
    float dsum = 0.f;
    for (int i = 0; i < 4; ++i) {
      float l[8], cs[8];
      const size_t gbase = (size_t)(i * 32 + tq * 8) * 1024 + h * 128 + kq;
#pragma unroll
      for (int e = 0; e < 8; ++e) l[e] = LFp[gbase + (size_t)e * 1024];
      cs[0] = l[0];
#pragma unroll
      for (int e = 1; e < 8; ++e) cs[e] = cs[e - 1] + l[e];
      seg[tq * 128 + kq] = cs[7];
#pragma unroll
      for (int e = 0; e < 8; ++e) vT[kq * 40 + tq * 8 + e] = Vp[gbase + (size_t)e * 1024];
      __syncthreads();
      float off = 0.f, tot = 0.f;
#pragma unroll
      for (int q = 0; q < 4; ++q) {
        const float s = seg[q * 128 + kq];
        if (q < tq) off += s;
        tot += s;
      }
#pragma unroll
      for (int e = 0; e < 8; ++e) {
        const float gc = cs[e] + off;
        const float f = __expf(l[e]);
        const float kh = (1.f - f) * __expf(-gc);
        const bf16_t khb = f2bf(kh);
        const int t = tq * 8 + e;
        KhT[kq * 40 + t] = khb;
        if (OUT) {
          Kh[t * 136 + kq] = khb;
          const float qv = bf2f(Qp[gbase + (size_t)e * 1024]);
          Qh[t * 136 + kq] = f2bf(qv * __expf(gc));
        }
      }
      if (tq == 0) { dec[kq] = __expf(tot); dsum += tot; }
      __syncthreads();
      f32x16 accO = zero16();
      if (OUT) {
        if (w == 0) {
          f32x16 accP = zero16();
#pragma unroll
          for (int k16 = 0; k16 < 8; ++k16) {
            const bfrag a = *(const bfrag*)(Qh + l31 * 136 + k16 * 16 + h8);
            const bfrag b = *(const bfrag*)(Kh + l31 * 136 + k16 * 16 + h8);
            accP = MFMA(a, b, accP);
          }
#pragma unroll
          for (int r = 0; r < 16; ++r) {
            const int t = ROWMAP(r, lane);
            Ps[t * 40 + l31] = (l31 <= t) ? f2bf(accP[r]) : (bf16_t)0;
          }
        } else if (w <= 4) {
          const int nt = w - 1;
#pragma unroll
          for (int k16 = 0; k16 < 8; ++k16) {
            const bfrag a = *(const bfrag*)(Qh + l31 * 136 + k16 * 16 + h8);
            const bfrag b = *(const bfrag*)(ST + (nt * 32 + l31) * 136 + k16 * 16 + h8);
            accO = MFMA(a, b, accO);
          }
        }
        __syncthreads();
        if (w >= 1 && w <= 4) {
          const int nt = w - 1;
#pragma unroll
          for (int k16 = 0; k16 < 2; ++k16) {
            const bfrag a = *(const bfrag*)(Ps + l31 * 40 + k16 * 16 + h8);
            const bfrag b = *(const bfrag*)(vT + (nt * 32 + l31) * 40 + k16 * 16 + h8);
            accO = MFMA(a, b, accO);
          }
#pragma unroll
          for (int r = 0; r < 16; ++r) oF[ROWMAP(r, lane) * 132 + nt * 32 + l31] = accO[r];
        }
      }
#pragma unroll
      for (int c2 = 0; c2 < 2; ++c2) {
#pragma unroll
        for (int k16 = 0; k16 < 2; ++k16) {
          const bfrag a = *(const bfrag*)(vT + (jt * 32 + l31) * 40 + k16 * 16 + h8);
          const bfrag b = *(const bfrag*)(KhT + ((kt0 + c2) * 32 + l31) * 40 + k16 * 16 + h8);
          accS[c2] = MFMA(a, b, accS[c2]);
        }
        const float dk = dec[(kt0 + c2) * 32 + l31];
#pragma unroll
        for (int r = 0; r < 16; ++r) accS[c2][r] *= dk;
        if (OUT) {
#pragma unroll
          for (int r = 0; r < 16; ++r)
            ST[(jt * 32 + ROWMAP(r, lane)) * 136 + (kt0 + c2) * 32 + l31] = f2bf(accS[c2][r]);
        }
      }
      __syncthreads();
      if (OUT) {
        const int t = tid >> 4, part = tid & 15;
        float x[8];
        float ss = 0.f;
#pragma unroll
        for (int e = 0; e < 8; ++e) { x[e] = oF[t * 132 + part * 8 + e]; ss += x[e] * x[e]; }
        ss += __shfl_xor(ss, 1, 64); ss += __shfl_xor(ss, 2, 64); ss += __shfl_xor(ss, 4, 64); ss += __shfl_xor(ss, 8, 64);
        const float rr = 1.0f / sqrtf(ss * (1.f / 128.f) + 1e-6f);
        const size_t gro = (size_t)(i * 32 + t) * 1024 + h * 128 + part * 8;
        const uint4 sg4 = *(const uint4*)(SGp + gro);
        const uint32_t su[4] = {sg4.x, sg4.y, sg4.z, sg4.w};
        uint32_t ov[4];
#pragma unroll
        for (int e = 0; e < 4; ++e) {
          const float g0 = ng[part * 8 + 2 * e], g1 = ng[part * 8 + 2 * e + 1];
          const float s0 = __uint_as_float(su[e] << 16), s1 = __uint_as_float(su[e] & 0xffff0000u);
          ov[e] = pack2(x[2 * e] * rr * g0 * s0, x[2 * e + 1] * rr * g1 * s1);
        }
        uint4 o4; o4.x = ov[0]; o4.y = ov[1]; o4.z = ov[2]; o4.w = ov[3];
        *(uint4*)(HBp + gro) = o4;
      }
    }
    if (!OUT) {
#pragma unroll
      for (int c2 = 0; c2 < 2; ++c2)
#pragma unroll
        for (int r = 0; r < 16; ++r)
          SBh[(jt * 32 + ROWMAP(r, lane)) * 128 + (kt0 + c2) * 32 + l31] = f2bf(accS[c2][r]);
      if (tq == 0) C.DEC()[(size_t)(p * 8 + h) * 128 + kq] = __expf(dsum);
    }
  }
  __syncthreads();
}

__device__ __forceinline__ void hgrn_scan(const Ctx& C) {
  for (int gid = blockIdx.x * 512 + threadIdx.x; gid < 131072; gid += gridDim.x * 512) {
    const int kp = gid & 63, j = (gid >> 6) & 127, h = (gid >> 13) & 7, b = gid >> 16;
    float s0 = 0.f, s1 = 0.f;
    for (int c0 = 0; c0 < 128; c0 += 8) {
      uint32_t d[8];
      float2 dc[8];
#pragma unroll
      for (int e = 0; e < 8; ++e) {
        const size_t ph = (size_t)((b * 128 + c0 + e) * 8 + h);
        d[e] = *(const uint32_t*)(C.DS() + ph * 16384 + j * 128 + kp * 2);
        dc[e] = *(const float2*)(C.DEC() + ph * 128 + kp * 2);
      }
#pragma unroll
      for (int e = 0; e < 8; ++e) {
        const size_t ph = (size_t)((b * 128 + c0 + e) * 8 + h);
        *(uint32_t*)(C.DS() + ph * 16384 + j * 128 + kp * 2) = pack2(s0, s1);
        s0 = dc[e].x * s0 + __uint_as_float(d[e] << 16);
        s1 = dc[e].y * s1 + __uint_as_float(d[e] & 0xffff0000u);
      }
    }
  }
}

__device__ __forceinline__ void attn_panel(const Ctx& C, int p, bf16_t* smem) {
  const int tid = opaque_tid(), lane = tid & 63;
  const int w = __builtin_amdgcn_readfirstlane(tid >> 6);
  const int l31 = lane & 31, h8 = (lane >> 5) * 8;
  bf16_t* K2 = smem;
  bf16_t* VT = smem + 18432;
  bf16_t* Pw = smem + 35328 + w * 1280;
  const int blk = p & 127;
  const size_t row0 = (size_t)p * 128;
  const bf16_t* Qp = C.ACT() + (size_t)p * 128 * 2816;
  bf16_t* HBp = C.HB() + row0 * 1024;
  const int qt = w & 3;
  for (int hk = 0; hk < 2; ++hk) {
    __syncthreads();
#pragma unroll
    for (int i = 0; i < 4; ++i) {
      const int c = tid + 512 * i;
      const int r = c >> 3, ch = c & 7;
      uint4 kv = make_uint4(0, 0, 0, 0), vv = make_uint4(0, 0, 0, 0);
      if (blk > 0 || r >= 128) {
        const size_t tok = row0 + r - 128;
        kv = *(const uint4*)(C.KB() + tok * 128 + hk * 64 + ch * 8);
        vv = *(const uint4*)(C.VB() + tok * 128 + hk * 64 + ch * 8);
      }
      *(uint4*)(K2 + r * 72 + ch * 8) = kv;
      const uint32_t vu[4] = {vv.x, vv.y, vv.z, vv.w};
#pragma unroll
      for (int e = 0; e < 4; ++e) {
        VT[(ch * 8 + 2 * e) * 264 + r] = (bf16_t)(vu[e] & 0xffffu);
        VT[(ch * 8 + 2 * e + 1) * 264 + r] = (bf16_t)(vu[e] >> 16);
      }
    }
    __syncthreads();
    for (int u = 0; u < 4; ++u) {
      const int hq = hk * 8 + (w >> 2) * 4 + u;
      const float sink = C.in[17][hq];
      bfrag aq[4];
#pragma unroll
      for (int k16 = 0; k16 < 4; ++k16)
        aq[k16] = *(const bfrag*)(Qp + (size_t)(qt * 32 + l31) * 1024 + hq * 64 + k16 * 16 + h8);
      f32x16 s[5];
#pragma unroll
      for (int c = 0; c < 5; ++c) {
        s[c] = zero16();
#pragma unroll
        for (int k16 = 0; k16 < 4; ++k16) {
          const bfrag b = *(const bfrag*)(K2 + ((qt + c) * 32 + l31) * 72 + k16 * 16 + h8);
          s[c] = MFMA(aq[k16], b, s[c]);
        }
      }
      float linv[16];
#pragma unroll
      for (int r = 0; r < 16; ++r) {
        const int qi = qt * 32 + ROWMAP(r, lane);
        float m = -1e30f;
#pragma unroll
        for (int c = 0; c < 5; ++c) {
          const int kp = (qt + c) * 32 + l31;
          const bool valid = (kp > qi) && (kp <= qi + 128) && (blk > 0 || kp >= 128);
          const float v = valid ? s[c][r] : -1e30f;
          s[c][r] = v;
          m = fmaxf(m, v);
        }
        m = fmaxf(m, __shfl_xor(m, 16, 64)); m = fmaxf(m, __shfl_xor(m, 8, 64)); m = fmaxf(m, __shfl_xor(m, 4, 64));
        m = fmaxf(m, __shfl_xor(m, 2, 64)); m = fmaxf(m, __shfl_xor(m, 1, 64));
        m = fmaxf(m, sink);
        float sum = 0.f;
#pragma unroll
        for (int c = 0; c < 5; ++c) {
          const float pv = (s[c][r] > -1e29f) ? __expf(s[c][r] - m) : 0.f;
          s[c][r] = pv;
          sum += pv;
        }
        sum += __shfl_xor(sum, 16, 64); sum += __shfl_xor(sum, 8, 64); sum += __shfl_xor(sum, 4, 64);
        sum += __shfl_xor(sum, 2, 64); sum += __shfl_xor(sum, 1, 64);
        sum += __expf(sink - m);
        linv[r] = 1.f / sum;
      }
      f32x16 o[2];
      o[0] = zero16(); o[1] = zero16();
#pragma unroll
      for (int c = 0; c < 5; ++c) {
#pragma unroll
        for (int r = 0; r < 16; ++r) Pw[ROWMAP(r, lane) * 40 + l31] = f2bf(s[c][r]);
        __syncthreads();
#pragma unroll
        for (int k16 = 0; k16 < 2; ++k16) {
          const bfrag a = *(const bfrag*)(Pw + l31 * 40 + k16 * 16 + h8);
#pragma unroll
          for (int dt = 0; dt < 2; ++dt) {
            const bfrag b = *(const bfrag*)(VT + (dt * 32 + l31) * 264 + (qt + c) * 32 + k16 * 16 + h8);
            o[dt] = MFMA(a, b, o[dt]);
          }
        }
        __syncthreads();
      }
#pragma unroll
      for (int dt = 0; dt < 2; ++dt)
#pragma unroll
        for (int r = 0; r < 16; ++r)
          HBp[(size_t)(qt * 32 + ROWMAP(r, lane)) * 1024 + hq * 64 + dt * 32 + l31] = f2bf(o[dt][r] * linv[r]);
    }
  }
  __syncthreads();
}

__device__ __forceinline__ void conv_weights(const float* __restrict__ src, bf16_t* __restrict__ dst, int nmat, int K,
                                             int Nsrc, int Ndst, int mode) {
  const int nk = K >> 5, nNt = Ndst >> 9;
  const int upm = nk * nNt;
  const int tid = threadIdx.x;
  for (int u = blockIdx.x; u < nmat * upm; u += gridDim.x) {
    const int m = u / upm, r = u - m * upm;
    const int nt = r / nk, ks = r - nt * nk;
    const int np = nt * 512 + tid;
    int sc;
    if (mode == 1) {
      const int b = np >> 7, rr = np & 127;
      sc = (rr < 64) ? (b * 64 + rr) : (2816 + b * 64 + rr - 64);
    } else {
      sc = (np < Nsrc) ? np : -1;
    }
    const float* s = src + (size_t)m * K * Nsrc + (size_t)(ks * 32) * Nsrc + (sc < 0 ? 0 : sc);
    uint32_t pk[16];
#pragma unroll
    for (int kk = 0; kk < 16; ++kk) {
      float v0 = s[(size_t)(2 * kk) * Nsrc], v1 = s[(size_t)(2 * kk + 1) * Nsrc];
      if (sc < 0) { v0 = 0.f; v1 = 0.f; }
      pk[kk] = pack2(v0, v1);
    }
    uint4* d = (uint4*)(dst + (size_t)m * K * Ndst + (size_t)(nt * nk + ks) * 16384 + tid * 32);
    d[0] = make_uint4(pk[0], pk[1], pk[2], pk[3]);
    d[1] = make_uint4(pk[4], pk[5], pk[6], pk[7]);
    d[2] = make_uint4(pk[8], pk[9], pk[10], pk[11]);
    d[3] = make_uint4(pk[12], pk[13], pk[14], pk[15]);
  }
}

__device__ __forceinline__ void phase0(const Ctx& C) {
  conv_weights(C.in[1], C.WGU(), 8, 1024, 5632, 5632, 1);
  conv_weights(C.in[2], C.WD(), 8, 2816, 1024, 1024, 0);
  conv_weights(C.in[5], C.WGI(), 2, 1024, 2048, 2048, 0);
  conv_weights(C.in[10], C.WGO(), 2, 1024, 1024, 1024, 0);
  conv_weights(C.in[11], C.WHI(), 1, 1024, 4096, 4096, 0);
  conv_weights(C.in[14], C.WHO(), 1, 1024, 1024, 1024, 0);
  conv_weights(C.in[15], C.WQKV(), 1, 1024, 1280, 1536, 0);
  conv_weights(C.in[18], C.WAO(), 1, 1024, 1024, 1024, 0);
  const size_t gtid = (size_t)blockIdx.x * 512 + threadIdx.x;
  const size_t gsz = (size_t)gridDim.x * 512;
  for (size_t i = gtid; i < (size_t)T_TOK * 1024 / 4; i += gsz) {
    const float4 v = ((const float4*)C.in[0])[i];
    ((float4*)C.H())[i] = v;
    uint2 pk;
    pk.x = pack2(v.x, v.y);
    pk.y = pack2(v.z, v.w);
    ((uint2*)C.HB())[i] = pk;
  }
  for (size_t i = gtid; i < (size_t)2 * 8 * 128 * 128; i += gsz) {
    const int s = (int)(i & 127), t = (int)((i >> 7) & 127);
    C.WSP()[i] = (s <= t) ? f2bf(C.in[8][i]) : (bf16_t)0;
  }
  for (size_t i = gtid; i < 1024; i += gsz) {
    const float* lp = C.in[12];
    const float a0 = lp[i], a1 = lp[1024 + i], a2 = lp[2048 + i], a3 = lp[3072 + i];
    const float m = fmaxf(fmaxf(a0, a1), fmaxf(a2, a3));
    const float e0 = expf(a0 - m), e1 = expf(a1 - m), e2 = expf(a2 - m), e3 = expf(a3 - m);
    C.LB()[i] = e1 / (e0 + e1 + e2 + e3);
  }
}

enum { OP_FFN = 0, OP_GMLP = 1, OP_HIN = 2, OP_HOUT = 3, OP_QKV = 4, OP_ATTN = 5 };

__device__ __forceinline__ void run_ops(const Ctx& C0, int op_lo, int op_hi, bf16_t* smem) {
  for (int p0 = blockIdx.x; p0 < NPANEL; p0 += gridDim.x) {
    for (int op = op_lo; op < op_hi; ++op) {
      const Ctx& C = C0;
      const int p = p0;
      bf16_t* HBp = C.HB() + (size_t)p * 128 * 1024;
      float* Hp = C.H() + (size_t)p * 128 * 1024;
      bf16_t* ACTp = C.ACT() + (size_t)p * 128 * 2816;
      int kind = OP_FFN, layer = 0, j = 0;
      switch (op) {
        case 0: kind = OP_FFN; layer = 0; j = 0; break;
        case 1: kind = OP_GMLP; layer = 0; j = 0; break;
        case 2: kind = OP_FFN; layer = 0; j = 1; break;
        case 3: kind = OP_FFN; layer = 1; j = 0; break;
        case 4: kind = OP_HIN; layer = 1; break;
        case 5: kind = OP_HOUT; layer = 1; break;
        case 6: kind = OP_FFN; layer = 1; j = 1; break;
        case 7: kind = OP_FFN; layer = 2; j = 0; break;
        case 8: kind = OP_QKV; layer = 2; break;
        case 9: kind = OP_ATTN; layer = 2; break;
        case 10: kind = OP_FFN; layer = 2; j = 1; break;
        case 11: kind = OP_FFN; layer = 3; j = 0; break;
        case 12: kind = OP_GMLP; layer = 3; j = 1; break;
        default: kind = OP_FFN; layer = 3; j = 1; break;
      }
      if (kind == OP_FFN) {
        ffn_panel(C, p, layer, j, op == 13, smem);
      } else if (kind == OP_GMLP) {
        gmlp_panel(C, p, layer, j, smem);
      } else if (kind == OP_HIN) {
        EpiHgrn e{ACTp, ACTp + 128 * 1024, C.out + (size_t)p * 128 * 1024, C.SG() + (size_t)p * 128 * 1024, C.LB()};
        gemm_panel(HBp, 1024, C.WHI(), 1024, 8, e, smem);
        hgrn_rec<false>(C, p, smem);
      } else if (kind == OP_HOUT) {
        hgrn_rec<true>(C, p, smem);
        EpiResLN e2{Hp, ALPHA, 1.0f, nullptr};
        gemm_panel(HBp, 1024, C.WHO(), 1024, 2, e2, smem);
        const int li = (1 * 3 + 1) * 1024;
        ln_panel(Hp, Hp, HBp, C.in[3] + li, C.in[4] + li);
      } else if (kind == OP_QKV) {
        EpiQkv e{ACTp, C.KB() + (size_t)p * 128 * 128, C.VB() + (size_t)p * 128 * 128, C.in[16]};
        gemm_panel(HBp, 1024, C.WQKV(), 1024, 3, e, smem);
      } else {
        attn_panel(C, p, smem);
        EpiResLN e2{Hp, ALPHA, 1.0f, C.in[19]};
        gemm_panel(HBp, 1024, C.WAO(), 1024, 2, e2, smem);
        const int li = (2 * 3 + 1) * 1024;
        ln_panel(Hp, Hp, HBp, C.in[3] + li, C.in[4] + li);
      }
    }
  }
}

#if COOP
__device__ __forceinline__ void grid_barrier(unsigned* bar, unsigned target) {
  __syncthreads();
  if (threadIdx.x == 0) {
    __threadfence();
    __hip_atomic_fetch_add(bar, 1u, __ATOMIC_RELEASE, __HIP_MEMORY_SCOPE_AGENT);
    while (__hip_atomic_load(bar, __ATOMIC_ACQUIRE, __HIP_MEMORY_SCOPE_AGENT) < target) __builtin_amdgcn_s_sleep(8);
    __threadfence();
  }
  __syncthreads();
}

__global__ void __launch_bounds__(512) mega(Params P) {
  extern __shared__ __attribute__((aligned(16))) unsigned char lds_raw[];
  bf16_t* smem = (bf16_t*)lds_raw;
  Ctx C;
  C.in = P.in;
  C.out = P.out;
  C.ws = P.ws;
  const int lo = P.ph_lo, hi = P.ph_hi;
#if COOP
  if (lo < 0) cg::this_grid().sync();
  unsigned* bar = (unsigned*)(P.ws + OFF_BAR);
#define GSYNC(k) do { if (lo <= (k) && (k) + 1 < hi) grid_barrier(bar, (unsigned)((k) + 1) * gridDim.x); } while (0)
#else
#define GSYNC(k) do { } while (0)
#endif
  if (lo <= 0 && 0 < hi) phase0(C);
  GSYNC(0);
  if (lo <= 1 && 1 < hi) run_ops(C, 0, 5, smem);
  GSYNC(1);
  if (lo <= 2 && 2 < hi) hgrn_scan(C);
  GSYNC(2);
  if (lo <= 3 && 3 < hi) run_ops(C, 5, 9, smem);
  GSYNC(3);
  if (lo <= 4 && 4 < hi) run_ops(C, 9, 14, smem);
}

#endif

#if !COOP
__device__ __forceinline__ Ctx make_ctx(const Params& P) { Ctx C; C.in = P.in; C.out = P.out; C.ws = P.ws; return C; }
#define OPK(name, ...) __global__ void __launch_bounds__(512) name(Params P) { \
    extern __shared__ __attribute__((aligned(16))) unsigned char lds_raw[]; bf16_t* smem = (bf16_t*)lds_raw; \
    Ctx C = make_ctx(P); const int p = blockIdx.x; const int layer = P.ph_lo, j = P.ph_hi; (void)p; (void)layer; (void)j; (void)smem; __VA_ARGS__; }
OPK(k_p0, phase0(C))
OPK(k_ffn, ffn_panel(C, p, layer, j & 1, (j >> 1) != 0, smem))
OPK(k_gmlp, gmlp_panel(C, p, layer, j, smem))
OPK(k_hin, { bf16_t* ACTp = C.ACT() + (size_t)p * 128 * 2816; EpiHgrn e{ACTp, ACTp + 128 * 1024, C.out + (size_t)p * 128 * 1024, C.SG() + (size_t)p * 128 * 1024, C.LB()}; gemm_panel(C.HB() + (size_t)p * 128 * 1024, 1024, C.WHI(), 1024, 8, e, smem); hgrn_rec<false>(C, p, smem); })
OPK(k_scan, hgrn_scan(C))
OPK(k_hout, { hgrn_rec<true>(C, p, smem); float* Hp = C.H() + (size_t)p * 128 * 1024; bf16_t* HBp = C.HB() + (size_t)p * 128 * 1024; EpiResLN e2{Hp, ALPHA, 1.0f, nullptr}; gemm_panel(HBp, 1024, C.WHO(), 1024, 2, e2, smem); ln_panel(Hp, Hp, HBp, C.in[3] + 4 * 1024, C.in[4] + 4 * 1024); })
OPK(k_qkv, { bf16_t* ACTp = C.ACT() + (size_t)p * 128 * 2816; EpiQkv e{ACTp, C.KB() + (size_t)p * 128 * 128, C.VB() + (size_t)p * 128 * 128, C.in[16]}; gemm_panel(C.HB() + (size_t)p * 128 * 1024, 1024, C.WQKV(), 1024, 3, e, smem); })
OPK(k_attn, { attn_panel(C, p, smem); float* Hp = C.H() + (size_t)p * 128 * 1024; bf16_t* HBp = C.HB() + (size_t)p * 128 * 1024; EpiResLN e2{Hp, ALPHA, 1.0f, C.in[19]}; gemm_panel(HBp, 1024, C.WAO(), 1024, 2, e2, smem); ln_panel(Hp, Hp, HBp, C.in[3] + 7 * 1024, C.in[4] + 7 * 1024); })
#endif

extern "C" void kernel_launch(void* const* d_in, const int* in_sizes, int n_in, void* d_out, int out_size, void* d_ws,
                              size_t ws_size, hipStream_t stream) {
  static int grid_blocks = 0;
  if (grid_blocks == 0) {
    if (n_in != 20 || ws_size < WS_END) {
      fprintf(stderr, "kernel_launch: unexpected n_in %d or ws_size %zu (need %zu)\n", n_in, ws_size, (size_t)WS_END);
      grid_blocks = -1;
      return;
    }
    int dev = 0, cus = 0, per_cu = 0;
    hipGetDevice(&dev);
    hipDeviceGetAttribute(&cus, hipDeviceAttributeMultiprocessorCount, dev);
#if COOP
    if (hipFuncSetAttribute((const void*)mega, hipFuncAttributeMaxDynamicSharedMemorySize, LDS_BYTES) != hipSuccess)
      fprintf(stderr, "kernel_launch: hipFuncSetAttribute failed\n");
    hipOccupancyMaxActiveBlocksPerMultiprocessor(&per_cu, (const void*)mega, 512, LDS_BYTES);
#else
    const void* ks[] = {(const void*)k_p0, (const void*)k_ffn, (const void*)k_gmlp, (const void*)k_hin, (const void*)k_scan, (const void*)k_hout, (const void*)k_qkv, (const void*)k_attn};
    for (int i = 0; i < 8; ++i) (void)hipFuncSetAttribute(ks[i], hipFuncAttributeMaxDynamicSharedMemorySize, LDS_BYTES);
    per_cu = 1;
#endif
    (void)hipGetLastError();
    if (per_cu < 1) per_cu = 1;
    grid_blocks = cus * per_cu;
    if (grid_blocks > NPANEL) grid_blocks = NPANEL;
    if (grid_blocks < 1) grid_blocks = NPANEL;
  }
  if (grid_blocks < 0) return;
  Params P{};
  for (int i = 0; i < 20; ++i) P.in[i] = (const float*)d_in[i];
  P.out = (float*)d_out;
  P.ws = (unsigned char*)d_ws;
#if COOP
  P.ph_lo = 0; P.ph_hi = 5;
  (void)hipMemsetAsync((unsigned char*)d_ws + OFF_BAR, 0, 256, stream);
  void* args[] = {&P};
  hipError_t e = hipLaunchCooperativeKernel((const void*)mega, dim3(grid_blocks), dim3(512), args, LDS_BYTES, stream);
  if (e != hipSuccess) fprintf(stderr, "cooperative launch failed: %s (grid %d)\n", hipGetErrorString(e), grid_blocks);
#else
#define LAUNCH(k, a, b) do { P.ph_lo = (a); P.ph_hi = (b); hipLaunchKernelGGL(k, dim3(NPANEL), dim3(512), LDS_BYTES, stream, P); } while (0)
  LAUNCH(k_p0, 0, 0);
  LAUNCH(k_ffn, 0, 0); LAUNCH(k_gmlp, 0, 0); LAUNCH(k_ffn, 0, 1);
  LAUNCH(k_ffn, 1, 0); LAUNCH(k_hin, 0, 0); LAUNCH(k_scan, 0, 0); LAUNCH(k_hout, 0, 0); LAUNCH(k_ffn, 1, 1);
  LAUNCH(k_ffn, 2, 0); LAUNCH(k_qkv, 0, 0); LAUNCH(k_attn, 0, 0); LAUNCH(k_ffn, 2, 1);
  LAUNCH(k_ffn, 3, 0); LAUNCH(k_gmlp, 3, 1); LAUNCH(k_ffn, 3, 3);
#endif
}
```

```cpp
#include <hip/hip_runtime.h>
#include <hip/hip_cooperative_groups.h>
#include <stdint.h>
#include <stdio.h>
namespace cg = cooperative_groups;

#ifndef COOP
#define COOP 1
#endif

typedef unsigned short bf16_t;
typedef __attribute__((ext_vector_type(8))) __bf16 bfrag;
typedef __attribute__((ext_vector_type(16))) float f32x16;

constexpr int T_TOK = 32768;
constexpr int NPANEL = 256;
constexpr float ALPHA = 1.6817928305074290f;
constexpr int LDS_BYTES = 123904;
constexpr int LDS_STATS_OFF = 122880;

constexpr size_t SZ_WGU = (size_t)8 * 5632 * 1024 * 2;
constexpr size_t SZ_WD = (size_t)8 * 1024 * 2816 * 2;
constexpr size_t SZ_WGI = (size_t)2 * 2048 * 1024 * 2;
constexpr size_t SZ_WGO = (size_t)2 * 1024 * 1024 * 2;
constexpr size_t SZ_WSP = (size_t)2 * 8 * 128 * 128 * 2;
constexpr size_t SZ_WHI = (size_t)4096 * 1024 * 2;
constexpr size_t SZ_WHO = (size_t)1024 * 1024 * 2;
constexpr size_t SZ_WQKV = (size_t)1536 * 1024 * 2;
constexpr size_t SZ_WAO = (size_t)1024 * 1024 * 2;
constexpr size_t SZ_LB = 4096;
constexpr size_t SZ_H = (size_t)T_TOK * 1024 * 4;
constexpr size_t SZ_HB = (size_t)T_TOK * 1024 * 2;
constexpr size_t SZ_ACT = (size_t)T_TOK * 2816 * 2;
constexpr size_t SZ_SG = (size_t)T_TOK * 1024 * 2;
constexpr size_t SZ_DS = (size_t)NPANEL * 8 * 128 * 128 * 2;
constexpr size_t SZ_DEC = (size_t)NPANEL * 8 * 128 * 4;
constexpr size_t SZ_KB = (size_t)T_TOK * 128 * 2;

constexpr size_t OFF_WGU = 0;
constexpr size_t OFF_WD = OFF_WGU + SZ_WGU;
constexpr size_t OFF_WGI = OFF_WD + SZ_WD;
constexpr size_t OFF_WGO = OFF_WGI + SZ_WGI;
constexpr size_t OFF_WSP = OFF_WGO + SZ_WGO;
constexpr size_t OFF_WHI = OFF_WSP + SZ_WSP;
constexpr size_t OFF_WHO = OFF_WHI + SZ_WHI;
constexpr size_t OFF_WQKV = OFF_WHO + SZ_WHO;
constexpr size_t OFF_WAO = OFF_WQKV + SZ_WQKV;
constexpr size_t OFF_LB = OFF_WAO + SZ_WAO;
constexpr size_t OFF_H = OFF_LB + SZ_LB;
constexpr size_t OFF_HB = OFF_H + SZ_H;
constexpr size_t OFF_ACT = OFF_HB + SZ_HB;
constexpr size_t OFF_SG = OFF_ACT + SZ_ACT;
constexpr size_t OFF_DS = OFF_SG + SZ_SG;
constexpr size_t OFF_DEC = OFF_DS + SZ_DS;
constexpr size_t OFF_KB = OFF_DEC + SZ_DEC;
constexpr size_t OFF_VB = OFF_KB + SZ_KB;
constexpr size_t OFF_BAR = OFF_VB + SZ_KB;
constexpr size_t OFF_STATS = OFF_BAR + 256;
constexpr size_t WS_END = OFF_STATS + (size_t)T_TOK * 8;

struct Params {
  const float* in[20];
  float* out;
  unsigned char* ws;
  int ph_lo, ph_hi;
};

struct Ctx {
  const float* const* in;
  float* out;
  unsigned char* ws;
  __device__ __forceinline__ bf16_t* WGU() const { return (bf16_t*)(ws + OFF_WGU); }
  __device__ __forceinline__ bf16_t* WD() const { return (bf16_t*)(ws + OFF_WD); }
  __device__ __forceinline__ bf16_t* WGI() const { return (bf16_t*)(ws + OFF_WGI); }
  __device__ __forceinline__ bf16_t* WGO() const { return (bf16_t*)(ws + OFF_WGO); }
  __device__ __forceinline__ bf16_t* WSP() const { return (bf16_t*)(ws + OFF_WSP); }
  __device__ __forceinline__ bf16_t* WHI() const { return (bf16_t*)(ws + OFF_WHI); }
  __device__ __forceinline__ bf16_t* WHO() const { return (bf16_t*)(ws + OFF_WHO); }
  __device__ __forceinline__ bf16_t* WQKV() const { return (bf16_t*)(ws + OFF_WQKV); }
  __device__ __forceinline__ bf16_t* WAO() const { return (bf16_t*)(ws + OFF_WAO); }
  __device__ __forceinline__ float* LB() const { return (float*)(ws + OFF_LB); }
  __device__ __forceinline__ float* H() const { return (float*)(ws + OFF_H); }
  __device__ __forceinline__ bf16_t* HB() const { return (bf16_t*)(ws + OFF_HB); }
  __device__ __forceinline__ bf16_t* ACT() const { return (bf16_t*)(ws + OFF_ACT); }
  __device__ __forceinline__ bf16_t* SG() const { return (bf16_t*)(ws + OFF_SG); }
  __device__ __forceinline__ bf16_t* DS() const { return (bf16_t*)(ws + OFF_DS); }
  __device__ __forceinline__ float* DEC() const { return (float*)(ws + OFF_DEC); }
  __device__ __forceinline__ bf16_t* KB() const { return (bf16_t*)(ws + OFF_KB); }
  __device__ __forceinline__ bf16_t* VB() const { return (bf16_t*)(ws + OFF_VB); }
  __device__ __forceinline__ float2* STATS() const { return (float2*)(ws + OFF_STATS); }
};

typedef __attribute__((ext_vector_type(2))) float f32x2_t;
typedef __attribute__((ext_vector_type(2))) __bf16 bf16x2_t;
__device__ __forceinline__ uint32_t pack2(float a, float b) {
  f32x2_t v = {a, b};
  bf16x2_t r = __builtin_convertvector(v, bf16x2_t);
  return __builtin_bit_cast(uint32_t, r);
}
__device__ __forceinline__ bf16_t f2bf(float f) { return (bf16_t)(pack2(f, 0.f) & 0xffffu); }
__device__ __forceinline__ float bf2f(bf16_t b) { return __uint_as_float(((uint32_t)b) << 16); }
__device__ __forceinline__ float wave_sum(float v) {
  v += __shfl_xor(v, 32, 64); v += __shfl_xor(v, 16, 64); v += __shfl_xor(v, 8, 64);
  v += __shfl_xor(v, 4, 64); v += __shfl_xor(v, 2, 64); v += __shfl_xor(v, 1, 64);
  return v;
}
__device__ __forceinline__ float silu_f(float x) { return x * __frcp_rn(1.f + __expf(-x)); }
#define ROWMAP(reg, lane) ((((reg)&3)) + 8 * ((reg) >> 2) + 4 * ((lane) >> 5))
#define MFMA(a, b, c) __builtin_amdgcn_mfma_f32_32x32x16_bf16((a), (b), (c), 0, 0, 0)

__device__ __forceinline__ int opaque_tid() {
  int t = threadIdx.x;
  asm volatile("" : "+v"(t));
  return t;
}

__device__ __forceinline__ unsigned long long opaque_u64(unsigned long long v) {
  unsigned lo = (unsigned)v, hi = (unsigned)(v >> 32);
  asm volatile("" : "+v"(lo), "+v"(hi));
  lo = __builtin_amdgcn_readfirstlane(lo);
  hi = __builtin_amdgcn_readfirstlane(hi);
  return ((unsigned long long)hi << 32) | lo;
}

__device__ __forceinline__ f32x16 zero16() {
  f32x16 z;
#pragma unroll
  for (int i = 0; i < 16; ++i) z[i] = 0.f;
  return z;
}

constexpr int G_STAGE_B = 40960;

__device__ __forceinline__ void glds16(const bf16_t* g, const char* l) {
  __builtin_amdgcn_global_load_lds((const unsigned*)g, (unsigned*)const_cast<char*>(l), 16, 0, 0);
}

#define RDFRAGS(F, stg, ok)                                                              \
  do {                                                                                   \
    const char* sa_ = lds + (stg) * G_STAGE_B + wm * 4096 + (ok);                         \
    const char* sb_ = lds + (stg) * G_STAGE_B + 8192 + wn * 8192 + (ok);                  \
    F[0] = *(const bfrag*)(sa_);                                                         \
    F[1] = *(const bfrag*)(sa_ + 2048);                                                  \
    F[2] = *(const bfrag*)(sb_);                                                         \
    F[3] = *(const bfrag*)(sb_ + 2048);                                                  \
    F[4] = *(const bfrag*)(sb_ + 4096);                                                  \
    F[5] = *(const bfrag*)(sb_ + 6144);                                                  \
  } while (0)
#define DOMFMA(F)                                                                        \
  do {                                                                                   \
    _Pragma("unroll") for (int ni_ = 0; ni_ < 4; ++ni_) {                                \
      acc[0][ni_] = MFMA(F[0], F[2 + ni_], acc[0][ni_]);                                 \
      acc[1][ni_] = MFMA(F[1], F[2 + ni_], acc[1][ni_]);                                 \
    }                                                                                    \
  } while (0)
#define ISSUE_SLAB(stg, ntv, krv)                                                        \
  do {                                                                                   \
    const char* st_ = lds + (stg) * G_STAGE_B + w * 1024;                                    \
    glds16(a_src + (krv) * 32, st_);                                                     \
    const bf16_t* bs_ = b_src + (size_t)((ntv) * nk + (krv)) * 16384;                    \
    _Pragma("unroll") for (int i_ = 0; i_ < 4; ++i_) glds16(bs_ + i_ * 4096, st_ + 8192 + i_ * 8192); \
  } while (0)

#define ISSUE_SLAB_LO(stg, ntv, krv)    \
  do {                                                                                   \
    const char* st_ = lds + (stg) * G_STAGE_B + w * 1024;                                \
    glds16(a_src + (krv) * 32, st_);                                                     \
    const bf16_t* bs_ = b_src + (size_t)((ntv) * nk + (krv)) * 16384;                    \
    glds16(bs_, st_ + 8192);                                                             \
    glds16(bs_ + 4096, st_ + 8192 + 8192);                                               \
  } while (0)
#define ISSUE_SLAB_HI(stg, ntv, krv)                        \
  do {                                                                                   \
    const char* st_ = lds + (stg) * G_STAGE_B + w * 1024;                                \
    const bf16_t* bs_ = b_src + (size_t)((ntv) * nk + (krv)) * 16384;                    \
    glds16(bs_ + 2 * 4096, st_ + 8192 + 2 * 8192);                                       \
    glds16(bs_ + 3 * 4096, st_ + 8192 + 3 * 8192);                                       \
  } while (0)

template <class Epi>
__device__ __forceinline__ void gemm_panel(const bf16_t* __restrict__ A, const int lda, const bf16_t* __restrict__ Wb,
                                           const int K, const int nN, const Epi epi, bf16_t* smem) {
  const int tid = opaque_tid(), lane = tid & 63;
  const int w = __builtin_amdgcn_readfirstlane(tid >> 6);
  const int wm = w & 1, wn = w >> 1;
  const int nk = K >> 5;
  const int total = nN * nk;
  const int l31 = lane & 31, h = lane >> 5;
  const int grow = lane >> 2;
  const int gch = (lane & 3) ^ ((lane >> 4) & 3);
  const bf16_t* a_src = A + (size_t)(w * 16 + grow) * lda + gch * 8;
  const bf16_t* b_src = Wb + (size_t)(w * 16 + grow) * 32 + gch * 8;
  const char* lds = (const char*)smem;
  const int pos0 = h ^ ((l31 >> 2) & 3);
  const int offk0 = l31 * 64 + pos0 * 16;
  const int offk1 = l31 * 64 + (pos0 ^ 2) * 16;
  f32x16 acc[2][4];
#pragma unroll
  for (int i = 0; i < 2; ++i)
#pragma unroll
    for (int j = 0; j < 4; ++j) acc[i][j] = zero16();
  const int rot = (int)(((blockIdx.x >> 3) & 31) * nk) >> 5;
  int kr3 = rot, nt3 = 0, cnt3 = 0;
  __syncthreads();
#pragma unroll
  for (int s3 = 0; s3 < 3; ++s3) {
    ISSUE_SLAB(s3, nt3, kr3);
    ++kr3; if (kr3 == nk) kr3 = 0;
    ++cnt3; if (cnt3 == nk) { cnt3 = 0; ++nt3; }
  }
  asm volatile("s_waitcnt vmcnt(10)" ::: "memory");
  asm volatile("s_waitcnt lgkmcnt(0)" ::: "memory");
  __builtin_amdgcn_s_barrier();
  asm volatile("" ::: "memory");
  bfrag F0[6], F1[6];
  RDFRAGS(F0, 0, offk0);
  int ks = 0, nt = 0, stage = 0, stage_n = 1, stage_p = 2;
  int kr3p = 0, nt3p = 0;
  for (int it = 0; it < total; ++it) {
#define SB() __builtin_amdgcn_sched_barrier(0)
#define MM(F, mi_, ni_) acc[mi_][ni_] = MFMA(F[mi_], F[2 + (ni_)], acc[mi_][ni_])
    {
      const char* sa_ = lds + stage * G_STAGE_B + wm * 4096 + offk1;
      const char* sb_ = lds + stage * G_STAGE_B + 8192 + wn * 8192 + offk1;
      const char* stp_ = lds + stage_p * G_STAGE_B + w * 1024;
      const bf16_t* bsp_ = b_src + (size_t)(nt3p * nk + kr3p) * 16384;
      MM(F0, 0, 0); SB();
      F1[0] = *(const bfrag*)(sa_); F1[1] = *(const bfrag*)(sa_ + 2048); SB();
      MM(F0, 1, 0); SB();
      if (it > 0) glds16(bsp_ + 2 * 4096, stp_ + 8192 + 2 * 8192);
      SB();
      MM(F0, 0, 1); SB();
      F1[2] = *(const bfrag*)(sb_); F1[3] = *(const bfrag*)(sb_ + 2048); SB();
      MM(F0, 1, 1); SB();
      if (it > 0) glds16(bsp_ + 3 * 4096, stp_ + 8192 + 3 * 8192);
      SB();
      MM(F0, 0, 2); SB();
      F1[4] = *(const bfrag*)(sb_ + 4096); F1[5] = *(const bfrag*)(sb_ + 6144); SB();
      MM(F0, 1, 2); MM(F0, 0, 3); MM(F0, 1, 3); SB();
    }
    asm volatile("s_waitcnt vmcnt(5)" ::: "memory");
    asm volatile("s_waitcnt lgkmcnt(0)" ::: "memory");
    __builtin_amdgcn_s_barrier();
    asm volatile("" ::: "memory");
    SB();
    {
      const char* sa_ = lds + stage_n * G_STAGE_B + wm * 4096 + offk0;
      const char* sb_ = lds + stage_n * G_STAGE_B + 8192 + wn * 8192 + offk0;
      const char* st_ = lds + stage * G_STAGE_B + w * 1024;
      const bf16_t* bs_ = b_src + (size_t)(nt3 * nk + kr3) * 16384;
      MM(F1, 0, 0); SB();
      glds16(a_src + kr3 * 32, st_); SB();
      MM(F1, 1, 0); SB();
      F0[0] = *(const bfrag*)(sa_); F0[1] = *(const bfrag*)(sa_ + 2048); SB();
      MM(F1, 0, 1); SB();
      glds16(bs_, st_ + 8192); SB();
      MM(F1, 1, 1); SB();
      F0[2] = *(const bfrag*)(sb_); F0[3] = *(const bfrag*)(sb_ + 2048); SB();
      MM(F1, 0, 2); SB();
      glds16(bs_ + 4096, st_ + 8192 + 8192); SB();
      MM(F1, 1, 2); SB();
      F0[4] = *(const bfrag*)(sb_ + 4096); F0[5] = *(const bfrag*)(sb_ + 6144); SB();
      MM(F1, 0, 3); MM(F1, 1, 3); SB();
    }
    kr3p = kr3; nt3p = nt3;
    ++kr3; if (kr3 == nk) kr3 = 0;
    ++cnt3; if (cnt3 == nk) { cnt3 = 0; ++nt3; }
    if (ks == nk - 1) {
      epi(acc, nt, wm, wn, lane);
#pragma unroll
      for (int i = 0; i < 2; ++i)
#pragma unroll
        for (int j = 0; j < 4; ++j) acc[i][j] = zero16();
      ++nt;
      asm volatile("s_waitcnt vmcnt(0)" ::: "memory");
      RDFRAGS(F0, stage_n, offk0);
    }
    ++ks; if (ks == nk) ks = 0;
    stage_p = stage;
    stage = stage_n;
    ++stage_n; if (stage_n == 3) stage_n = 0;
  }
  asm volatile("s_waitcnt vmcnt(0)" ::: "memory");
  __syncthreads();
}

struct EpiSwiglu {
  bf16_t* act;
  __device__ __forceinline__ void operator()(f32x16 (&acc)[2][4], int nt, int wm, int wn, int lane_in) const {
    int lane = lane_in;
    asm volatile("" : "+v"(lane));
    const int l31 = lane & 31;
#pragma unroll
    for (int mi = 0; mi < 2; ++mi)
#pragma unroll
      for (int n2 = 0; n2 < 2; ++n2)
#pragma unroll
        for (int r = 0; r < 16; ++r) {
          const int row = wm * 64 + mi * 32 + ROWMAP(r, lane);
          const int col = (nt * 4 + wn) * 64 + n2 * 32 + l31;
          const float g = acc[mi][n2][r], u = acc[mi][n2 + 2][r];
          act[(size_t)row * 2816 + col] = f2bf(silu_f(g) * u);
        }
  }
};
struct EpiResLN {
  float* Hp;
  const float2* st;
  const float* gp;
  const float* bp;
  float alpha, c;
  const float* bias;
  __device__ __forceinline__ void operator()(f32x16 (&acc)[2][4], int nt, int wm, int wn, int lane_in) const {
    int lane = lane_in;
    asm volatile("" : "+v"(lane));
    const int l31 = lane & 31;
    const int rb = wm * 64 + 4 * (lane >> 5);
    float* base = Hp + (size_t)rb * 1024 + nt * 512 + wn * 128 + l31;
#pragma unroll
    for (int ni = 0; ni < 4; ++ni) {
      const int col = nt * 512 + wn * 128 + ni * 32 + l31;
      float ag = alpha, ab = bias ? c * bias[col] : 0.f;
      if (st) { ag = alpha * gp[col]; ab += alpha * bp[col]; }
#pragma unroll
      for (int mi = 0; mi < 2; ++mi) {
        float hv[16];
#pragma unroll
        for (int r = 0; r < 16; ++r) hv[r] = base[(size_t)(mi * 32 + (r & 3) + 8 * (r >> 2)) * 1024 + ni * 32];
#pragma unroll
        for (int r = 0; r < 16; ++r) {
          float mu = 0.f, rs = 1.f;
          if (st) { const float2 ms = st[rb + mi * 32 + (r & 3) + 8 * (r >> 2)]; mu = ms.x; rs = ms.y; }
          base[(size_t)(mi * 32 + (r & 3) + 8 * (r >> 2)) * 1024 + ni * 32] = (hv[r] - mu) * rs * ag + ab + c * acc[mi][ni][r];
        }
        __builtin_amdgcn_sched_barrier(0);
      }
    }
  }
};
struct EpiGelu {
  bf16_t* Z;
  __device__ __forceinline__ void operator()(f32x16 (&acc)[2][4], int nt, int wm, int wn, int lane_in) const {
    int lane = lane_in;
    asm volatile("" : "+v"(lane));
    const int l31 = lane & 31;
#pragma unroll
    for (int ni = 0; ni < 4; ++ni) {
      const int col = nt * 512 + wn * 128 + ni * 32 + l31;
#pragma unroll
      for (int mi = 0; mi < 2; ++mi)
#pragma unroll
        for (int r = 0; r < 16; ++r) {
          const int row = wm * 64 + mi * 32 + ROWMAP(r, lane);
          const float x = acc[mi][ni][r];
          Z[(size_t)row * 2048 + col] = f2bf(0.5f * x * (1.f + erff(x * 0.70710678118654752f)));
        }
    }
  }
};
struct EpiHgrn {
  bf16_t* Qp;
  bf16_t* Vp;
  float* LFp;
  bf16_t* SGp;
  const float* lb;
  __device__ __forceinline__ void operator()(f32x16 (&acc)[2][4], int nt, int wm, int wn, int lane_in) const {
    int lane = lane_in;
    asm volatile("" : "+v"(lane));
    const int l31 = lane & 31;
    const int sec = nt >> 1;
    const int cb = (nt & 1) * 512 + wn * 128 + l31;
    const int rb = wm * 64 + 4 * (lane >> 5);
    if (sec == 0 || sec == 3) {
      bf16_t* dst = (sec == 0) ? Qp : SGp;
#pragma unroll
      for (int ni = 0; ni < 4; ++ni)
#pragma unroll
        for (int mi = 0; mi < 2; ++mi)
#pragma unroll
          for (int r = 0; r < 16; ++r) {
            const int row = rb + mi * 32 + (r & 3) + 8 * (r >> 2);
            dst[(size_t)row * 1024 + cb + ni * 32] = f2bf(silu_f(acc[mi][ni][r]));
          }
    } else if (sec == 1) {
#pragma unroll
      for (int ni = 0; ni < 4; ++ni) {
        const float lbv = lb[cb + ni * 32];
#pragma unroll
        for (int mi = 0; mi < 2; ++mi)
#pragma unroll
          for (int r = 0; r < 16; ++r) {
            const int row = rb + mi * 32 + (r & 3) + 8 * (r >> 2);
            const float f = lbv + (1.f - lbv) * __frcp_rn(1.f + __expf(-acc[mi][ni][r]));
            LFp[(size_t)row * 1024 + cb + ni * 32] = __logf(f);
          }
      }
    } else {
#pragma unroll
      for (int ni = 0; ni < 4; ++ni)
#pragma unroll
        for (int mi = 0; mi < 2; ++mi)
#pragma unroll
          for (int r = 0; r < 16; ++r) {
            const int row = rb + mi * 32 + (r & 3) + 8 * (r >> 2);
            Vp[(size_t)row * 1024 + cb + ni * 32] = f2bf(acc[mi][ni][r]);
          }
    }
  }
};
struct EpiQkv {
  bf16_t* Qp;
  bf16_t* Kp;
  bf16_t* Vp;
  const float* bias;
  __device__ __forceinline__ void operator()(f32x16 (&acc)[2][4], int nt, int wm, int wn, int lane_in) const {
    int lane = lane_in;
    asm volatile("" : "+v"(lane));
    const int l31 = lane & 31;
#pragma unroll
    for (int ni = 0; ni < 4; ++ni) {
      const int col = nt * 512 + wn * 128 + ni * 32 + l31;
      if (col < 1280) {
        const float bv = bias[col];
#pragma unroll
        for (int mi = 0; mi < 2; ++mi)
#pragma unroll
          for (int r = 0; r < 16; ++r) {
            const int row = wm * 64 + mi * 32 + ROWMAP(r, lane);
            const float x = acc[mi][ni][r] + bv;
            if (col < 1024) Qp[(size_t)row * 1024 + col] = f2bf(x * 0.125f);
            else if (col < 1152) Kp[(size_t)row * 128 + (col - 1024)] = f2bf(x);
            else Vp[(size_t)row * 128 + (col - 1152)] = f2bf(x);
          }
      }
    }
  }
};

__device__ __forceinline__ void ln_panel(const float* Hp, float* outp, bf16_t* HBp, const float* g, const float* b,
                                         float2* stg, float2* stl) {
  const int tid = opaque_tid(), lane = tid & 63;
  const int w = __builtin_amdgcn_readfirstlane(tid >> 6);
  float4 gv[4], bv[4];
#pragma unroll
  for (int j = 0; j < 4; ++j) {
    gv[j] = *(const float4*)(g + j * 256 + lane * 4);
    bv[j] = *(const float4*)(b + j * 256 + lane * 4);
  }
  for (int r = w; r < 128; r += 8) {
    float4 x[4];
    float s = 0.f;
#pragma unroll
    for (int j = 0; j < 4; ++j) {
      x[j] = *(const float4*)(Hp + (size_t)r * 1024 + j * 256 + lane * 4);
      s += x[j].x + x[j].y + x[j].z + x[j].w;
    }
    s = wave_sum(s);
    const float mean = s * (1.f / 1024.f);
    float v = 0.f;
#pragma unroll
    for (int j = 0; j < 4; ++j) {
      x[j].x -= mean; x[j].y -= mean; x[j].z -= mean; x[j].w -= mean;
      v += x[j].x * x[j].x + x[j].y * x[j].y + x[j].z * x[j].z + x[j].w * x[j].w;
    }
    v = wave_sum(v);
    const float rstd = 1.0f / sqrtf(v * (1.f / 1024.f) + 1e-5f);
    if (lane == 0) { stg[r] = make_float2(mean, rstd); stl[r] = make_float2(mean, rstd); }
#pragma unroll
    for (int j = 0; j < 4; ++j) {
      float4 y;
      y.x = x[j].x * rstd * gv[j].x + bv[j].x;
      y.y = x[j].y * rstd * gv[j].y + bv[j].y;
      y.z = x[j].z * rstd * gv[j].z + bv[j].z;
      y.w = x[j].w * rstd * gv[j].w + bv[j].w;
      if (outp) *(float4*)(outp + (size_t)r * 1024 + j * 256 + lane * 4) = y;
      uint2 pk;
      pk.x = pack2(y.x, y.y);
      pk.y = pack2(y.z, y.w);
      *(uint2*)(HBp + (size_t)r * 1024 + j * 256 + lane * 4) = pk;
    }
  }
  __syncthreads();
}

__device__ __forceinline__ void ffn_panel(const Ctx& C, int p, int layer, int j, bool final_out, int sub, bf16_t* smem) {
  const int wi = layer * 2 + j;
  bf16_t* HBp = C.HB() + (size_t)p * 128 * 1024;
  bf16_t* ACTp = C.ACT() + (size_t)p * 128 * 2816;
  float* Hp = C.H() + (size_t)p * 128 * 1024;
  EpiSwiglu e1{ACTp};
  gemm_panel(HBp, 1024, C.WGU() + (size_t)wi * 5632 * 1024, 1024, 11, e1, smem);
  float2* stl = (float2*)((char*)smem + LDS_STATS_OFF);
  float2* stg = C.STATS() + (size_t)p * 128;
  EpiResLN e2{Hp, sub > 0 ? stl : nullptr, C.in[3] + (sub > 0 ? sub - 1 : 0) * 1024, C.in[4] + (sub > 0 ? sub - 1 : 0) * 1024, ALPHA, 0.5f, nullptr};
  gemm_panel(ACTp, 2816, C.WD() + (size_t)wi * 1024 * 2816, 2816, 2, e2, smem);
  const int li = (layer * 3 + (j == 0 ? 0 : 2)) * 1024;
  float* outp = final_out ? (C.out + (size_t)p * 128 * 1024) : nullptr;
  ln_panel(Hp, outp, HBp, C.in[3] + li, C.in[4] + li, stg, stl);
}

__device__ __forceinline__ void gmlp_panel(const Ctx& C, int p, int layer, int slot, int sub, bf16_t* smem) {
  const int tid = opaque_tid(), lane = tid & 63;
  const int w = __builtin_amdgcn_readfirstlane(tid >> 6);
  const int l31 = lane & 31, h8 = (lane >> 5) * 8;
  bf16_t* HBp = C.HB() + (size_t)p * 128 * 1024;
  bf16_t* Zp = C.ACT() + (size_t)p * 128 * 2816;
  float* Hp = C.H() + (size_t)p * 128 * 1024;
  {
    EpiGelu e{Zp};
    gemm_panel(HBp, 1024, C.WGI() + (size_t)slot * 2048 * 1024, 1024, 4, e, smem);
  }
  bf16_t* As = smem;
  bf16_t* Bs = smem + 128 * 136;
  float* st = (float*)(smem + 2 * 128 * 136);
  for (int r = w; r < 128; r += 8) {
    const uint4 q0 = *(const uint4*)(Zp + (size_t)r * 2048 + 1024 + lane * 16);
    const uint4 q1 = *(const uint4*)(Zp + (size_t)r * 2048 + 1024 + lane * 16 + 8);
    const uint32_t u[8] = {q0.x, q0.y, q0.z, q0.w, q1.x, q1.y, q1.z, q1.w};
    float x[16];
    float s = 0.f;
#pragma unroll
    for (int e = 0; e < 8; ++e) {
      x[2 * e] = __uint_as_float(u[e] << 16);
      x[2 * e + 1] = __uint_as_float(u[e] & 0xffff0000u);
      s += x[2 * e] + x[2 * e + 1];
    }
    s = wave_sum(s);
    const float mean = s * (1.f / 1024.f);
    float v = 0.f;
#pragma unroll
    for (int e = 0; e < 16; ++e) { const float d = x[e] - mean; v += d * d; }
    v = wave_sum(v);
    if (lane == 0) { st[r * 2] = mean; st[r * 2 + 1] = 1.0f / sqrtf(v * (1.f / 1024.f) + 1e-5f); }
  }
  __syncthreads();
  const float* lng = C.in[6] + slot * 1024;
  const float* lnb = C.in[7] + slot * 1024;
  const float* bsp = C.in[9] + slot * 1024;
  const bf16_t* Wsp = C.WSP() + (size_t)slot * 8 * 16384;
  const int nd = w & 3, mt0 = (w >> 2) * 2;
  for (int g = 0; g < 8; ++g) {
#pragma unroll
    for (int i = 0; i < 4; ++i) {
      const int c = tid + 512 * i;
      *(uint4*)(As + (c >> 4) * 136 + (c & 15) * 8) = *(const uint4*)(Wsp + (size_t)g * 16384 + c * 8);
    }
    {
      const int s = tid >> 2, dq = tid & 3;
      const float mean = st[s * 2], rstd = st[s * 2 + 1];
      const bf16_t* src = Zp + (size_t)s * 2048 + 1024 + g * 128 + dq * 32;
#pragma unroll
      for (int q = 0; q < 4; ++q) {
        const uint4 v4 = *(const uint4*)(src + q * 8);
        const uint32_t u[4] = {v4.x, v4.y, v4.z, v4.w};
#pragma unroll
        for (int e = 0; e < 4; ++e) {
          const int d0 = dq * 32 + q * 8 + e * 2;
          const int ch = g * 128 + d0;
          const float x0 = __uint_as_float(u[e] << 16), x1 = __uint_as_float(u[e] & 0xffff0000u);
          Bs[d0 * 136 + s] = f2bf((x0 - mean) * rstd * lng[ch] + lnb[ch]);
          Bs[(d0 + 1) * 136 + s] = f2bf((x1 - mean) * rstd * lng[ch + 1] + lnb[ch + 1]);
        }
      }
    }
    __syncthreads();
    f32x16 acc[2];
    acc[0] = zero16(); acc[1] = zero16();
#pragma unroll
    for (int k16 = 0; k16 < 8; ++k16) {
      const bfrag b = *(const bfrag*)(Bs + (nd * 32 + l31) * 136 + k16 * 16 + h8);
#pragma unroll
      for (int mi = 0; mi < 2; ++mi) {
        const bfrag a = *(const bfrag*)(As + ((mt0 + mi) * 32 + l31) * 136 + k16 * 16 + h8);
        acc[mi] = MFMA(a, b, acc[mi]);
      }
    }
#pragma unroll
    for (int mi = 0; mi < 2; ++mi)
#pragma unroll
      for (int r = 0; r < 16; ++r) {
        const int t = (mt0 + mi) * 32 + ROWMAP(r, lane);
        const int ch = g * 128 + nd * 32 + l31;
        const float mixed = acc[mi][r] + bsp[g * 128 + t];
        const float u = bf2f(Zp[(size_t)t * 2048 + ch]);
        HBp[(size_t)t * 1024 + ch] = f2bf(u * mixed);
      }
    __syncthreads();
  }
  {
    EpiResLN e2{Hp, (float2*)((char*)smem + LDS_STATS_OFF), C.in[3] + (sub - 1) * 1024, C.in[4] + (sub - 1) * 1024, ALPHA, 1.0f, nullptr};
    gemm_panel(HBp, 1024, C.WGO() + (size_t)slot * 1024 * 1024, 1024, 2, e2, smem);
  }
  const int li = (layer * 3 + 1) * 1024;
  ln_panel(Hp, nullptr, HBp, C.in[3] + li, C.in[4] + li, C.STATS() + (size_t)p * 128, (float2*)((char*)smem + LDS_STATS_OFF));
}

template <bool OUT>
__device__ __forceinline__ void hgrn_rec(const Ctx& C, int p, bf16_t* smem) {
  const int tid = opaque_tid(), lane = tid & 63;
  const int w = __builtin_amdgcn_readfirstlane(tid >> 6);
  const int l31 = lane & 31, h8 = (lane >> 5) * 8;
  bf16_t* ST = smem;
  bf16_t* Qh = smem + 17408;
  bf16_t* Kh = smem + 21760;
  bf16_t* KhT = smem + 26112;
  bf16_t* vT = smem + 31232;
  bf16_t* Ps = smem + 36352;
  float* seg = (float*)(smem + 37632);
  float* dec = seg + 512;
  float* oF = dec + 128;
  const size_t row0 = (size_t)p * 128;
  const bf16_t* Qp = C.ACT() + (size_t)p * 128 * 2816;
  const bf16_t* Vp = Qp + 128 * 1024;
  const float* LFp = C.out + row0 * 1024;
  const bf16_t* SGp = C.SG() + row0 * 1024;
  bf16_t* HBp = C.HB() + row0 * 1024;
  const float* ng = C.in[13];
  const int jt = w >> 1, kt0 = (w & 1) * 2;
  const int kq = tid & 127, tq = tid >> 7;
  for (int h = 0; h < 8; ++h) {
    f32x16 accS[2];
    bf16_t* SBh = C.DS() + ((size_t)(p * 8 + h)) * 16384;
    if (OUT) {
      __syncthreads();
#pragma unroll
      for (int i = 0; i < 4; ++i) {
        const int c = tid + 512 * i;
        *(uint4*)(ST + (c >> 4) * 136 + (c & 15) * 8) = *(const uint4*)(SBh + c * 8);
      }
      __syncthreads();
#pragma unroll
      for (int c2 = 0; c2 < 2; ++c2)
#pragma unroll
        for (int r = 0; r < 16; ++r)
          accS[c2][r] = bf2f(ST[(jt * 32 + ROWMAP(r, lane)) * 136 + (kt0 + c2) * 32 + l31]);
    } else {
      accS[0] = zero16(); accS[1] = zero16();
    }
    float dsum = 0.f;
    for (int i = 0; i < 4; ++i) {
      float l[8], cs[8];
      const size_t gbase = (size_t)(i * 32 + tq * 8) * 1024 + h * 128 + kq;
#pragma unroll
      for (int e = 0; e < 8; ++e) l[e] = LFp[gbase + (size_t)e * 1024];
      cs[0] = l[0];
#pragma unroll
      for (int e = 1; e < 8; ++e) cs[e] = cs[e - 1] + l[e];
      seg[tq * 128 + kq] = cs[7];
#pragma unroll
      for (int e = 0; e < 8; ++e) vT[kq * 40 + tq * 8 + e] = Vp[gbase + (size_t)e * 1024];
      __syncthreads();
      float off = 0.f, tot = 0.f;
#pragma unroll
      for (int q = 0; q < 4; ++q) {
        const float s = seg[q * 128 + kq];
        if (q < tq) off += s;
        tot += s;
      }
#pragma unroll
      for (int e = 0; e < 8; ++e) {
        const float gc = cs[e] + off;
        const float f = __expf(l[e]);
        const float kh = (1.f - f) * __expf(-gc);
        const bf16_t khb = f2bf(kh);
        const int t = tq * 8 + e;
        KhT[kq * 40 + t] = khb;
        if (OUT) {
          Kh[t * 136 + kq] = khb;
          const float qv = bf2f(Qp[gbase + (size_t)e * 1024]);
          Qh[t * 136 + kq] = f2bf(qv * __expf(gc));
        }
      }
      if (tq == 0) { dec[kq] = __expf(tot); dsum += tot; }
      __syncthreads();
      f32x16 accO = zero16();
      if (OUT) {
        if (w == 0) {
          f32x16 accP = zero16();
#pragma unroll
          for (int k16 = 0; k16 < 8; ++k16) {
            const bfrag a = *(const bfrag*)(Qh + l31 * 136 + k16 * 16 + h8);
            const bfrag b = *(const bfrag*)(Kh + l31 * 136 + k16 * 16 + h8);
            accP = MFMA(a, b, accP);
          }
#pragma unroll
          for (int r = 0; r < 16; ++r) {
            const int t = ROWMAP(r, lane);
            Ps[t * 40 + l31] = (l31 <= t) ? f2bf(accP[r]) : (bf16_t)0;
          }
        } else if (w <= 4) {
          const int nt = w - 1;
#pragma unroll
          for (int k16 = 0; k16 < 8; ++k16) {
            const bfrag a = *(const bfrag*)(Qh + l31 * 136 + k16 * 16 + h8);
            const bfrag b = *(const bfrag*)(ST + (nt * 32 + l31) * 136 + k16 * 16 + h8);
            accO = MFMA(a, b, accO);
          }
        }
        __syncthreads();
        if (w >= 1 && w <= 4) {
          const int nt = w - 1;
#pragma unroll
          for (int k16 = 0; k16 < 2; ++k16) {
            const bfrag a = *(const bfrag*)(Ps + l31 * 40 + k16 * 16 + h8);
            const bfrag b = *(const bfrag*)(vT + (nt * 32 + l31) * 40 + k16 * 16 + h8);
            accO = MFMA(a, b, accO);
          }
#pragma unroll
          for (int r = 0; r < 16; ++r) oF[ROWMAP(r, lane) * 132 + nt * 32 + l31] = accO[r];
        }
      }
#pragma unroll
      for (int c2 = 0; c2 < 2; ++c2) {
#pragma unroll
        for (int k16 = 0; k16 < 2; ++k16) {
          const bfrag a = *(const bfrag*)(vT + (jt * 32 + l31) * 40 + k16 * 16 + h8);
          const bfrag b = *(const bfrag*)(KhT + ((kt0 + c2) * 32 + l31) * 40 + k16 * 16 + h8);
          accS[c2] = MFMA(a, b, accS[c2]);
        }
        const float dk = dec[(kt0 + c2) * 32 + l31];
#pragma unroll
        for (int r = 0; r < 16; ++r) accS[c2][r] *= dk;
        if (OUT) {
#pragma unroll
          for (int r = 0; r < 16; ++r)
            ST[(jt * 32 + ROWMAP(r, lane)) * 136 + (kt0 + c2) * 32 + l31] = f2bf(accS[c2][r]);
        }
      }
      __syncthreads();
      if (OUT) {
        const int t = tid >> 4, part = tid & 15;
        float x[8];
        float ss = 0.f;
#pragma unroll
        for (int e = 0; e < 8; ++e) { x[e] = oF[t * 132 + part * 8 + e]; ss += x[e] * x[e]; }
        ss += __shfl_xor(ss, 1, 64); ss += __shfl_xor(ss, 2, 64); ss += __shfl_xor(ss, 4, 64); ss += __shfl_xor(ss, 8, 64);
        const float rr = 1.0f / sqrtf(ss * (1.f / 128.f) + 1e-6f);
        const size_t gro = (size_t)(i * 32 + t) * 1024 + h * 128 + part * 8;
        const uint4 sg4 = *(const uint4*)(SGp + gro);
        const uint32_t su[4] = {sg4.x, sg4.y, sg4.z, sg4.w};
        uint32_t ov[4];
#pragma unroll
        for (int e = 0; e < 4; ++e) {
          const float g0 = ng[part * 8 + 2 * e], g1 = ng[part * 8 + 2 * e + 1];
          const float s0 = __uint_as_float(su[e] << 16), s1 = __uint_as_float(su[e] & 0xffff0000u);
          ov[e] = pack2(x[2 * e] * rr * g0 * s0, x[2 * e + 1] * rr * g1 * s1);
        }
        uint4 o4; o4.x = ov[0]; o4.y = ov[1]; o4.z = ov[2]; o4.w = ov[3];
        *(uint4*)(HBp + gro) = o4;
      }
    }
    if (!OUT) {
#pragma unroll
      for (int c2 = 0; c2 < 2; ++c2)
#pragma unroll
        for (int r = 0; r < 16; ++r)
          SBh[(jt * 32 + ROWMAP(r, lane)) * 128 + (kt0 + c2) * 32 + l31] = f2bf(accS[c2][r]);
      if (tq == 0) C.DEC()[(size_t)(p * 8 + h) * 128 + kq] = __expf(dsum);
    }
  }
  __syncthreads();
}

__device__ __forceinline__ void hgrn_scan(const Ctx& C) {
  for (int gid = blockIdx.x * 512 + threadIdx.x; gid < 131072; gid += gridDim.x * 512) {
    const int kp = gid & 63, j = (gid >> 6) & 127, h = (gid >> 13) & 7, b = gid >> 16;
    float s0 = 0.f, s1 = 0.f;
    for (int c0 = 0; c0 < 128; c0 += 8) {
      uint32_t d[8];
      float2 dc[8];
#pragma unroll
      for (int e = 0; e < 8; ++e) {
        const size_t ph = (size_t)((b * 128 + c0 + e) * 8 + h);
        d[e] = *(const uint32_t*)(C.DS() + ph * 16384 + j * 128 + kp * 2);
        dc[e] = *(const float2*)(C.DEC() + ph * 128 + kp * 2);
      }
#pragma unroll
      for (int e = 0; e < 8; ++e) {
        const size_t ph = (size_t)((b * 128 + c0 + e) * 8 + h);
        *(uint32_t*)(C.DS() + ph * 16384 + j * 128 + kp * 2) = pack2(s0, s1);
        s0 = dc[e].x * s0 + __uint_as_float(d[e] << 16);
        s1 = dc[e].y * s1 + __uint_as_float(d[e] & 0xffff0000u);
      }
    }
  }
}

__device__ __forceinline__ void attn_panel(const Ctx& C, int p, bf16_t* smem) {
  const int tid = opaque_tid(), lane = tid & 63;
  const int w = __builtin_amdgcn_readfirstlane(tid >> 6);
  const int l31 = lane & 31, h8 = (lane >> 5) * 8;
  bf16_t* K2 = smem;
  bf16_t* VT = smem + 18432;
  bf16_t* Pw = smem + 35328 + w * 1280;
  const int blk = p & 127;
  const size_t row0 = (size_t)p * 128;
  const bf16_t* Qp = C.ACT() + (size_t)p * 128 * 2816;
  bf16_t* HBp = C.HB() + row0 * 1024;
  const int qt = w & 3;
  for (int hk = 0; hk < 2; ++hk) {
    __syncthreads();
#pragma unroll
    for (int i = 0; i < 4; ++i) {
      const int c = tid + 512 * i;
      const int r = c >> 3, ch = c & 7;
      uint4 kv = make_uint4(0, 0, 0, 0), vv = make_uint4(0, 0, 0, 0);
      if (blk > 0 || r >= 128) {
        const size_t tok = row0 + r - 128;
        kv = *(const uint4*)(C.KB() + tok * 128 + hk * 64 + ch * 8);
        vv = *(const uint4*)(C.VB() + tok * 128 + hk * 64 + ch * 8);
      }
      *(uint4*)(K2 + r * 72 + ch * 8) = kv;
      const uint32_t vu[4] = {vv.x, vv.y, vv.z, vv.w};
#pragma unroll
      for (int e = 0; e < 4; ++e) {
        VT[(ch * 8 + 2 * e) * 264 + r] = (bf16_t)(vu[e] & 0xffffu);
        VT[(ch * 8 + 2 * e + 1) * 264 + r] = (bf16_t)(vu[e] >> 16);
      }
    }
    __syncthreads();
    for (int u = 0; u < 4; ++u) {
      const int hq = hk * 8 + (w >> 2) * 4 + u;
      const float sink = C.in[17][hq];
      bfrag aq[4];
#pragma unroll
      for (int k16 = 0; k16 < 4; ++k16)
        aq[k16] = *(const bfrag*)(Qp + (size_t)(qt * 32 + l31) * 1024 + hq * 64 + k16 * 16 + h8);
      f32x16 s[5];
#pragma unroll
      for (int c = 0; c < 5; ++c) {
        s[c] = zero16();
#pragma unroll
        for (int k16 = 0; k16 < 4; ++k16) {
          const bfrag b = *(const bfrag*)(K2 + ((qt + c) * 32 + l31) * 72 + k16 * 16 + h8);
          s[c] = MFMA(aq[k16], b, s[c]);
        }
      }
      float linv[16];
#pragma unroll
      for (int r = 0; r < 16; ++r) {
        const int qi = qt * 32 + ROWMAP(r, lane);
        float m = -1e30f;
#pragma unroll
        for (int c = 0; c < 5; ++c) {
          const int kp = (qt + c) * 32 + l31;
          const bool valid = (kp > qi) && (kp <= qi + 128) && (blk > 0 || kp >= 128);
          const float v = valid ? s[c][r] : -1e30f;
          s[c][r] = v;
          m = fmaxf(m, v);
        }
        m = fmaxf(m, __shfl_xor(m, 16, 64)); m = fmaxf(m, __shfl_xor(m, 8, 64)); m = fmaxf(m, __shfl_xor(m, 4, 64));
        m = fmaxf(m, __shfl_xor(m, 2, 64)); m = fmaxf(m, __shfl_xor(m, 1, 64));
        m = fmaxf(m, sink);
        float sum = 0.f;
#pragma unroll
        for (int c = 0; c < 5; ++c) {
          const float pv = (s[c][r] > -1e29f) ? __expf(s[c][r] - m) : 0.f;
          s[c][r] = pv;
          sum += pv;
        }
        sum += __shfl_xor(sum, 16, 64); sum += __shfl_xor(sum, 8, 64); sum += __shfl_xor(sum, 4, 64);
        sum += __shfl_xor(sum, 2, 64); sum += __shfl_xor(sum, 1, 64);
        sum += __expf(sink - m);
        linv[r] = 1.f / sum;
      }
      f32x16 o[2];
      o[0] = zero16(); o[1] = zero16();
#pragma unroll
      for (int c = 0; c < 5; ++c) {
#pragma unroll
        for (int r = 0; r < 16; ++r) Pw[ROWMAP(r, lane) * 40 + l31] = f2bf(s[c][r]);
        __syncthreads();
#pragma unroll
        for (int k16 = 0; k16 < 2; ++k16) {
          const bfrag a = *(const bfrag*)(Pw + l31 * 40 + k16 * 16 + h8);
#pragma unroll
          for (int dt = 0; dt < 2; ++dt) {
            const bfrag b = *(const bfrag*)(VT + (dt * 32 + l31) * 264 + (qt + c) * 32 + k16 * 16 + h8);
            o[dt] = MFMA(a, b, o[dt]);
          }
        }
        __syncthreads();
      }
#pragma unroll
      for (int dt = 0; dt < 2; ++dt)
#pragma unroll
        for (int r = 0; r < 16; ++r)
          HBp[(size_t)(qt * 32 + ROWMAP(r, lane)) * 1024 + hq * 64 + dt * 32 + l31] = f2bf(o[dt][r] * linv[r]);
    }
  }
  __syncthreads();
}

__device__ __forceinline__ void conv_weights(const float* __restrict__ src, bf16_t* __restrict__ dst, int nmat, int K,
                                             int Nsrc, int Ndst, int mode) {
  const int nk = K >> 5, nNt = Ndst >> 9;
  const int upm = nk * nNt;
  const int tid = threadIdx.x;
  for (int u = blockIdx.x; u < nmat * upm; u += gridDim.x) {
    const int m = u / upm, r = u - m * upm;
    const int nt = r / nk, ks = r - nt * nk;
    const int np = nt * 512 + tid;
    int sc;
    if (mode == 1) {
      const int b = np >> 7, rr = np & 127;
      sc = (rr < 64) ? (b * 64 + rr) : (2816 + b * 64 + rr - 64);
    } else {
      sc = (np < Nsrc) ? np : -1;
    }
    const float* s = src + (size_t)m * K * Nsrc + (size_t)(ks * 32) * Nsrc + (sc < 0 ? 0 : sc);
    uint32_t pk[16];
#pragma unroll
    for (int kk = 0; kk < 16; ++kk) {
      float v0 = s[(size_t)(2 * kk) * Nsrc], v1 = s[(size_t)(2 * kk + 1) * Nsrc];
      if (sc < 0) { v0 = 0.f; v1 = 0.f; }
      pk[kk] = pack2(v0, v1);
    }
    uint4* d = (uint4*)(dst + (size_t)m * K * Ndst + (size_t)(nt * nk + ks) * 16384 + tid * 32);
    d[0] = make_uint4(pk[0], pk[1], pk[2], pk[3]);
    d[1] = make_uint4(pk[4], pk[5], pk[6], pk[7]);
    d[2] = make_uint4(pk[8], pk[9], pk[10], pk[11]);
    d[3] = make_uint4(pk[12], pk[13], pk[14], pk[15]);
  }
}

__device__ __forceinline__ void phase0(const Ctx& C) {
  conv_weights(C.in[1], C.WGU(), 8, 1024, 5632, 5632, 1);
  conv_weights(C.in[2], C.WD(), 8, 2816, 1024, 1024, 0);
  conv_weights(C.in[5], C.WGI(), 2, 1024, 2048, 2048, 0);
  conv_weights(C.in[10], C.WGO(), 2, 1024, 1024, 1024, 0);
  conv_weights(C.in[11], C.WHI(), 1, 1024, 4096, 4096, 0);
  conv_weights(C.in[14], C.WHO(), 1, 1024, 1024, 1024, 0);
  conv_weights(C.in[15], C.WQKV(), 1, 1024, 1280, 1536, 0);
  conv_weights(C.in[18], C.WAO(), 1, 1024, 1024, 1024, 0);
  const size_t gtid = (size_t)blockIdx.x * 512 + threadIdx.x;
  const size_t gsz = (size_t)gridDim.x * 512;
  for (size_t i = gtid; i < (size_t)T_TOK * 1024 / 4; i += gsz) {
    const float4 v = ((const float4*)C.in[0])[i];
    ((float4*)C.H())[i] = v;
    uint2 pk;
    pk.x = pack2(v.x, v.y);
    pk.y = pack2(v.z, v.w);
    ((uint2*)C.HB())[i] = pk;
  }
  for (size_t i = gtid; i < (size_t)2 * 8 * 128 * 128; i += gsz) {
    const int s = (int)(i & 127), t = (int)((i >> 7) & 127);
    C.WSP()[i] = (s <= t) ? f2bf(C.in[8][i]) : (bf16_t)0;
  }
  for (size_t i = gtid; i < 1024; i += gsz) {
    const float* lp = C.in[12];
    const float a0 = lp[i], a1 = lp[1024 + i], a2 = lp[2048 + i], a3 = lp[3072 + i];
    const float m = fmaxf(fmaxf(a0, a1), fmaxf(a2, a3));
    const float e0 = expf(a0 - m), e1 = expf(a1 - m), e2 = expf(a2 - m), e3 = expf(a3 - m);
    C.LB()[i] = e1 / (e0 + e1 + e2 + e3);
  }
}

enum { OP_FFN = 0, OP_GMLP = 1, OP_HIN = 2, OP_HOUT = 3, OP_QKV = 4, OP_ATTN = 5 };

__device__ __forceinline__ void run_ops(const Ctx& C0, int op_lo, int op_hi, bf16_t* smem) {
  for (int p0 = blockIdx.x; p0 < NPANEL; p0 += gridDim.x) {
    for (int op = op_lo; op < op_hi; ++op) {
      const Ctx& C = C0;
      const int p = p0;
      bf16_t* HBp = C.HB() + (size_t)p * 128 * 1024;
      float* Hp = C.H() + (size_t)p * 128 * 1024;
      bf16_t* ACTp = C.ACT() + (size_t)p * 128 * 2816;
      int kind = OP_FFN, layer = 0, j = 0, sub = 0;
      switch (op) {
        case 0: kind = OP_FFN; layer = 0; j = 0; sub = 0; break;
        case 1: kind = OP_GMLP; layer = 0; j = 0; sub = 1; break;
        case 2: kind = OP_FFN; layer = 0; j = 1; sub = 2; break;
        case 3: kind = OP_FFN; layer = 1; j = 0; sub = 3; break;
        case 4: kind = OP_HIN; layer = 1; break;
        case 5: kind = OP_HOUT; layer = 1; sub = 4; break;
        case 6: kind = OP_FFN; layer = 1; j = 1; sub = 5; break;
        case 7: kind = OP_FFN; layer = 2; j = 0; sub = 6; break;
        case 8: kind = OP_QKV; layer = 2; break;
        case 9: kind = OP_ATTN; layer = 2; sub = 7; break;
        case 10: kind = OP_FFN; layer = 2; j = 1; sub = 8; break;
        case 11: kind = OP_FFN; layer = 3; j = 0; sub = 9; break;
        case 12: kind = OP_GMLP; layer = 3; j = 1; sub = 10; break;
        default: kind = OP_FFN; layer = 3; j = 1; sub = 11; break;
      }
      float2* stl = (float2*)((char*)smem + LDS_STATS_OFF);
      float2* stg = C.STATS() + (size_t)p * 128;
      if (threadIdx.x < 128) stl[threadIdx.x] = stg[threadIdx.x];
      if (kind == OP_FFN) {
        ffn_panel(C, p, layer, j, op == 13, sub, smem);
      } else if (kind == OP_GMLP) {
        gmlp_panel(C, p, layer, j, sub, smem);
      } else if (kind == OP_HIN) {
        EpiHgrn e{ACTp, ACTp + 128 * 1024, C.out + (size_t)p * 128 * 1024, C.SG() + (size_t)p * 128 * 1024, C.LB()};
        gemm_panel(HBp, 1024, C.WHI(), 1024, 8, e, smem);
        hgrn_rec<false>(C, p, smem);
      } else if (kind == OP_HOUT) {
        hgrn_rec<true>(C, p, smem);
        EpiResLN e2{Hp, stl, C.in[3] + (sub - 1) * 1024, C.in[4] + (sub - 1) * 1024, ALPHA, 1.0f, nullptr};
        gemm_panel(HBp, 1024, C.WHO(), 1024, 2, e2, smem);
        const int li = (1 * 3 + 1) * 1024;
        ln_panel(Hp, nullptr, HBp, C.in[3] + li, C.in[4] + li, stg, stl);
      } else if (kind == OP_QKV) {
        EpiQkv e{ACTp, C.KB() + (size_t)p * 128 * 128, C.VB() + (size_t)p * 128 * 128, C.in[16]};
        gemm_panel(HBp, 1024, C.WQKV(), 1024, 3, e, smem);
      } else {
        attn_panel(C, p, smem);
        EpiResLN e2{Hp, stl, C.in[3] + (sub - 1) * 1024, C.in[4] + (sub - 1) * 1024, ALPHA, 1.0f, C.in[19]};
        gemm_panel(HBp, 1024, C.WAO(), 1024, 2, e2, smem);
        const int li = (2 * 3 + 1) * 1024;
        ln_panel(Hp, nullptr, HBp, C.in[3] + li, C.in[4] + li, stg, stl);
      }
    }
  }
}

#if COOP
__device__ __forceinline__ void grid_barrier(unsigned* bar, unsigned target) {
  __syncthreads();
  if (threadIdx.x == 0) {
    __threadfence();
    __hip_atomic_fetch_add(bar, 1u, __ATOMIC_RELEASE, __HIP_MEMORY_SCOPE_AGENT);
    while (__hip_atomic_load(bar, __ATOMIC_ACQUIRE, __HIP_MEMORY_SCOPE_AGENT) < target) __builtin_amdgcn_s_sleep(8);
    __threadfence();
  }
  __syncthreads();
}

__global__ void __launch_bounds__(512) mega(Params P) {
  extern __shared__ __attribute__((aligned(16))) unsigned char lds_raw[];
  bf16_t* smem = (bf16_t*)lds_raw;
  Ctx C;
  C.in = P.in;
  C.out = P.out;
  C.ws = P.ws;
  const int lo = P.ph_lo, hi = P.ph_hi;
#if COOP
  if (lo < 0) cg::this_grid().sync();
  unsigned* bar = (unsigned*)(P.ws + OFF_BAR);
#define GSYNC(k) do { if (lo <= (k) && (k) + 1 < hi) grid_barrier(bar, (unsigned)((k) + 1) * gridDim.x); } while (0)
#else
#define GSYNC(k) do { } while (0)
#endif
  if (lo <= 0 && 0 < hi) phase0(C);
  GSYNC(0);
  if (lo <= 1 && 1 < hi) run_ops(C, 0, 5, smem);
  GSYNC(1);
  if (lo <= 2 && 2 < hi) hgrn_scan(C);
  GSYNC(2);
  if (lo <= 3 && 3 < hi) run_ops(C, 5, 9, smem);
  GSYNC(3);
  if (lo <= 4 && 4 < hi) run_ops(C, 9, 14, smem);
}

#endif

extern "C" void kernel_launch(void* const* d_in, const int* in_sizes, int n_in, void* d_out, int out_size, void* d_ws,
                              size_t ws_size, hipStream_t stream) {
  static int grid_blocks = 0;
  if (grid_blocks == 0) {
    if (n_in != 20 || ws_size < WS_END) {
      fprintf(stderr, "kernel_launch: unexpected n_in %d or ws_size %zu (need %zu)\n", n_in, ws_size, (size_t)WS_END);
      grid_blocks = -1;
      return;
    }
    int dev = 0, cus = 0, per_cu = 0;
    hipGetDevice(&dev);
    hipDeviceGetAttribute(&cus, hipDeviceAttributeMultiprocessorCount, dev);
#if COOP
    if (hipFuncSetAttribute((const void*)mega, hipFuncAttributeMaxDynamicSharedMemorySize, LDS_BYTES) != hipSuccess)
      fprintf(stderr, "kernel_launch: hipFuncSetAttribute failed\n");
    hipOccupancyMaxActiveBlocksPerMultiprocessor(&per_cu, (const void*)mega, 512, LDS_BYTES);
#endif
    (void)hipGetLastError();
    if (per_cu < 1) per_cu = 1;
    grid_blocks = cus * per_cu;
    if (grid_blocks > NPANEL) grid_blocks = NPANEL;
    if (grid_blocks < 1) grid_blocks = NPANEL;
  }
  if (grid_blocks < 0) return;
  Params P{};
  for (int i = 0; i < 20; ++i) P.in[i] = (const float*)d_in[i];
  P.out = (float*)d_out;
  P.ws = (unsigned char*)d_ws;
#if COOP
  P.ph_lo = 0; P.ph_hi = 5;
  (void)hipMemsetAsync((unsigned char*)d_ws + OFF_BAR, 0, 256, stream);
  void* args[] = {&P};
  hipError_t e = hipLaunchCooperativeKernel((const void*)mega, dim3(grid_blocks), dim3(512), args, LDS_BYTES, stream);
  if (e != hipSuccess) fprintf(stderr, "cooperative launch failed: %s (grid %d)\n", hipGetErrorString(e), grid_blocks);
#endif
}
```

```cpp
#include <hip/hip_runtime.h>
#include <hip/hip_cooperative_groups.h>
#include <stdint.h>
#include <stdio.h>
namespace cg = cooperative_groups;

#ifndef COOP
#define COOP 1
#endif

typedef unsigned short bf16_t;
typedef __attribute__((ext_vector_type(8))) __bf16 bfrag;
typedef __attribute__((ext_vector_type(16))) float f32x16;

constexpr int T_TOK = 32768;
constexpr int NPANEL = 256;
constexpr float ALPHA = 1.6817928305074290f;
constexpr int LDS_BYTES = 123904;
constexpr int LDS_STATS_OFF = 122880;

constexpr size_t SZ_WGU = (size_t)8 * 5632 * 1024 * 2;
constexpr size_t SZ_WD = (size_t)8 * 1024 * 2816 * 2;
constexpr size_t SZ_WGI = (size_t)2 * 2048 * 1024 * 2;
constexpr size_t SZ_WGO = (size_t)2 * 1024 * 1024 * 2;
constexpr size_t SZ_WSP = (size_t)2 * 8 * 128 * 128 * 2;
constexpr size_t SZ_WHI = (size_t)4096 * 1024 * 2;
constexpr size_t SZ_WHO = (size_t)1024 * 1024 * 2;
constexpr size_t SZ_WQKV = (size_t)1536 * 1024 * 2;
constexpr size_t SZ_WAO = (size_t)1024 * 1024 * 2;
constexpr size_t SZ_LB = 4096;
constexpr size_t SZ_H = (size_t)T_TOK * 1024 * 4;
constexpr size_t SZ_HB = (size_t)T_TOK * 1024 * 2;
constexpr size_t SZ_ACT = (size_t)T_TOK * 2816 * 2;
constexpr size_t SZ_SG = (size_t)T_TOK * 1024 * 2;
constexpr size_t SZ_DS = (size_t)NPANEL * 8 * 128 * 128 * 2;
constexpr size_t SZ_DEC = (size_t)NPANEL * 8 * 128 * 4;
constexpr size_t SZ_KB = (size_t)T_TOK * 128 * 2;

constexpr size_t OFF_WGU = 0;
constexpr size_t OFF_WD = OFF_WGU + SZ_WGU;
constexpr size_t OFF_WGI = OFF_WD + SZ_WD;
constexpr size_t OFF_WGO = OFF_WGI + SZ_WGI;
constexpr size_t OFF_WSP = OFF_WGO + SZ_WGO;
constexpr size_t OFF_WHI = OFF_WSP + SZ_WSP;
constexpr size_t OFF_WHO = OFF_WHI + SZ_WHI;
constexpr size_t OFF_WQKV = OFF_WHO + SZ_WHO;
constexpr size_t OFF_WAO = OFF_WQKV + SZ_WQKV;
constexpr size_t OFF_LB = OFF_WAO + SZ_WAO;
constexpr size_t OFF_H = OFF_LB + SZ_LB;
constexpr size_t OFF_HB = OFF_H + SZ_H;
constexpr size_t OFF_ACT = OFF_HB + SZ_HB;
constexpr size_t OFF_SG = OFF_ACT + SZ_ACT;
constexpr size_t OFF_DS = OFF_SG + SZ_SG;
constexpr size_t OFF_DEC = OFF_DS + SZ_DS;
constexpr size_t OFF_KB = OFF_DEC + SZ_DEC;
constexpr size_t OFF_VB = OFF_KB + SZ_KB;
constexpr size_t OFF_BAR = OFF_VB + SZ_KB;
constexpr size_t OFF_STATS = OFF_BAR + 256;
constexpr size_t WS_END = OFF_STATS + (size_t)T_TOK * 8;

struct Params {
  const float* in[20];
  float* out;
  unsigned char* ws;
  int ph_lo, ph_hi;
};

struct Ctx {
  const float* const* in;
  float* out;
  unsigned char* ws;
  __device__ __forceinline__ bf16_t* WGU() const { return (bf16_t*)(ws + OFF_WGU); }
  __device__ __forceinline__ bf16_t* WD() const { return (bf16_t*)(ws + OFF_WD); }
  __device__ __forceinline__ bf16_t* WGI() const { return (bf16_t*)(ws + OFF_WGI); }
  __device__ __forceinline__ bf16_t* WGO() const { return (bf16_t*)(ws + OFF_WGO); }
  __device__ __forceinline__ bf16_t* WSP() const { return (bf16_t*)(ws + OFF_WSP); }
  __device__ __forceinline__ bf16_t* WHI() const { return (bf16_t*)(ws + OFF_WHI); }
  __device__ __forceinline__ bf16_t* WHO() const { return (bf16_t*)(ws + OFF_WHO); }
  __device__ __forceinline__ bf16_t* WQKV() const { return (bf16_t*)(ws + OFF_WQKV); }
  __device__ __forceinline__ bf16_t* WAO() const { return (bf16_t*)(ws + OFF_WAO); }
  __device__ __forceinline__ float* LB() const { return (float*)(ws + OFF_LB); }
  __device__ __forceinline__ float* H() const { return (float*)(ws + OFF_H); }
  __device__ __forceinline__ bf16_t* HB() const { return (bf16_t*)(ws + OFF_HB); }
  __device__ __forceinline__ bf16_t* ACT() const { return (bf16_t*)(ws + OFF_ACT); }
  __device__ __forceinline__ bf16_t* SG() const { return (bf16_t*)(ws + OFF_SG); }
  __device__ __forceinline__ bf16_t* DS() const { return (bf16_t*)(ws + OFF_DS); }
  __device__ __forceinline__ float* DEC() const { return (float*)(ws + OFF_DEC); }
  __device__ __forceinline__ bf16_t* KB() const { return (bf16_t*)(ws + OFF_KB); }
  __device__ __forceinline__ bf16_t* VB() const { return (bf16_t*)(ws + OFF_VB); }
  __device__ __forceinline__ float2* STATS() const { return (float2*)(ws + OFF_STATS); }
};

typedef __attribute__((ext_vector_type(2))) float f32x2_t;
typedef __attribute__((ext_vector_type(2))) __bf16 bf16x2_t;
__device__ __forceinline__ uint32_t pack2(float a, float b) {
  f32x2_t v = {a, b};
  bf16x2_t r = __builtin_convertvector(v, bf16x2_t);
  return __builtin_bit_cast(uint32_t, r);
}
__device__ __forceinline__ bf16_t f2bf(float f) { return (bf16_t)(pack2(f, 0.f) & 0xffffu); }
__device__ __forceinline__ float bf2f(bf16_t b) { return __uint_as_float(((uint32_t)b) << 16); }
__device__ __forceinline__ float wave_sum(float v) {
  v += __shfl_xor(v, 32, 64); v += __shfl_xor(v, 16, 64); v += __shfl_xor(v, 8, 64);
  v += __shfl_xor(v, 4, 64); v += __shfl_xor(v, 2, 64); v += __shfl_xor(v, 1, 64);
  return v;
}
__device__ __forceinline__ size_t ablk(int row, int col) { return (size_t)(col >> 5) * 4096 + row * 32 + (col & 31); }
__device__ __forceinline__ float silu_f(float x) { return x * __frcp_rn(1.f + __expf(-x)); }
#define ROWMAP(reg, lane) ((((reg)&3)) + 8 * ((reg) >> 2) + 4 * ((lane) >> 5))
#define MFMA(a, b, c) __builtin_amdgcn_mfma_f32_32x32x16_bf16((a), (b), (c), 0, 0, 0)

__device__ __forceinline__ int opaque_tid() {
  int t = threadIdx.x;
  asm volatile("" : "+v"(t));
  return t;
}

__device__ __forceinline__ unsigned long long opaque_u64(unsigned long long v) {
  unsigned lo = (unsigned)v, hi = (unsigned)(v >> 32);
  asm volatile("" : "+v"(lo), "+v"(hi));
  lo = __builtin_amdgcn_readfirstlane(lo);
  hi = __builtin_amdgcn_readfirstlane(hi);
  return ((unsigned long long)hi << 32) | lo;
}

__device__ __forceinline__ f32x16 zero16() {
  f32x16 z;
#pragma unroll
  for (int i = 0; i < 16; ++i) z[i] = 0.f;
  return z;
}

constexpr int G_STAGE_B = 40960;

__device__ __forceinline__ void glds16(const bf16_t* g, const char* l) {
  __builtin_amdgcn_global_load_lds((const unsigned*)g, (unsigned*)const_cast<char*>(l), 16, 0, 0);
}

#define RDFRAGS(F, stg, ok)                                                              \
  do {                                                                                   \
    const char* sa_ = lds + (stg) * G_STAGE_B + wm * 4096 + (ok);                         \
    const char* sb_ = lds + (stg) * G_STAGE_B + 8192 + wn * 8192 + (ok);                  \
    F[0] = *(const bfrag*)(sa_);                                                         \
    F[1] = *(const bfrag*)(sa_ + 2048);                                                  \
    F[2] = *(const bfrag*)(sb_);                                                         \
    F[3] = *(const bfrag*)(sb_ + 2048);                                                  \
    F[4] = *(const bfrag*)(sb_ + 4096);                                                  \
    F[5] = *(const bfrag*)(sb_ + 6144);                                                  \
  } while (0)
#define DOMFMA(F)                                                                        \
  do {                                                                                   \
    _Pragma("unroll") for (int ni_ = 0; ni_ < 4; ++ni_) {                                \
      acc[0][ni_] = MFMA(F[0], F[2 + ni_], acc[0][ni_]);                                 \
      acc[1][ni_] = MFMA(F[1], F[2 + ni_], acc[1][ni_]);                                 \
    }                                                                                    \
  } while (0)
#define ISSUE_SLAB(stg, ntv, krv)                                                        \
  do {                                                                                   \
    const char* st_ = lds + (stg) * G_STAGE_B + w * 1024;                                    \
    glds16(a_src + (krv) * 4096, st_);                                                   \
    const bf16_t* bs_ = b_src + (size_t)((ntv) * nk + (krv)) * 16384;                    \
    _Pragma("unroll") for (int i_ = 0; i_ < 4; ++i_) glds16(bs_ + i_ * 4096, st_ + 8192 + i_ * 8192); \
  } while (0)

#define ISSUE_SLAB_LO(stg, ntv, krv)    \
  do {                                                                                   \
    const char* st_ = lds + (stg) * G_STAGE_B + w * 1024;                                \
    glds16(a_src + (krv) * 4096, st_);                                                   \
    const bf16_t* bs_ = b_src + (size_t)((ntv) * nk + (krv)) * 16384;                    \
    glds16(bs_, st_ + 8192);                                                             \
    glds16(bs_ + 4096, st_ + 8192 + 8192);                                               \
  } while (0)
#define ISSUE_SLAB_HI(stg, ntv, krv)                        \
  do {                                                                                   \
    const char* st_ = lds + (stg) * G_STAGE_B + w * 1024;                                \
    const bf16_t* bs_ = b_src + (size_t)((ntv) * nk + (krv)) * 16384;                    \
    glds16(bs_ + 2 * 4096, st_ + 8192 + 2 * 8192);                                       \
    glds16(bs_ + 3 * 4096, st_ + 8192 + 3 * 8192);                                       \
  } while (0)

template <class Epi>
__device__ __forceinline__ void gemm_panel(const bf16_t* __restrict__ A, const int lda, const bf16_t* __restrict__ Wb,
                                           const int K, const int nN, const Epi epi, bf16_t* smem) {
  const int tid = opaque_tid(), lane = tid & 63;
  const int w = __builtin_amdgcn_readfirstlane(tid >> 6);
  const int wm = w & 1, wn = w >> 1;
  const int nk = K >> 5;
  const int total = nN * nk;
  const int l31 = lane & 31, h = lane >> 5;
  const int grow = lane >> 2;
  const int gch = (lane & 3) ^ ((lane >> 4) & 3);
  const bf16_t* a_src = A + (size_t)(w * 16 + grow) * 32 + gch * 8;
  const bf16_t* b_src = Wb + (size_t)(w * 16 + grow) * 32 + gch * 8;
  const char* lds = (const char*)smem;
  const int pos0 = h ^ ((l31 >> 2) & 3);
  const int offk0 = l31 * 64 + pos0 * 16;
  const int offk1 = l31 * 64 + (pos0 ^ 2) * 16;
  f32x16 acc[2][4];
#pragma unroll
  for (int i = 0; i < 2; ++i)
#pragma unroll
    for (int j = 0; j < 4; ++j) acc[i][j] = zero16();
  const int rot = (int)(((blockIdx.x >> 3) & 31) * nk) >> 5;
  int kr3 = rot, nt3 = 0, cnt3 = 0;
  __syncthreads();
#pragma unroll
  for (int s3 = 0; s3 < 3; ++s3) {
    ISSUE_SLAB(s3, nt3, kr3);
    ++kr3; if (kr3 == nk) kr3 = 0;
    ++cnt3; if (cnt3 == nk) { cnt3 = 0; ++nt3; }
  }
  asm volatile("s_waitcnt vmcnt(10)" ::: "memory");
  asm volatile("s_waitcnt lgkmcnt(0)" ::: "memory");
  __builtin_amdgcn_s_barrier();
  asm volatile("" ::: "memory");
  bfrag F0[6], F1[6];
  RDFRAGS(F0, 0, offk0);
  int ks = 0, nt = 0, stage = 0, stage_n = 1, stage_p = 2;
  int kr3p = 0, nt3p = 0;
  for (int it = 0; it < total; ++it) {
#define SB() __builtin_amdgcn_sched_barrier(0)
#define MM(F, mi_, ni_) acc[mi_][ni_] = MFMA(F[mi_], F[2 + (ni_)], acc[mi_][ni_])
    {
      const char* sa_ = lds + stage * G_STAGE_B + wm * 4096 + offk1;
      const char* sb_ = lds + stage * G_STAGE_B + 8192 + wn * 8192 + offk1;
      const char* stp_ = lds + stage_p * G_STAGE_B + w * 1024;
      const bf16_t* bsp_ = b_src + (size_t)(nt3p * nk + kr3p) * 16384;
      MM(F0, 0, 0); SB();
      F1[0] = *(const bfrag*)(sa_); F1[1] = *(const bfrag*)(sa_ + 2048); SB();
      MM(F0, 1, 0); SB();
      if (it > 0) glds16(bsp_ + 2 * 4096, stp_ + 8192 + 2 * 8192);
      SB();
      MM(F0, 0, 1); SB();
      F1[2] = *(const bfrag*)(sb_); F1[3] = *(const bfrag*)(sb_ + 2048); SB();
      MM(F0, 1, 1); SB();
      if (it > 0) glds16(bsp_ + 3 * 4096, stp_ + 8192 + 3 * 8192);
      SB();
      MM(F0, 0, 2); SB();
      F1[4] = *(const bfrag*)(sb_ + 4096); F1[5] = *(const bfrag*)(sb_ + 6144); SB();
      MM(F0, 1, 2); MM(F0, 0, 3); MM(F0, 1, 3); SB();
    }
    asm volatile("s_waitcnt vmcnt(5)" ::: "memory");
    asm volatile("s_waitcnt lgkmcnt(0)" ::: "memory");
    __builtin_amdgcn_s_barrier();
    asm volatile("" ::: "memory");
    SB();
    {
      const char* sa_ = lds + stage_n * G_STAGE_B + wm * 4096 + offk0;
      const char* sb_ = lds + stage_n * G_STAGE_B + 8192 + wn * 8192 + offk0;
      const char* st_ = lds + stage * G_STAGE_B + w * 1024;
      const bf16_t* bs_ = b_src + (size_t)(nt3 * nk + kr3) * 16384;
      MM(F1, 0, 0); SB();
      glds16(a_src + kr3 * 4096, st_); SB();
      MM(F1, 1, 0); SB();
      F0[0] = *(const bfrag*)(sa_); F0[1] = *(const bfrag*)(sa_ + 2048); SB();
      MM(F1, 0, 1); SB();
      glds16(bs_, st_ + 8192); SB();
      MM(F1, 1, 1); SB();
      F0[2] = *(const bfrag*)(sb_); F0[3] = *(const bfrag*)(sb_ + 2048); SB();
      MM(F1, 0, 2); SB();
      glds16(bs_ + 4096, st_ + 8192 + 8192); SB();
      MM(F1, 1, 2); SB();
      F0[4] = *(const bfrag*)(sb_ + 4096); F0[5] = *(const bfrag*)(sb_ + 6144); SB();
      MM(F1, 0, 3); MM(F1, 1, 3); SB();
    }
    kr3p = kr3; nt3p = nt3;
    ++kr3; if (kr3 == nk) kr3 = 0;
    ++cnt3; if (cnt3 == nk) { cnt3 = 0; ++nt3; }
    if (ks == nk - 1) {
      epi(acc, nt, wm, wn, lane);
#pragma unroll
      for (int i = 0; i < 2; ++i)
#pragma unroll
        for (int j = 0; j < 4; ++j) acc[i][j] = zero16();
      ++nt;
      asm volatile("s_waitcnt vmcnt(0)" ::: "memory");
      RDFRAGS(F0, stage_n, offk0);
    }
    ++ks; if (ks == nk) ks = 0;
    stage_p = stage;
    stage = stage_n;
    ++stage_n; if (stage_n == 3) stage_n = 0;
  }
  asm volatile("s_waitcnt vmcnt(0)" ::: "memory");
  __syncthreads();
}

struct EpiSwiglu {
  bf16_t* act;
  __device__ __forceinline__ void operator()(f32x16 (&acc)[2][4], int nt, int wm, int wn, int lane_in) const {
    int lane = lane_in;
    asm volatile("" : "+v"(lane));
    const int l31 = lane & 31;
#pragma unroll
    for (int mi = 0; mi < 2; ++mi)
#pragma unroll
      for (int n2 = 0; n2 < 2; ++n2)
#pragma unroll
        for (int r = 0; r < 16; ++r) {
          const int row = wm * 64 + mi * 32 + ROWMAP(r, lane);
          const int col = (nt * 4 + wn) * 64 + n2 * 32 + l31;
          const float g = acc[mi][n2][r], u = acc[mi][n2 + 2][r];
          act[ablk(row, col)] = f2bf(silu_f(g) * u);
        }
  }
};
struct EpiResLN {
  float* Hp;
  const float2* st;
  const float* gp;
  const float* bp;
  float alpha, c;
  const float* bias;
  __device__ __forceinline__ void operator()(f32x16 (&acc)[2][4], int nt, int wm, int wn, int lane_in) const {
    int lane = lane_in;
    asm volatile("" : "+v"(lane));
    const int l31 = lane & 31;
    const int rb = wm * 64 + 4 * (lane >> 5);
    float* base = Hp + (size_t)rb * 1024 + nt * 512 + wn * 128 + l31;
#pragma unroll
    for (int ni = 0; ni < 4; ++ni) {
      const int col = nt * 512 + wn * 128 + ni * 32 + l31;
      float ag = alpha, ab = bias ? c * bias[col] : 0.f;
      if (st) { ag = alpha * gp[col]; ab += alpha * bp[col]; }
#pragma unroll
      for (int mi = 0; mi < 2; ++mi) {
        float hv[16];
#pragma unroll
        for (int r = 0; r < 16; ++r) hv[r] = base[(size_t)(mi * 32 + (r & 3) + 8 * (r >> 2)) * 1024 + ni * 32];
#pragma unroll
        for (int r = 0; r < 16; ++r) {
          float mu = 0.f, rs = 1.f;
          if (st) { const float2 ms = st[rb + mi * 32 + (r & 3) + 8 * (r >> 2)]; mu = ms.x; rs = ms.y; }
          base[(size_t)(mi * 32 + (r & 3) + 8 * (r >> 2)) * 1024 + ni * 32] = (hv[r] - mu) * rs * ag + ab + c * acc[mi][ni][r];
        }
        __builtin_amdgcn_sched_barrier(0);
      }
    }
  }
};
struct EpiGelu {
  bf16_t* Z;
  __device__ __forceinline__ void operator()(f32x16 (&acc)[2][4], int nt, int wm, int wn, int lane_in) const {
    int lane = lane_in;
    asm volatile("" : "+v"(lane));
    const int l31 = lane & 31;
#pragma unroll
    for (int ni = 0; ni < 4; ++ni) {
      const int col = nt * 512 + wn * 128 + ni * 32 + l31;
#pragma unroll
      for (int mi = 0; mi < 2; ++mi)
#pragma unroll
        for (int r = 0; r < 16; ++r) {
          const int row = wm * 64 + mi * 32 + ROWMAP(r, lane);
          const float x = acc[mi][ni][r];
          Z[(size_t)row * 2048 + col] = f2bf(0.5f * x * (1.f + erff(x * 0.70710678118654752f)));
        }
    }
  }
};
struct EpiHgrn {
  bf16_t* Qp;
  bf16_t* Vp;
  float* LFp;
  bf16_t* SGp;
  const float* lb;
  __device__ __forceinline__ void operator()(f32x16 (&acc)[2][4], int nt, int wm, int wn, int lane_in) const {
    int lane = lane_in;
    asm volatile("" : "+v"(lane));
    const int l31 = lane & 31;
    const int sec = nt >> 1;
    const int cb = (nt & 1) * 512 + wn * 128 + l31;
    const int rb = wm * 64 + 4 * (lane >> 5);
    if (sec == 0 || sec == 3) {
      bf16_t* dst = (sec == 0) ? Qp : SGp;
#pragma unroll
      for (int ni = 0; ni < 4; ++ni)
#pragma unroll
        for (int mi = 0; mi < 2; ++mi)
#pragma unroll
          for (int r = 0; r < 16; ++r) {
            const int row = rb + mi * 32 + (r & 3) + 8 * (r >> 2);
            dst[(size_t)row * 1024 + cb + ni * 32] = f2bf(silu_f(acc[mi][ni][r]));
          }
    } else if (sec == 1) {
#pragma unroll
      for (int ni = 0; ni < 4; ++ni) {
        const float lbv = lb[cb + ni * 32];
#pragma unroll
        for (int mi = 0; mi < 2; ++mi)
#pragma unroll
          for (int r = 0; r < 16; ++r) {
            const int row = rb + mi * 32 + (r & 3) + 8 * (r >> 2);
            const float f = lbv + (1.f - lbv) * __frcp_rn(1.f + __expf(-acc[mi][ni][r]));
            LFp[(size_t)row * 1024 + cb + ni * 32] = __logf(f);
          }
      }
    } else {
#pragma unroll
      for (int ni = 0; ni < 4; ++ni)
#pragma unroll
        for (int mi = 0; mi < 2; ++mi)
#pragma unroll
          for (int r = 0; r < 16; ++r) {
            const int row = rb + mi * 32 + (r & 3) + 8 * (r >> 2);
            Vp[(size_t)row * 1024 + cb + ni * 32] = f2bf(acc[mi][ni][r]);
          }
    }
  }
};
struct EpiQkv {
  bf16_t* Qp;
  bf16_t* Kp;
  bf16_t* Vp;
  const float* bias;
  __device__ __forceinline__ void operator()(f32x16 (&acc)[2][4], int nt, int wm, int wn, int lane_in) const {
    int lane = lane_in;
    asm volatile("" : "+v"(lane));
    const int l31 = lane & 31;
#pragma unroll
    for (int ni = 0; ni < 4; ++ni) {
      const int col = nt * 512 + wn * 128 + ni * 32 + l31;
      if (col < 1280) {
        const float bv = bias[col];
#pragma unroll
        for (int mi = 0; mi < 2; ++mi)
#pragma unroll
          for (int r = 0; r < 16; ++r) {
            const int row = wm * 64 + mi * 32 + ROWMAP(r, lane);
            const float x = acc[mi][ni][r] + bv;
            if (col < 1024) Qp[(size_t)row * 1024 + col] = f2bf(x * 0.125f);
            else if (col < 1152) Kp[(size_t)row * 128 + (col - 1024)] = f2bf(x);
            else Vp[(size_t)row * 128 + (col - 1152)] = f2bf(x);
          }
      }
    }
  }
};

__device__ __forceinline__ void ln_panel(const float* Hp, float* outp, bf16_t* HBp, const float* g, const float* b,
                                         float2* stg, float2* stl) {
  const int tid = opaque_tid(), lane = tid & 63;
  const int w = __builtin_amdgcn_readfirstlane(tid >> 6);
  float4 gv[4], bv[4];
#pragma unroll
  for (int j = 0; j < 4; ++j) {
    gv[j] = *(const float4*)(g + j * 256 + lane * 4);
    bv[j] = *(const float4*)(b + j * 256 + lane * 4);
  }
  for (int r = w; r < 128; r += 8) {
    float4 x[4];
    float s = 0.f;
#pragma unroll
    for (int j = 0; j < 4; ++j) {
      x[j] = *(const float4*)(Hp + (size_t)r * 1024 + j * 256 + lane * 4);
      s += x[j].x + x[j].y + x[j].z + x[j].w;
    }
    s = wave_sum(s);
    const float mean = s * (1.f / 1024.f);
    float v = 0.f;
#pragma unroll
    for (int j = 0; j < 4; ++j) {
      x[j].x -= mean; x[j].y -= mean; x[j].z -= mean; x[j].w -= mean;
      v += x[j].x * x[j].x + x[j].y * x[j].y + x[j].z * x[j].z + x[j].w * x[j].w;
    }
    v = wave_sum(v);
    const float rstd = 1.0f / sqrtf(v * (1.f / 1024.f) + 1e-5f);
    if (lane == 0) { stg[r] = make_float2(mean, rstd); stl[r] = make_float2(mean, rstd); }
#pragma unroll
    for (int j = 0; j < 4; ++j) {
      float4 y;
      y.x = x[j].x * rstd * gv[j].x + bv[j].x;
      y.y = x[j].y * rstd * gv[j].y + bv[j].y;
      y.z = x[j].z * rstd * gv[j].z + bv[j].z;
      y.w = x[j].w * rstd * gv[j].w + bv[j].w;
      if (outp) *(float4*)(outp + (size_t)r * 1024 + j * 256 + lane * 4) = y;
      uint2 pk;
      pk.x = pack2(y.x, y.y);
      pk.y = pack2(y.z, y.w);
      *(uint2*)(HBp + ablk(r, j * 256 + lane * 4)) = pk;
    }
  }
  __syncthreads();
}

__device__ __forceinline__ void ffn_panel(const Ctx& C, int p, int layer, int j, bool final_out, int sub, bf16_t* smem) {
  const int wi = layer * 2 + j;
  bf16_t* HBp = C.HB() + (size_t)p * 128 * 1024;
  bf16_t* ACTp = C.ACT() + (size_t)p * 128 * 2816;
  float* Hp = C.H() + (size_t)p * 128 * 1024;
  EpiSwiglu e1{ACTp};
  gemm_panel(HBp, 1024, C.WGU() + (size_t)wi * 5632 * 1024, 1024, 11, e1, smem);
  float2* stl = (float2*)((char*)smem + LDS_STATS_OFF);
  float2* stg = C.STATS() + (size_t)p * 128;
  EpiResLN e2{Hp, sub > 0 ? stl : nullptr, C.in[3] + (sub > 0 ? sub - 1 : 0) * 1024, C.in[4] + (sub > 0 ? sub - 1 : 0) * 1024, ALPHA, 0.5f, nullptr};
  gemm_panel(ACTp, 2816, C.WD() + (size_t)wi * 1024 * 2816, 2816, 2, e2, smem);
  const int li = (layer * 3 + (j == 0 ? 0 : 2)) * 1024;
  float* outp = final_out ? (C.out + (size_t)p * 128 * 1024) : nullptr;
  ln_panel(Hp, outp, HBp, C.in[3] + li, C.in[4] + li, stg, stl);
}

__device__ __forceinline__ void gmlp_panel(const Ctx& C, int p, int layer, int slot, int sub, bf16_t* smem) {
  const int tid = opaque_tid(), lane = tid & 63;
  const int w = __builtin_amdgcn_readfirstlane(tid >> 6);
  const int l31 = lane & 31, h8 = (lane >> 5) * 8;
  bf16_t* HBp = C.HB() + (size_t)p * 128 * 1024;
  bf16_t* Zp = C.ACT() + (size_t)p * 128 * 2816;
  float* Hp = C.H() + (size_t)p * 128 * 1024;
  {
    EpiGelu e{Zp};
    gemm_panel(HBp, 1024, C.WGI() + (size_t)slot * 2048 * 1024, 1024, 4, e, smem);
  }
  bf16_t* As = smem;
  bf16_t* Bs = smem + 128 * 136;
  float* st = (float*)(smem + 2 * 128 * 136);
  for (int r = w; r < 128; r += 8) {
    const uint4 q0 = *(const uint4*)(Zp + (size_t)r * 2048 + 1024 + lane * 16);
    const uint4 q1 = *(const uint4*)(Zp + (size_t)r * 2048 + 1024 + lane * 16 + 8);
    const uint32_t u[8] = {q0.x, q0.y, q0.z, q0.w, q1.x, q1.y, q1.z, q1.w};
    float x[16];
    float s = 0.f;
#pragma unroll
    for (int e = 0; e < 8; ++e) {
      x[2 * e] = __uint_as_float(u[e] << 16);
      x[2 * e + 1] = __uint_as_float(u[e] & 0xffff0000u);
      s += x[2 * e] + x[2 * e + 1];
    }
    s = wave_sum(s);
    const float mean = s * (1.f / 1024.f);
    float v = 0.f;
#pragma unroll
    for (int e = 0; e < 16; ++e) { const float d = x[e] - mean; v += d * d; }
    v = wave_sum(v);
    if (lane == 0) { st[r * 2] = mean; st[r * 2 + 1] = 1.0f / sqrtf(v * (1.f / 1024.f) + 1e-5f); }
  }
  __syncthreads();
  const float* lng = C.in[6] + slot * 1024;
  const float* lnb = C.in[7] + slot * 1024;
  const float* bsp = C.in[9] + slot * 1024;
  const bf16_t* Wsp = C.WSP() + (size_t)slot * 8 * 16384;
  const int nd = w & 3, mt0 = (w >> 2) * 2;
  for (int g = 0; g < 8; ++g) {
#pragma unroll
    for (int i = 0; i < 4; ++i) {
      const int c = tid + 512 * i;
      *(uint4*)(As + (c >> 4) * 136 + (c & 15) * 8) = *(const uint4*)(Wsp + (size_t)g * 16384 + c * 8);
    }
    {
      const int s = tid >> 2, dq = tid & 3;
      const float mean = st[s * 2], rstd = st[s * 2 + 1];
      const bf16_t* src = Zp + (size_t)s * 2048 + 1024 + g * 128 + dq * 32;
#pragma unroll
      for (int q = 0; q < 4; ++q) {
        const uint4 v4 = *(const uint4*)(src + q * 8);
        const uint32_t u[4] = {v4.x, v4.y, v4.z, v4.w};
#pragma unroll
        for (int e = 0; e < 4; ++e) {
          const int d0 = dq * 32 + q * 8 + e * 2;
          const int ch = g * 128 + d0;
          const float x0 = __uint_as_float(u[e] << 16), x1 = __uint_as_float(u[e] & 0xffff0000u);
          Bs[d0 * 136 + s] = f2bf((x0 - mean) * rstd * lng[ch] + lnb[ch]);
          Bs[(d0 + 1) * 136 + s] = f2bf((x1 - mean) * rstd * lng[ch + 1] + lnb[ch + 1]);
        }
      }
    }
    __syncthreads();
    f32x16 acc[2];
    acc[0] = zero16(); acc[1] = zero16();
#pragma unroll
    for (int k16 = 0; k16 < 8; ++k16) {
      const bfrag b = *(const bfrag*)(Bs + (nd * 32 + l31) * 136 + k16 * 16 + h8);
#pragma unroll
      for (int mi = 0; mi < 2; ++mi) {
        const bfrag a = *(const bfrag*)(As + ((mt0 + mi) * 32 + l31) * 136 + k16 * 16 + h8);
        acc[mi] = MFMA(a, b, acc[mi]);
      }
    }
#pragma unroll
    for (int mi = 0; mi < 2; ++mi)
#pragma unroll
      for (int r = 0; r < 16; ++r) {
        const int t = (mt0 + mi) * 32 + ROWMAP(r, lane);
        const int ch = g * 128 + nd * 32 + l31;
        const float mixed = acc[mi][r] + bsp[g * 128 + t];
        const float u = bf2f(Zp[(size_t)t * 2048 + ch]);
        HBp[ablk(t, ch)] = f2bf(u * mixed);
      }
    __syncthreads();
  }
  {
    EpiResLN e2{Hp, (float2*)((char*)smem + LDS_STATS_OFF), C.in[3] + (sub - 1) * 1024, C.in[4] + (sub - 1) * 1024, ALPHA, 1.0f, nullptr};
    gemm_panel(HBp, 1024, C.WGO() + (size_t)slot * 1024 * 1024, 1024, 2, e2, smem);
  }
  const int li = (layer * 3 + 1) * 1024;
  ln_panel(Hp, nullptr, HBp, C.in[3] + li, C.in[4] + li, C.STATS() + (size_t)p * 128, (float2*)((char*)smem + LDS_STATS_OFF));
}

template <bool OUT>
__device__ __forceinline__ void hgrn_rec(const Ctx& C, int p, bf16_t* smem) {
  const int tid = opaque_tid(), lane = tid & 63;
  const int w = __builtin_amdgcn_readfirstlane(tid >> 6);
  const int l31 = lane & 31, h8 = (lane >> 5) * 8;
  bf16_t* ST = smem;
  bf16_t* Qh = smem + 17408;
  bf16_t* Kh = smem + 21760;
  bf16_t* KhT = smem + 26112;
  bf16_t* vT = smem + 31232;
  bf16_t* Ps = smem + 36352;
  float* seg = (float*)(smem + 37632);
  float* dec = seg + 512;
  float* oF = dec + 128;
  const size_t row0 = (size_t)p * 128;
  const bf16_t* Qp = C.ACT() + (size_t)p * 128 * 2816;
  const bf16_t* Vp = Qp + 128 * 1024;
  const float* LFp = C.out + row0 * 1024;
  const bf16_t* SGp = C.SG() + row0 * 1024;
  bf16_t* HBp = C.HB() + row0 * 1024;
  const float* ng = C.in[13];
  const int jt = w >> 1, kt0 = (w & 1) * 2;
  const int kq = tid & 127, tq = tid >> 7;
  for (int h = 0; h < 8; ++h) {
    f32x16 accS[2];
    bf16_t* SBh = C.DS() + ((size_t)(p * 8 + h)) * 16384;
    if (OUT) {
      __syncthreads();
#pragma unroll
      for (int i = 0; i < 4; ++i) {
        const int c = tid + 512 * i;
        *(uint4*)(ST + (c >> 4) * 136 + (c & 15) * 8) = *(const uint4*)(SBh + c * 8);
      }
      __syncthreads();
#pragma unroll
      for (int c2 = 0; c2 < 2; ++c2)
#pragma unroll
        for (int r = 0; r < 16; ++r)
          accS[c2][r] = bf2f(ST[(jt * 32 + ROWMAP(r, lane)) * 136 + (kt0 + c2) * 32 + l31]);
    } else {
      accS[0] = zero16(); accS[1] = zero16();
    }
    float dsum = 0.f;
    for (int i = 0; i < 4; ++i) {
      float l[8], cs[8];
      const size_t gbase = (size_t)(i * 32 + tq * 8) * 1024 + h * 128 + kq;
#pragma unroll
      for (int e = 0; e < 8; ++e) l[e] = LFp[gbase + (size_t)e * 1024];
      cs[0] = l[0];
#pragma unroll
      for (int e = 1; e < 8; ++e) cs[e] = cs[e - 1] + l[e];
      seg[tq * 128 + kq] = cs[7];
#pragma unroll
      for (int e = 0; e < 8; ++e) vT[kq * 40 + tq * 8 + e] = Vp[gbase + (size_t)e * 1024];
      __syncthreads();
      float off = 0.f, tot = 0.f;
#pragma unroll
      for (int q = 0; q < 4; ++q) {
        const float s = seg[q * 128 + kq];
        if (q < tq) off += s;
        tot += s;
      }
#pragma unroll
      for (int e = 0; e < 8; ++e) {
        const float gc = cs[e] + off;
        const float f = __expf(l[e]);
        const float kh = (1.f - f) * __expf(-gc);
        const bf16_t khb = f2bf(kh);
        const int t = tq * 8 + e;
        KhT[kq * 40 + t] = khb;
        if (OUT) {
          Kh[t * 136 + kq] = khb;
          const float qv = bf2f(Qp[gbase + (size_t)e * 1024]);
          Qh[t * 136 + kq] = f2bf(qv * __expf(gc));
        }
      }
      if (tq == 0) { dec[kq] = __expf(tot); dsum += tot; }
      __syncthreads();
      f32x16 accO = zero16();
      if (OUT) {
        if (w == 0) {
          f32x16 accP = zero16();
#pragma unroll
          for (int k16 = 0; k16 < 8; ++k16) {
            const bfrag a = *(const bfrag*)(Qh + l31 * 136 + k16 * 16 + h8);
            const bfrag b = *(const bfrag*)(Kh + l31 * 136 + k16 * 16 + h8);
            accP = MFMA(a, b, accP);
          }
#pragma unroll
          for (int r = 0; r < 16; ++r) {
            const int t = ROWMAP(r, lane);
            Ps[t * 40 + l31] = (l31 <= t) ? f2bf(accP[r]) : (bf16_t)0;
          }
        } else if (w <= 4) {
          const int nt = w - 1;
#pragma unroll
          for (int k16 = 0; k16 < 8; ++k16) {
            const bfrag a = *(const bfrag*)(Qh + l31 * 136 + k16 * 16 + h8);
            const bfrag b = *(const bfrag*)(ST + (nt * 32 + l31) * 136 + k16 * 16 + h8);
            accO = MFMA(a, b, accO);
          }
        }
        __syncthreads();
        if (w >= 1 && w <= 4) {
          const int nt = w - 1;
#pragma unroll
          for (int k16 = 0; k16 < 2; ++k16) {
            const bfrag a = *(const bfrag*)(Ps + l31 * 40 + k16 * 16 + h8);
            const bfrag b = *(const bfrag*)(vT + (nt * 32 + l31) * 40 + k16 * 16 + h8);
            accO = MFMA(a, b, accO);
          }
#pragma unroll
          for (int r = 0; r < 16; ++r) oF[ROWMAP(r, lane) * 132 + nt * 32 + l31] = accO[r];
        }
      }
#pragma unroll
      for (int c2 = 0; c2 < 2; ++c2) {
#pragma unroll
        for (int k16 = 0; k16 < 2; ++k16) {
          const bfrag a = *(const bfrag*)(vT + (jt * 32 + l31) * 40 + k16 * 16 + h8);
          const bfrag b = *(const bfrag*)(KhT + ((kt0 + c2) * 32 + l31) * 40 + k16 * 16 + h8);
          accS[c2] = MFMA(a, b, accS[c2]);
        }
        const float dk = dec[(kt0 + c2) * 32 + l31];
#pragma unroll
        for (int r = 0; r < 16; ++r) accS[c2][r] *= dk;
        if (OUT) {
#pragma unroll
          for (int r = 0; r < 16; ++r)
            ST[(jt * 32 + ROWMAP(r, lane)) * 136 + (kt0 + c2) * 32 + l31] = f2bf(accS[c2][r]);
        }
      }
      __syncthreads();
      if (OUT) {
        const int t = tid >> 4, part = tid & 15;
        float x[8];
        float ss = 0.f;
#pragma unroll
        for (int e = 0; e < 8; ++e) { x[e] = oF[t * 132 + part * 8 + e]; ss += x[e] * x[e]; }
        ss += __shfl_xor(ss, 1, 64); ss += __shfl_xor(ss, 2, 64); ss += __shfl_xor(ss, 4, 64); ss += __shfl_xor(ss, 8, 64);
        const float rr = 1.0f / sqrtf(ss * (1.f / 128.f) + 1e-6f);
        const size_t gro = (size_t)(i * 32 + t) * 1024 + h * 128 + part * 8;
        const uint4 sg4 = *(const uint4*)(SGp + gro);
        const uint32_t su[4] = {sg4.x, sg4.y, sg4.z, sg4.w};
        uint32_t ov[4];
#pragma unroll
        for (int e = 0; e < 4; ++e) {
          const float g0 = ng[part * 8 + 2 * e], g1 = ng[part * 8 + 2 * e + 1];
          const float s0 = __uint_as_float(su[e] << 16), s1 = __uint_as_float(su[e] & 0xffff0000u);
          ov[e] = pack2(x[2 * e] * rr * g0 * s0, x[2 * e + 1] * rr * g1 * s1);
        }
        uint4 o4; o4.x = ov[0]; o4.y = ov[1]; o4.z = ov[2]; o4.w = ov[3];
        *(uint4*)(HBp + ablk(i * 32 + t, h * 128 + part * 8)) = o4;
      }
    }
    if (!OUT) {
#pragma unroll
      for (int c2 = 0; c2 < 2; ++c2)
#pragma unroll
        for (int r = 0; r < 16; ++r)
          SBh[(jt * 32 + ROWMAP(r, lane)) * 128 + (kt0 + c2) * 32 + l31] = f2bf(accS[c2][r]);
      if (tq == 0) C.DEC()[(size_t)(p * 8 + h) * 128 + kq] = __expf(dsum);
    }
  }
  __syncthreads();
}

__device__ __forceinline__ void hgrn_scan(const Ctx& C) {
  for (int gid = blockIdx.x * 512 + threadIdx.x; gid < 131072; gid += gridDim.x * 512) {
    const int kp = gid & 63, j = (gid >> 6) & 127, h = (gid >> 13) & 7, b = gid >> 16;
    float s0 = 0.f, s1 = 0.f;
    for (int c0 = 0; c0 < 128; c0 += 8) {
      uint32_t d[8];
      float2 dc[8];
#pragma unroll
      for (int e = 0; e < 8; ++e) {
        const size_t ph = (size_t)((b * 128 + c0 + e) * 8 + h);
        d[e] = *(const uint32_t*)(C.DS() + ph * 16384 + j * 128 + kp * 2);
        dc[e] = *(const float2*)(C.DEC() + ph * 128 + kp * 2);
      }
#pragma unroll
      for (int e = 0; e < 8; ++e) {
        const size_t ph = (size_t)((b * 128 + c0 + e) * 8 + h);
        *(uint32_t*)(C.DS() + ph * 16384 + j * 128 + kp * 2) = pack2(s0, s1);
        s0 = dc[e].x * s0 + __uint_as_float(d[e] << 16);
        s1 = dc[e].y * s1 + __uint_as_float(d[e] & 0xffff0000u);
      }
    }
  }
}

__device__ __forceinline__ void attn_panel(const Ctx& C, int p, bf16_t* smem) {
  const int tid = opaque_tid(), lane = tid & 63;
  const int w = __builtin_amdgcn_readfirstlane(tid >> 6);
  const int l31 = lane & 31, h8 = (lane >> 5) * 8;
  bf16_t* K2 = smem;
  bf16_t* VT = smem + 18432;
  bf16_t* Pw = smem + 35328 + w * 1280;
  const int blk = p & 127;
  const size_t row0 = (size_t)p * 128;
  const bf16_t* Qp = C.ACT() + (size_t)p * 128 * 2816;
  bf16_t* HBp = C.HB() + row0 * 1024;
  const int qt = w & 3;
  for (int hk = 0; hk < 2; ++hk) {
    __syncthreads();
#pragma unroll
    for (int i = 0; i < 4; ++i) {
      const int c = tid + 512 * i;
      const int r = c >> 3, ch = c & 7;
      uint4 kv = make_uint4(0, 0, 0, 0), vv = make_uint4(0, 0, 0, 0);
      if (blk > 0 || r >= 128) {
        const size_t tok = row0 + r - 128;
        kv = *(const uint4*)(C.KB() + tok * 128 + hk * 64 + ch * 8);
        vv = *(const uint4*)(C.VB() + tok * 128 + hk * 64 + ch * 8);
      }
      *(uint4*)(K2 + r * 72 + ch * 8) = kv;
      const uint32_t vu[4] = {vv.x, vv.y, vv.z, vv.w};
#pragma unroll
      for (int e = 0; e < 4; ++e) {
        VT[(ch * 8 + 2 * e) * 264 + r] = (bf16_t)(vu[e] & 0xffffu);
        VT[(ch * 8 + 2 * e + 1) * 264 + r] = (bf16_t)(vu[e] >> 16);
      }
    }
    __syncthreads();
    for (int u = 0; u < 4; ++u) {
      const int hq = hk * 8 + (w >> 2) * 4 + u;
      const float sink = C.in[17][hq];
      bfrag aq[4];
#pragma unroll
      for (int k16 = 0; k16 < 4; ++k16)
        aq[k16] = *(const bfrag*)(Qp + (size_t)(qt * 32 + l31) * 1024 + hq * 64 + k16 * 16 + h8);
      f32x16 s[5];
#pragma unroll
      for (int c = 0; c < 5; ++c) {
        s[c] = zero16();
#pragma unroll
        for (int k16 = 0; k16 < 4; ++k16) {
          const bfrag b = *(const bfrag*)(K2 + ((qt + c) * 32 + l31) * 72 + k16 * 16 + h8);
          s[c] = MFMA(aq[k16], b, s[c]);
        }
      }
      float linv[16];
#pragma unroll
      for (int r = 0; r < 16; ++r) {
        const int qi = qt * 32 + ROWMAP(r, lane);
        float m = -1e30f;
#pragma unroll
        for (int c = 0; c < 5; ++c) {
          const int kp = (qt + c) * 32 + l31;
          const bool valid = (kp > qi) && (kp <= qi + 128) && (blk > 0 || kp >= 128);
          const float v = valid ? s[c][r] : -1e30f;
          s[c][r] = v;
          m = fmaxf(m, v);
        }
        m = fmaxf(m, __shfl_xor(m, 16, 64)); m = fmaxf(m, __shfl_xor(m, 8, 64)); m = fmaxf(m, __shfl_xor(m, 4, 64));
        m = fmaxf(m, __shfl_xor(m, 2, 64)); m = fmaxf(m, __shfl_xor(m, 1, 64));
        m = fmaxf(m, sink);
        float sum = 0.f;
#pragma unroll
        for (int c = 0; c < 5; ++c) {
          const float pv = (s[c][r] > -1e29f) ? __expf(s[c][r] - m) : 0.f;
          s[c][r] = pv;
          sum += pv;
        }
        sum += __shfl_xor(sum, 16, 64); sum += __shfl_xor(sum, 8, 64); sum += __shfl_xor(sum, 4, 64);
        sum += __shfl_xor(sum, 2, 64); sum += __shfl_xor(sum, 1, 64);
        sum += __expf(sink - m);
        linv[r] = 1.f / sum;
      }
      f32x16 o[2];
      o[0] = zero16(); o[1] = zero16();
#pragma unroll
      for (int c = 0; c < 5; ++c) {
#pragma unroll
        for (int r = 0; r < 16; ++r) Pw[ROWMAP(r, lane) * 40 + l31] = f2bf(s[c][r]);
        __syncthreads();
#pragma unroll
        for (int k16 = 0; k16 < 2; ++k16) {
          const bfrag a = *(const bfrag*)(Pw + l31 * 40 + k16 * 16 + h8);
#pragma unroll
          for (int dt = 0; dt < 2; ++dt) {
            const bfrag b = *(const bfrag*)(VT + (dt * 32 + l31) * 264 + (qt + c) * 32 + k16 * 16 + h8);
            o[dt] = MFMA(a, b, o[dt]);
          }
        }
        __syncthreads();
      }
#pragma unroll
      for (int dt = 0; dt < 2; ++dt)
#pragma unroll
        for (int r = 0; r < 16; ++r)
          HBp[ablk(qt * 32 + ROWMAP(r, lane), hq * 64 + dt * 32 + l31)] = f2bf(o[dt][r] * linv[r]);
    }
  }
  __syncthreads();
}

__device__ __forceinline__ void conv_weights(const float* __restrict__ src, bf16_t* __restrict__ dst, int nmat, int K,
                                             int Nsrc, int Ndst, int mode) {
  const int nk = K >> 5, nNt = Ndst >> 9;
  const int upm = nk * nNt;
  const int tid = threadIdx.x;
  for (int u = blockIdx.x; u < nmat * upm; u += gridDim.x) {
    const int m = u / upm, r = u - m * upm;
    const int nt = r / nk, ks = r - nt * nk;
    const int np = nt * 512 + tid;
    int sc;
    if (mode == 1) {
      const int b = np >> 7, rr = np & 127;
      sc = (rr < 64) ? (b * 64 + rr) : (2816 + b * 64 + rr - 64);
    } else {
      sc = (np < Nsrc) ? np : -1;
    }
    const float* s = src + (size_t)m * K * Nsrc + (size_t)(ks * 32) * Nsrc + (sc < 0 ? 0 : sc);
    uint32_t pk[16];
#pragma unroll
    for (int kk = 0; kk < 16; ++kk) {
      float v0 = s[(size_t)(2 * kk) * Nsrc], v1 = s[(size_t)(2 * kk + 1) * Nsrc];
      if (sc < 0) { v0 = 0.f; v1 = 0.f; }
      pk[kk] = pack2(v0, v1);
    }
    uint4* d = (uint4*)(dst + (size_t)m * K * Ndst + (size_t)(nt * nk + ks) * 16384 + tid * 32);
    d[0] = make_uint4(pk[0], pk[1], pk[2], pk[3]);
    d[1] = make_uint4(pk[4], pk[5], pk[6], pk[7]);
    d[2] = make_uint4(pk[8], pk[9], pk[10], pk[11]);
    d[3] = make_uint4(pk[12], pk[13], pk[14], pk[15]);
  }
}

__device__ __forceinline__ void phase0(const Ctx& C) {
  conv_weights(C.in[1], C.WGU(), 8, 1024, 5632, 5632, 1);
  conv_weights(C.in[2], C.WD(), 8, 2816, 1024, 1024, 0);
  conv_weights(C.in[5], C.WGI(), 2, 1024, 2048, 2048, 0);
  conv_weights(C.in[10], C.WGO(), 2, 1024, 1024, 1024, 0);
  conv_weights(C.in[11], C.WHI(), 1, 1024, 4096, 4096, 0);
  conv_weights(C.in[14], C.WHO(), 1, 1024, 1024, 1024, 0);
  conv_weights(C.in[15], C.WQKV(), 1, 1024, 1280, 1536, 0);
  conv_weights(C.in[18], C.WAO(), 1, 1024, 1024, 1024, 0);
  const size_t gtid = (size_t)blockIdx.x * 512 + threadIdx.x;
  const size_t gsz = (size_t)gridDim.x * 512;
  for (size_t i = gtid; i < (size_t)T_TOK * 1024 / 4; i += gsz) {
    const float4 v = ((const float4*)C.in[0])[i];
    ((float4*)C.H())[i] = v;
    uint2 pk;
    pk.x = pack2(v.x, v.y);
    pk.y = pack2(v.z, v.w);
    {
      const int row = (int)(i >> 8), col = (int)(i & 255) * 4;
      *(uint2*)(C.HB() + (size_t)(row >> 7) * 131072 + ablk(row & 127, col)) = pk;
    }
  }
  for (size_t i = gtid; i < (size_t)2 * 8 * 128 * 128; i += gsz) {
    const int s = (int)(i & 127), t = (int)((i >> 7) & 127);
    C.WSP()[i] = (s <= t) ? f2bf(C.in[8][i]) : (bf16_t)0;
  }
  for (size_t i = gtid; i < 1024; i += gsz) {
    const float* lp = C.in[12];
    const float a0 = lp[i], a1 = lp[1024 + i], a2 = lp[2048 + i], a3 = lp[3072 + i];
    const float m = fmaxf(fmaxf(a0, a1), fmaxf(a2, a3));
    const float e0 = expf(a0 - m), e1 = expf(a1 - m), e2 = expf(a2 - m), e3 = expf(a3 - m);
    C.LB()[i] = e1 / (e0 + e1 + e2 + e3);
  }
}

enum { OP_FFN = 0, OP_GMLP = 1, OP_HIN = 2, OP_HOUT = 3, OP_QKV = 4, OP_ATTN = 5 };

__device__ __forceinline__ void run_ops(const Ctx& C0, int op_lo, int op_hi, bf16_t* smem) {
  for (int p0 = blockIdx.x; p0 < NPANEL; p0 += gridDim.x) {
    for (int op = op_lo; op < op_hi; ++op) {
      const Ctx& C = C0;
      const int p = p0;
      bf16_t* HBp = C.HB() + (size_t)p * 128 * 1024;
      float* Hp = C.H() + (size_t)p * 128 * 1024;
      bf16_t* ACTp = C.ACT() + (size_t)p * 128 * 2816;
      int kind = OP_FFN, layer = 0, j = 0, sub = 0;
      switch (op) {
        case 0: kind = OP_FFN; layer = 0; j = 0; sub = 0; break;
        case 1: kind = OP_GMLP; layer = 0; j = 0; sub = 1; break;
        case 2: kind = OP_FFN; layer = 0; j = 1; sub = 2; break;
        case 3: kind = OP_FFN; layer = 1; j = 0; sub = 3; break;
        case 4: kind = OP_HIN; layer = 1; break;
        case 5: kind = OP_HOUT; layer = 1; sub = 4; break;
        case 6: kind = OP_FFN; layer = 1; j = 1; sub = 5; break;
        case 7: kind = OP_FFN; layer = 2; j = 0; sub = 6; break;
        case 8: kind = OP_QKV; layer = 2; break;
        case 9: kind = OP_ATTN; layer = 2; sub = 7; break;
        case 10: kind = OP_FFN; layer = 2; j = 1; sub = 8; break;
        case 11: kind = OP_FFN; layer = 3; j = 0; sub = 9; break;
        case 12: kind = OP_GMLP; layer = 3; j = 1; sub = 10; break;
        default: kind = OP_FFN; layer = 3; j = 1; sub = 11; break;
      }
      float2* stl = (float2*)((char*)smem + LDS_STATS_OFF);
      float2* stg = C.STATS() + (size_t)p * 128;
      if (threadIdx.x < 128) stl[threadIdx.x] = stg[threadIdx.x];
      if (kind == OP_FFN) {
        ffn_panel(C, p, layer, j, op == 13, sub, smem);
      } else if (kind == OP_GMLP) {
        gmlp_panel(C, p, layer, j, sub, smem);
      } else if (kind == OP_HIN) {
        EpiHgrn e{ACTp, ACTp + 128 * 1024, C.out + (size_t)p * 128 * 1024, C.SG() + (size_t)p * 128 * 1024, C.LB()};
        gemm_panel(HBp, 1024, C.WHI(), 1024, 8, e, smem);
        hgrn_rec<false>(C, p, smem);
      } else if (kind == OP_HOUT) {
        hgrn_rec<true>(C, p, smem);
        EpiResLN e2{Hp, stl, C.in[3] + (sub - 1) * 1024, C.in[4] + (sub - 1) * 1024, ALPHA, 1.0f, nullptr};
        gemm_panel(HBp, 1024, C.WHO(), 1024, 2, e2, smem);
        const int li = (1 * 3 + 1) * 1024;
        ln_panel(Hp, nullptr, HBp, C.in[3] + li, C.in[4] + li, stg, stl);
      } else if (kind == OP_QKV) {
        EpiQkv e{ACTp, C.KB() + (size_t)p * 128 * 128, C.VB() + (size_t)p * 128 * 128, C.in[16]};
        gemm_panel(HBp, 1024, C.WQKV(), 1024, 3, e, smem);
      } else {
        attn_panel(C, p, smem);
        EpiResLN e2{Hp, stl, C.in[3] + (sub - 1) * 1024, C.in[4] + (sub - 1) * 1024, ALPHA, 1.0f, C.in[19]};
        gemm_panel(HBp, 1024, C.WAO(), 1024, 2, e2, smem);
        const int li = (2 * 3 + 1) * 1024;
        ln_panel(Hp, nullptr, HBp, C.in[3] + li, C.in[4] + li, stg, stl);
      }
    }
  }
}

#if COOP
__device__ __forceinline__ void grid_barrier(unsigned* bar, unsigned target) {
  __syncthreads();
  if (threadIdx.x == 0) {
    __threadfence();
    __hip_atomic_fetch_add(bar, 1u, __ATOMIC_RELEASE, __HIP_MEMORY_SCOPE_AGENT);
    while (__hip_atomic_load(bar, __ATOMIC_ACQUIRE, __HIP_MEMORY_SCOPE_AGENT) < target) __builtin_amdgcn_s_sleep(8);
    __threadfence();
  }
  __syncthreads();
}

__global__ void __launch_bounds__(512) mega(Params P) {
  extern __shared__ __attribute__((aligned(16))) unsigned char lds_raw[];
  bf16_t* smem = (bf16_t*)lds_raw;
  Ctx C;
  C.in = P.in;
  C.out = P.out;
  C.ws = P.ws;
  const int lo = P.ph_lo, hi = P.ph_hi;
#if COOP
  if (lo < 0) cg::this_grid().sync();
  unsigned* bar = (unsigned*)(P.ws + OFF_BAR);
#define GSYNC(k) do { if (lo <= (k) && (k) + 1 < hi) grid_barrier(bar, (unsigned)((k) + 1) * gridDim.x); } while (0)
#else
#define GSYNC(k) do { } while (0)
#endif
  if (lo <= 0 && 0 < hi) phase0(C);
  GSYNC(0);
  if (lo <= 1 && 1 < hi) run_ops(C, 0, 5, smem);
  GSYNC(1);
  if (lo <= 2 && 2 < hi) hgrn_scan(C);
  GSYNC(2);
  if (lo <= 3 && 3 < hi) run_ops(C, 5, 9, smem);
  GSYNC(3);
  if (lo <= 4 && 4 < hi) run_ops(C, 9, 14, smem);
}

#endif

extern "C" void kernel_launch(void* const* d_in, const int* in_sizes, int n_in, void* d_out, int out_size, void* d_ws,
                              size_t ws_size, hipStream_t stream) {
  static int grid_blocks = 0;
  if (grid_blocks == 0) {
    if (n_in != 20 || ws_size < WS_END) {
      fprintf(stderr, "kernel_launch: unexpected n_in %d or ws_size %zu (need %zu)\n", n_in, ws_size, (size_t)WS_END);
      grid_blocks = -1;
      return;
    }
    int dev = 0, cus = 0, per_cu = 0;
    hipGetDevice(&dev);
    hipDeviceGetAttribute(&cus, hipDeviceAttributeMultiprocessorCount, dev);
#if COOP
    if (hipFuncSetAttribute((const void*)mega, hipFuncAttributeMaxDynamicSharedMemorySize, LDS_BYTES) != hipSuccess)
      fprintf(stderr, "kernel_launch: hipFuncSetAttribute failed\n");
    hipOccupancyMaxActiveBlocksPerMultiprocessor(&per_cu, (const void*)mega, 512, LDS_BYTES);
#endif
    (void)hipGetLastError();
    if (per_cu < 1) per_cu = 1;
    grid_blocks = cus * per_cu;
    if (grid_blocks > NPANEL) grid_blocks = NPANEL;
    if (grid_blocks < 1) grid_blocks = NPANEL;
  }
  if (grid_blocks < 0) return;
  Params P{};
  for (int i = 0; i < 20; ++i) P.in[i] = (const float*)d_in[i];
  P.out = (float*)d_out;
  P.ws = (unsigned char*)d_ws;
#if COOP
  P.ph_lo = 0; P.ph_hi = 5;
  (void)hipMemsetAsync((unsigned char*)d_ws + OFF_BAR, 0, 256, stream);
  void* args[] = {&P};
  hipError_t e = hipLaunchCooperativeKernel((const void*)mega, dim3(grid_blocks), dim3(512), args, LDS_BYTES, stream);
  if (e != hipSuccess) fprintf(stderr, "cooperative launch failed: %s (grid %d)\n", hipGetErrorString(e), grid_blocks);
#endif
}
```

```cpp
#include <hip/hip_runtime.h>
#include <hip/hip_cooperative_groups.h>
#include <stdint.h>
#include <stdio.h>
namespace cg = cooperative_groups;

#ifndef COOP
#define COOP 1
#endif

typedef unsigned short bf16_t;
typedef __attribute__((ext_vector_type(8))) __bf16 bfrag;
typedef __attribute__((ext_vector_type(16))) float f32x16;

constexpr int T_TOK = 32768;
constexpr int NPANEL = 256;
constexpr float ALPHA = 1.6817928305074290f;
constexpr int LDS_BYTES = 123904;
constexpr int LDS_STATS_OFF = 122880;

constexpr size_t SZ_WGU = (size_t)8 * 5632 * 1024 * 2;
constexpr size_t SZ_WD = (size_t)8 * 1024 * 2816 * 2;
constexpr size_t SZ_WGI = (size_t)2 * 2048 * 1024 * 2;
constexpr size_t SZ_WGO = (size_t)2 * 1024 * 1024 * 2;
constexpr size_t SZ_WSP = (size_t)2 * 8 * 128 * 128 * 2;
constexpr size_t SZ_WHI = (size_t)4096 * 1024 * 2;
constexpr size_t SZ_WHO = (size_t)1024 * 1024 * 2;
constexpr size_t SZ_WQKV = (size_t)1536 * 1024 * 2;
constexpr size_t SZ_WAO = (size_t)1024 * 1024 * 2;
constexpr size_t SZ_LB = 4096;
constexpr size_t SZ_H = (size_t)T_TOK * 1024 * 4;
constexpr size_t SZ_HB = (size_t)T_TOK * 1024 * 2;
constexpr size_t SZ_ACT = (size_t)T_TOK * 2816 * 2;
constexpr size_t SZ_SG = (size_t)T_TOK * 1024 * 2;
constexpr size_t SZ_DS = (size_t)NPANEL * 8 * 128 * 128 * 2;
constexpr size_t SZ_DEC = (size_t)NPANEL * 8 * 128 * 4;
constexpr size_t SZ_KB = (size_t)T_TOK * 128 * 2;

constexpr size_t OFF_WGU = 0;
constexpr size_t OFF_WD = OFF_WGU + SZ_WGU;
constexpr size_t OFF_WGI = OFF_WD + SZ_WD;
constexpr size_t OFF_WGO = OFF_WGI + SZ_WGI;
constexpr size_t OFF_WSP = OFF_WGO + SZ_WGO;
constexpr size_t OFF_WHI = OFF_WSP + SZ_WSP;
constexpr size_t OFF_WHO = OFF_WHI + SZ_WHI;
constexpr size_t OFF_WQKV = OFF_WHO + SZ_WHO;
constexpr size_t OFF_WAO = OFF_WQKV + SZ_WQKV;
constexpr size_t OFF_LB = OFF_WAO + SZ_WAO;
constexpr size_t OFF_H = OFF_LB + SZ_LB;
constexpr size_t OFF_HB = OFF_H + SZ_H;
constexpr size_t OFF_ACT = OFF_HB + SZ_HB;
constexpr size_t OFF_SG = OFF_ACT + SZ_ACT;
constexpr size_t OFF_DS = OFF_SG + SZ_SG;
constexpr size_t OFF_DEC = OFF_DS + SZ_DS;
constexpr size_t OFF_KB = OFF_DEC + SZ_DEC;
constexpr size_t OFF_VB = OFF_KB + SZ_KB;
constexpr size_t OFF_BAR = OFF_VB + SZ_KB;
constexpr size_t OFF_STATS = OFF_BAR + 256;
constexpr size_t WS_END = OFF_STATS + (size_t)T_TOK * 8;

struct Params {
  const float* in[20];
  float* out;
  unsigned char* ws;
  int ph_lo, ph_hi;
};

struct Ctx {
  const float* const* in;
  float* out;
  unsigned char* ws;
  __device__ __forceinline__ bf16_t* WGU() const { return (bf16_t*)(ws + OFF_WGU); }
  __device__ __forceinline__ bf16_t* WD() const { return (bf16_t*)(ws + OFF_WD); }
  __device__ __forceinline__ bf16_t* WGI() const { return (bf16_t*)(ws + OFF_WGI); }
  __device__ __forceinline__ bf16_t* WGO() const { return (bf16_t*)(ws + OFF_WGO); }
  __device__ __forceinline__ bf16_t* WSP() const { return (bf16_t*)(ws + OFF_WSP); }
  __device__ __forceinline__ bf16_t* WHI() const { return (bf16_t*)(ws + OFF_WHI); }
  __device__ __forceinline__ bf16_t* WHO() const { return (bf16_t*)(ws + OFF_WHO); }
  __device__ __forceinline__ bf16_t* WQKV() const { return (bf16_t*)(ws + OFF_WQKV); }
  __device__ __forceinline__ bf16_t* WAO() const { return (bf16_t*)(ws + OFF_WAO); }
  __device__ __forceinline__ float* LB() const { return (float*)(ws + OFF_LB); }
  __device__ __forceinline__ float* H() const { return (float*)(ws + OFF_H); }
  __device__ __forceinline__ bf16_t* HB() const { return (bf16_t*)(ws + OFF_HB); }
  __device__ __forceinline__ bf16_t* ACT() const { return (bf16_t*)(ws + OFF_ACT); }
  __device__ __forceinline__ bf16_t* SG() const { return (bf16_t*)(ws + OFF_SG); }
  __device__ __forceinline__ bf16_t* DS() const { return (bf16_t*)(ws + OFF_DS); }
  __device__ __forceinline__ float* DEC() const { return (float*)(ws + OFF_DEC); }
  __device__ __forceinline__ bf16_t* KB() const { return (bf16_t*)(ws + OFF_KB); }
  __device__ __forceinline__ bf16_t* VB() const { return (bf16_t*)(ws + OFF_VB); }
  __device__ __forceinline__ float2* STATS() const { return (float2*)(ws + OFF_STATS); }
};

typedef __attribute__((ext_vector_type(2))) float f32x2_t;
typedef __attribute__((ext_vector_type(2))) __bf16 bf16x2_t;
__device__ __forceinline__ uint32_t pack2(float a, float b) {
  f32x2_t v = {a, b};
  bf16x2_t r = __builtin_convertvector(v, bf16x2_t);
  return __builtin_bit_cast(uint32_t, r);
}
__device__ __forceinline__ bf16_t f2bf(float f) { return (bf16_t)(pack2(f, 0.f) & 0xffffu); }
__device__ __forceinline__ float bf2f(bf16_t b) { return __uint_as_float(((uint32_t)b) << 16); }
__device__ __forceinline__ float wave_sum(float v) {
  v += __shfl_xor(v, 32, 64); v += __shfl_xor(v, 16, 64); v += __shfl_xor(v, 8, 64);
  v += __shfl_xor(v, 4, 64); v += __shfl_xor(v, 2, 64); v += __shfl_xor(v, 1, 64);
  return v;
}
__device__ __forceinline__ size_t ablk(int row, int col) { return (size_t)(col >> 5) * 4096 + row * 32 + (col & 31); }
__device__ __forceinline__ float silu_f(float x) { return x * __frcp_rn(1.f + __expf(-x)); }
#define ROWMAP(reg, lane) ((((reg)&3)) + 8 * ((reg) >> 2) + 4 * ((lane) >> 5))
#define MFMA(a, b, c) __builtin_amdgcn_mfma_f32_32x32x16_bf16((a), (b), (c), 0, 0, 0)

__device__ __forceinline__ int opaque_tid() {
  int t = threadIdx.x;
  asm volatile("" : "+v"(t));
  return t;
}

__device__ __forceinline__ unsigned long long opaque_u64(unsigned long long v) {
  unsigned lo = (unsigned)v, hi = (unsigned)(v >> 32);
  asm volatile("" : "+v"(lo), "+v"(hi));
  lo = __builtin_amdgcn_readfirstlane(lo);
  hi = __builtin_amdgcn_readfirstlane(hi);
  return ((unsigned long long)hi << 32) | lo;
}

__device__ __forceinline__ f32x16 zero16() {
  f32x16 z;
#pragma unroll
  for (int i = 0; i < 16; ++i) z[i] = 0.f;
  return z;
}

constexpr int G_STAGE_B = 40960;

__device__ __forceinline__ void glds16(const bf16_t* g, const char* l) {
  __builtin_amdgcn_global_load_lds((const unsigned*)g, (unsigned*)const_cast<char*>(l), 16, 0, 0);
}

#define RDFRAGS(F, stg, ok)                                                              \
  do {                                                                                   \
    const char* sa_ = lds + (stg) * G_STAGE_B + wm * 4096 + (ok);                         \
    const char* sb_ = lds + (stg) * G_STAGE_B + 8192 + wn * 8192 + (ok);                  \
    F[0] = *(const bfrag*)(sa_);                                                         \
    F[1] = *(const bfrag*)(sa_ + 2048);                                                  \
    F[2] = *(const bfrag*)(sb_);                                                         \
    F[3] = *(const bfrag*)(sb_ + 2048);                                                  \
    F[4] = *(const bfrag*)(sb_ + 4096);                                                  \
    F[5] = *(const bfrag*)(sb_ + 6144);                                                  \
  } while (0)
#define DOMFMA(F)                                                                        \
  do {                                                                                   \
    _Pragma("unroll") for (int ni_ = 0; ni_ < 4; ++ni_) {                                \
      acc[0][ni_] = MFMA(F[0], F[2 + ni_], acc[0][ni_]);                                 \
      acc[1][ni_] = MFMA(F[1], F[2 + ni_], acc[1][ni_]);                                 \
    }                                                                                    \
  } while (0)
#define ISSUE_SLAB(stg, ntv, krv)                                                        \
  do {                                                                                   \
    const char* st_ = lds + (stg) * G_STAGE_B + w * 1024;                                    \
    glds16(a_src + (krv) * 4096, st_);                                                   \
    const bf16_t* bs_ = b_src + (size_t)((ntv) * nk + (krv)) * 16384;                    \
    _Pragma("unroll") for (int i_ = 0; i_ < 4; ++i_) glds16(bs_ + i_ * 4096, st_ + 8192 + i_ * 8192); \
  } while (0)

#define ISSUE_SLAB_LO(stg, ntv, krv)    \
  do {                                                                                   \
    const char* st_ = lds + (stg) * G_STAGE_B + w * 1024;                                \
    glds16(a_src + (krv) * 4096, st_);                                                   \
    const bf16_t* bs_ = b_src + (size_t)((ntv) * nk + (krv)) * 16384;                    \
    glds16(bs_, st_ + 8192);                                                             \
    glds16(bs_ + 4096, st_ + 8192 + 8192);                                               \
  } while (0)
#define ISSUE_SLAB_HI(stg, ntv, krv)                        \
  do {                                                                                   \
    const char* st_ = lds + (stg) * G_STAGE_B + w * 1024;                                \
    const bf16_t* bs_ = b_src + (size_t)((ntv) * nk + (krv)) * 16384;                    \
    glds16(bs_ + 2 * 4096, st_ + 8192 + 2 * 8192);                                       \
    glds16(bs_ + 3 * 4096, st_ + 8192 + 3 * 8192);                                       \
  } while (0)

template <class Epi>
__device__ __forceinline__ void gemm_panel(const bf16_t* __restrict__ A, const int lda, const bf16_t* __restrict__ Wb,
                                           const int K, const int nN, const Epi epi, bf16_t* smem) {
  const int tid = opaque_tid(), lane = tid & 63;
  const int w = __builtin_amdgcn_readfirstlane(tid >> 6);
  const int wm = w & 1, wn = w >> 1;
  const int nk = K >> 5;
  const int total = nN * nk;
  const int l31 = lane & 31, h = lane >> 5;
  const int grow = lane >> 2;
  const int gch = (lane & 3) ^ ((lane >> 4) & 3);
  const bf16_t* a_src = A + (size_t)(w * 16 + grow) * 32 + gch * 8;
  const bf16_t* b_src = Wb + (size_t)(w * 16 + grow) * 32 + gch * 8;
  const char* lds = (const char*)smem;
  const int pos0 = h ^ ((l31 >> 2) & 3);
  const int offk0 = l31 * 64 + pos0 * 16;
  const int offk1 = l31 * 64 + (pos0 ^ 2) * 16;
  f32x16 acc[2][4];
#pragma unroll
  for (int i = 0; i < 2; ++i)
#pragma unroll
    for (int j = 0; j < 4; ++j) acc[i][j] = zero16();
  const int rot = (int)(((blockIdx.x >> 3) & 31) * nk) >> 5;
  int kr3 = rot, nt3 = 0, cnt3 = 0;
  __syncthreads();
#pragma unroll
  for (int s3 = 0; s3 < 3; ++s3) {
    ISSUE_SLAB(s3, nt3, kr3);
    ++kr3; if (kr3 == nk) kr3 = 0;
    ++cnt3; if (cnt3 == nk) { cnt3 = 0; ++nt3; }
  }
  asm volatile("s_waitcnt vmcnt(10)" ::: "memory");
  asm volatile("s_waitcnt lgkmcnt(0)" ::: "memory");
  __builtin_amdgcn_s_barrier();
  asm volatile("" ::: "memory");
  bfrag F0[6], F1[6];
  RDFRAGS(F0, 0, offk0);
  int ks = 0, nt = 0, stage = 0, stage_n = 1, stage_p = 2;
  int kr3p = 0, nt3p = 0;
  for (int it = 0; it < total; ++it) {
#define SB() __builtin_amdgcn_sched_barrier(0)
#define MM(F, mi_, ni_) acc[mi_][ni_] = MFMA(F[mi_], F[2 + (ni_)], acc[mi_][ni_])
    {
      const char* sa_ = lds + stage * G_STAGE_B + wm * 4096 + offk1;
      const char* sb_ = lds + stage * G_STAGE_B + 8192 + wn * 8192 + offk1;
      const char* stp_ = lds + stage_p * G_STAGE_B + w * 1024;
      const bf16_t* bsp_ = b_src + (size_t)(nt3p * nk + kr3p) * 16384;
      MM(F0, 0, 0); SB();
      F1[0] = *(const bfrag*)(sa_); F1[1] = *(const bfrag*)(sa_ + 2048); SB();
      MM(F0, 1, 0); SB();
      if (it > 0) glds16(bsp_ + 2 * 4096, stp_ + 8192 + 2 * 8192);
      SB();
      MM(F0, 0, 1); SB();
      F1[2] = *(const bfrag*)(sb_); F1[3] = *(const bfrag*)(sb_ + 2048); SB();
      MM(F0, 1, 1); SB();
      if (it > 0) glds16(bsp_ + 3 * 4096, stp_ + 8192 + 3 * 8192);
      SB();
      MM(F0, 0, 2); SB();
      F1[4] = *(const bfrag*)(sb_ + 4096); F1[5] = *(const bfrag*)(sb_ + 6144); SB();
      MM(F0, 1, 2); MM(F0, 0, 3); MM(F0, 1, 3); SB();
    }
    asm volatile("s_waitcnt vmcnt(5)" ::: "memory");
    asm volatile("s_waitcnt lgkmcnt(0)" ::: "memory");
    __builtin_amdgcn_s_barrier();
    asm volatile("" ::: "memory");
    SB();
    {
      const char* sa_ = lds + stage_n * G_STAGE_B + wm * 4096 + offk0;
      const char* sb_ = lds + stage_n * G_STAGE_B + 8192 + wn * 8192 + offk0;
      const char* st_ = lds + stage * G_STAGE_B + w * 1024;
      const bf16_t* bs_ = b_src + (size_t)(nt3 * nk + kr3) * 16384;
      MM(F1, 0, 0); SB();
      glds16(a_src + kr3 * 4096, st_); SB();
      MM(F1, 1, 0); SB();
      F0[0] = *(const bfrag*)(sa_); F0[1] = *(const bfrag*)(sa_ + 2048); SB();
      MM(F1, 0, 1); SB();
      glds16(bs_, st_ + 8192); SB();
      MM(F1, 1, 1); SB();
      F0[2] = *(const bfrag*)(sb_); F0[3] = *(const bfrag*)(sb_ + 2048); SB();
      MM(F1, 0, 2); SB();
      glds16(bs_ + 4096, st_ + 8192 + 8192); SB();
      MM(F1, 1, 2); SB();
      F0[4] = *(const bfrag*)(sb_ + 4096); F0[5] = *(const bfrag*)(sb_ + 6144); SB();
      MM(F1, 0, 3); MM(F1, 1, 3); SB();
    }
    kr3p = kr3; nt3p = nt3;
    ++kr3; if (kr3 == nk) kr3 = 0;
    ++cnt3; if (cnt3 == nk) { cnt3 = 0; ++nt3; }
    if (ks == nk - 1) {
      epi(acc, nt, wm, wn, lane);
#pragma unroll
      for (int i = 0; i < 2; ++i)
#pragma unroll
        for (int j = 0; j < 4; ++j) acc[i][j] = zero16();
      ++nt;
      asm volatile("s_waitcnt vmcnt(0)" ::: "memory");
      RDFRAGS(F0, stage_n, offk0);
    }
    ++ks; if (ks == nk) ks = 0;
    stage_p = stage;
    stage = stage_n;
    ++stage_n; if (stage_n == 3) stage_n = 0;
  }
  asm volatile("s_waitcnt vmcnt(0)" ::: "memory");
  __syncthreads();
}

struct EpiSwiglu {
  bf16_t* act;
  __device__ __forceinline__ void operator()(f32x16 (&acc)[2][4], int nt, int wm, int wn, int lane_in) const {
    int lane = lane_in;
    asm volatile("" : "+v"(lane));
    const int l31 = lane & 31;
#pragma unroll
    for (int mi = 0; mi < 2; ++mi)
#pragma unroll
      for (int n2 = 0; n2 < 2; ++n2)
#pragma unroll
        for (int r = 0; r < 16; ++r) {
          const int row = wm * 64 + mi * 32 + ROWMAP(r, lane);
          const int col = (nt * 4 + wn) * 64 + n2 * 32 + l31;
          const float g = acc[mi][n2][r], u = acc[mi][n2 + 2][r];
          act[ablk(row, col)] = f2bf(silu_f(g) * u);
        }
  }
};
struct EpiResLN {
  float* Hp;
  const float2* st;
  const float* gp;
  const float* bp;
  float alpha, c;
  const float* bias;
  __device__ __forceinline__ void operator()(f32x16 (&acc)[2][4], int nt, int wm, int wn, int lane_in) const {
    int lane = lane_in;
    asm volatile("" : "+v"(lane));
    const int l31 = lane & 31;
    const int rb = wm * 64 + 4 * (lane >> 5);
    float* base = Hp + (size_t)rb * 1024 + nt * 512 + wn * 128 + l31;
#pragma unroll
    for (int ni = 0; ni < 4; ++ni) {
      const int col = nt * 512 + wn * 128 + ni * 32 + l31;
      float ag = alpha, ab = bias ? c * bias[col] : 0.f;
      if (st) { ag = alpha * gp[col]; ab += alpha * bp[col]; }
#pragma unroll
      for (int mi = 0; mi < 2; ++mi) {
        float hv[16];
#pragma unroll
        for (int r = 0; r < 16; ++r) hv[r] = base[(size_t)(mi * 32 + (r & 3) + 8 * (r >> 2)) * 1024 + ni * 32];
#pragma unroll
        for (int r = 0; r < 16; ++r) {
          float mu = 0.f, rs = 1.f;
          if (st) { const float2 ms = st[rb + mi * 32 + (r & 3) + 8 * (r >> 2)]; mu = ms.x; rs = ms.y; }
          base[(size_t)(mi * 32 + (r & 3) + 8 * (r >> 2)) * 1024 + ni * 32] = (hv[r] - mu) * rs * ag + ab + c * acc[mi][ni][r];
        }
        __builtin_amdgcn_sched_barrier(0);
      }
    }
  }
};
struct EpiGelu {
  bf16_t* Z;
  __device__ __forceinline__ void operator()(f32x16 (&acc)[2][4], int nt, int wm, int wn, int lane_in) const {
    int lane = lane_in;
    asm volatile("" : "+v"(lane));
    const int l31 = lane & 31;
#pragma unroll
    for (int ni = 0; ni < 4; ++ni) {
      const int col = nt * 512 + wn * 128 + ni * 32 + l31;
#pragma unroll
      for (int mi = 0; mi < 2; ++mi)
#pragma unroll
        for (int r = 0; r < 16; ++r) {
          const int row = wm * 64 + mi * 32 + ROWMAP(r, lane);
          const float x = acc[mi][ni][r];
          Z[(size_t)row * 2048 + col] = f2bf(0.5f * x * (1.f + erff(x * 0.70710678118654752f)));
        }
    }
  }
};
struct EpiHgrn {
  bf16_t* Qp;
  bf16_t* Vp;
  float* LFp;
  bf16_t* SGp;
  const float* lb;
  __device__ __forceinline__ void operator()(f32x16 (&acc)[2][4], int nt, int wm, int wn, int lane_in) const {
    int lane = lane_in;
    asm volatile("" : "+v"(lane));
    const int l31 = lane & 31;
    const int sec = nt >> 1;
    const int cb = (nt & 1) * 512 + wn * 128 + l31;
    const int rb = wm * 64 + 4 * (lane >> 5);
    if (sec == 0 || sec == 3) {
      bf16_t* dst = (sec == 0) ? Qp : SGp;
#pragma unroll
      for (int ni = 0; ni < 4; ++ni)
#pragma unroll
        for (int mi = 0; mi < 2; ++mi)
#pragma unroll
          for (int r = 0; r < 16; ++r) {
            const int row = rb + mi * 32 + (r & 3) + 8 * (r >> 2);
            dst[(size_t)row * 1024 + cb + ni * 32] = f2bf(silu_f(acc[mi][ni][r]));
          }
    } else if (sec == 1) {
#pragma unroll
      for (int ni = 0; ni < 4; ++ni) {
        const float lbv = lb[cb + ni * 32];
#pragma unroll
        for (int mi = 0; mi < 2; ++mi)
#pragma unroll
          for (int r = 0; r < 16; ++r) {
            const int row = rb + mi * 32 + (r & 3) + 8 * (r >> 2);
            const float f = lbv + (1.f - lbv) * __frcp_rn(1.f + __expf(-acc[mi][ni][r]));
            LFp[(size_t)row * 1024 + cb + ni * 32] = __logf(f);
          }
      }
    } else {
#pragma unroll
      for (int ni = 0; ni < 4; ++ni)
#pragma unroll
        for (int mi = 0; mi < 2; ++mi)
#pragma unroll
          for (int r = 0; r < 16; ++r) {
            const int row = rb + mi * 32 + (r & 3) + 8 * (r >> 2);
            Vp[(size_t)row * 1024 + cb + ni * 32] = f2bf(acc[mi][ni][r]);
          }
    }
  }
};
struct EpiQkv {
  bf16_t* Qp;
  bf16_t* Kp;
  bf16_t* Vp;
  const float* bias;
  __device__ __forceinline__ void operator()(f32x16 (&acc)[2][4], int nt, int wm, int wn, int lane_in) const {
    int lane = lane_in;
    asm volatile("" : "+v"(lane));
    const int l31 = lane & 31;
#pragma unroll
    for (int ni = 0; ni < 4; ++ni) {
      const int col = nt * 512 + wn * 128 + ni * 32 + l31;
      if (col < 1280) {
        const float bv = bias[col];
#pragma unroll
        for (int mi = 0; mi < 2; ++mi)
#pragma unroll
          for (int r = 0; r < 16; ++r) {
            const int row = wm * 64 + mi * 32 + ROWMAP(r, lane);
            const float x = acc[mi][ni][r] + bv;
            if (col < 1024) Qp[(size_t)row * 1024 + col] = f2bf(x * 0.125f);
            else if (col < 1152) Kp[(size_t)row * 128 + (col - 1024)] = f2bf(x);
            else Vp[(size_t)row * 128 + (col - 1152)] = f2bf(x);
          }
      }
    }
  }
};

__device__ __forceinline__ void ln_panel(const float* Hp, float* outp, bf16_t* HBp, const float* g, const float* b,
                                         float2* stg, float2* stl) {
  const int tid = opaque_tid(), lane = tid & 63;
  const int w = __builtin_amdgcn_readfirstlane(tid >> 6);
  float4 gv[4], bv[4];
#pragma unroll
  for (int j = 0; j < 4; ++j) {
    gv[j] = *(const float4*)(g + j * 256 + lane * 4);
    bv[j] = *(const float4*)(b + j * 256 + lane * 4);
  }
  for (int r0 = w; r0 < 128; r0 += 32) {
    float4 x[4][4];
#pragma unroll
    for (int u = 0; u < 4; ++u)
#pragma unroll
      for (int j = 0; j < 4; ++j) x[u][j] = *(const float4*)(Hp + (size_t)(r0 + 8 * u) * 1024 + j * 256 + lane * 4);
#pragma unroll
    for (int u = 0; u < 4; ++u) {
      const int r = r0 + 8 * u;
      float s = 0.f;
#pragma unroll
      for (int j = 0; j < 4; ++j) s += x[u][j].x + x[u][j].y + x[u][j].z + x[u][j].w;
      s = wave_sum(s);
      const float mean = s * (1.f / 1024.f);
      float v = 0.f;
#pragma unroll
      for (int j = 0; j < 4; ++j) {
        x[u][j].x -= mean; x[u][j].y -= mean; x[u][j].z -= mean; x[u][j].w -= mean;
        v += x[u][j].x * x[u][j].x + x[u][j].y * x[u][j].y + x[u][j].z * x[u][j].z + x[u][j].w * x[u][j].w;
      }
      v = wave_sum(v);
      const float rstd = 1.0f / sqrtf(v * (1.f / 1024.f) + 1e-5f);
      if (lane == 0) { stg[r] = make_float2(mean, rstd); stl[r] = make_float2(mean, rstd); }
#pragma unroll
      for (int j = 0; j < 4; ++j) {
        float4 y;
        y.x = x[u][j].x * rstd * gv[j].x + bv[j].x;
        y.y = x[u][j].y * rstd * gv[j].y + bv[j].y;
        y.z = x[u][j].z * rstd * gv[j].z + bv[j].z;
        y.w = x[u][j].w * rstd * gv[j].w + bv[j].w;
        if (outp) *(float4*)(outp + (size_t)r * 1024 + j * 256 + lane * 4) = y;
        uint2 pk;
        pk.x = pack2(y.x, y.y);
        pk.y = pack2(y.z, y.w);
        *(uint2*)(HBp + ablk(r, j * 256 + lane * 4)) = pk;
      }
    }
  }
  __syncthreads();
}

__device__ __forceinline__ void ffn_panel(const Ctx& C, int p, int layer, int j, bool final_out, int sub, bf16_t* smem) {
  const int wi = layer * 2 + j;
  bf16_t* HBp = C.HB() + (size_t)p * 128 * 1024;
  bf16_t* ACTp = C.ACT() + (size_t)p * 128 * 2816;
  float* Hp = C.H() + (size_t)p * 128 * 1024;
  EpiSwiglu e1{ACTp};
  gemm_panel(HBp, 1024, C.WGU() + (size_t)wi * 5632 * 1024, 1024, 11, e1, smem);
  float2* stl = (float2*)((char*)smem + LDS_STATS_OFF);
  float2* stg = C.STATS() + (size_t)p * 128;
  EpiResLN e2{Hp, sub > 0 ? stl : nullptr, C.in[3] + (sub > 0 ? sub - 1 : 0) * 1024, C.in[4] + (sub > 0 ? sub - 1 : 0) * 1024, ALPHA, 0.5f, nullptr};
  gemm_panel(ACTp, 2816, C.WD() + (size_t)wi * 1024 * 2816, 2816, 2, e2, smem);
  const int li = (layer * 3 + (j == 0 ? 0 : 2)) * 1024;
  float* outp = final_out ? (C.out + (size_t)p * 128 * 1024) : nullptr;
  ln_panel(Hp, outp, HBp, C.in[3] + li, C.in[4] + li, stg, stl);
}

__device__ __forceinline__ void gmlp_panel(const Ctx& C, int p, int layer, int slot, int sub, bf16_t* smem) {
  const int tid = opaque_tid(), lane = tid & 63;
  const int w = __builtin_amdgcn_readfirstlane(tid >> 6);
  const int l31 = lane & 31, h8 = (lane >> 5) * 8;
  bf16_t* HBp = C.HB() + (size_t)p * 128 * 1024;
  bf16_t* Zp = C.ACT() + (size_t)p * 128 * 2816;
  float* Hp = C.H() + (size_t)p * 128 * 1024;
  {
    EpiGelu e{Zp};
    gemm_panel(HBp, 1024, C.WGI() + (size_t)slot * 2048 * 1024, 1024, 4, e, smem);
  }
  bf16_t* As = smem;
  bf16_t* Bs = smem + 128 * 136;
  float* st = (float*)(smem + 2 * 128 * 136);
  for (int r = w; r < 128; r += 8) {
    const uint4 q0 = *(const uint4*)(Zp + (size_t)r * 2048 + 1024 + lane * 16);
    const uint4 q1 = *(const uint4*)(Zp + (size_t)r * 2048 + 1024 + lane * 16 + 8);
    const uint32_t u[8] = {q0.x, q0.y, q0.z, q0.w, q1.x, q1.y, q1.z, q1.w};
    float x[16];
    float s = 0.f;
#pragma unroll
    for (int e = 0; e < 8; ++e) {
      x[2 * e] = __uint_as_float(u[e] << 16);
      x[2 * e + 1] = __uint_as_float(u[e] & 0xffff0000u);
      s += x[2 * e] + x[2 * e + 1];
    }
    s = wave_sum(s);
    const float mean = s * (1.f / 1024.f);
    float v = 0.f;
#pragma unroll
    for (int e = 0; e < 16; ++e) { const float d = x[e] - mean; v += d * d; }
    v = wave_sum(v);
    if (lane == 0) { st[r * 2] = mean; st[r * 2 + 1] = 1.0f / sqrtf(v * (1.f / 1024.f) + 1e-5f); }
  }
  __syncthreads();
  const float* lng = C.in[6] + slot * 1024;
  const float* lnb = C.in[7] + slot * 1024;
  const float* bsp = C.in[9] + slot * 1024;
  const bf16_t* Wsp = C.WSP() + (size_t)slot * 8 * 16384;
  const int nd = w & 3, mt0 = (w >> 2) * 2;
  for (int g = 0; g < 8; ++g) {
#pragma unroll
    for (int i = 0; i < 4; ++i) {
      const int c = tid + 512 * i;
      *(uint4*)(As + (c >> 4) * 136 + (c & 15) * 8) = *(const uint4*)(Wsp + (size_t)g * 16384 + c * 8);
    }
    {
      const int s = tid >> 2, dq = tid & 3;
      const float mean = st[s * 2], rstd = st[s * 2 + 1];
      const bf16_t* src = Zp + (size_t)s * 2048 + 1024 + g * 128 + dq * 32;
#pragma unroll
      for (int q = 0; q < 4; ++q) {
        const uint4 v4 = *(const uint4*)(src + q * 8);
        const uint32_t u[4] = {v4.x, v4.y, v4.z, v4.w};
#pragma unroll
        for (int e = 0; e < 4; ++e) {
          const int d0 = dq * 32 + q * 8 + e * 2;
          const int ch = g * 128 + d0;
          const float x0 = __uint_as_float(u[e] << 16), x1 = __uint_as_float(u[e] & 0xffff0000u);
          Bs[d0 * 136 + s] = f2bf((x0 - mean) * rstd * lng[ch] + lnb[ch]);
          Bs[(d0 + 1) * 136 + s] = f2bf((x1 - mean) * rstd * lng[ch + 1] + lnb[ch + 1]);
        }
      }
    }
    __syncthreads();
    f32x16 acc[2];
    acc[0] = zero16(); acc[1] = zero16();
#pragma unroll
    for (int k16 = 0; k16 < 8; ++k16) {
      const bfrag b = *(const bfrag*)(Bs + (nd * 32 + l31) * 136 + k16 * 16 + h8);
#pragma unroll
      for (int mi = 0; mi < 2; ++mi) {
        const bfrag a = *(const bfrag*)(As + ((mt0 + mi) * 32 + l31) * 136 + k16 * 16 + h8);
        acc[mi] = MFMA(a, b, acc[mi]);
      }
    }
#pragma unroll
    for (int mi = 0; mi < 2; ++mi)
#pragma unroll
      for (int r = 0; r < 16; ++r) {
        const int t = (mt0 + mi) * 32 + ROWMAP(r, lane);
        const int ch = g * 128 + nd * 32 + l31;
        const float mixed = acc[mi][r] + bsp[g * 128 + t];
        const float u = bf2f(Zp[(size_t)t * 2048 + ch]);
        HBp[ablk(t, ch)] = f2bf(u * mixed);
      }
    __syncthreads();
  }
  {
    EpiResLN e2{Hp, (float2*)((char*)smem + LDS_STATS_OFF), C.in[3] + (sub - 1) * 1024, C.in[4] + (sub - 1) * 1024, ALPHA, 1.0f, nullptr};
    gemm_panel(HBp, 1024, C.WGO() + (size_t)slot * 1024 * 1024, 1024, 2, e2, smem);
  }
  const int li = (layer * 3 + 1) * 1024;
  ln_panel(Hp, nullptr, HBp, C.in[3] + li, C.in[4] + li, C.STATS() + (size_t)p * 128, (float2*)((char*)smem + LDS_STATS_OFF));
}

template <bool OUT>
__device__ __forceinline__ void hgrn_rec(const Ctx& C, int p, bf16_t* smem) {
  const int tid = opaque_tid(), lane = tid & 63;
  const int w = __builtin_amdgcn_readfirstlane(tid >> 6);
  const int l31 = lane & 31, h8 = (lane >> 5) * 8;
  bf16_t* ST = smem;
  bf16_t* Qh = smem + 17408;
  bf16_t* Kh = smem + 21760;
  bf16_t* KhT = smem + 26112;
  bf16_t* vT = smem + 31232;
  bf16_t* Ps = smem + 36352;
  float* seg = (float*)(smem + 37632);
  float* dec = seg + 512;
  float* oF = dec + 128;
  const size_t row0 = (size_t)p * 128;
  const bf16_t* Qp = C.ACT() + (size_t)p * 128 * 2816;
  const bf16_t* Vp = Qp + 128 * 1024;
  const float* LFp = C.out + row0 * 1024;
  const bf16_t* SGp = C.SG() + row0 * 1024;
  bf16_t* HBp = C.HB() + row0 * 1024;
  const float* ng = C.in[13];
  const int jt = w >> 1, kt0 = (w & 1) * 2;
  const int kq = tid & 127, tq = tid >> 7;
  for (int h = 0; h < 8; ++h) {
    f32x16 accS[2];
    bf16_t* SBh = C.DS() + ((size_t)(p * 8 + h)) * 16384;
    if (OUT) {
      __syncthreads();
#pragma unroll
      for (int i = 0; i < 4; ++i) {
        const int c = tid + 512 * i;
        *(uint4*)(ST + (c >> 4) * 136 + (c & 15) * 8) = *(const uint4*)(SBh + c * 8);
      }
      __syncthreads();
#pragma unroll
      for (int c2 = 0; c2 < 2; ++c2)
#pragma unroll
        for (int r = 0; r < 16; ++r)
          accS[c2][r] = bf2f(ST[(jt * 32 + ROWMAP(r, lane)) * 136 + (kt0 + c2) * 32 + l31]);
    } else {
      accS[0] = zero16(); accS[1] = zero16();
    }
    float dsum = 0.f;
    for (int i = 0; i < 4; ++i) {
      float l[8], cs[8];
      const size_t gbase = (size_t)(i * 32 + tq * 8) * 1024 + h * 128 + kq;
#pragma unroll
      for (int e = 0; e < 8; ++e) l[e] = LFp[gbase + (size_t)e * 1024];
      cs[0] = l[0];
#pragma unroll
      for (int e = 1; e < 8; ++e) cs[e] = cs[e - 1] + l[e];
      seg[tq * 128 + kq] = cs[7];
#pragma unroll
      for (int e = 0; e < 8; ++e) vT[kq * 40 + tq * 8 + e] = Vp[gbase + (size_t)e * 1024];
      __syncthreads();
      float off = 0.f, tot = 0.f;
#pragma unroll
      for (int q = 0; q < 4; ++q) {
        const float s = seg[q * 128 + kq];
        if (q < tq) off += s;
        tot += s;
      }
#pragma unroll
      for (int e = 0; e < 8; ++e) {
        const float gc = cs[e] + off;
        const float f = __expf(l[e]);
        const float kh = (1.f - f) * __expf(-gc);
        const bf16_t khb = f2bf(kh);
        const int t = tq * 8 + e;
        KhT[kq * 40 + t] = khb;
        if (OUT) {
          Kh[t * 136 + kq] = khb;
          const float qv = bf2f(Qp[gbase + (size_t)e * 1024]);
          Qh[t * 136 + kq] = f2bf(qv * __expf(gc));
        }
      }
      if (tq == 0) { dec[kq] = __expf(tot); dsum += tot; }
      __syncthreads();
      f32x16 accO = zero16();
      if (OUT) {
        if (w == 0) {
          f32x16 accP = zero16();
#pragma unroll
          for (int k16 = 0; k16 < 8; ++k16) {
            const bfrag a = *(const bfrag*)(Qh + l31 * 136 + k16 * 16 + h8);
            const bfrag b = *(const bfrag*)(Kh + l31 * 136 + k16 * 16 + h8);
            accP = MFMA(a, b, accP);
          }
#pragma unroll
          for (int r = 0; r < 16; ++r) {
            const int t = ROWMAP(r, lane);
            Ps[t * 40 + l31] = (l31 <= t) ? f2bf(accP[r]) : (bf16_t)0;
          }
        } else if (w <= 4) {
          const int nt = w - 1;
#pragma unroll
          for (int k16 = 0; k16 < 8; ++k16) {
            const bfrag a = *(const bfrag*)(Qh + l31 * 136 + k16 * 16 + h8);
            const bfrag b = *(const bfrag*)(ST + (nt * 32 + l31) * 136 + k16 * 16 + h8);
            accO = MFMA(a, b, accO);
          }
        }
        __syncthreads();
        if (w >= 1 && w <= 4) {
          const int nt = w - 1;
#pragma unroll
          for (int k16 = 0; k16 < 2; ++k16) {
            const bfrag a = *(const bfrag*)(Ps + l31 * 40 + k16 * 16 + h8);
            const bfrag b = *(const bfrag*)(vT + (nt * 32 + l31) * 40 + k16 * 16 + h8);
            accO = MFMA(a, b, accO);
          }
#pragma unroll
          for (int r = 0; r < 16; ++r) oF[ROWMAP(r, lane) * 132 + nt * 32 + l31] = accO[r];
        }
      }
#pragma unroll
      for (int c2 = 0; c2 < 2; ++c2) {
#pragma unroll
        for (int k16 = 0; k16 < 2; ++k16) {
          const bfrag a = *(const bfrag*)(vT + (jt * 32 + l31) * 40 + k16 * 16 + h8);
          const bfrag b = *(const bfrag*)(KhT + ((kt0 + c2) * 32 + l31) * 40 + k16 * 16 + h8);
          accS[c2] = MFMA(a, b, accS[c2]);
        }
        const float dk = dec[(kt0 + c2) * 32 + l31];
#pragma unroll
        for (int r = 0; r < 16; ++r) accS[c2][r] *= dk;
        if (OUT) {
#pragma unroll
          for (int r = 0; r < 16; ++r)
            ST[(jt * 32 + ROWMAP(r, lane)) * 136 + (kt0 + c2) * 32 + l31] = f2bf(accS[c2][r]);
        }
      }
      __syncthreads();
      if (OUT) {
        const int t = tid >> 4, part = tid & 15;
        float x[8];
        float ss = 0.f;
#pragma unroll
        for (int e = 0; e < 8; ++e) { x[e] = oF[t * 132 + part * 8 + e]; ss += x[e] * x[e]; }
        ss += __shfl_xor(ss, 1, 64); ss += __shfl_xor(ss, 2, 64); ss += __shfl_xor(ss, 4, 64); ss += __shfl_xor(ss, 8, 64);
        const float rr = 1.0f / sqrtf(ss * (1.f / 128.f) + 1e-6f);
        const size_t gro = (size_t)(i * 32 + t) * 1024 + h * 128 + part * 8;
        const uint4 sg4 = *(const uint4*)(SGp + gro);
        const uint32_t su[4] = {sg4.x, sg4.y, sg4.z, sg4.w};
        uint32_t ov[4];
#pragma unroll
        for (int e = 0; e < 4; ++e) {
          const float g0 = ng[part * 8 + 2 * e], g1 = ng[part * 8 + 2 * e + 1];
          const float s0 = __uint_as_float(su[e] << 16), s1 = __uint_as_float(su[e] & 0xffff0000u);
          ov[e] = pack2(x[2 * e] * rr * g0 * s0, x[2 * e + 1] * rr * g1 * s1);
        }
        uint4 o4; o4.x = ov[0]; o4.y = ov[1]; o4.z = ov[2]; o4.w = ov[3];
        *(uint4*)(HBp + ablk(i * 32 + t, h * 128 + part * 8)) = o4;
      }
    }
    if (!OUT) {
#pragma unroll
      for (int c2 = 0; c2 < 2; ++c2)
#pragma unroll
        for (int r = 0; r < 16; ++r)
          SBh[(jt * 32 + ROWMAP(r, lane)) * 128 + (kt0 + c2) * 32 + l31] = f2bf(accS[c2][r]);
      if (tq == 0) C.DEC()[(size_t)(p * 8 + h) * 128 + kq] = __expf(dsum);
    }
  }
  __syncthreads();
}

__device__ __forceinline__ void hgrn_scan(const Ctx& C) {
  for (int gid = blockIdx.x * 512 + threadIdx.x; gid < 131072; gid += gridDim.x * 512) {
    const int kp = gid & 63, j = (gid >> 6) & 127, h = (gid >> 13) & 7, b = gid >> 16;
    float s0 = 0.f, s1 = 0.f;
    for (int c0 = 0; c0 < 128; c0 += 8) {
      uint32_t d[8];
      float2 dc[8];
#pragma unroll
      for (int e = 0; e < 8; ++e) {
        const size_t ph = (size_t)((b * 128 + c0 + e) * 8 + h);
        d[e] = *(const uint32_t*)(C.DS() + ph * 16384 + j * 128 + kp * 2);
        dc[e] = *(const float2*)(C.DEC() + ph * 128 + kp * 2);
      }
#pragma unroll
      for (int e = 0; e < 8; ++e) {
        const size_t ph = (size_t)((b * 128 + c0 + e) * 8 + h);
        *(uint32_t*)(C.DS() + ph * 16384 + j * 128 + kp * 2) = pack2(s0, s1);
        s0 = dc[e].x * s0 + __uint_as_float(d[e] << 16);
        s1 = dc[e].y * s1 + __uint_as_float(d[e] & 0xffff0000u);
      }
    }
  }
}

__device__ __forceinline__ void attn_panel(const Ctx& C, int p, bf16_t* smem) {
  const int tid = opaque_tid(), lane = tid & 63;
  const int w = __builtin_amdgcn_readfirstlane(tid >> 6);
  const int l31 = lane & 31, h8 = (lane >> 5) * 8;
  bf16_t* K2 = smem;
  bf16_t* VT = smem + 18432;
  bf16_t* Pw = smem + 35328 + w * 1280;
  const int blk = p & 127;
  const size_t row0 = (size_t)p * 128;
  const bf16_t* Qp = C.ACT() + (size_t)p * 128 * 2816;
  bf16_t* HBp = C.HB() + row0 * 1024;
  const int qt = w & 3;
  for (int hk = 0; hk < 2; ++hk) {
    __syncthreads();
#pragma unroll
    for (int i = 0; i < 4; ++i) {
      const int c = tid + 512 * i;
      const int r = c >> 3, ch = c & 7;
      uint4 kv = make_uint4(0, 0, 0, 0), vv = make_uint4(0, 0, 0, 0);
      if (blk > 0 || r >= 128) {
        const size_t tok = row0 + r - 128;
        kv = *(const uint4*)(C.KB() + tok * 128 + hk * 64 + ch * 8);
        vv = *(const uint4*)(C.VB() + tok * 128 + hk * 64 + ch * 8);
      }
      *(uint4*)(K2 + r * 72 + ch * 8) = kv;
      const uint32_t vu[4] = {vv.x, vv.y, vv.z, vv.w};
#pragma unroll
      for (int e = 0; e < 4; ++e) {
        VT[(ch * 8 + 2 * e) * 264 + r] = (bf16_t)(vu[e] & 0xffffu);
        VT[(ch * 8 + 2 * e + 1) * 264 + r] = (bf16_t)(vu[e] >> 16);
      }
    }
    __syncthreads();
    for (int u = 0; u < 4; ++u) {
      const int hq = hk * 8 + (w >> 2) * 4 + u;
      const float sink = C.in[17][hq];
      bfrag aq[4];
#pragma unroll
      for (int k16 = 0; k16 < 4; ++k16)
        aq[k16] = *(const bfrag*)(Qp + (size_t)(qt * 32 + l31) * 1024 + hq * 64 + k16 * 16 + h8);
      f32x16 s[5];
#pragma unroll
      for (int c = 0; c < 5; ++c) {
        s[c] = zero16();
#pragma unroll
        for (int k16 = 0; k16 < 4; ++k16) {
          const bfrag b = *(const bfrag*)(K2 + ((qt + c) * 32 + l31) * 72 + k16 * 16 + h8);
          s[c] = MFMA(aq[k16], b, s[c]);
        }
      }
      float linv[16];
#pragma unroll
      for (int r = 0; r < 16; ++r) {
        const int qi = qt * 32 + ROWMAP(r, lane);
        float m = -1e30f;
#pragma unroll
        for (int c = 0; c < 5; ++c) {
          const int kp = (qt + c) * 32 + l31;
          const bool valid = (kp > qi) && (kp <= qi + 128) && (blk > 0 || kp >= 128);
          const float v = valid ? s[c][r] : -1e30f;
          s[c][r] = v;
          m = fmaxf(m, v);
        }
        m = fmaxf(m, __shfl_xor(m, 16, 64)); m = fmaxf(m, __shfl_xor(m, 8, 64)); m = fmaxf(m, __shfl_xor(m, 4, 64));
        m = fmaxf(m, __shfl_xor(m, 2, 64)); m = fmaxf(m, __shfl_xor(m, 1, 64));
        m = fmaxf(m, sink);
        float sum = 0.f;
#pragma unroll
        for (int c = 0; c < 5; ++c) {
          const float pv = (s[c][r] > -1e29f) ? __expf(s[c][r] - m) : 0.f;
          s[c][r] = pv;
          sum += pv;
        }
        sum += __shfl_xor(sum, 16, 64); sum += __shfl_xor(sum, 8, 64); sum += __shfl_xor(sum, 4, 64);
        sum += __shfl_xor(sum, 2, 64); sum += __shfl_xor(sum, 1, 64);
        sum += __expf(sink - m);
        linv[r] = 1.f / sum;
      }
      f32x16 o[2];
      o[0] = zero16(); o[1] = zero16();
#pragma unroll
      for (int c = 0; c < 5; ++c) {
#pragma unroll
        for (int r = 0; r < 16; ++r) Pw[ROWMAP(r, lane) * 40 + l31] = f2bf(s[c][r]);
        __syncthreads();
#pragma unroll
        for (int k16 = 0; k16 < 2; ++k16) {
          const bfrag a = *(const bfrag*)(Pw + l31 * 40 + k16 * 16 + h8);
#pragma unroll
          for (int dt = 0; dt < 2; ++dt) {
            const bfrag b = *(const bfrag*)(VT + (dt * 32 + l31) * 264 + (qt + c) * 32 + k16 * 16 + h8);
            o[dt] = MFMA(a, b, o[dt]);
          }
        }
        __syncthreads();
      }
#pragma unroll
      for (int dt = 0; dt < 2; ++dt)
#pragma unroll
        for (int r = 0; r < 16; ++r)
          HBp[ablk(qt * 32 + ROWMAP(r, lane), hq * 64 + dt * 32 + l31)] = f2bf(o[dt][r] * linv[r]);
    }
  }
  __syncthreads();
}

__device__ __forceinline__ void conv_weights(const float* __restrict__ src, bf16_t* __restrict__ dst, int nmat, int K,
                                             int Nsrc, int Ndst, int mode) {
  const int nk = K >> 5, nNt = Ndst >> 9;
  const int upm = nk * nNt;
  const int tid = threadIdx.x;
  for (int u = blockIdx.x; u < nmat * upm; u += gridDim.x) {
    const int m = u / upm, r = u - m * upm;
    const int nt = r / nk, ks = r - nt * nk;
    const int np = nt * 512 + tid;
    int sc;
    if (mode == 1) {
      const int b = np >> 7, rr = np & 127;
      sc = (rr < 64) ? (b * 64 + rr) : (2816 + b * 64 + rr - 64);
    } else {
      sc = (np < Nsrc) ? np : -1;
    }
    const float* s = src + (size_t)m * K * Nsrc + (size_t)(ks * 32) * Nsrc + (sc < 0 ? 0 : sc);
    uint32_t pk[16];
#pragma unroll
    for (int kk = 0; kk < 16; ++kk) {
      float v0 = s[(size_t)(2 * kk) * Nsrc], v1 = s[(size_t)(2 * kk + 1) * Nsrc];
      if (sc < 0) { v0 = 0.f; v1 = 0.f; }
      pk[kk] = pack2(v0, v1);
    }
    uint4* d = (uint4*)(dst + (size_t)m * K * Ndst + (size_t)(nt * nk + ks) * 16384 + tid * 32);
    d[0] = make_uint4(pk[0], pk[1], pk[2], pk[3]);
    d[1] = make_uint4(pk[4], pk[5], pk[6], pk[7]);
    d[2] = make_uint4(pk[8], pk[9], pk[10], pk[11]);
    d[3] = make_uint4(pk[12], pk[13], pk[14], pk[15]);
  }
}

__device__ __forceinline__ void phase0(const Ctx& C) {
  conv_weights(C.in[1], C.WGU(), 8, 1024, 5632, 5632, 1);
  conv_weights(C.in[2], C.WD(), 8, 2816, 1024, 1024, 0);
  conv_weights(C.in[5], C.WGI(), 2, 1024, 2048, 2048, 0);
  conv_weights(C.in[10], C.WGO(), 2, 1024, 1024, 1024, 0);
  conv_weights(C.in[11], C.WHI(), 1, 1024, 4096, 4096, 0);
  conv_weights(C.in[14], C.WHO(), 1, 1024, 1024, 1024, 0);
  conv_weights(C.in[15], C.WQKV(), 1, 1024, 1280, 1536, 0);
  conv_weights(C.in[18], C.WAO(), 1, 1024, 1024, 1024, 0);
  const size_t gtid = (size_t)blockIdx.x * 512 + threadIdx.x;
  const size_t gsz = (size_t)gridDim.x * 512;
  for (size_t i = gtid; i < (size_t)T_TOK * 1024 / 4; i += gsz) {
    const float4 v = ((const float4*)C.in[0])[i];
    ((float4*)C.H())[i] = v;
    uint2 pk;
    pk.x = pack2(v.x, v.y);
    pk.y = pack2(v.z, v.w);
    {
      const int row = (int)(i >> 8), col = (int)(i & 255) * 4;
      *(uint2*)(C.HB() + (size_t)(row >> 7) * 131072 + ablk(row & 127, col)) = pk;
    }
  }
  for (size_t i = gtid; i < (size_t)2 * 8 * 128 * 128; i += gsz) {
    const int s = (int)(i & 127), t = (int)((i >> 7) & 127);
    C.WSP()[i] = (s <= t) ? f2bf(C.in[8][i]) : (bf16_t)0;
  }
  for (size_t i = gtid; i < 1024; i += gsz) {
    const float* lp = C.in[12];
    const float a0 = lp[i], a1 = lp[1024 + i], a2 = lp[2048 + i], a3 = lp[3072 + i];
    const float m = fmaxf(fmaxf(a0, a1), fmaxf(a2, a3));
    const float e0 = expf(a0 - m), e1 = expf(a1 - m), e2 = expf(a2 - m), e3 = expf(a3 - m);
    C.LB()[i] = e1 / (e0 + e1 + e2 + e3);
  }
}

enum { OP_FFN = 0, OP_GMLP = 1, OP_HIN = 2, OP_HOUT = 3, OP_QKV = 4, OP_ATTN = 5 };

__device__ __forceinline__ void run_ops(const Ctx& C0, int op_lo, int op_hi, bf16_t* smem) {
  for (int p0 = blockIdx.x; p0 < NPANEL; p0 += gridDim.x) {
    for (int op = op_lo; op < op_hi; ++op) {
      const Ctx& C = C0;
      const int p = p0;
      bf16_t* HBp = C.HB() + (size_t)p * 128 * 1024;
      float* Hp = C.H() + (size_t)p * 128 * 1024;
      bf16_t* ACTp = C.ACT() + (size_t)p * 128 * 2816;
      int kind = OP_FFN, layer = 0, j = 0, sub = 0;
      switch (op) {
        case 0: kind = OP_FFN; layer = 0; j = 0; sub = 0; break;
        case 1: kind = OP_GMLP; layer = 0; j = 0; sub = 1; break;
        case 2: kind = OP_FFN; layer = 0; j = 1; sub = 2; break;
        case 3: kind = OP_FFN; layer = 1; j = 0; sub = 3; break;
        case 4: kind = OP_HIN; layer = 1; break;
        case 5: kind = OP_HOUT; layer = 1; sub = 4; break;
        case 6: kind = OP_FFN; layer = 1; j = 1; sub = 5; break;
        case 7: kind = OP_FFN; layer = 2; j = 0; sub = 6; break;
        case 8: kind = OP_QKV; layer = 2; break;
        case 9: kind = OP_ATTN; layer = 2; sub = 7; break;
        case 10: kind = OP_FFN; layer = 2; j = 1; sub = 8; break;
        case 11: kind = OP_FFN; layer = 3; j = 0; sub = 9; break;
        case 12: kind = OP_GMLP; layer = 3; j = 1; sub = 10; break;
        default: kind = OP_FFN; layer = 3; j = 1; sub = 11; break;
      }
      float2* stl = (float2*)((char*)smem + LDS_STATS_OFF);
      float2* stg = C.STATS() + (size_t)p * 128;
      if (threadIdx.x < 128) stl[threadIdx.x] = stg[threadIdx.x];
      if (kind == OP_FFN) {
        ffn_panel(C, p, layer, j, op == 13, sub, smem);
      } else if (kind == OP_GMLP) {
        gmlp_panel(C, p, layer, j, sub, smem);
      } else if (kind == OP_HIN) {
        EpiHgrn e{ACTp, ACTp + 128 * 1024, C.out + (size_t)p * 128 * 1024, C.SG() + (size_t)p * 128 * 1024, C.LB()};
        gemm_panel(HBp, 1024, C.WHI(), 1024, 8, e, smem);
        hgrn_rec<false>(C, p, smem);
      } else if (kind == OP_HOUT) {
        hgrn_rec<true>(C, p, smem);
        EpiResLN e2{Hp, stl, C.in[3] + (sub - 1) * 1024, C.in[4] + (sub - 1) * 1024, ALPHA, 1.0f, nullptr};
        gemm_panel(HBp, 1024, C.WHO(), 1024, 2, e2, smem);
        const int li = (1 * 3 + 1) * 1024;
        ln_panel(Hp, nullptr, HBp, C.in[3] + li, C.in[4] + li, stg, stl);
      } else if (kind == OP_QKV) {
        EpiQkv e{ACTp, C.KB() + (size_t)p * 128 * 128, C.VB() + (size_t)p * 128 * 128, C.in[16]};
        gemm_panel(HBp, 1024, C.WQKV(), 1024, 3, e, smem);
      } else {
        attn_panel(C, p, smem);
        EpiResLN e2{Hp, stl, C.in[3] + (sub - 1) * 1024, C.in[4] + (sub - 1) * 1024, ALPHA, 1.0f, C.in[19]};
        gemm_panel(HBp, 1024, C.WAO(), 1024, 2, e2, smem);
        const int li = (2 * 3 + 1) * 1024;
        ln_panel(Hp, nullptr, HBp, C.in[3] + li, C.in[4] + li, stg, stl);
      }
    }
  }
}

#if COOP
__device__ __forceinline__ void grid_barrier(unsigned* bar, unsigned target) {
  __syncthreads();
  if (threadIdx.x == 0) {
    __threadfence();
    __hip_atomic_fetch_add(bar, 1u, __ATOMIC_RELEASE, __HIP_MEMORY_SCOPE_AGENT);
    while (__hip_atomic_load(bar, __ATOMIC_ACQUIRE, __HIP_MEMORY_SCOPE_AGENT) < target) __builtin_amdgcn_s_sleep(8);
    __threadfence();
  }
  __syncthreads();
}

__global__ void __launch_bounds__(512) mega(Params P) {
  extern __shared__ __attribute__((aligned(16))) unsigned char lds_raw[];
  bf16_t* smem = (bf16_t*)lds_raw;
  Ctx C;
  C.in = P.in;
  C.out = P.out;
  C.ws = P.ws;
  const int lo = P.ph_lo, hi = P.ph_hi;
#if COOP
  if (lo < 0) cg::this_grid().sync();
  unsigned* bar = (unsigned*)(P.ws + OFF_BAR);
#define GSYNC(k) do { if (lo <= (k) && (k) + 1 < hi) grid_barrier(bar, (unsigned)((k) + 1) * gridDim.x); } while (0)
#else
#define GSYNC(k) do { } while (0)
#endif
  if (lo <= 0 && 0 < hi) phase0(C);
  GSYNC(0);
  if (lo <= 1 && 1 < hi) run_ops(C, 0, 5, smem);
  GSYNC(1);
  if (lo <= 2 && 2 < hi) hgrn_scan(C);
  GSYNC(2);
  if (lo <= 3 && 3 < hi) run_ops(C, 5, 9, smem);
  GSYNC(3);
  if (lo <= 4 && 4 < hi) run_ops(C, 9, 14, smem);
}

#endif

extern "C" void kernel_launch(void* const* d_in, const int* in_sizes, int n_in, void* d_out, int out_size, void* d_ws,
                              size_t ws_size, hipStream_t stream) {
  static int grid_blocks = 0;
  if (grid_blocks == 0) {
    if (n_in != 20 || ws_size < WS_END) {
      fprintf(stderr, "kernel_launch: unexpected n_in %d or ws_size %zu (need %zu)\n", n_in, ws_size, (size_t)WS_END);
      grid_blocks = -1;
      return;
    }
    int dev = 0, cus = 0, per_cu = 0;
    hipGetDevice(&dev);
    hipDeviceGetAttribute(&cus, hipDeviceAttributeMultiprocessorCount, dev);
#if COOP
    if (hipFuncSetAttribute((const void*)mega, hipFuncAttributeMaxDynamicSharedMemorySize, LDS_BYTES) != hipSuccess)
      fprintf(stderr, "kernel_launch: hipFuncSetAttribute failed\n");
    hipOccupancyMaxActiveBlocksPerMultiprocessor(&per_cu, (const void*)mega, 512, LDS_BYTES);
#endif
    (void)hipGetLastError();
    if (per_cu < 1) per_cu = 1;
    grid_blocks = cus * per_cu;
    if (grid_blocks > NPANEL) grid_blocks = NPANEL;
    if (grid_blocks < 1) grid_blocks = NPANEL;
  }
  if (grid_blocks < 0) return;
  Params P{};
  for (int i = 0; i < 20; ++i) P.in[i] = (const float*)d_in[i];
  P.out = (float*)d_out;
  P.ws = (unsigned char*)d_ws;
#if COOP
  P.ph_lo = 0; P.ph_hi = 5;
  (void)hipMemsetAsync((unsigned char*)d_ws + OFF_BAR, 0, 256, stream);
  void* args[] = {&P};
  hipError_t e = hipLaunchCooperativeKernel((const void*)mega, dim3(grid_blocks), dim3(512), args, LDS_BYTES, stream);
  if (e != hipSuccess) fprintf(stderr, "cooperative launch failed: %s (grid %d)\n", hipGetErrorString(e), grid_blocks);
#endif
}
```

```cpp
#include <hip/hip_runtime.h>
#include <hip/hip_cooperative_groups.h>
#include <stdint.h>
#include <stdio.h>
namespace cg = cooperative_groups;

#ifndef COOP
#define COOP 1
#endif

typedef unsigned short bf16_t;
typedef __attribute__((ext_vector_type(8))) __bf16 bfrag;
typedef __attribute__((ext_vector_type(16))) float f32x16;

constexpr int T_TOK = 32768;
constexpr int NPANEL = 256;
constexpr float ALPHA = 1.6817928305074290f;
constexpr int LDS_BYTES = 123904;
constexpr int LDS_STATS_OFF = 122880;

constexpr size_t SZ_WGU = (size_t)8 * 5632 * 1024 * 2;
constexpr size_t SZ_WD = (size_t)8 * 1024 * 2816 * 2;
constexpr size_t SZ_WGI = (size_t)2 * 2048 * 1024 * 2;
constexpr size_t SZ_WGO = (size_t)2 * 1024 * 1024 * 2;
constexpr size_t SZ_WSP = (size_t)2 * 8 * 128 * 128 * 2;
constexpr size_t SZ_WHI = (size_t)4096 * 1024 * 2;
constexpr size_t SZ_WHO = (size_t)1024 * 1024 * 2;
constexpr size_t SZ_WQKV = (size_t)1536 * 1024 * 2;
constexpr size_t SZ_WAO = (size_t)1024 * 1024 * 2;
constexpr size_t SZ_LB = 4096;
constexpr size_t SZ_H = (size_t)T_TOK * 1024 * 4;
constexpr size_t SZ_HB = (size_t)T_TOK * 1024 * 2;
constexpr size_t SZ_ACT = (size_t)T_TOK * 2816 * 2;
constexpr size_t SZ_SG = (size_t)T_TOK * 1024 * 2;
constexpr size_t SZ_DS = (size_t)NPANEL * 8 * 128 * 128 * 2;
constexpr size_t SZ_DEC = (size_t)NPANEL * 8 * 128 * 4;
constexpr size_t SZ_KB = (size_t)T_TOK * 128 * 2;

constexpr size_t OFF_WGU = 0;
constexpr size_t OFF_WD = OFF_WGU + SZ_WGU;
constexpr size_t OFF_WGI = OFF_WD + SZ_WD;
constexpr size_t OFF_WGO = OFF_WGI + SZ_WGI;
constexpr size_t OFF_WSP = OFF_WGO + SZ_WGO;
constexpr size_t OFF_WHI = OFF_WSP + SZ_WSP;
constexpr size_t OFF_WHO = OFF_WHI + SZ_WHI;
constexpr size_t OFF_WQKV = OFF_WHO + SZ_WHO;
constexpr size_t OFF_WAO = OFF_WQKV + SZ_WQKV;
constexpr size_t OFF_LB = OFF_WAO + SZ_WAO;
constexpr size_t OFF_H = OFF_LB + SZ_LB;
constexpr size_t OFF_HB = OFF_H + SZ_H;
constexpr size_t OFF_ACT = OFF_HB + SZ_HB;
constexpr size_t OFF_SG = OFF_ACT + SZ_ACT;
constexpr size_t OFF_DS = OFF_SG + SZ_SG;
constexpr size_t OFF_DEC = OFF_DS + SZ_DS;
constexpr size_t OFF_KB = OFF_DEC + SZ_DEC;
constexpr size_t OFF_VB = OFF_KB + SZ_KB;
constexpr size_t OFF_BAR = OFF_VB + SZ_KB;
constexpr size_t OFF_STATS = OFF_BAR + 256;
constexpr size_t WS_END = OFF_STATS + (size_t)T_TOK * 8;

struct Params {
  const float* in[20];
  float* out;
  unsigned char* ws;
  int ph_lo, ph_hi;
};

struct Ctx {
  const float* const* in;
  float* out;
  unsigned char* ws;
  __device__ __forceinline__ bf16_t* WGU() const { return (bf16_t*)(ws + OFF_WGU); }
  __device__ __forceinline__ bf16_t* WD() const { return (bf16_t*)(ws + OFF_WD); }
  __device__ __forceinline__ bf16_t* WGI() const { return (bf16_t*)(ws + OFF_WGI); }
  __device__ __forceinline__ bf16_t* WGO() const { return (bf16_t*)(ws + OFF_WGO); }
  __device__ __forceinline__ bf16_t* WSP() const { return (bf16_t*)(ws + OFF_WSP); }
  __device__ __forceinline__ bf16_t* WHI() const { return (bf16_t*)(ws + OFF_WHI); }
  __device__ __forceinline__ bf16_t* WHO() const { return (bf16_t*)(ws + OFF_WHO); }
  __device__ __forceinline__ bf16_t* WQKV() const { return (bf16_t*)(ws + OFF_WQKV); }
  __device__ __forceinline__ bf16_t* WAO() const { return (bf16_t*)(ws + OFF_WAO); }
  __device__ __forceinline__ float* LB() const { return (float*)(ws + OFF_LB); }
  __device__ __forceinline__ float* H() const { return (float*)(ws + OFF_H); }
  __device__ __forceinline__ bf16_t* HB() const { return (bf16_t*)(ws + OFF_HB); }
  __device__ __forceinline__ bf16_t* ACT() const { return (bf16_t*)(ws + OFF_ACT); }
  __device__ __forceinline__ bf16_t* SG() const { return (bf16_t*)(ws + OFF_SG); }
  __device__ __forceinline__ bf16_t* DS() const { return (bf16_t*)(ws + OFF_DS); }
  __device__ __forceinline__ float* DEC() const { return (float*)(ws + OFF_DEC); }
  __device__ __forceinline__ bf16_t* KB() const { return (bf16_t*)(ws + OFF_KB); }
  __device__ __forceinline__ bf16_t* VB() const { return (bf16_t*)(ws + OFF_VB); }
  __device__ __forceinline__ float2* STATS() const { return (float2*)(ws + OFF_STATS); }
};

typedef __attribute__((ext_vector_type(2))) float f32x2_t;
typedef __attribute__((ext_vector_type(2))) __bf16 bf16x2_t;
__device__ __forceinline__ uint32_t pack2(float a, float b) {
  f32x2_t v = {a, b};
  bf16x2_t r = __builtin_convertvector(v, bf16x2_t);
  return __builtin_bit_cast(uint32_t, r);
}
__device__ __forceinline__ bf16_t f2bf(float f) { return (bf16_t)(pack2(f, 0.f) & 0xffffu); }
__device__ __forceinline__ float bf2f(bf16_t b) { return __uint_as_float(((uint32_t)b) << 16); }
__device__ __forceinline__ float wave_sum(float v) {
  v += __shfl_xor(v, 32, 64); v += __shfl_xor(v, 16, 64); v += __shfl_xor(v, 8, 64);
  v += __shfl_xor(v, 4, 64); v += __shfl_xor(v, 2, 64); v += __shfl_xor(v, 1, 64);
  return v;
}
__device__ __forceinline__ size_t ablk(int row, int col) { return (size_t)(col >> 5) * 4096 + row * 32 + (col & 31); }
__device__ __forceinline__ float silu_f(float x) { return x * __frcp_rn(1.f + __expf(-x)); }
#define ROWMAP(reg, lane) ((((reg)&3)) + 8 * ((reg) >> 2) + 4 * ((lane) >> 5))
#define MFMA(a, b, c) __builtin_amdgcn_mfma_f32_32x32x16_bf16((a), (b), (c), 0, 0, 0)

__device__ __forceinline__ int opaque_tid() {
  int t = threadIdx.x;
  asm volatile("" : "+v"(t));
  return t;
}

__device__ __forceinline__ unsigned long long opaque_u64(unsigned long long v) {
  unsigned lo = (unsigned)v, hi = (unsigned)(v >> 32);
  asm volatile("" : "+v"(lo), "+v"(hi));
  lo = __builtin_amdgcn_readfirstlane(lo);
  hi = __builtin_amdgcn_readfirstlane(hi);
  return ((unsigned long long)hi << 32) | lo;
}

__device__ __forceinline__ f32x16 zero16() {
  f32x16 z;
#pragma unroll
  for (int i = 0; i < 16; ++i) z[i] = 0.f;
  return z;
}

constexpr int G_STAGE_B = 40960;

__device__ __forceinline__ void glds16(const bf16_t* g, const char* l) {
  __builtin_amdgcn_global_load_lds((const unsigned*)g, (unsigned*)const_cast<char*>(l), 16, 0, 0);
}

#define RDFRAGS(F, stg, ok)                                                              \
  do {                                                                                   \
    const char* sa_ = lds + (stg) * G_STAGE_B + wm * 4096 + (ok);                         \
    const char* sb_ = lds + (stg) * G_STAGE_B + 8192 + wn * 8192 + (ok);                  \
    F[0] = *(const bfrag*)(sa_);                                                         \
    F[1] = *(const bfrag*)(sa_ + 2048);                                                  \
    F[2] = *(const bfrag*)(sb_);                                                         \
    F[3] = *(const bfrag*)(sb_ + 2048);                                                  \
    F[4] = *(const bfrag*)(sb_ + 4096);                                                  \
    F[5] = *(const bfrag*)(sb_ + 6144);                                                  \
  } while (0)
#define DOMFMA(F)                                                                        \
  do {                                                                                   \
    _Pragma("unroll") for (int ni_ = 0; ni_ < 4; ++ni_) {                                \
      acc[0][ni_] = MFMA(F[0], F[2 + ni_], acc[0][ni_]);                                 \
      acc[1][ni_] = MFMA(F[1], F[2 + ni_], acc[1][ni_]);                                 \
    }                                                                                    \
  } while (0)
#define ISSUE_SLAB(stg, ntv, krv)                                                        \
  do {                                                                                   \
    const char* st_ = lds + (stg) * G_STAGE_B + w * 1024;                                    \
    glds16(a_src + (krv) * 4096, st_);                                                   \
    const bf16_t* bs_ = b_src + (size_t)((ntv) * nk + (krv)) * 16384;                    \
    _Pragma("unroll") for (int i_ = 0; i_ < 4; ++i_) glds16(bs_ + i_ * 4096, st_ + 8192 + i_ * 8192); \
  } while (0)

#define ISSUE_SLAB_LO(stg, ntv, krv)    \
  do {                                                                                   \
    const char* st_ = lds + (stg) * G_STAGE_B + w * 1024;                                \
    glds16(a_src + (krv) * 4096, st_);                                                   \
    const bf16_t* bs_ = b_src + (size_t)((ntv) * nk + (krv)) * 16384;                    \
    glds16(bs_, st_ + 8192);                                                             \
    glds16(bs_ + 4096, st_ + 8192 + 8192);                                               \
  } while (0)
#define ISSUE_SLAB_HI(stg, ntv, krv)                        \
  do {                                                                                   \
    const char* st_ = lds + (stg) * G_STAGE_B + w * 1024;                                \
    const bf16_t* bs_ = b_src + (size_t)((ntv) * nk + (krv)) * 16384;                    \
    glds16(bs_ + 2 * 4096, st_ + 8192 + 2 * 8192);                                       \
    glds16(bs_ + 3 * 4096, st_ + 8192 + 3 * 8192);                                       \
  } while (0)

template <class Epi>
__device__ __forceinline__ void gemm_panel(const bf16_t* __restrict__ A, const int lda, const bf16_t* __restrict__ Wb,
                                           const int K, const int nN, const Epi epi, bf16_t* smem) {
  const int tid = opaque_tid(), lane = tid & 63;
  const int w = __builtin_amdgcn_readfirstlane(tid >> 6);
  const int wm = w & 1, wn = w >> 1;
  const int nk = K >> 5;
  const int total = nN * nk;
  const int l31 = lane & 31, h = lane >> 5;
  const int grow = lane >> 2;
  const int gch = (lane & 3) ^ ((lane >> 4) & 3);
  const bf16_t* a_src = A + (size_t)(w * 16 + grow) * 32 + gch * 8;
  const bf16_t* b_src = Wb + (size_t)(w * 16 + grow) * 32 + gch * 8;
  const char* lds = (const char*)smem;
  const int pos0 = h ^ ((l31 >> 2) & 3);
  const int offk0 = l31 * 64 + pos0 * 16;
  const int offk1 = l31 * 64 + (pos0 ^ 2) * 16;
  f32x16 acc[2][4];
#pragma unroll
  for (int i = 0; i < 2; ++i)
#pragma unroll
    for (int j = 0; j < 4; ++j) acc[i][j] = zero16();
  const int rot = (int)(((blockIdx.x >> 3) & 31) * nk) >> 5;
  int kr3 = rot, nt3 = 0, cnt3 = 0;
  __syncthreads();
#pragma unroll
  for (int s3 = 0; s3 < 3; ++s3) {
    ISSUE_SLAB(s3, nt3, kr3);
    ++kr3; if (kr3 == nk) kr3 = 0;
    ++cnt3; if (cnt3 == nk) { cnt3 = 0; ++nt3; }
  }
  asm volatile("s_waitcnt vmcnt(10)" ::: "memory");
  asm volatile("s_waitcnt lgkmcnt(0)" ::: "memory");
  __builtin_amdgcn_s_barrier();
  asm volatile("" ::: "memory");
  bfrag F0[6], F1[6];
  RDFRAGS(F0, 0, offk0);
  int ks = 0, nt = 0, stage = 0, stage_n = 1, stage_p = 2;
  int kr3p = 0, nt3p = 0;
  for (int it = 0; it < total; ++it) {
#define SB() __builtin_amdgcn_sched_barrier(0)
#define MM(F, mi_, ni_) acc[mi_][ni_] = MFMA(F[mi_], F[2 + (ni_)], acc[mi_][ni_])
    {
      const char* sa_ = lds + stage * G_STAGE_B + wm * 4096 + offk1;
      const char* sb_ = lds + stage * G_STAGE_B + 8192 + wn * 8192 + offk1;
      const char* stp_ = lds + stage_p * G_STAGE_B + w * 1024;
      const bf16_t* bsp_ = b_src + (size_t)(nt3p * nk + kr3p) * 16384;
      MM(F0, 0, 0); SB();
      F1[0] = *(const bfrag*)(sa_); F1[1] = *(const bfrag*)(sa_ + 2048); SB();
      MM(F0, 1, 0); SB();
      if (it > 0) glds16(bsp_ + 2 * 4096, stp_ + 8192 + 2 * 8192);
      SB();
      MM(F0, 0, 1); SB();
      F1[2] = *(const bfrag*)(sb_); F1[3] = *(const bfrag*)(sb_ + 2048); SB();
      MM(F0, 1, 1); SB();
      if (it > 0) glds16(bsp_ + 3 * 4096, stp_ + 8192 + 3 * 8192);
      SB();
      MM(F0, 0, 2); SB();
      F1[4] = *(const bfrag*)(sb_ + 4096); F1[5] = *(const bfrag*)(sb_ + 6144); SB();
      MM(F0, 1, 2); MM(F0, 0, 3); MM(F0, 1, 3); SB();
    }
    asm volatile("s_waitcnt vmcnt(5)" ::: "memory");
    asm volatile("s_waitcnt lgkmcnt(0)" ::: "memory");
    __builtin_amdgcn_s_barrier();
    asm volatile("" ::: "memory");
    SB();
    {
      const char* sa_ = lds + stage_n * G_STAGE_B + wm * 4096 + offk0;
      const char* sb_ = lds + stage_n * G_STAGE_B + 8192 + wn * 8192 + offk0;
      const char* st_ = lds + stage * G_STAGE_B + w * 1024;
      const bf16_t* bs_ = b_src + (size_t)(nt3 * nk + kr3) * 16384;
      MM(F1, 0, 0); SB();
      glds16(a_src + kr3 * 4096, st_); SB();
      MM(F1, 1, 0); SB();
      F0[0] = *(const bfrag*)(sa_); F0[1] = *(const bfrag*)(sa_ + 2048); SB();
      MM(F1, 0, 1); SB();
      glds16(bs_, st_ + 8192); SB();
      MM(F1, 1, 1); SB();
      F0[2] = *(const bfrag*)(sb_); F0[3] = *(const bfrag*)(sb_ + 2048); SB();
      MM(F1, 0, 2); SB();
      glds16(bs_ + 4096, st_ + 8192 + 8192); SB();
      MM(F1, 1, 2); SB();
      F0[4] = *(const bfrag*)(sb_ + 4096); F0[5] = *(const bfrag*)(sb_ + 6144); SB();
      MM(F1, 0, 3); MM(F1, 1, 3); SB();
    }
    kr3p = kr3; nt3p = nt3;
    ++kr3; if (kr3 == nk) kr3 = 0;
    ++cnt3; if (cnt3 == nk) { cnt3 = 0; ++nt3; }
    if (ks == nk - 1) {
      epi(acc, nt, wm, wn, lane);
#pragma unroll
      for (int i = 0; i < 2; ++i)
#pragma unroll
        for (int j = 0; j < 4; ++j) acc[i][j] = zero16();
      ++nt;
      asm volatile("s_waitcnt vmcnt(0)" ::: "memory");
      RDFRAGS(F0, stage_n, offk0);
    }
    ++ks; if (ks == nk) ks = 0;
    stage_p = stage;
    stage = stage_n;
    ++stage_n; if (stage_n == 3) stage_n = 0;
  }
  asm volatile("s_waitcnt vmcnt(0)" ::: "memory");
  __syncthreads();
}

struct EpiSwiglu {
  bf16_t* act;
  __device__ __forceinline__ void operator()(f32x16 (&acc)[2][4], int nt, int wm, int wn, int lane_in) const {
    int lane = lane_in;
    asm volatile("" : "+v"(lane));
    const int l31 = lane & 31;
#pragma unroll
    for (int mi = 0; mi < 2; ++mi)
#pragma unroll
      for (int n2 = 0; n2 < 2; ++n2)
#pragma unroll
        for (int r = 0; r < 16; ++r) {
          const int row = wm * 64 + mi * 32 + ROWMAP(r, lane);
          const int col = (nt * 4 + wn) * 64 + n2 * 32 + l31;
          const float g = acc[mi][n2][r], u = acc[mi][n2 + 2][r];
          act[ablk(row, col)] = f2bf(silu_f(g) * u);
        }
  }
};
struct EpiResLN {
  float* Hp;
  const float2* st;
  const float* gp;
  const float* bp;
  float alpha, c;
  const float* bias;
  __device__ __forceinline__ void operator()(f32x16 (&acc)[2][4], int nt, int wm, int wn, int lane_in) const {
    int lane = lane_in;
    asm volatile("" : "+v"(lane));
    const int l31 = lane & 31;
    const int rb = wm * 64 + 4 * (lane >> 5);
    float* base = Hp + (size_t)rb * 1024 + nt * 512 + wn * 128 + l31;
#pragma unroll
    for (int ni = 0; ni < 4; ++ni) {
      const int col = nt * 512 + wn * 128 + ni * 32 + l31;
      float ag = alpha, ab = bias ? c * bias[col] : 0.f;
      if (st) { ag = alpha * gp[col]; ab += alpha * bp[col]; }
#pragma unroll
      for (int mi = 0; mi < 2; ++mi) {
        float hv[16];
#pragma unroll
        for (int r = 0; r < 16; ++r) hv[r] = base[(size_t)(mi * 32 + (r & 3) + 8 * (r >> 2)) * 1024 + ni * 32];
#pragma unroll
        for (int r = 0; r < 16; ++r) {
          float mu = 0.f, rs = 1.f;
          if (st) { const float2 ms = st[rb + mi * 32 + (r & 3) + 8 * (r >> 2)]; mu = ms.x; rs = ms.y; }
          base[(size_t)(mi * 32 + (r & 3) + 8 * (r >> 2)) * 1024 + ni * 32] = (hv[r] - mu) * rs * ag + ab + c * acc[mi][ni][r];
        }
        __builtin_amdgcn_sched_barrier(0);
      }
    }
  }
};
struct EpiGelu {
  bf16_t* Z;
  __device__ __forceinline__ void operator()(f32x16 (&acc)[2][4], int nt, int wm, int wn, int lane_in) const {
    int lane = lane_in;
    asm volatile("" : "+v"(lane));
    const int l31 = lane & 31;
#pragma unroll
    for (int ni = 0; ni < 4; ++ni) {
      const int col = nt * 512 + wn * 128 + ni * 32 + l31;
#pragma unroll
      for (int mi = 0; mi < 2; ++mi)
#pragma unroll
        for (int r = 0; r < 16; ++r) {
          const int row = wm * 64 + mi * 32 + ROWMAP(r, lane);
          const float x = acc[mi][ni][r];
          Z[(size_t)row * 2048 + col] = f2bf(0.5f * x * (1.f + erff(x * 0.70710678118654752f)));
        }
    }
  }
};
struct EpiHgrn {
  bf16_t* Qp;
  bf16_t* Vp;
  float* LFp;
  bf16_t* SGp;
  const float* lb;
  __device__ __forceinline__ void operator()(f32x16 (&acc)[2][4], int nt, int wm, int wn, int lane_in) const {
    int lane = lane_in;
    asm volatile("" : "+v"(lane));
    const int l31 = lane & 31;
    const int sec = nt >> 1;
    const int cb = (nt & 1) * 512 + wn * 128 + l31;
    const int rb = wm * 64 + 4 * (lane >> 5);
    if (sec == 0 || sec == 3) {
      bf16_t* dst = (sec == 0) ? Qp : SGp;
#pragma unroll
      for (int ni = 0; ni < 4; ++ni)
#pragma unroll
        for (int mi = 0; mi < 2; ++mi)
#pragma unroll
          for (int r = 0; r < 16; ++r) {
            const int row = rb + mi * 32 + (r & 3) + 8 * (r >> 2);
            dst[(size_t)row * 1024 + cb + ni * 32] = f2bf(silu_f(acc[mi][ni][r]));
          }
    } else if (sec == 1) {
#pragma unroll
      for (int ni = 0; ni < 4; ++ni) {
        const float lbv = lb[cb + ni * 32];
#pragma unroll
        for (int mi = 0; mi < 2; ++mi)
#pragma unroll
          for (int r = 0; r < 16; ++r) {
            const int row = rb + mi * 32 + (r & 3) + 8 * (r >> 2);
            const float f = lbv + (1.f - lbv) * __frcp_rn(1.f + __expf(-acc[mi][ni][r]));
            LFp[(size_t)row * 1024 + cb + ni * 32] = __logf(f);
          }
      }
    } else {
#pragma unroll
      for (int ni = 0; ni < 4; ++ni)
#pragma unroll
        for (int mi = 0; mi < 2; ++mi)
#pragma unroll
          for (int r = 0; r < 16; ++r) {
            const int row = rb + mi * 32 + (r & 3) + 8 * (r >> 2);
            Vp[(size_t)row * 1024 + cb + ni * 32] = f2bf(acc[mi][ni][r]);
          }
    }
  }
};
struct EpiQkv {
  bf16_t* Qp;
  bf16_t* Kp;
  bf16_t* Vp;
  const float* bias;
  __device__ __forceinline__ void operator()(f32x16 (&acc)[2][4], int nt, int wm, int wn, int lane_in) const {
    int lane = lane_in;
    asm volatile("" : "+v"(lane));
    const int l31 = lane & 31;
#pragma unroll
    for (int ni = 0; ni < 4; ++ni) {
      const int col = nt * 512 + wn * 128 + ni * 32 + l31;
      if (col < 1280) {
        const float bv = bias[col];
#pragma unroll
        for (int mi = 0; mi < 2; ++mi)
#pragma unroll
          for (int r = 0; r < 16; ++r) {
            const int row = wm * 64 + mi * 32 + ROWMAP(r, lane);
            const float x = acc[mi][ni][r] + bv;
            if (col < 1024) Qp[(size_t)row * 1024 + col] = f2bf(x * 0.125f);
            else if (col < 1152) Kp[(size_t)row * 128 + (col - 1024)] = f2bf(x);
            else Vp[(size_t)row * 128 + (col - 1152)] = f2bf(x);
          }
      }
    }
  }
};

__device__ __forceinline__ void ln_panel(const float* Hp, float* outp, bf16_t* HBp, const float* g, const float* b,
                                         float2* stg, float2* stl) {
  const int tid = opaque_tid(), lane = tid & 63;
  const int w = __builtin_amdgcn_readfirstlane(tid >> 6);
  float4 gv[4], bv[4];
#pragma unroll
  for (int j = 0; j < 4; ++j) {
    gv[j] = *(const float4*)(g + j * 256 + lane * 4);
    bv[j] = *(const float4*)(b + j * 256 + lane * 4);
  }
  for (int r0 = w; r0 < 128; r0 += 32) {
    float4 x[4][4];
#pragma unroll
    for (int u = 0; u < 4; ++u)
#pragma unroll
      for (int j = 0; j < 4; ++j) x[u][j] = *(const float4*)(Hp + (size_t)(r0 + 8 * u) * 1024 + j * 256 + lane * 4);
#pragma unroll
    for (int u = 0; u < 4; ++u) {
      const int r = r0 + 8 * u;
      float s = 0.f;
#pragma unroll
      for (int j = 0; j < 4; ++j) s += x[u][j].x + x[u][j].y + x[u][j].z + x[u][j].w;
      s = wave_sum(s);
      const float mean = s * (1.f / 1024.f);
      float v = 0.f;
#pragma unroll
      for (int j = 0; j < 4; ++j) {
        x[u][j].x -= mean; x[u][j].y -= mean; x[u][j].z -= mean; x[u][j].w -= mean;
        v += x[u][j].x * x[u][j].x + x[u][j].y * x[u][j].y + x[u][j].z * x[u][j].z + x[u][j].w * x[u][j].w;
      }
      v = wave_sum(v);
      const float rstd = 1.0f / sqrtf(v * (1.f / 1024.f) + 1e-5f);
      if (lane == 0) { stg[r] = make_float2(mean, rstd); stl[r] = make_float2(mean, rstd); }
#pragma unroll
      for (int j = 0; j < 4; ++j) {
        float4 y;
        y.x = x[u][j].x * rstd * gv[j].x + bv[j].x;
        y.y = x[u][j].y * rstd * gv[j].y + bv[j].y;
        y.z = x[u][j].z * rstd * gv[j].z + bv[j].z;
        y.w = x[u][j].w * rstd * gv[j].w + bv[j].w;
        if (outp) *(float4*)(outp + (size_t)r * 1024 + j * 256 + lane * 4) = y;
        uint2 pk;
        pk.x = pack2(y.x, y.y);
        pk.y = pack2(y.z, y.w);
        *(uint2*)(HBp + ablk(r, j * 256 + lane * 4)) = pk;
      }
    }
  }
  __syncthreads();
}

__device__ __forceinline__ void ffn_panel(const Ctx& C, int p, int layer, int j, bool final_out, int sub, bf16_t* smem) {
  const int wi = layer * 2 + j;
  bf16_t* HBp = C.HB() + (size_t)p * 128 * 1024;
  bf16_t* ACTp = C.ACT() + (size_t)p * 128 * 2816;
  float* Hp = C.H() + (size_t)p * 128 * 1024;
  EpiSwiglu e1{ACTp};
  gemm_panel(HBp, 1024, C.WGU() + (size_t)wi * 5632 * 1024, 1024, 11, e1, smem);
  float2* stl = (float2*)((char*)smem + LDS_STATS_OFF);
  float2* stg = C.STATS() + (size_t)p * 128;
  EpiResLN e2{Hp, sub > 0 ? stl : nullptr, C.in[3] + (sub > 0 ? sub - 1 : 0) * 1024, C.in[4] + (sub > 0 ? sub - 1 : 0) * 1024, ALPHA, 0.5f, nullptr};
  gemm_panel(ACTp, 2816, C.WD() + (size_t)wi * 1024 * 2816, 2816, 2, e2, smem);
  const int li = (layer * 3 + (j == 0 ? 0 : 2)) * 1024;
  float* outp = final_out ? (C.out + (size_t)p * 128 * 1024) : nullptr;
  ln_panel(Hp, outp, HBp, C.in[3] + li, C.in[4] + li, stg, stl);
}

__device__ __forceinline__ void gmlp_panel(const Ctx& C, int p, int layer, int slot, int sub, bf16_t* smem) {
  const int tid = opaque_tid(), lane = tid & 63;
  const int w = __builtin_amdgcn_readfirstlane(tid >> 6);
  const int l31 = lane & 31, h8 = (lane >> 5) * 8;
  bf16_t* HBp = C.HB() + (size_t)p * 128 * 1024;
  bf16_t* Zp = C.ACT() + (size_t)p * 128 * 2816;
  float* Hp = C.H() + (size_t)p * 128 * 1024;
  {
    EpiGelu e{Zp};
    gemm_panel(HBp, 1024, C.WGI() + (size_t)slot * 2048 * 1024, 1024, 4, e, smem);
  }
  bf16_t* As = smem;
  bf16_t* Bs = smem + 128 * 136;
  float* st = (float*)(smem + 2 * 128 * 136);
  for (int r = w; r < 128; r += 8) {
    const uint4 q0 = *(const uint4*)(Zp + (size_t)r * 2048 + 1024 + lane * 16);
    const uint4 q1 = *(const uint4*)(Zp + (size_t)r * 2048 + 1024 + lane * 16 + 8);
    const uint32_t u[8] = {q0.x, q0.y, q0.z, q0.w, q1.x, q1.y, q1.z, q1.w};
    float x[16];
    float s = 0.f;
#pragma unroll
    for (int e = 0; e < 8; ++e) {
      x[2 * e] = __uint_as_float(u[e] << 16);
      x[2 * e + 1] = __uint_as_float(u[e] & 0xffff0000u);
      s += x[2 * e] + x[2 * e + 1];
    }
    s = wave_sum(s);
    const float mean = s * (1.f / 1024.f);
    float v = 0.f;
#pragma unroll
    for (int e = 0; e < 16; ++e) { const float d = x[e] - mean; v += d * d; }
    v = wave_sum(v);
    if (lane == 0) { st[r * 2] = mean; st[r * 2 + 1] = 1.0f / sqrtf(v * (1.f / 1024.f) + 1e-5f); }
  }
  __syncthreads();
  const float* lng = C.in[6] + slot * 1024;
  const float* lnb = C.in[7] + slot * 1024;
  const float* bsp = C.in[9] + slot * 1024;
  const bf16_t* Wsp = C.WSP() + (size_t)slot * 8 * 16384;
  const int nd = w & 3, mt0 = (w >> 2) * 2;
  for (int g = 0; g < 8; ++g) {
#pragma unroll
    for (int i = 0; i < 4; ++i) {
      const int c = tid + 512 * i;
      *(uint4*)(As + (c >> 4) * 136 + (c & 15) * 8) = *(const uint4*)(Wsp + (size_t)g * 16384 + c * 8);
    }
    {
      const int s = tid >> 2, dq = tid & 3;
      const float mean = st[s * 2], rstd = st[s * 2 + 1];
      const bf16_t* src = Zp + (size_t)s * 2048 + 1024 + g * 128 + dq * 32;
#pragma unroll
      for (int q = 0; q < 4; ++q) {
        const uint4 v4 = *(const uint4*)(src + q * 8);
        const uint32_t u[4] = {v4.x, v4.y, v4.z, v4.w};
#pragma unroll
        for (int e = 0; e < 4; ++e) {
          const int d0 = dq * 32 + q * 8 + e * 2;
          const int ch = g * 128 + d0;
          const float x0 = __uint_as_float(u[e] << 16), x1 = __uint_as_float(u[e] & 0xffff0000u);
          Bs[d0 * 136 + s] = f2bf((x0 - mean) * rstd * lng[ch] + lnb[ch]);
          Bs[(d0 + 1) * 136 + s] = f2bf((x1 - mean) * rstd * lng[ch + 1] + lnb[ch + 1]);
        }
      }
    }
    __syncthreads();
    f32x16 acc[2];
    acc[0] = zero16(); acc[1] = zero16();
#pragma unroll
    for (int k16 = 0; k16 < 8; ++k16) {
      const bfrag b = *(const bfrag*)(Bs + (nd * 32 + l31) * 136 + k16 * 16 + h8);
#pragma unroll
      for (int mi = 0; mi < 2; ++mi) {
        const bfrag a = *(const bfrag*)(As + ((mt0 + mi) * 32 + l31) * 136 + k16 * 16 + h8);
        acc[mi] = MFMA(a, b, acc[mi]);
      }
    }
#pragma unroll
    for (int mi = 0; mi < 2; ++mi)
#pragma unroll
      for (int r = 0; r < 16; ++r) {
        const int t = (mt0 + mi) * 32 + ROWMAP(r, lane);
        const int ch = g * 128 + nd * 32 + l31;
        const float mixed = acc[mi][r] + bsp[g * 128 + t];
        const float u = bf2f(Zp[(size_t)t * 2048 + ch]);
        HBp[ablk(t, ch)] = f2bf(u * mixed);
      }
    __syncthreads();
  }
  {
    EpiResLN e2{Hp, (float2*)((char*)smem + LDS_STATS_OFF), C.in[3] + (sub - 1) * 1024, C.in[4] + (sub - 1) * 1024, ALPHA, 1.0f, nullptr};
    gemm_panel(HBp, 1024, C.WGO() + (size_t)slot * 1024 * 1024, 1024, 2, e2, smem);
  }
  const int li = (layer * 3 + 1) * 1024;
  ln_panel(Hp, nullptr, HBp, C.in[3] + li, C.in[4] + li, C.STATS() + (size_t)p * 128, (float2*)((char*)smem + LDS_STATS_OFF));
}

template <bool OUT>
__device__ __forceinline__ void hgrn_rec(const Ctx& C, int p, bf16_t* smem) {
  const int tid = opaque_tid(), lane = tid & 63;
  const int w = __builtin_amdgcn_readfirstlane(tid >> 6);
  const int l31 = lane & 31, h8 = (lane >> 5) * 8;
  bf16_t* ST = smem;
  bf16_t* Qh = smem + 17408;
  bf16_t* Kh = smem + 21760;
  bf16_t* KhT = smem + 26112;
  bf16_t* vT = smem + 31232;
  bf16_t* Ps = smem + 36352;
  float* seg = (float*)(smem + 37632);
  float* dec = seg + 512;
  float* oF = dec + 128;
  const size_t row0 = (size_t)p * 128;
  const bf16_t* Qp = C.ACT() + (size_t)p * 128 * 2816;
  const bf16_t* Vp = Qp + 128 * 1024;
  const float* LFp = C.out + row0 * 1024;
  const bf16_t* SGp = C.SG() + row0 * 1024;
  bf16_t* HBp = C.HB() + row0 * 1024;
  const float* ng = C.in[13];
  const int jt = w >> 1, kt0 = (w & 1) * 2;
  const int kq = tid & 127, tq = tid >> 7;
  for (int h = 0; h < 8; ++h) {
    f32x16 accS[2];
    bf16_t* SBh = C.DS() + ((size_t)(p * 8 + h)) * 16384;
    if (OUT) {
      __syncthreads();
#pragma unroll
      for (int i = 0; i < 4; ++i) {
        const int c = tid + 512 * i;
        *(uint4*)(ST + (c >> 4) * 136 + (c & 15) * 8) = *(const uint4*)(SBh + c * 8);
      }
      __syncthreads();
#pragma unroll
      for (int c2 = 0; c2 < 2; ++c2)
#pragma unroll
        for (int r = 0; r < 16; ++r)
          accS[c2][r] = bf2f(ST[(jt * 32 + ROWMAP(r, lane)) * 136 + (kt0 + c2) * 32 + l31]);
    } else {
      accS[0] = zero16(); accS[1] = zero16();
    }
    float dsum = 0.f;
    float ln_[8];
    bf16_t vn_[8], qn_[8];
    {
      const size_t g0 = (size_t)(tq * 8) * 1024 + h * 128 + kq;
#pragma unroll
      for (int e = 0; e < 8; ++e) {
        ln_[e] = LFp[g0 + (size_t)e * 1024];
        vn_[e] = Vp[g0 + (size_t)e * 1024];
        qn_[e] = OUT ? Qp[g0 + (size_t)e * 1024] : (bf16_t)0;
      }
    }
    for (int i = 0; i < 4; ++i) {
      float l[8], cs[8];
      bf16_t vcur[8], qcur[8];
      const size_t gbase = (size_t)(i * 32 + tq * 8) * 1024 + h * 128 + kq;
#pragma unroll
      for (int e = 0; e < 8; ++e) { l[e] = ln_[e]; vcur[e] = vn_[e]; qcur[e] = qn_[e]; }
      if (i < 3) {
        const size_t gn = gbase + (size_t)32 * 1024;
#pragma unroll
        for (int e = 0; e < 8; ++e) {
          ln_[e] = LFp[gn + (size_t)e * 1024];
          vn_[e] = Vp[gn + (size_t)e * 1024];
          if (OUT) qn_[e] = Qp[gn + (size_t)e * 1024];
        }
      }
      cs[0] = l[0];
#pragma unroll
      for (int e = 1; e < 8; ++e) cs[e] = cs[e - 1] + l[e];
      seg[tq * 128 + kq] = cs[7];
#pragma unroll
      for (int e = 0; e < 8; ++e) vT[kq * 40 + tq * 8 + e] = vcur[e];
      __syncthreads();
      float off = 0.f, tot = 0.f;
#pragma unroll
      for (int q = 0; q < 4; ++q) {
        const float s = seg[q * 128 + kq];
        if (q < tq) off += s;
        tot += s;
      }
#pragma unroll
      for (int e = 0; e < 8; ++e) {
        const float gc = cs[e] + off;
        const float f = __expf(l[e]);
        const float kh = (1.f - f) * __expf(-gc);
        const bf16_t khb = f2bf(kh);
        const int t = tq * 8 + e;
        KhT[kq * 40 + t] = khb;
        if (OUT) {
          Kh[t * 136 + kq] = khb;
          const float qv = bf2f(qcur[e]);
          Qh[t * 136 + kq] = f2bf(qv * __expf(gc));
        }
      }
      if (tq == 0) { dec[kq] = __expf(tot); dsum += tot; }
      __syncthreads();
      f32x16 accO = zero16();
      if (OUT) {
        if (w == 0) {
          f32x16 accP = zero16();
#pragma unroll
          for (int k16 = 0; k16 < 8; ++k16) {
            const bfrag a = *(const bfrag*)(Qh + l31 * 136 + k16 * 16 + h8);
            const bfrag b = *(const bfrag*)(Kh + l31 * 136 + k16 * 16 + h8);
            accP = MFMA(a, b, accP);
          }
#pragma unroll
          for (int r = 0; r < 16; ++r) {
            const int t = ROWMAP(r, lane);
            Ps[t * 40 + l31] = (l31 <= t) ? f2bf(accP[r]) : (bf16_t)0;
          }
        } else if (w <= 4) {
          const int nt = w - 1;
#pragma unroll
          for (int k16 = 0; k16 < 8; ++k16) {
            const bfrag a = *(const bfrag*)(Qh + l31 * 136 + k16 * 16 + h8);
            const bfrag b = *(const bfrag*)(ST + (nt * 32 + l31) * 136 + k16 * 16 + h8);
            accO = MFMA(a, b, accO);
          }
        }
        __syncthreads();
        if (w >= 1 && w <= 4) {
          const int nt = w - 1;
#pragma unroll
          for (int k16 = 0; k16 < 2; ++k16) {
            const bfrag a = *(const bfrag*)(Ps + l31 * 40 + k16 * 16 + h8);
            const bfrag b = *(const bfrag*)(vT + (nt * 32 + l31) * 40 + k16 * 16 + h8);
            accO = MFMA(a, b, accO);
          }
#pragma unroll
          for (int r = 0; r < 16; ++r) oF[ROWMAP(r, lane) * 132 + nt * 32 + l31] = accO[r];
        }
      }
#pragma unroll
      for (int c2 = 0; c2 < 2; ++c2) {
#pragma unroll
        for (int k16 = 0; k16 < 2; ++k16) {
          const bfrag a = *(const bfrag*)(vT + (jt * 32 + l31) * 40 + k16 * 16 + h8);
          const bfrag b = *(const bfrag*)(KhT + ((kt0 + c2) * 32 + l31) * 40 + k16 * 16 + h8);
          accS[c2] = MFMA(a, b, accS[c2]);
        }
        const float dk = dec[(kt0 + c2) * 32 + l31];
#pragma unroll
        for (int r = 0; r < 16; ++r) accS[c2][r] *= dk;
        if (OUT) {
#pragma unroll
          for (int r = 0; r < 16; ++r)
            ST[(jt * 32 + ROWMAP(r, lane)) * 136 + (kt0 + c2) * 32 + l31] = f2bf(accS[c2][r]);
        }
      }
      __syncthreads();
      if (OUT) {
        const int t = tid >> 4, part = tid & 15;
        float x[8];
        float ss = 0.f;
#pragma unroll
        for (int e = 0; e < 8; ++e) { x[e] = oF[t * 132 + part * 8 + e]; ss += x[e] * x[e]; }
        ss += __shfl_xor(ss, 1, 64); ss += __shfl_xor(ss, 2, 64); ss += __shfl_xor(ss, 4, 64); ss += __shfl_xor(ss, 8, 64);
        const float rr = 1.0f / sqrtf(ss * (1.f / 128.f) + 1e-6f);
        const size_t gro = (size_t)(i * 32 + t) * 1024 + h * 128 + part * 8;
        const uint4 sg4 = *(const uint4*)(SGp + gro);
        const uint32_t su[4] = {sg4.x, sg4.y, sg4.z, sg4.w};
        uint32_t ov[4];
#pragma unroll
        for (int e = 0; e < 4; ++e) {
          const float g0 = ng[part * 8 + 2 * e], g1 = ng[part * 8 + 2 * e + 1];
          const float s0 = __uint_as_float(su[e] << 16), s1 = __uint_as_float(su[e] & 0xffff0000u);
          ov[e] = pack2(x[2 * e] * rr * g0 * s0, x[2 * e + 1] * rr * g1 * s1);
        }
        uint4 o4; o4.x = ov[0]; o4.y = ov[1]; o4.z = ov[2]; o4.w = ov[3];
        *(uint4*)(HBp + ablk(i * 32 + t, h * 128 + part * 8)) = o4;
      }
    }
    if (!OUT) {
#pragma unroll
      for (int c2 = 0; c2 < 2; ++c2)
#pragma unroll
        for (int r = 0; r < 16; ++r)
          SBh[(jt * 32 + ROWMAP(r, lane)) * 128 + (kt0 + c2) * 32 + l31] = f2bf(accS[c2][r]);
      if (tq == 0) C.DEC()[(size_t)(p * 8 + h) * 128 + kq] = __expf(dsum);
    }
  }
  __syncthreads();
}

__device__ __forceinline__ void hgrn_scan(const Ctx& C) {
  for (int gid = blockIdx.x * 512 + threadIdx.x; gid < 131072; gid += gridDim.x * 512) {
    const int kp = gid & 63, j = (gid >> 6) & 127, h = (gid >> 13) & 7, b = gid >> 16;
    float s0 = 0.f, s1 = 0.f;
    for (int c0 = 0; c0 < 128; c0 += 8) {
      uint32_t d[8];
      float2 dc[8];
#pragma unroll
      for (int e = 0; e < 8; ++e) {
        const size_t ph = (size_t)((b * 128 + c0 + e) * 8 + h);
        d[e] = *(const uint32_t*)(C.DS() + ph * 16384 + j * 128 + kp * 2);
        dc[e] = *(const float2*)(C.DEC() + ph * 128 + kp * 2);
      }
#pragma unroll
      for (int e = 0; e < 8; ++e) {
        const size_t ph = (size_t)((b * 128 + c0 + e) * 8 + h);
        *(uint32_t*)(C.DS() + ph * 16384 + j * 128 + kp * 2) = pack2(s0, s1);
        s0 = dc[e].x * s0 + __uint_as_float(d[e] << 16);
        s1 = dc[e].y * s1 + __uint_as_float(d[e] & 0xffff0000u);
      }
    }
  }
}

__device__ __forceinline__ void attn_panel(const Ctx& C, int p, bf16_t* smem) {
  const int tid = opaque_tid(), lane = tid & 63;
  const int w = __builtin_amdgcn_readfirstlane(tid >> 6);
  const int l31 = lane & 31, h8 = (lane >> 5) * 8;
  bf16_t* K2 = smem;
  bf16_t* VT = smem + 18432;
  bf16_t* Pw = smem + 35328 + w * 1280;
  const int blk = p & 127;
  const size_t row0 = (size_t)p * 128;
  const bf16_t* Qp = C.ACT() + (size_t)p * 128 * 2816;
  bf16_t* HBp = C.HB() + row0 * 1024;
  const int qt = w & 3;
  for (int hk = 0; hk < 2; ++hk) {
    __syncthreads();
#pragma unroll
    for (int i = 0; i < 4; ++i) {
      const int c = tid + 512 * i;
      const int r = c >> 3, ch = c & 7;
      uint4 kv = make_uint4(0, 0, 0, 0), vv = make_uint4(0, 0, 0, 0);
      if (blk > 0 || r >= 128) {
        const size_t tok = row0 + r - 128;
        kv = *(const uint4*)(C.KB() + tok * 128 + hk * 64 + ch * 8);
        vv = *(const uint4*)(C.VB() + tok * 128 + hk * 64 + ch * 8);
      }
      *(uint4*)(K2 + r * 72 + ch * 8) = kv;
      const uint32_t vu[4] = {vv.x, vv.y, vv.z, vv.w};
#pragma unroll
      for (int e = 0; e < 4; ++e) {
        VT[(ch * 8 + 2 * e) * 264 + r] = (bf16_t)(vu[e] & 0xffffu);
        VT[(ch * 8 + 2 * e + 1) * 264 + r] = (bf16_t)(vu[e] >> 16);
      }
    }
    __syncthreads();
    for (int u = 0; u < 4; ++u) {
      const int hq = hk * 8 + (w >> 2) * 4 + u;
      const float sink = C.in[17][hq];
      bfrag aq[4];
#pragma unroll
      for (int k16 = 0; k16 < 4; ++k16)
        aq[k16] = *(const bfrag*)(Qp + (size_t)(qt * 32 + l31) * 1024 + hq * 64 + k16 * 16 + h8);
      f32x16 s[5];
#pragma unroll
      for (int c = 0; c < 5; ++c) {
        s[c] = zero16();
#pragma unroll
        for (int k16 = 0; k16 < 4; ++k16) {
          const bfrag b = *(const bfrag*)(K2 + ((qt + c) * 32 + l31) * 72 + k16 * 16 + h8);
          s[c] = MFMA(aq[k16], b, s[c]);
        }
      }
      float linv[16];
#pragma unroll
      for (int r = 0; r < 16; ++r) {
        const int qi = qt * 32 + ROWMAP(r, lane);
        float m = -1e30f;
#pragma unroll
        for (int c = 0; c < 5; ++c) {
          const int kp = (qt + c) * 32 + l31;
          const bool valid = (kp > qi) && (kp <= qi + 128) && (blk > 0 || kp >= 128);
          const float v = valid ? s[c][r] : -1e30f;
          s[c][r] = v;
          m = fmaxf(m, v);
        }
        m = fmaxf(m, __shfl_xor(m, 16, 64)); m = fmaxf(m, __shfl_xor(m, 8, 64)); m = fmaxf(m, __shfl_xor(m, 4, 64));
        m = fmaxf(m, __shfl_xor(m, 2, 64)); m = fmaxf(m, __shfl_xor(m, 1, 64));
        m = fmaxf(m, sink);
        float sum = 0.f;
#pragma unroll
        for (int c = 0; c < 5; ++c) {
          const float pv = (s[c][r] > -1e29f) ? __expf(s[c][r] - m) : 0.f;
          s[c][r] = pv;
          sum += pv;
        }
        sum += __shfl_xor(sum, 16, 64); sum += __shfl_xor(sum, 8, 64); sum += __shfl_xor(sum, 4, 64);
        sum += __shfl_xor(sum, 2, 64); sum += __shfl_xor(sum, 1, 64);
        sum += __expf(sink - m);
        linv[r] = 1.f / sum;
      }
      f32x16 o[2];
      o[0] = zero16(); o[1] = zero16();
#pragma unroll
      for (int c = 0; c < 5; ++c) {
#pragma unroll
        for (int r = 0; r < 16; ++r) Pw[ROWMAP(r, lane) * 40 + l31] = f2bf(s[c][r]);
        __syncthreads();
#pragma unroll
        for (int k16 = 0; k16 < 2; ++k16) {
          const bfrag a = *(const bfrag*)(Pw + l31 * 40 + k16 * 16 + h8);
#pragma unroll
          for (int dt = 0; dt < 2; ++dt) {
            const bfrag b = *(const bfrag*)(VT + (dt * 32 + l31) * 264 + (qt + c) * 32 + k16 * 16 + h8);
            o[dt] = MFMA(a, b, o[dt]);
          }
        }
        __syncthreads();
      }
#pragma unroll
      for (int dt = 0; dt < 2; ++dt)
#pragma unroll
        for (int r = 0; r < 16; ++r)
          HBp[ablk(qt * 32 + ROWMAP(r, lane), hq * 64 + dt * 32 + l31)] = f2bf(o[dt][r] * linv[r]);
    }
  }
  __syncthreads();
}

__device__ __forceinline__ void conv_weights(const float* __restrict__ src, bf16_t* __restrict__ dst, int nmat, int K,
                                             int Nsrc, int Ndst, int mode) {
  const int nk = K >> 5, nNt = Ndst >> 9;
  const int upm = nk * nNt;
  const int tid = threadIdx.x;
  for (int u = blockIdx.x; u < nmat * upm; u += gridDim.x) {
    const int m = u / upm, r = u - m * upm;
    const int nt = r / nk, ks = r - nt * nk;
    const int np = nt * 512 + tid;
    int sc;
    if (mode == 1) {
      const int b = np >> 7, rr = np & 127;
      sc = (rr < 64) ? (b * 64 + rr) : (2816 + b * 64 + rr - 64);
    } else {
      sc = (np < Nsrc) ? np : -1;
    }
    const float* s = src + (size_t)m * K * Nsrc + (size_t)(ks * 32) * Nsrc + (sc < 0 ? 0 : sc);
    uint32_t pk[16];
#pragma unroll
    for (int kk = 0; kk < 16; ++kk) {
      float v0 = s[(size_t)(2 * kk) * Nsrc], v1 = s[(size_t)(2 * kk + 1) * Nsrc];
      if (sc < 0) { v0 = 0.f; v1 = 0.f; }
      pk[kk] = pack2(v0, v1);
    }
    uint4* d = (uint4*)(dst + (size_t)m * K * Ndst + (size_t)(nt * nk + ks) * 16384 + tid * 32);
    d[0] = make_uint4(pk[0], pk[1], pk[2], pk[3]);
    d[1] = make_uint4(pk[4], pk[5], pk[6], pk[7]);
    d[2] = make_uint4(pk[8], pk[9], pk[10], pk[11]);
    d[3] = make_uint4(pk[12], pk[13], pk[14], pk[15]);
  }
}

__device__ __forceinline__ void phase0(const Ctx& C) {
  conv_weights(C.in[1], C.WGU(), 8, 1024, 5632, 5632, 1);
  conv_weights(C.in[2], C.WD(), 8, 2816, 1024, 1024, 0);
  conv_weights(C.in[5], C.WGI(), 2, 1024, 2048, 2048, 0);
  conv_weights(C.in[10], C.WGO(), 2, 1024, 1024, 1024, 0);
  conv_weights(C.in[11], C.WHI(), 1, 1024, 4096, 4096, 0);
  conv_weights(C.in[14], C.WHO(), 1, 1024, 1024, 1024, 0);
  conv_weights(C.in[15], C.WQKV(), 1, 1024, 1280, 1536, 0);
  conv_weights(C.in[18], C.WAO(), 1, 1024, 1024, 1024, 0);
  const size_t gtid = (size_t)blockIdx.x * 512 + threadIdx.x;
  const size_t gsz = (size_t)gridDim.x * 512;
  for (size_t i = gtid; i < (size_t)T_TOK * 1024 / 4; i += gsz) {
    const float4 v = ((const float4*)C.in[0])[i];
    ((float4*)C.H())[i] = v;
    uint2 pk;
    pk.x = pack2(v.x, v.y);
    pk.y = pack2(v.z, v.w);
    {
      const int row = (int)(i >> 8), col = (int)(i & 255) * 4;
      *(uint2*)(C.HB() + (size_t)(row >> 7) * 131072 + ablk(row & 127, col)) = pk;
    }
  }
  for (size_t i = gtid; i < (size_t)2 * 8 * 128 * 128; i += gsz) {
    const int s = (int)(i & 127), t = (int)((i >> 7) & 127);
    C.WSP()[i] = (s <= t) ? f2bf(C.in[8][i]) : (bf16_t)0;
  }
  for (size_t i = gtid; i < 1024; i += gsz) {
    const float* lp = C.in[12];
    const float a0 = lp[i], a1 = lp[1024 + i], a2 = lp[2048 + i], a3 = lp[3072 + i];
    const float m = fmaxf(fmaxf(a0, a1), fmaxf(a2, a3));
    const float e0 = expf(a0 - m), e1 = expf(a1 - m), e2 = expf(a2 - m), e3 = expf(a3 - m);
    C.LB()[i] = e1 / (e0 + e1 + e2 + e3);
  }
}

enum { OP_FFN = 0, OP_GMLP = 1, OP_HIN = 2, OP_HOUT = 3, OP_QKV = 4, OP_ATTN = 5 };

__device__ __forceinline__ void run_ops(const Ctx& C0, int op_lo, int op_hi, bf16_t* smem) {
  for (int p0 = blockIdx.x; p0 < NPANEL; p0 += gridDim.x) {
    for (int op = op_lo; op < op_hi; ++op) {
      const Ctx& C = C0;
      const int p = p0;
      bf16_t* HBp = C.HB() + (size_t)p * 128 * 1024;
      float* Hp = C.H() + (size_t)p * 128 * 1024;
      bf16_t* ACTp = C.ACT() + (size_t)p * 128 * 2816;
      int kind = OP_FFN, layer = 0, j = 0, sub = 0;
      switch (op) {
        case 0: kind = OP_FFN; layer = 0; j = 0; sub = 0; break;
        case 1: kind = OP_GMLP; layer = 0; j = 0; sub = 1; break;
        case 2: kind = OP_FFN; layer = 0; j = 1; sub = 2; break;
        case 3: kind = OP_FFN; layer = 1; j = 0; sub = 3; break;
        case 4: kind = OP_HIN; layer = 1; break;
        case 5: kind = OP_HOUT; layer = 1; sub = 4; break;
        case 6: kind = OP_FFN; layer = 1; j = 1; sub = 5; break;
        case 7: kind = OP_FFN; layer = 2; j = 0; sub = 6; break;
        case 8: kind = OP_QKV; layer = 2; break;
        case 9: kind = OP_ATTN; layer = 2; sub = 7; break;
        case 10: kind = OP_FFN; layer = 2; j = 1; sub = 8; break;
        case 11: kind = OP_FFN; layer = 3; j = 0; sub = 9; break;
        case 12: kind = OP_GMLP; layer = 3; j = 1; sub = 10; break;
        default: kind = OP_FFN; layer = 3; j = 1; sub = 11; break;
      }
      float2* stl = (float2*)((char*)smem + LDS_STATS_OFF);
      float2* stg = C.STATS() + (size_t)p * 128;
      if (threadIdx.x < 128) stl[threadIdx.x] = stg[threadIdx.x];
      if (kind == OP_FFN) {
        ffn_panel(C, p, layer, j, op == 13, sub, smem);
      } else if (kind == OP_GMLP) {
        gmlp_panel(C, p, layer, j, sub, smem);
      } else if (kind == OP_HIN) {
        EpiHgrn e{ACTp, ACTp + 128 * 1024, C.out + (size_t)p * 128 * 1024, C.SG() + (size_t)p * 128 * 1024, C.LB()};
        gemm_panel(HBp, 1024, C.WHI(), 1024, 8, e, smem);
        hgrn_rec<false>(C, p, smem);
      } else if (kind == OP_HOUT) {
        hgrn_rec<true>(C, p, smem);
        EpiResLN e2{Hp, stl, C.in[3] + (sub - 1) * 1024, C.in[4] + (sub - 1) * 1024, ALPHA, 1.0f, nullptr};
        gemm_panel(HBp, 1024, C.WHO(), 1024, 2, e2, smem);
        const int li = (1 * 3 + 1) * 1024;
        ln_panel(Hp, nullptr, HBp, C.in[3] + li, C.in[4] + li, stg, stl);
      } else if (kind == OP_QKV) {
        EpiQkv e{ACTp, C.KB() + (size_t)p * 128 * 128, C.VB() + (size_t)p * 128 * 128, C.in[16]};
        gemm_panel(HBp, 1024, C.WQKV(), 1024, 3, e, smem);
      } else {
        attn_panel(C, p, smem);
        EpiResLN e2{Hp, stl, C.in[3] + (sub - 1) * 1024, C.in[4] + (sub - 1) * 1024, ALPHA, 1.0f, C.in[19]};
        gemm_panel(HBp, 1024, C.WAO(), 1024, 2, e2, smem);
        const int li = (2 * 3 + 1) * 1024;
        ln_panel(Hp, nullptr, HBp, C.in[3] + li, C.in[4] + li, stg, stl);
      }
    }
  }
}

#if COOP
__device__ __forceinline__ void grid_barrier(unsigned* bar, unsigned target) {
  __syncthreads();
  if (threadIdx.x == 0) {
    __threadfence();
    __hip_atomic_fetch_add(bar, 1u, __ATOMIC_RELEASE, __HIP_MEMORY_SCOPE_AGENT);
    while (__hip_atomic_load(bar, __ATOMIC_ACQUIRE, __HIP_MEMORY_SCOPE_AGENT) < target) __builtin_amdgcn_s_sleep(8);
    __threadfence();
  }
  __syncthreads();
}

__global__ void __launch_bounds__(512) mega(Params P) {
  extern __shared__ __attribute__((aligned(16))) unsigned char lds_raw[];
  bf16_t* smem = (bf16_t*)lds_raw;
  Ctx C;
  C.in = P.in;
  C.out = P.out;
  C.ws = P.ws;
  const int lo = P.ph_lo, hi = P.ph_hi;
#if COOP
  if (lo < 0) cg::this_grid().sync();
  unsigned* bar = (unsigned*)(P.ws + OFF_BAR);
#define GSYNC(k) do { if (lo <= (k) && (k) + 1 < hi) grid_barrier(bar, (unsigned)((k) + 1) * gridDim.x); } while (0)
#else
#define GSYNC(k) do { } while (0)
#endif
  if (lo <= 0 && 0 < hi) phase0(C);
  GSYNC(0);
  if (lo <= 1 && 1 < hi) run_ops(C, 0, 5, smem);
  GSYNC(1);
  if (lo <= 2 && 2 < hi) hgrn_scan(C);
  GSYNC(2);
  if (lo <= 3 && 3 < hi) run_ops(C, 5, 9, smem);
  GSYNC(3);
  if (lo <= 4 && 4 < hi) run_ops(C, 9, 14, smem);
}

#endif

extern "C" void kernel_launch(void* const* d_in, const int* in_sizes, int n_in, void* d_out, int out_size, void* d_ws,
                              size_t ws_size, hipStream_t stream) {
  static int grid_blocks = 0;
  if (grid_blocks == 0) {
    if (n_in != 20 || ws_size < WS_END) {
      fprintf(stderr, "kernel_launch: unexpected n_in %d or ws_size %zu (need %zu)\n", n_in, ws_size, (size_t)WS_END);
      grid_blocks = -1;
      return;
    }
    int dev = 0, cus = 0, per_cu = 0;
    hipGetDevice(&dev);
    hipDeviceGetAttribute(&cus, hipDeviceAttributeMultiprocessorCount, dev);
#if COOP
    if (hipFuncSetAttribute((const void*)mega, hipFuncAttributeMaxDynamicSharedMemorySize, LDS_BYTES) != hipSuccess)
      fprintf(stderr, "kernel_launch: hipFuncSetAttribute failed\n");
    hipOccupancyMaxActiveBlocksPerMultiprocessor(&per_cu, (const void*)mega, 512, LDS_BYTES);
#endif
    (void)hipGetLastError();
    if (per_cu < 1) per_cu = 1;
    grid_blocks = cus * per_cu;
    if (grid_blocks > NPANEL) grid_blocks = NPANEL;
    if (grid_blocks < 1) grid_blocks = NPANEL;
  }
  if (grid_blocks < 0) return;
  Params P{};
  for (int i = 0; i < 20; ++i) P.in[i] = (const float*)d_in[i];
  P.out = (float*)d_out;
  P.ws = (unsigned char*)d_ws;
#if COOP
  P.ph_lo = 0; P.ph_hi = 5;
  (void)hipMemsetAsync((unsigned char*)d_ws + OFF_BAR, 0, 256, stream);
  void* args[] = {&P};
  hipError_t e = hipLaunchCooperativeKernel((const void*)mega, dim3(grid_blocks), dim3(512), args, LDS_BYTES, stream);
  if (e != hipSuccess) fprintf(stderr, "cooperative launch failed: %s (grid %d)\n", hipGetErrorString(e), grid_blocks);
#endif
}
```

```cpp
#include <hip/hip_runtime.h>
#include <hip/hip_cooperative_groups.h>
#include <stdint.h>
#include <stdio.h>
namespace cg = cooperative_groups;

#ifndef COOP
#define COOP 1
#endif

typedef unsigned short bf16_t;
typedef __attribute__((ext_vector_type(8))) __bf16 bfrag;
typedef __attribute__((ext_vector_type(16))) float f32x16;

constexpr int T_TOK = 32768;
constexpr int NPANEL = 256;
constexpr float ALPHA = 1.6817928305074290f;
constexpr int LDS_BYTES = 123904;
constexpr int LDS_STATS_OFF = 122880;

constexpr size_t SZ_WGU = (size_t)8 * 5632 * 1024 * 2;
constexpr size_t SZ_WD = (size_t)8 * 1024 * 2816 * 2;
constexpr size_t SZ_WGI = (size_t)2 * 2048 * 1024 * 2;
constexpr size_t SZ_WGO = (size_t)2 * 1024 * 1024 * 2;
constexpr size_t SZ_WSP = (size_t)2 * 8 * 128 * 128 * 2;
constexpr size_t SZ_WHI = (size_t)4096 * 1024 * 2;
constexpr size_t SZ_WHO = (size_t)1024 * 1024 * 2;
constexpr size_t SZ_WQKV = (size_t)1536 * 1024 * 2;
constexpr size_t SZ_WAO = (size_t)1024 * 1024 * 2;
constexpr size_t SZ_LB = 4096;
constexpr size_t SZ_H = (size_t)T_TOK * 1024 * 4;
constexpr size_t SZ_HB = (size_t)T_TOK * 1024 * 2;
constexpr size_t SZ_ACT = (size_t)T_TOK * 2816 * 2;
constexpr size_t SZ_SG = (size_t)T_TOK * 1024 * 2;
constexpr size_t SZ_DS = (size_t)NPANEL * 8 * 128 * 128 * 2;
constexpr size_t SZ_DEC = (size_t)NPANEL * 8 * 128 * 4;
constexpr size_t SZ_KB = (size_t)T_TOK * 128 * 2;

constexpr size_t OFF_WGU = 0;
constexpr size_t OFF_WD = OFF_WGU + SZ_WGU;
constexpr size_t OFF_WGI = OFF_WD + SZ_WD;
constexpr size_t OFF_WGO = OFF_WGI + SZ_WGI;
constexpr size_t OFF_WSP = OFF_WGO + SZ_WGO;
constexpr size_t OFF_WHI = OFF_WSP + SZ_WSP;
constexpr size_t OFF_WHO = OFF_WHI + SZ_WHI;
constexpr size_t OFF_WQKV = OFF_WHO + SZ_WHO;
constexpr size_t OFF_WAO = OFF_WQKV + SZ_WQKV;
constexpr size_t OFF_LB = OFF_WAO + SZ_WAO;
constexpr size_t OFF_H = OFF_LB + SZ_LB;
constexpr size_t OFF_HB = OFF_H + SZ_H;
constexpr size_t OFF_ACT = OFF_HB + SZ_HB;
constexpr size_t OFF_SG = OFF_ACT + SZ_ACT;
constexpr size_t OFF_DS = OFF_SG + SZ_SG;
constexpr size_t OFF_DEC = OFF_DS + SZ_DS;
constexpr size_t OFF_KB = OFF_DEC + SZ_DEC;
constexpr size_t OFF_VB = OFF_KB + SZ_KB;
constexpr size_t OFF_BAR = OFF_VB + SZ_KB;
constexpr size_t OFF_STATS = OFF_BAR + 256;
constexpr size_t WS_END = OFF_STATS + (size_t)T_TOK * 8;

struct Params {
  const float* in[20];
  float* out;
  unsigned char* ws;
  int ph_lo, ph_hi;
};

struct Ctx {
  const float* const* in;
  float* out;
  unsigned char* ws;
  __device__ __forceinline__ bf16_t* WGU() const { return (bf16_t*)(ws + OFF_WGU); }
  __device__ __forceinline__ bf16_t* WD() const { return (bf16_t*)(ws + OFF_WD); }
  __device__ __forceinline__ bf16_t* WGI() const { return (bf16_t*)(ws + OFF_WGI); }
  __device__ __forceinline__ bf16_t* WGO() const { return (bf16_t*)(ws + OFF_WGO); }
  __device__ __forceinline__ bf16_t* WSP() const { return (bf16_t*)(ws + OFF_WSP); }
  __device__ __forceinline__ bf16_t* WHI() const { return (bf16_t*)(ws + OFF_WHI); }
  __device__ __forceinline__ bf16_t* WHO() const { return (bf16_t*)(ws + OFF_WHO); }
  __device__ __forceinline__ bf16_t* WQKV() const { return (bf16_t*)(ws + OFF_WQKV); }
  __device__ __forceinline__ bf16_t* WAO() const { return (bf16_t*)(ws + OFF_WAO); }
  __device__ __forceinline__ float* LB() const { return (float*)(ws + OFF_LB); }
  __device__ __forceinline__ float* H() const { return (float*)(ws + OFF_H); }
  __device__ __forceinline__ bf16_t* HB() const { return (bf16_t*)(ws + OFF_HB); }
  __device__ __forceinline__ bf16_t* ACT() const { return (bf16_t*)(ws + OFF_ACT); }
  __device__ __forceinline__ bf16_t* SG() const { return (bf16_t*)(ws + OFF_SG); }
  __device__ __forceinline__ bf16_t* DS() const { return (bf16_t*)(ws + OFF_DS); }
  __device__ __forceinline__ float* DEC() const { return (float*)(ws + OFF_DEC); }
  __device__ __forceinline__ bf16_t* KB() const { return (bf16_t*)(ws + OFF_KB); }
  __device__ __forceinline__ bf16_t* VB() const { return (bf16_t*)(ws + OFF_VB); }
  __device__ __forceinline__ float2* STATS() const { return (float2*)(ws + OFF_STATS); }
};

typedef __attribute__((ext_vector_type(2))) float f32x2_t;
typedef __attribute__((ext_vector_type(2))) __bf16 bf16x2_t;
__device__ __forceinline__ uint32_t pack2(float a, float b) {
  f32x2_t v = {a, b};
  bf16x2_t r = __builtin_convertvector(v, bf16x2_t);
  return __builtin_bit_cast(uint32_t, r);
}
__device__ __forceinline__ bf16_t f2bf(float f) { return (bf16_t)(pack2(f, 0.f) & 0xffffu); }
__device__ __forceinline__ float bf2f(bf16_t b) { return __uint_as_float(((uint32_t)b) << 16); }
__device__ __forceinline__ float dpp_add(float v, const int ctrl_quad_perm_b1, const int which) {
  int x = __builtin_bit_cast(int, v), y;
  if (which == 0) y = __builtin_amdgcn_update_dpp(0, x, 0xB1, 0xF, 0xF, true);
  else if (which == 1) y = __builtin_amdgcn_update_dpp(0, x, 0x4E, 0xF, 0xF, true);
  else if (which == 2) y = __builtin_amdgcn_update_dpp(0, x, 0x141, 0xF, 0xF, true);
  else y = __builtin_amdgcn_update_dpp(0, x, 0x140, 0xF, 0xF, true);
  (void)ctrl_quad_perm_b1;
  return v + __builtin_bit_cast(float, y);
}
__device__ __forceinline__ float wave_sum(float v) {
  v = dpp_add(v, 0, 0);
  v = dpp_add(v, 0, 1);
  v = dpp_add(v, 0, 2);
  v = dpp_add(v, 0, 3);
  const int x = __builtin_bit_cast(int, v);
  const float s0 = __builtin_bit_cast(float, __builtin_amdgcn_readlane(x, 0));
  const float s1 = __builtin_bit_cast(float, __builtin_amdgcn_readlane(x, 16));
  const float s2 = __builtin_bit_cast(float, __builtin_amdgcn_readlane(x, 32));
  const float s3 = __builtin_bit_cast(float, __builtin_amdgcn_readlane(x, 48));
  return (s0 + s1) + (s2 + s3);
}
__device__ __forceinline__ size_t ablk(int row, int col) { return (size_t)(col >> 5) * 4096 + row * 32 + (col & 31); }
__device__ __forceinline__ float silu_f(float x) { return x * __frcp_rn(1.f + __expf(-x)); }
#define ROWMAP(reg, lane) ((((reg)&3)) + 8 * ((reg) >> 2) + 4 * ((lane) >> 5))
#define MFMA(a, b, c) __builtin_amdgcn_mfma_f32_32x32x16_bf16((a), (b), (c), 0, 0, 0)

__device__ __forceinline__ int opaque_tid() {
  int t = threadIdx.x;
  asm volatile("" : "+v"(t));
  return t;
}

__device__ __forceinline__ unsigned long long opaque_u64(unsigned long long v) {
  unsigned lo = (unsigned)v, hi = (unsigned)(v >> 32);
  asm volatile("" : "+v"(lo), "+v"(hi));
  lo = __builtin_amdgcn_readfirstlane(lo);
  hi = __builtin_amdgcn_readfirstlane(hi);
  return ((unsigned long long)hi << 32) | lo;
}

__device__ __forceinline__ f32x16 zero16() {
  f32x16 z;
#pragma unroll
  for (int i = 0; i < 16; ++i) z[i] = 0.f;
  return z;
}

constexpr int G_STAGE_B = 40960;

__device__ __forceinline__ void glds16(const bf16_t* g, const char* l) {
  __builtin_amdgcn_global_load_lds((const unsigned*)g, (unsigned*)const_cast<char*>(l), 16, 0, 0);
}

#define RDFRAGS(F, stg, ok)                                                              \
  do {                                                                                   \
    const char* sa_ = lds + (stg) * G_STAGE_B + wm * 4096 + (ok);                         \
    const char* sb_ = lds + (stg) * G_STAGE_B + 8192 + wn * 8192 + (ok);                  \
    F[0] = *(const bfrag*)(sa_);                                                         \
    F[1] = *(const bfrag*)(sa_ + 2048);                                                  \
    F[2] = *(const bfrag*)(sb_);                                                         \
    F[3] = *(const bfrag*)(sb_ + 2048);                                                  \
    F[4] = *(const bfrag*)(sb_ + 4096);                                                  \
    F[5] = *(const bfrag*)(sb_ + 6144);                                                  \
  } while (0)
#define DOMFMA(F)                                                                        \
  do {                                                                                   \
    _Pragma("unroll") for (int ni_ = 0; ni_ < 4; ++ni_) {                                \
      acc[0][ni_] = MFMA(F[0], F[2 + ni_], acc[0][ni_]);                                 \
      acc[1][ni_] = MFMA(F[1], F[2 + ni_], acc[1][ni_]);                                 \
    }                                                                                    \
  } while (0)
#define ISSUE_SLAB(stg, ntv, krv)                                                        \
  do {                                                                                   \
    const char* st_ = lds + (stg) * G_STAGE_B + w * 1024;                                    \
    glds16(a_src + (krv) * 4096, st_);                                                   \
    const bf16_t* bs_ = b_src + (size_t)((ntv) * nk + (krv)) * 16384;                    \
    _Pragma("unroll") for (int i_ = 0; i_ < 4; ++i_) glds16(bs_ + i_ * 4096, st_ + 8192 + i_ * 8192); \
  } while (0)

#define ISSUE_SLAB_LO(stg, ntv, krv)    \
  do {                                                                                   \
    const char* st_ = lds + (stg) * G_STAGE_B + w * 1024;                                \
    glds16(a_src + (krv) * 4096, st_);                                                   \
    const bf16_t* bs_ = b_src + (size_t)((ntv) * nk + (krv)) * 16384;                    \
    glds16(bs_, st_ + 8192);                                                             \
    glds16(bs_ + 4096, st_ + 8192 + 8192);                                               \
  } while (0)
#define ISSUE_SLAB_HI(stg, ntv, krv)                        \
  do {                                                                                   \
    const char* st_ = lds + (stg) * G_STAGE_B + w * 1024;                                \
    const bf16_t* bs_ = b_src + (size_t)((ntv) * nk + (krv)) * 16384;                    \
    glds16(bs_ + 2 * 4096, st_ + 8192 + 2 * 8192);                                       \
    glds16(bs_ + 3 * 4096, st_ + 8192 + 3 * 8192);                                       \
  } while (0)

template <class Epi>
__device__ __forceinline__ void gemm_panel(const bf16_t* __restrict__ A, const int lda, const bf16_t* __restrict__ Wb,
                                           const int K, const int nN, const Epi epi, bf16_t* smem) {
  const int tid = opaque_tid(), lane = tid & 63;
  const int w = __builtin_amdgcn_readfirstlane(tid >> 6);
  const int wm = w & 1, wn = w >> 1;
  const int nk = K >> 5;
  const int total = nN * nk;
  const int l31 = lane & 31, h = lane >> 5;
  const int grow = lane >> 2;
  const int gch = (lane & 3) ^ ((lane >> 4) & 3);
  const bf16_t* a_src = A + (size_t)(w * 16 + grow) * 32 + gch * 8;
  const bf16_t* b_src = Wb + (size_t)(w * 16 + grow) * 32 + gch * 8;
  const char* lds = (const char*)smem;
  const int pos0 = h ^ ((l31 >> 2) & 3);
  const int offk0 = l31 * 64 + pos0 * 16;
  const int offk1 = l31 * 64 + (pos0 ^ 2) * 16;
  f32x16 acc[2][4];
#pragma unroll
  for (int i = 0; i < 2; ++i)
#pragma unroll
    for (int j = 0; j < 4; ++j) acc[i][j] = zero16();
  const int rot = (int)(((blockIdx.x >> 3) & 31) * nk) >> 5;
  int kr3 = rot, nt3 = 0, cnt3 = 0;
  __syncthreads();
#pragma unroll
  for (int s3 = 0; s3 < 3; ++s3) {
    ISSUE_SLAB(s3, nt3, kr3);
    ++kr3; if (kr3 == nk) kr3 = 0;
    ++cnt3; if (cnt3 == nk) { cnt3 = 0; ++nt3; }
  }
  asm volatile("s_waitcnt vmcnt(10)" ::: "memory");
  asm volatile("s_waitcnt lgkmcnt(0)" ::: "memory");
  __builtin_amdgcn_s_barrier();
  asm volatile("" ::: "memory");
  bfrag F0[6], F1[6];
  RDFRAGS(F0, 0, offk0);
  int ks = 0, nt = 0, stage = 0, stage_n = 1, stage_p = 2;
  int kr3p = 0, nt3p = 0;
  for (int it = 0; it < total; ++it) {
#define SB() __builtin_amdgcn_sched_barrier(0)
#define MM(F, mi_, ni_) acc[mi_][ni_] = MFMA(F[mi_], F[2 + (ni_)], acc[mi_][ni_])
    {
      const char* sa_ = lds + stage * G_STAGE_B + wm * 4096 + offk1;
      const char* sb_ = lds + stage * G_STAGE_B + 8192 + wn * 8192 + offk1;
      const char* stp_ = lds + stage_p * G_STAGE_B + w * 1024;
      const bf16_t* bsp_ = b_src + (size_t)(nt3p * nk + kr3p) * 16384;
      MM(F0, 0, 0); SB();
      F1[0] = *(const bfrag*)(sa_); F1[1] = *(const bfrag*)(sa_ + 2048); SB();
      MM(F0, 1, 0); SB();
      if (it > 0) glds16(bsp_ + 2 * 4096, stp_ + 8192 + 2 * 8192);
      SB();
      MM(F0, 0, 1); SB();
      F1[2] = *(const bfrag*)(sb_); F1[3] = *(const bfrag*)(sb_ + 2048); SB();
      MM(F0, 1, 1); SB();
      if (it > 0) glds16(bsp_ + 3 * 4096, stp_ + 8192 + 3 * 8192);
      SB();
      MM(F0, 0, 2); SB();
      F1[4] = *(const bfrag*)(sb_ + 4096); F1[5] = *(const bfrag*)(sb_ + 6144); SB();
      MM(F0, 1, 2); MM(F0, 0, 3); MM(F0, 1, 3); SB();
    }
    asm volatile("s_waitcnt vmcnt(5)" ::: "memory");
    asm volatile("s_waitcnt lgkmcnt(0)" ::: "memory");
    __builtin_amdgcn_s_barrier();
    asm volatile("" ::: "memory");
    SB();
    {
      const char* sa_ = lds + stage_n * G_STAGE_B + wm * 4096 + offk0;
      const char* sb_ = lds + stage_n * G_STAGE_B + 8192 + wn * 8192 + offk0;
      const char* st_ = lds + stage * G_STAGE_B + w * 1024;
      const bf16_t* bs_ = b_src + (size_t)(nt3 * nk + kr3) * 16384;
      MM(F1, 0, 0); SB();
      glds16(a_src + kr3 * 4096, st_); SB();
      MM(F1, 1, 0); SB();
      F0[0] = *(const bfrag*)(sa_); F0[1] = *(const bfrag*)(sa_ + 2048); SB();
      MM(F1, 0, 1); SB();
      glds16(bs_, st_ + 8192); SB();
      MM(F1, 1, 1); SB();
      F0[2] = *(const bfrag*)(sb_); F0[3] = *(const bfrag*)(sb_ + 2048); SB();
      MM(F1, 0, 2); SB();
      glds16(bs_ + 4096, st_ + 8192 + 8192); SB();
      MM(F1, 1, 2); SB();
      F0[4] = *(const bfrag*)(sb_ + 4096); F0[5] = *(const bfrag*)(sb_ + 6144); SB();
      MM(F1, 0, 3); MM(F1, 1, 3); SB();
    }
    kr3p = kr3; nt3p = nt3;
    ++kr3; if (kr3 == nk) kr3 = 0;
    ++cnt3; if (cnt3 == nk) { cnt3 = 0; ++nt3; }
    if (ks == nk - 1) {
      epi(acc, nt, wm, wn, lane);
#pragma unroll
      for (int i = 0; i < 2; ++i)
#pragma unroll
        for (int j = 0; j < 4; ++j) acc[i][j] = zero16();
      ++nt;
      asm volatile("s_waitcnt vmcnt(0)" ::: "memory");
      RDFRAGS(F0, stage_n, offk0);
    }
    ++ks; if (ks == nk) ks = 0;
    stage_p = stage;
    stage = stage_n;
    ++stage_n; if (stage_n == 3) stage_n = 0;
  }
  asm volatile("s_waitcnt vmcnt(0)" ::: "memory");
  __syncthreads();
}

struct EpiSwiglu {
  bf16_t* act;
  __device__ __forceinline__ void operator()(f32x16 (&acc)[2][4], int nt, int wm, int wn, int lane_in) const {
    int lane = lane_in;
    asm volatile("" : "+v"(lane));
    const int l31 = lane & 31;
#pragma unroll
    for (int mi = 0; mi < 2; ++mi)
#pragma unroll
      for (int n2 = 0; n2 < 2; ++n2)
#pragma unroll
        for (int r = 0; r < 16; ++r) {
          const int row = wm * 64 + mi * 32 + ROWMAP(r, lane);
          const int col = (nt * 4 + wn) * 64 + n2 * 32 + l31;
          const float g = acc[mi][n2][r], u = acc[mi][n2 + 2][r];
          act[ablk(row, col)] = f2bf(silu_f(g) * u);
        }
  }
};
struct EpiResLN {
  float* Hp;
  const float2* st;
  const float* gp;
  const float* bp;
  float alpha, c;
  const float* bias;
  __device__ __forceinline__ void operator()(f32x16 (&acc)[2][4], int nt, int wm, int wn, int lane_in) const {
    int lane = lane_in;
    asm volatile("" : "+v"(lane));
    const int l31 = lane & 31;
    const int rb = wm * 64 + 4 * (lane >> 5);
    float* base = Hp + (size_t)rb * 1024 + nt * 512 + wn * 128 + l31;
#pragma unroll
    for (int ni = 0; ni < 4; ++ni) {
      const int col = nt * 512 + wn * 128 + ni * 32 + l31;
      float ag = alpha, ab = bias ? c * bias[col] : 0.f;
      if (st) { ag = alpha * gp[col]; ab += alpha * bp[col]; }
#pragma unroll
      for (int mi = 0; mi < 2; ++mi) {
        float hv[16];
#pragma unroll
        for (int r = 0; r < 16; ++r) hv[r] = base[(size_t)(mi * 32 + (r & 3) + 8 * (r >> 2)) * 1024 + ni * 32];
#pragma unroll
        for (int r = 0; r < 16; ++r) {
          float mu = 0.f, rs = 1.f;
          if (st) { const float2 ms = st[rb + mi * 32 + (r & 3) + 8 * (r >> 2)]; mu = ms.x; rs = ms.y; }
          base[(size_t)(mi * 32 + (r & 3) + 8 * (r >> 2)) * 1024 + ni * 32] = (hv[r] - mu) * rs * ag + ab + c * acc[mi][ni][r];
        }
        __builtin_amdgcn_sched_barrier(0);
      }
    }
  }
};
struct EpiGelu {
  bf16_t* Z;
  __device__ __forceinline__ void operator()(f32x16 (&acc)[2][4], int nt, int wm, int wn, int lane_in) const {
    int lane = lane_in;
    asm volatile("" : "+v"(lane));
    const int l31 = lane & 31;
#pragma unroll
    for (int ni = 0; ni < 4; ++ni) {
      const int col = nt * 512 + wn * 128 + ni * 32 + l31;
#pragma unroll
      for (int mi = 0; mi < 2; ++mi)
#pragma unroll
        for (int r = 0; r < 16; ++r) {
          const int row = wm * 64 + mi * 32 + ROWMAP(r, lane);
          const float x = acc[mi][ni][r];
          Z[(size_t)row * 2048 + col] = f2bf(0.5f * x * (1.f + erff(x * 0.70710678118654752f)));
        }
    }
  }
};
struct EpiHgrn {
  bf16_t* Qp;
  bf16_t* Vp;
  float* LFp;
  bf16_t* SGp;
  const float* lb;
  __device__ __forceinline__ void operator()(f32x16 (&acc)[2][4], int nt, int wm, int wn, int lane_in) const {
    int lane = lane_in;
    asm volatile("" : "+v"(lane));
    const int l31 = lane & 31;
    const int sec = nt >> 1;
    const int cb = (nt & 1) * 512 + wn * 128 + l31;
    const int rb = wm * 64 + 4 * (lane >> 5);
    if (sec == 0 || sec == 3) {
      bf16_t* dst = (sec == 0) ? Qp : SGp;
#pragma unroll
      for (int ni = 0; ni < 4; ++ni)
#pragma unroll
        for (int mi = 0; mi < 2; ++mi)
#pragma unroll
          for (int r = 0; r < 16; ++r) {
            const int row = rb + mi * 32 + (r & 3) + 8 * (r >> 2);
            dst[(size_t)row * 1024 + cb + ni * 32] = f2bf(silu_f(acc[mi][ni][r]));
          }
    } else if (sec == 1) {
#pragma unroll
      for (int ni = 0; ni < 4; ++ni) {
        const float lbv = lb[cb + ni * 32];
#pragma unroll
        for (int mi = 0; mi < 2; ++mi)
#pragma unroll
          for (int r = 0; r < 16; ++r) {
            const int row = rb + mi * 32 + (r & 3) + 8 * (r >> 2);
            const float f = lbv + (1.f - lbv) * __frcp_rn(1.f + __expf(-acc[mi][ni][r]));
            LFp[(size_t)row * 1024 + cb + ni * 32] = __logf(f);
          }
      }
    } else {
#pragma unroll
      for (int ni = 0; ni < 4; ++ni)
#pragma unroll
        for (int mi = 0; mi < 2; ++mi)
#pragma unroll
          for (int r = 0; r < 16; ++r) {
            const int row = rb + mi * 32 + (r & 3) + 8 * (r >> 2);
            Vp[(size_t)row * 1024 + cb + ni * 32] = f2bf(acc[mi][ni][r]);
          }
    }
  }
};
struct EpiQkv {
  bf16_t* Qp;
  bf16_t* Kp;
  bf16_t* Vp;
  const float* bias;
  __device__ __forceinline__ void operator()(f32x16 (&acc)[2][4], int nt, int wm, int wn, int lane_in) const {
    int lane = lane_in;
    asm volatile("" : "+v"(lane));
    const int l31 = lane & 31;
#pragma unroll
    for (int ni = 0; ni < 4; ++ni) {
      const int col = nt * 512 + wn * 128 + ni * 32 + l31;
      if (col < 1280) {
        const float bv = bias[col];
#pragma unroll
        for (int mi = 0; mi < 2; ++mi)
#pragma unroll
          for (int r = 0; r < 16; ++r) {
            const int row = wm * 64 + mi * 32 + ROWMAP(r, lane);
            const float x = acc[mi][ni][r] + bv;
            if (col < 1024) Qp[(size_t)row * 1024 + col] = f2bf(x * 0.125f);
            else if (col < 1152) Kp[(size_t)row * 128 + (col - 1024)] = f2bf(x);
            else Vp[(size_t)row * 128 + (col - 1152)] = f2bf(x);
          }
      }
    }
  }
};

__device__ __forceinline__ void ln_panel(const float* Hp, float* outp, bf16_t* HBp, const float* g, const float* b,
                                         float2* stg, float2* stl) {
  const int tid = opaque_tid(), lane = tid & 63;
  const int w = __builtin_amdgcn_readfirstlane(tid >> 6);
  float4 gv[4], bv[4];
#pragma unroll
  for (int j = 0; j < 4; ++j) {
    gv[j] = *(const float4*)(g + j * 256 + lane * 4);
    bv[j] = *(const float4*)(b + j * 256 + lane * 4);
  }
  for (int r0 = w; r0 < 128; r0 += 32) {
    float4 x[4][4];
#pragma unroll
    for (int u = 0; u < 4; ++u)
#pragma unroll
      for (int j = 0; j < 4; ++j) x[u][j] = *(const float4*)(Hp + (size_t)(r0 + 8 * u) * 1024 + j * 256 + lane * 4);
#pragma unroll
    for (int u = 0; u < 4; ++u) {
      const int r = r0 + 8 * u;
      float s = 0.f;
#pragma unroll
      for (int j = 0; j < 4; ++j) s += x[u][j].x + x[u][j].y + x[u][j].z + x[u][j].w;
      s = wave_sum(s);
      const float mean = s * (1.f / 1024.f);
      float v = 0.f;
#pragma unroll
      for (int j = 0; j < 4; ++j) {
        x[u][j].x -= mean; x[u][j].y -= mean; x[u][j].z -= mean; x[u][j].w -= mean;
        v += x[u][j].x * x[u][j].x + x[u][j].y * x[u][j].y + x[u][j].z * x[u][j].z + x[u][j].w * x[u][j].w;
      }
      v = wave_sum(v);
      const float rstd = 1.0f / sqrtf(v * (1.f / 1024.f) + 1e-5f);
      if (lane == 0) { stg[r] = make_float2(mean, rstd); stl[r] = make_float2(mean, rstd); }
#pragma unroll
      for (int j = 0; j < 4; ++j) {
        float4 y;
        y.x = x[u][j].x * rstd * gv[j].x + bv[j].x;
        y.y = x[u][j].y * rstd * gv[j].y + bv[j].y;
        y.z = x[u][j].z * rstd * gv[j].z + bv[j].z;
        y.w = x[u][j].w * rstd * gv[j].w + bv[j].w;
        if (outp) *(float4*)(outp + (size_t)r * 1024 + j * 256 + lane * 4) = y;
        uint2 pk;
        pk.x = pack2(y.x, y.y);
        pk.y = pack2(y.z, y.w);
        *(uint2*)(HBp + ablk(r, j * 256 + lane * 4)) = pk;
      }
    }
  }
  __syncthreads();
}

__device__ __forceinline__ void ffn_panel(const Ctx& C, int p, int layer, int j, bool final_out, int sub, bf16_t* smem) {
  const int wi = layer * 2 + j;
  bf16_t* HBp = C.HB() + (size_t)p * 128 * 1024;
  bf16_t* ACTp = C.ACT() + (size_t)p * 128 * 2816;
  float* Hp = C.H() + (size_t)p * 128 * 1024;
  EpiSwiglu e1{ACTp};
  gemm_panel(HBp, 1024, C.WGU() + (size_t)wi * 5632 * 1024, 1024, 11, e1, smem);
  float2* stl = (float2*)((char*)smem + LDS_STATS_OFF);
  float2* stg = C.STATS() + (size_t)p * 128;
  EpiResLN e2{Hp, sub > 0 ? stl : nullptr, C.in[3] + (sub > 0 ? sub - 1 : 0) * 1024, C.in[4] + (sub > 0 ? sub - 1 : 0) * 1024, ALPHA, 0.5f, nullptr};
  gemm_panel(ACTp, 2816, C.WD() + (size_t)wi * 1024 * 2816, 2816, 2, e2, smem);
  const int li = (layer * 3 + (j == 0 ? 0 : 2)) * 1024;
  float* outp = final_out ? (C.out + (size_t)p * 128 * 1024) : nullptr;
  ln_panel(Hp, outp, HBp, C.in[3] + li, C.in[4] + li, stg, stl);
}

__device__ __forceinline__ void gmlp_panel(const Ctx& C, int p, int layer, int slot, int sub, bf16_t* smem) {
  const int tid = opaque_tid(), lane = tid & 63;
  const int w = __builtin_amdgcn_readfirstlane(tid >> 6);
  const int l31 = lane & 31, h8 = (lane >> 5) * 8;
  bf16_t* HBp = C.HB() + (size_t)p * 128 * 1024;
  bf16_t* Zp = C.ACT() + (size_t)p * 128 * 2816;
  float* Hp = C.H() + (size_t)p * 128 * 1024;
  {
    EpiGelu e{Zp};
    gemm_panel(HBp, 1024, C.WGI() + (size_t)slot * 2048 * 1024, 1024, 4, e, smem);
  }
  bf16_t* As = smem;
  bf16_t* Bs = smem + 128 * 136;
  float* st = (float*)(smem + 2 * 128 * 136);
  for (int r = w; r < 128; r += 8) {
    const uint4 q0 = *(const uint4*)(Zp + (size_t)r * 2048 + 1024 + lane * 16);
    const uint4 q1 = *(const uint4*)(Zp + (size_t)r * 2048 + 1024 + lane * 16 + 8);
    const uint32_t u[8] = {q0.x, q0.y, q0.z, q0.w, q1.x, q1.y, q1.z, q1.w};
    float x[16];
    float s = 0.f;
#pragma unroll
    for (int e = 0; e < 8; ++e) {
      x[2 * e] = __uint_as_float(u[e] << 16);
      x[2 * e + 1] = __uint_as_float(u[e] & 0xffff0000u);
      s += x[2 * e] + x[2 * e + 1];
    }
    s = wave_sum(s);
    const float mean = s * (1.f / 1024.f);
    float v = 0.f;
#pragma unroll
    for (int e = 0; e < 16; ++e) { const float d = x[e] - mean; v += d * d; }
    v = wave_sum(v);
    if (lane == 0) { st[r * 2] = mean; st[r * 2 + 1] = 1.0f / sqrtf(v * (1.f / 1024.f) + 1e-5f); }
  }
  __syncthreads();
  const float* lng = C.in[6] + slot * 1024;
  const float* lnb = C.in[7] + slot * 1024;
  const float* bsp = C.in[9] + slot * 1024;
  const bf16_t* Wsp = C.WSP() + (size_t)slot * 8 * 16384;
  const int nd = w & 3, mt0 = (w >> 2) * 2;
  for (int g = 0; g < 8; ++g) {
#pragma unroll
    for (int i = 0; i < 4; ++i) {
      const int c = tid + 512 * i;
      *(uint4*)(As + (c >> 4) * 136 + (c & 15) * 8) = *(const uint4*)(Wsp + (size_t)g * 16384 + c * 8);
    }
    {
      const int s = tid >> 2, dq = tid & 3;
      const float mean = st[s * 2], rstd = st[s * 2 + 1];
      const bf16_t* src = Zp + (size_t)s * 2048 + 1024 + g * 128 + dq * 32;
#pragma unroll
      for (int q = 0; q < 4; ++q) {
        const uint4 v4 = *(const uint4*)(src + q * 8);
        const uint32_t u[4] = {v4.x, v4.y, v4.z, v4.w};
#pragma unroll
        for (int e = 0; e < 4; ++e) {
          const int d0 = dq * 32 + q * 8 + e * 2;
          const int ch = g * 128 + d0;
          const float x0 = __uint_as_float(u[e] << 16), x1 = __uint_as_float(u[e] & 0xffff0000u);
          Bs[d0 * 136 + s] = f2bf((x0 - mean) * rstd * lng[ch] + lnb[ch]);
          Bs[(d0 + 1) * 136 + s] = f2bf((x1 - mean) * rstd * lng[ch + 1] + lnb[ch + 1]);
        }
      }
    }
    __syncthreads();
    f32x16 acc[2];
    acc[0] = zero16(); acc[1] = zero16();
#pragma unroll
    for (int k16 = 0; k16 < 8; ++k16) {
      const bfrag b = *(const bfrag*)(Bs + (nd * 32 + l31) * 136 + k16 * 16 + h8);
#pragma unroll
      for (int mi = 0; mi < 2; ++mi) {
        const bfrag a = *(const bfrag*)(As + ((mt0 + mi) * 32 + l31) * 136 + k16 * 16 + h8);
        acc[mi] = MFMA(a, b, acc[mi]);
      }
    }
#pragma unroll
    for (int mi = 0; mi < 2; ++mi)
#pragma unroll
      for (int r = 0; r < 16; ++r) {
        const int t = (mt0 + mi) * 32 + ROWMAP(r, lane);
        const int ch = g * 128 + nd * 32 + l31;
        const float mixed = acc[mi][r] + bsp[g * 128 + t];
        const float u = bf2f(Zp[(size_t)t * 2048 + ch]);
        HBp[ablk(t, ch)] = f2bf(u * mixed);
      }
    __syncthreads();
  }
  {
    EpiResLN e2{Hp, (float2*)((char*)smem + LDS_STATS_OFF), C.in[3] + (sub - 1) * 1024, C.in[4] + (sub - 1) * 1024, ALPHA, 1.0f, nullptr};
    gemm_panel(HBp, 1024, C.WGO() + (size_t)slot * 1024 * 1024, 1024, 2, e2, smem);
  }
  const int li = (layer * 3 + 1) * 1024;
  ln_panel(Hp, nullptr, HBp, C.in[3] + li, C.in[4] + li, C.STATS() + (size_t)p * 128, (float2*)((char*)smem + LDS_STATS_OFF));
}

template <bool OUT>
__device__ __forceinline__ void hgrn_rec(const Ctx& C, int p, bf16_t* smem) {
  const int tid = opaque_tid(), lane = tid & 63;
  const int w = __builtin_amdgcn_readfirstlane(tid >> 6);
  const int l31 = lane & 31, h8 = (lane >> 5) * 8;
  bf16_t* ST = smem;
  bf16_t* Qh = smem + 17408;
  bf16_t* Kh = smem + 21760;
  bf16_t* KhT = smem + 26112;
  bf16_t* vT = smem + 31232;
  bf16_t* Ps = smem + 36352;
  float* seg = (float*)(smem + 37632);
  float* dec = seg + 512;
  float* oF = dec + 128;
  const size_t row0 = (size_t)p * 128;
  const bf16_t* Qp = C.ACT() + (size_t)p * 128 * 2816;
  const bf16_t* Vp = Qp + 128 * 1024;
  const float* LFp = C.out + row0 * 1024;
  const bf16_t* SGp = C.SG() + row0 * 1024;
  bf16_t* HBp = C.HB() + row0 * 1024;
  const float* ng = C.in[13];
  const int jt = w >> 1, kt0 = (w & 1) * 2;
  const int kq = tid & 127, tq = tid >> 7;
  for (int h = 0; h < 8; ++h) {
    f32x16 accS[2];
    bf16_t* SBh = C.DS() + ((size_t)(p * 8 + h)) * 16384;
    if (OUT) {
      __syncthreads();
#pragma unroll
      for (int i = 0; i < 4; ++i) {
        const int c = tid + 512 * i;
        *(uint4*)(ST + (c >> 4) * 136 + (c & 15) * 8) = *(const uint4*)(SBh + c * 8);
      }
      __syncthreads();
#pragma unroll
      for (int c2 = 0; c2 < 2; ++c2)
#pragma unroll
        for (int r = 0; r < 16; ++r)
          accS[c2][r] = bf2f(ST[(jt * 32 + ROWMAP(r, lane)) * 136 + (kt0 + c2) * 32 + l31]);
    } else {
      accS[0] = zero16(); accS[1] = zero16();
    }
    float dsum = 0.f;
    float ln_[8];
    bf16_t vn_[8], qn_[8];
    {
      const size_t g0 = (size_t)(tq * 8) * 1024 + h * 128 + kq;
#pragma unroll
      for (int e = 0; e < 8; ++e) {
        ln_[e] = LFp[g0 + (size_t)e * 1024];
        vn_[e] = Vp[g0 + (size_t)e * 1024];
        qn_[e] = OUT ? Qp[g0 + (size_t)e * 1024] : (bf16_t)0;
      }
    }
    for (int i = 0; i < 4; ++i) {
      float l[8], cs[8];
      bf16_t vcur[8], qcur[8];
      const size_t gbase = (size_t)(i * 32 + tq * 8) * 1024 + h * 128 + kq;
#pragma unroll
      for (int e = 0; e < 8; ++e) { l[e] = ln_[e]; vcur[e] = vn_[e]; qcur[e] = qn_[e]; }
      if (i < 3) {
        const size_t gn = gbase + (size_t)32 * 1024;
#pragma unroll
        for (int e = 0; e < 8; ++e) {
          ln_[e] = LFp[gn + (size_t)e * 1024];
          vn_[e] = Vp[gn + (size_t)e * 1024];
          if (OUT) qn_[e] = Qp[gn + (size_t)e * 1024];
        }
      }
      cs[0] = l[0];
#pragma unroll
      for (int e = 1; e < 8; ++e) cs[e] = cs[e - 1] + l[e];
      seg[tq * 128 + kq] = cs[7];
#pragma unroll
      for (int e = 0; e < 8; ++e) vT[kq * 40 + tq * 8 + e] = vcur[e];
      __syncthreads();
      float off = 0.f, tot = 0.f;
#pragma unroll
      for (int q = 0; q < 4; ++q) {
        const float s = seg[q * 128 + kq];
        if (q < tq) off += s;
        tot += s;
      }
#pragma unroll
      for (int e = 0; e < 8; ++e) {
        const float gc = cs[e] + off;
        const float f = __expf(l[e]);
        const float kh = (1.f - f) * __expf(-gc);
        const bf16_t khb = f2bf(kh);
        const int t = tq * 8 + e;
        KhT[kq * 40 + t] = khb;
        if (OUT) {
          Kh[t * 136 + kq] = khb;
          const float qv = bf2f(qcur[e]);
          Qh[t * 136 + kq] = f2bf(qv * __expf(gc));
        }
      }
      if (tq == 0) { dec[kq] = __expf(tot); dsum += tot; }
      __syncthreads();
      f32x16 accO = zero16();
      if (OUT) {
        if (w == 0) {
          f32x16 accP = zero16();
#pragma unroll
          for (int k16 = 0; k16 < 8; ++k16) {
            const bfrag a = *(const bfrag*)(Qh + l31 * 136 + k16 * 16 + h8);
            const bfrag b = *(const bfrag*)(Kh + l31 * 136 + k16 * 16 + h8);
            accP = MFMA(a, b, accP);
          }
#pragma unroll
          for (int r = 0; r < 16; ++r) {
            const int t = ROWMAP(r, lane);
            Ps[t * 40 + l31] = (l31 <= t) ? f2bf(accP[r]) : (bf16_t)0;
          }
        } else if (w <= 4) {
          const int nt = w - 1;
#pragma unroll
          for (int k16 = 0; k16 < 8; ++k16) {
            const bfrag a = *(const bfrag*)(Qh + l31 * 136 + k16 * 16 + h8);
            const bfrag b = *(const bfrag*)(ST + (nt * 32 + l31) * 136 + k16 * 16 + h8);
            accO = MFMA(a, b, accO);
          }
        }
        __syncthreads();
        if (w >= 1 && w <= 4) {
          const int nt = w - 1;
#pragma unroll
          for (int k16 = 0; k16 < 2; ++k16) {
            const bfrag a = *(const bfrag*)(Ps + l31 * 40 + k16 * 16 + h8);
            const bfrag b = *(const bfrag*)(vT + (nt * 32 + l31) * 40 + k16 * 16 + h8);
            accO = MFMA(a, b, accO);
          }
#pragma unroll
          for (int r = 0; r < 16; ++r) oF[ROWMAP(r, lane) * 132 + nt * 32 + l31] = accO[r];
        }
      }
#pragma unroll
      for (int c2 = 0; c2 < 2; ++c2) {
#pragma unroll
        for (int k16 = 0; k16 < 2; ++k16) {
          const bfrag a = *(const bfrag*)(vT + (jt * 32 + l31) * 40 + k16 * 16 + h8);
          const bfrag b = *(const bfrag*)(KhT + ((kt0 + c2) * 32 + l31) * 40 + k16 * 16 + h8);
          accS[c2] = MFMA(a, b, accS[c2]);
        }
        const float dk = dec[(kt0 + c2) * 32 + l31];
#pragma unroll
        for (int r = 0; r < 16; ++r) accS[c2][r] *= dk;
        if (OUT) {
#pragma unroll
          for (int r = 0; r < 16; ++r)
            ST[(jt * 32 + ROWMAP(r, lane)) * 136 + (kt0 + c2) * 32 + l31] = f2bf(accS[c2][r]);
        }
      }
      __syncthreads();
      if (OUT) {
        const int t = tid >> 4, part = tid & 15;
        float x[8];
        float ss = 0.f;
#pragma unroll
        for (int e = 0; e < 8; ++e) { x[e] = oF[t * 132 + part * 8 + e]; ss += x[e] * x[e]; }
        ss += __shfl_xor(ss, 1, 64); ss += __shfl_xor(ss, 2, 64); ss += __shfl_xor(ss, 4, 64); ss += __shfl_xor(ss, 8, 64);
        const float rr = 1.0f / sqrtf(ss * (1.f / 128.f) + 1e-6f);
        const size_t gro = (size_t)(i * 32 + t) * 1024 + h * 128 + part * 8;
        const uint4 sg4 = *(const uint4*)(SGp + gro);
        const uint32_t su[4] = {sg4.x, sg4.y, sg4.z, sg4.w};
        uint32_t ov[4];
#pragma unroll
        for (int e = 0; e < 4; ++e) {
          const float g0 = ng[part * 8 + 2 * e], g1 = ng[part * 8 + 2 * e + 1];
          const float s0 = __uint_as_float(su[e] << 16), s1 = __uint_as_float(su[e] & 0xffff0000u);
          ov[e] = pack2(x[2 * e] * rr * g0 * s0, x[2 * e + 1] * rr * g1 * s1);
        }
        uint4 o4; o4.x = ov[0]; o4.y = ov[1]; o4.z = ov[2]; o4.w = ov[3];
        *(uint4*)(HBp + ablk(i * 32 + t, h * 128 + part * 8)) = o4;
      }
    }
    if (!OUT) {
#pragma unroll
      for (int c2 = 0; c2 < 2; ++c2)
#pragma unroll
        for (int r = 0; r < 16; ++r)
          SBh[(jt * 32 + ROWMAP(r, lane)) * 128 + (kt0 + c2) * 32 + l31] = f2bf(accS[c2][r]);
      if (tq == 0) C.DEC()[(size_t)(p * 8 + h) * 128 + kq] = __expf(dsum);
    }
  }
  __syncthreads();
}

__device__ __forceinline__ void hgrn_scan(const Ctx& C) {
  for (int gid = blockIdx.x * 512 + threadIdx.x; gid < 131072; gid += gridDim.x * 512) {
    const int kp = gid & 63, j = (gid >> 6) & 127, h = (gid >> 13) & 7, b = gid >> 16;
    float s0 = 0.f, s1 = 0.f;
    for (int c0 = 0; c0 < 128; c0 += 8) {
      uint32_t d[8];
      float2 dc[8];
#pragma unroll
      for (int e = 0; e < 8; ++e) {
        const size_t ph = (size_t)((b * 128 + c0 + e) * 8 + h);
        d[e] = *(const uint32_t*)(C.DS() + ph * 16384 + j * 128 + kp * 2);
        dc[e] = *(const float2*)(C.DEC() + ph * 128 + kp * 2);
      }
#pragma unroll
      for (int e = 0; e < 8; ++e) {
        const size_t ph = (size_t)((b * 128 + c0 + e) * 8 + h);
        *(uint32_t*)(C.DS() + ph * 16384 + j * 128 + kp * 2) = pack2(s0, s1);
        s0 = dc[e].x * s0 + __uint_as_float(d[e] << 16);
        s1 = dc[e].y * s1 + __uint_as_float(d[e] & 0xffff0000u);
      }
    }
  }
}

__device__ __forceinline__ void attn_panel(const Ctx& C, int p, bf16_t* smem) {
  const int tid = opaque_tid(), lane = tid & 63;
  const int w = __builtin_amdgcn_readfirstlane(tid >> 6);
  const int l31 = lane & 31, h8 = (lane >> 5) * 8;
  bf16_t* K2 = smem;
  bf16_t* VT = smem + 18432;
  bf16_t* Pw = smem + 35328 + w * 1280;
  const int blk = p & 127;
  const size_t row0 = (size_t)p * 128;
  const bf16_t* Qp = C.ACT() + (size_t)p * 128 * 2816;
  bf16_t* HBp = C.HB() + row0 * 1024;
  const int qt = w & 3;
  for (int hk = 0; hk < 2; ++hk) {
    __syncthreads();
#pragma unroll
    for (int i = 0; i < 4; ++i) {
      const int c = tid + 512 * i;
      const int r = c >> 3, ch = c & 7;
      uint4 kv = make_uint4(0, 0, 0, 0), vv = make_uint4(0, 0, 0, 0);
      if (blk > 0 || r >= 128) {
        const size_t tok = row0 + r - 128;
        kv = *(const uint4*)(C.KB() + tok * 128 + hk * 64 + ch * 8);
        vv = *(const uint4*)(C.VB() + tok * 128 + hk * 64 + ch * 8);
      }
      *(uint4*)(K2 + r * 72 + ch * 8) = kv;
      const uint32_t vu[4] = {vv.x, vv.y, vv.z, vv.w};
#pragma unroll
      for (int e = 0; e < 4; ++e) {
        VT[(ch * 8 + 2 * e) * 264 + r] = (bf16_t)(vu[e] & 0xffffu);
        VT[(ch * 8 + 2 * e + 1) * 264 + r] = (bf16_t)(vu[e] >> 16);
      }
    }
    __syncthreads();
    for (int u = 0; u < 4; ++u) {
      const int hq = hk * 8 + (w >> 2) * 4 + u;
      const float sink = C.in[17][hq];
      bfrag aq[4];
#pragma unroll
      for (int k16 = 0; k16 < 4; ++k16)
        aq[k16] = *(const bfrag*)(Qp + (size_t)(qt * 32 + l31) * 1024 + hq * 64 + k16 * 16 + h8);
      f32x16 s[5];
#pragma unroll
      for (int c = 0; c < 5; ++c) {
        s[c] = zero16();
#pragma unroll
        for (int k16 = 0; k16 < 4; ++k16) {
          const bfrag b = *(const bfrag*)(K2 + ((qt + c) * 32 + l31) * 72 + k16 * 16 + h8);
          s[c] = MFMA(aq[k16], b, s[c]);
        }
      }
      float linv[16];
#pragma unroll
      for (int r = 0; r < 16; ++r) {
        const int qi = qt * 32 + ROWMAP(r, lane);
        float m = -1e30f;
#pragma unroll
        for (int c = 0; c < 5; ++c) {
          const int kp = (qt + c) * 32 + l31;
          const bool valid = (kp > qi) && (kp <= qi + 128) && (blk > 0 || kp >= 128);
          const float v = valid ? s[c][r] : -1e30f;
          s[c][r] = v;
          m = fmaxf(m, v);
        }
        m = fmaxf(m, __shfl_xor(m, 16, 64)); m = fmaxf(m, __shfl_xor(m, 8, 64)); m = fmaxf(m, __shfl_xor(m, 4, 64));
        m = fmaxf(m, __shfl_xor(m, 2, 64)); m = fmaxf(m, __shfl_xor(m, 1, 64));
        m = fmaxf(m, sink);
        float sum = 0.f;
#pragma unroll
        for (int c = 0; c < 5; ++c) {
          const float pv = (s[c][r] > -1e29f) ? __expf(s[c][r] - m) : 0.f;
          s[c][r] = pv;
          sum += pv;
        }
        sum += __shfl_xor(sum, 16, 64); sum += __shfl_xor(sum, 8, 64); sum += __shfl_xor(sum, 4, 64);
        sum += __shfl_xor(sum, 2, 64); sum += __shfl_xor(sum, 1, 64);
        sum += __expf(sink - m);
        linv[r] = 1.f / sum;
      }
      f32x16 o[2];
      o[0] = zero16(); o[1] = zero16();
#pragma unroll
      for (int c = 0; c < 5; ++c) {
#pragma unroll
        for (int r = 0; r < 16; ++r) Pw[ROWMAP(r, lane) * 40 + l31] = f2bf(s[c][r]);
        __syncthreads();
#pragma unroll
        for (int k16 = 0; k16 < 2; ++k16) {
          const bfrag a = *(const bfrag*)(Pw + l31 * 40 + k16 * 16 + h8);
#pragma unroll
          for (int dt = 0; dt < 2; ++dt) {
            const bfrag b = *(const bfrag*)(VT + (dt * 32 + l31) * 264 + (qt + c) * 32 + k16 * 16 + h8);
            o[dt] = MFMA(a, b, o[dt]);
          }
        }
        __syncthreads();
      }
#pragma unroll
      for (int dt = 0; dt < 2; ++dt)
#pragma unroll
        for (int r = 0; r < 16; ++r)
          HBp[ablk(qt * 32 + ROWMAP(r, lane), hq * 64 + dt * 32 + l31)] = f2bf(o[dt][r] * linv[r]);
    }
  }
  __syncthreads();
}

__device__ __forceinline__ void conv_weights(const float* __restrict__ src, bf16_t* __restrict__ dst, int nmat, int K,
                                             int Nsrc, int Ndst, int mode) {
  const int nk = K >> 5, nNt = Ndst >> 9;
  const int upm = nk * nNt;
  const int tid = threadIdx.x;
  for (int u = blockIdx.x; u < nmat * upm; u += gridDim.x) {
    const int m = u / upm, r = u - m * upm;
    const int nt = r / nk, ks = r - nt * nk;
    const int np = nt * 512 + tid;
    int sc;
    if (mode == 1) {
      const int b = np >> 7, rr = np & 127;
      sc = (rr < 64) ? (b * 64 + rr) : (2816 + b * 64 + rr - 64);
    } else {
      sc = (np < Nsrc) ? np : -1;
    }
    const float* s = src + (size_t)m * K * Nsrc + (size_t)(ks * 32) * Nsrc + (sc < 0 ? 0 : sc);
    uint32_t pk[16];
#pragma unroll
    for (int kk = 0; kk < 16; ++kk) {
      float v0 = s[(size_t)(2 * kk) * Nsrc], v1 = s[(size_t)(2 * kk + 1) * Nsrc];
      if (sc < 0) { v0 = 0.f; v1 = 0.f; }
      pk[kk] = pack2(v0, v1);
    }
    uint4* d = (uint4*)(dst + (size_t)m * K * Ndst + (size_t)(nt * nk + ks) * 16384 + tid * 32);
    d[0] = make_uint4(pk[0], pk[1], pk[2], pk[3]);
    d[1] = make_uint4(pk[4], pk[5], pk[6], pk[7]);
    d[2] = make_uint4(pk[8], pk[9], pk[10], pk[11]);
    d[3] = make_uint4(pk[12], pk[13], pk[14], pk[15]);
  }
}

__device__ __forceinline__ void phase0(const Ctx& C) {
  conv_weights(C.in[1], C.WGU(), 8, 1024, 5632, 5632, 1);
  conv_weights(C.in[2], C.WD(), 8, 2816, 1024, 1024, 0);
  conv_weights(C.in[5], C.WGI(), 2, 1024, 2048, 2048, 0);
  conv_weights(C.in[10], C.WGO(), 2, 1024, 1024, 1024, 0);
  conv_weights(C.in[11], C.WHI(), 1, 1024, 4096, 4096, 0);
  conv_weights(C.in[14], C.WHO(), 1, 1024, 1024, 1024, 0);
  conv_weights(C.in[15], C.WQKV(), 1, 1024, 1280, 1536, 0);
  conv_weights(C.in[18], C.WAO(), 1, 1024, 1024, 1024, 0);
  const size_t gtid = (size_t)blockIdx.x * 512 + threadIdx.x;
  const size_t gsz = (size_t)gridDim.x * 512;
  for (size_t i = gtid; i < (size_t)T_TOK * 1024 / 4; i += gsz) {
    const float4 v = ((const float4*)C.in[0])[i];
    ((float4*)C.H())[i] = v;
    uint2 pk;
    pk.x = pack2(v.x, v.y);
    pk.y = pack2(v.z, v.w);
    {
      const int row = (int)(i >> 8), col = (int)(i & 255) * 4;
      *(uint2*)(C.HB() + (size_t)(row >> 7) * 131072 + ablk(row & 127, col)) = pk;
    }
  }
  for (size_t i = gtid; i < (size_t)2 * 8 * 128 * 128; i += gsz) {
    const int s = (int)(i & 127), t = (int)((i >> 7) & 127);
    C.WSP()[i] = (s <= t) ? f2bf(C.in[8][i]) : (bf16_t)0;
  }
  for (size_t i = gtid; i < 1024; i += gsz) {
    const float* lp = C.in[12];
    const float a0 = lp[i], a1 = lp[1024 + i], a2 = lp[2048 + i], a3 = lp[3072 + i];
    const float m = fmaxf(fmaxf(a0, a1), fmaxf(a2, a3));
    const float e0 = expf(a0 - m), e1 = expf(a1 - m), e2 = expf(a2 - m), e3 = expf(a3 - m);
    C.LB()[i] = e1 / (e0 + e1 + e2 + e3);
  }
}

enum { OP_FFN = 0, OP_GMLP = 1, OP_HIN = 2, OP_HOUT = 3, OP_QKV = 4, OP_ATTN = 5 };

__device__ __forceinline__ void run_ops(const Ctx& C0, int op_lo, int op_hi, bf16_t* smem) {
  for (int p0 = blockIdx.x; p0 < NPANEL; p0 += gridDim.x) {
    for (int op = op_lo; op < op_hi; ++op) {
      const Ctx& C = C0;
      const int p = p0;
      bf16_t* HBp = C.HB() + (size_t)p * 128 * 1024;
      float* Hp = C.H() + (size_t)p * 128 * 1024;
      bf16_t* ACTp = C.ACT() + (size_t)p * 128 * 2816;
      int kind = OP_FFN, layer = 0, j = 0, sub = 0;
      switch (op) {
        case 0: kind = OP_FFN; layer = 0; j = 0; sub = 0; break;
        case 1: kind = OP_GMLP; layer = 0; j = 0; sub = 1; break;
        case 2: kind = OP_FFN; layer = 0; j = 1; sub = 2; break;
        case 3: kind = OP_FFN; layer = 1; j = 0; sub = 3; break;
        case 4: kind = OP_HIN; layer = 1; break;
        case 5: kind = OP_HOUT; layer = 1; sub = 4; break;
        case 6: kind = OP_FFN; layer = 1; j = 1; sub = 5; break;
        case 7: kind = OP_FFN; layer = 2; j = 0; sub = 6; break;
        case 8: kind = OP_QKV; layer = 2; break;
        case 9: kind = OP_ATTN; layer = 2; sub = 7; break;
        case 10: kind = OP_FFN; layer = 2; j = 1; sub = 8; break;
        case 11: kind = OP_FFN; layer = 3; j = 0; sub = 9; break;
        case 12: kind = OP_GMLP; layer = 3; j = 1; sub = 10; break;
        default: kind = OP_FFN; layer = 3; j = 1; sub = 11; break;
      }
      float2* stl = (float2*)((char*)smem + LDS_STATS_OFF);
      float2* stg = C.STATS() + (size_t)p * 128;
      if (threadIdx.x < 128) stl[threadIdx.x] = stg[threadIdx.x];
      if (kind == OP_FFN) {
        ffn_panel(C, p, layer, j, op == 13, sub, smem);
      } else if (kind == OP_GMLP) {
        gmlp_panel(C, p, layer, j, sub, smem);
      } else if (kind == OP_HIN) {
        EpiHgrn e{ACTp, ACTp + 128 * 1024, C.out + (size_t)p * 128 * 1024, C.SG() + (size_t)p * 128 * 1024, C.LB()};
        gemm_panel(HBp, 1024, C.WHI(), 1024, 8, e, smem);
        hgrn_rec<false>(C, p, smem);
      } else if (kind == OP_HOUT) {
        hgrn_rec<true>(C, p, smem);
        EpiResLN e2{Hp, stl, C.in[3] + (sub - 1) * 1024, C.in[4] + (sub - 1) * 1024, ALPHA, 1.0f, nullptr};
        gemm_panel(HBp, 1024, C.WHO(), 1024, 2, e2, smem);
        const int li = (1 * 3 + 1) * 1024;
        ln_panel(Hp, nullptr, HBp, C.in[3] + li, C.in[4] + li, stg, stl);
      } else if (kind == OP_QKV) {
        EpiQkv e{ACTp, C.KB() + (size_t)p * 128 * 128, C.VB() + (size_t)p * 128 * 128, C.in[16]};
        gemm_panel(HBp, 1024, C.WQKV(), 1024, 3, e, smem);
      } else {
        attn_panel(C, p, smem);
        EpiResLN e2{Hp, stl, C.in[3] + (sub - 1) * 1024, C.in[4] + (sub - 1) * 1024, ALPHA, 1.0f, C.in[19]};
        gemm_panel(HBp, 1024, C.WAO(), 1024, 2, e2, smem);
        const int li = (2 * 3 + 1) * 1024;
        ln_panel(Hp, nullptr, HBp, C.in[3] + li, C.in[4] + li, stg, stl);
      }
    }
  }
}

#if COOP
__device__ __forceinline__ void grid_barrier(unsigned* bar, unsigned target) {
  __syncthreads();
  if (threadIdx.x == 0) {
    __threadfence();
    __hip_atomic_fetch_add(bar, 1u, __ATOMIC_RELEASE, __HIP_MEMORY_SCOPE_AGENT);
    while (__hip_atomic_load(bar, __ATOMIC_ACQUIRE, __HIP_MEMORY_SCOPE_AGENT) < target) __builtin_amdgcn_s_sleep(8);
    __threadfence();
  }
  __syncthreads();
}

__global__ void __launch_bounds__(512) mega(Params P) {
  extern __shared__ __attribute__((aligned(16))) unsigned char lds_raw[];
  bf16_t* smem = (bf16_t*)lds_raw;
  Ctx C;
  C.in = P.in;
  C.out = P.out;
  C.ws = P.ws;
  const int lo = P.ph_lo, hi = P.ph_hi;
#if COOP
  if (lo < 0) cg::this_grid().sync();
  unsigned* bar = (unsigned*)(P.ws + OFF_BAR);
#define GSYNC(k) do { if (lo <= (k) && (k) + 1 < hi) grid_barrier(bar, (unsigned)((k) + 1) * gridDim.x); } while (0)
#else
#define GSYNC(k) do { } while (0)
#endif
  if (lo <= 0 && 0 < hi) phase0(C);
  GSYNC(0);
  if (lo <= 1 && 1 < hi) run_ops(C, 0, 5, smem);
  GSYNC(1);
  if (lo <= 2 && 2 < hi) hgrn_scan(C);
  GSYNC(2);
  if (lo <= 3 && 3 < hi) run_ops(C, 5, 9, smem);
  GSYNC(3);
  if (lo <= 4 && 4 < hi) run_ops(C, 9, 14, smem);
}

#endif

extern "C" void kernel_launch(void* const* d_in, const int* in_sizes, int n_in, void* d_out, int out_size, void* d_ws,
                              size_t ws_size, hipStream_t stream) {
  static int grid_blocks = 0;
  if (grid_blocks == 0) {
    if (n_in != 20 || ws_size < WS_END) {
      fprintf(stderr, "kernel_launch: unexpected n_in %d or ws_size %zu (need %zu)\n", n_in, ws_size, (size_t)WS_END);
      grid_blocks = -1;
      return;
    }
    int dev = 0, cus = 0, per_cu = 0;
    hipGetDevice(&dev);
    hipDeviceGetAttribute(&cus, hipDeviceAttributeMultiprocessorCount, dev);
#if COOP
    if (hipFuncSetAttribute((const void*)mega, hipFuncAttributeMaxDynamicSharedMemorySize, LDS_BYTES) != hipSuccess)
      fprintf(stderr, "kernel_launch: hipFuncSetAttribute failed\n");
    hipOccupancyMaxActiveBlocksPerMultiprocessor(&per_cu, (const void*)mega, 512, LDS_BYTES);
#endif
    (void)hipGetLastError();
    if (per_cu < 1) per_cu = 1;
    grid_blocks = cus * per_cu;
    if (grid_blocks > NPANEL) grid_blocks = NPANEL;
    if (grid_blocks < 1) grid_blocks = NPANEL;
  }
  if (grid_blocks < 0) return;
  Params P{};
  for (int i = 0; i < 20; ++i) P.in[i] = (const float*)d_in[i];
  P.out = (float*)d_out;
  P.ws = (unsigned char*)d_ws;
#if COOP
  P.ph_lo = 0; P.ph_hi = 5;
  (void)hipMemsetAsync((unsigned char*)d_ws + OFF_BAR, 0, 256, stream);
  void* args[] = {&P};
  hipError_t e = hipLaunchCooperativeKernel((const void*)mega, dim3(grid_blocks), dim3(512), args, LDS_BYTES, stream);
  if (e != hipSuccess) fprintf(stderr, "cooperative launch failed: %s (grid %d)\n", hipGetErrorString(e), grid_blocks);
#endif
}
```

```cpp
#include <hip/hip_runtime.h>
#include <hip/hip_cooperative_groups.h>
#include <stdint.h>
#include <stdio.h>
namespace cg = cooperative_groups;

#ifndef COOP
#define COOP 1
#endif

typedef unsigned short bf16_t;
typedef __attribute__((ext_vector_type(8))) __bf16 bfrag;
typedef __attribute__((ext_vector_type(16))) float f32x16;

constexpr int T_TOK = 32768;
constexpr int NPANEL = 256;
constexpr float ALPHA = 1.6817928305074290f;
constexpr int LDS_BYTES = 123904;
constexpr int LDS_STATS_OFF = 122880;

constexpr size_t SZ_WGU = (size_t)8 * 5632 * 1024 * 2;
constexpr size_t SZ_WD = (size_t)8 * 1024 * 2816 * 2;
constexpr size_t SZ_WGI = (size_t)2 * 2048 * 1024 * 2;
constexpr size_t SZ_WGO = (size_t)2 * 1024 * 1024 * 2;
constexpr size_t SZ_WSP = (size_t)2 * 8 * 128 * 128 * 2;
constexpr size_t SZ_WHI = (size_t)4096 * 1024 * 2;
constexpr size_t SZ_WHO = (size_t)1024 * 1024 * 2;
constexpr size_t SZ_WQKV = (size_t)1536 * 1024 * 2;
constexpr size_t SZ_WAO = (size_t)1024 * 1024 * 2;
constexpr size_t SZ_LB = 4096;
constexpr size_t SZ_H = (size_t)T_TOK * 1024 * 4;
constexpr size_t SZ_HB = (size_t)T_TOK * 1024 * 2;
constexpr size_t SZ_ACT = (size_t)T_TOK * 2816 * 2;
constexpr size_t SZ_SG = (size_t)T_TOK * 1024 * 2;
constexpr size_t SZ_DS = (size_t)NPANEL * 8 * 128 * 128 * 2;
constexpr size_t SZ_DEC = (size_t)NPANEL * 8 * 128 * 4;
constexpr size_t SZ_KB = (size_t)T_TOK * 128 * 2;

constexpr size_t OFF_WGU = 0;
constexpr size_t OFF_WD = OFF_WGU + SZ_WGU;
constexpr size_t OFF_WGI = OFF_WD + SZ_WD;
constexpr size_t OFF_WGO = OFF_WGI + SZ_WGI;
constexpr size_t OFF_WSP = OFF_WGO + SZ_WGO;
constexpr size_t OFF_WHI = OFF_WSP + SZ_WSP;
constexpr size_t OFF_WHO = OFF_WHI + SZ_WHI;
constexpr size_t OFF_WQKV = OFF_WHO + SZ_WHO;
constexpr size_t OFF_WAO = OFF_WQKV + SZ_WQKV;
constexpr size_t OFF_LB = OFF_WAO + SZ_WAO;
constexpr size_t OFF_H = OFF_LB + SZ_LB;
constexpr size_t OFF_HB = OFF_H + SZ_H;
constexpr size_t OFF_ACT = OFF_HB + SZ_HB;
constexpr size_t OFF_SG = OFF_ACT + SZ_ACT;
constexpr size_t OFF_DS = OFF_SG + SZ_SG;
constexpr size_t OFF_DEC = OFF_DS + SZ_DS;
constexpr size_t OFF_KB = OFF_DEC + SZ_DEC;
constexpr size_t OFF_VB = OFF_KB + SZ_KB;
constexpr size_t OFF_BAR = OFF_VB + SZ_KB;
constexpr size_t OFF_STATS = OFF_BAR + 256;
constexpr size_t WS_END = OFF_STATS + (size_t)T_TOK * 8;

struct Params {
  const float* in[20];
  float* out;
  unsigned char* ws;
  int ph_lo, ph_hi;
};

struct Ctx {
  const float* const* in;
  float* out;
  unsigned char* ws;
  __device__ __forceinline__ bf16_t* WGU() const { return (bf16_t*)(ws + OFF_WGU); }
  __device__ __forceinline__ bf16_t* WD() const { return (bf16_t*)(ws + OFF_WD); }
  __device__ __forceinline__ bf16_t* WGI() const { return (bf16_t*)(ws + OFF_WGI); }
  __device__ __forceinline__ bf16_t* WGO() const { return (bf16_t*)(ws + OFF_WGO); }
  __device__ __forceinline__ bf16_t* WSP() const { return (bf16_t*)(ws + OFF_WSP); }
  __device__ __forceinline__ bf16_t* WHI() const { return (bf16_t*)(ws + OFF_WHI); }
  __device__ __forceinline__ bf16_t* WHO() const { return (bf16_t*)(ws + OFF_WHO); }
  __device__ __forceinline__ bf16_t* WQKV() const { return (bf16_t*)(ws + OFF_WQKV); }
  __device__ __forceinline__ bf16_t* WAO() const { return (bf16_t*)(ws + OFF_WAO); }
  __device__ __forceinline__ float* LB() const { return (float*)(ws + OFF_LB); }
  __device__ __forceinline__ float* H() const { return (float*)(ws + OFF_H); }
  __device__ __forceinline__ bf16_t* HB() const { return (bf16_t*)(ws + OFF_HB); }
  __device__ __forceinline__ bf16_t* ACT() const { return (bf16_t*)(ws + OFF_ACT); }
  __device__ __forceinline__ bf16_t* SG() const { return (bf16_t*)(ws + OFF_SG); }
  __device__ __forceinline__ bf16_t* DS() const { return (bf16_t*)(ws + OFF_DS); }
  __device__ __forceinline__ float* DEC() const { return (float*)(ws + OFF_DEC); }
  __device__ __forceinline__ bf16_t* KB() const { return (bf16_t*)(ws + OFF_KB); }
  __device__ __forceinline__ bf16_t* VB() const { return (bf16_t*)(ws + OFF_VB); }
  __device__ __forceinline__ float2* STATS() const { return (float2*)(ws + OFF_STATS); }
};

typedef __attribute__((ext_vector_type(2))) float f32x2_t;
typedef __attribute__((ext_vector_type(2))) __bf16 bf16x2_t;
__device__ __forceinline__ uint32_t pack2(float a, float b) {
  f32x2_t v = {a, b};
  bf16x2_t r = __builtin_convertvector(v, bf16x2_t);
  return __builtin_bit_cast(uint32_t, r);
}
__device__ __forceinline__ bf16_t f2bf(float f) { return (bf16_t)(pack2(f, 0.f) & 0xffffu); }
__device__ __forceinline__ float bf2f(bf16_t b) { return __uint_as_float(((uint32_t)b) << 16); }
__device__ __forceinline__ float dpp_add(float v, const int ctrl_quad_perm_b1, const int which) {
  int x = __builtin_bit_cast(int, v), y;
  if (which == 0) y = __builtin_amdgcn_update_dpp(0, x, 0xB1, 0xF, 0xF, true);
  else if (which == 1) y = __builtin_amdgcn_update_dpp(0, x, 0x4E, 0xF, 0xF, true);
  else if (which == 2) y = __builtin_amdgcn_update_dpp(0, x, 0x141, 0xF, 0xF, true);
  else y = __builtin_amdgcn_update_dpp(0, x, 0x140, 0xF, 0xF, true);
  (void)ctrl_quad_perm_b1;
  return v + __builtin_bit_cast(float, y);
}
__device__ __forceinline__ float wave_sum(float v) {
  v = dpp_add(v, 0, 0);
  v = dpp_add(v, 0, 1);
  v = dpp_add(v, 0, 2);
  v = dpp_add(v, 0, 3);
  const int x = __builtin_bit_cast(int, v);
  const float s0 = __builtin_bit_cast(float, __builtin_amdgcn_readlane(x, 0));
  const float s1 = __builtin_bit_cast(float, __builtin_amdgcn_readlane(x, 16));
  const float s2 = __builtin_bit_cast(float, __builtin_amdgcn_readlane(x, 32));
  const float s3 = __builtin_bit_cast(float, __builtin_amdgcn_readlane(x, 48));
  return (s0 + s1) + (s2 + s3);
}
__device__ __forceinline__ size_t ablk(int row, int col) { return (size_t)(col >> 5) * 4096 + row * 32 + (col & 31); }
__device__ __forceinline__ float silu_f(float x) { return x * __builtin_amdgcn_rcpf(1.f + __expf(-x)); }
#define ROWMAP(reg, lane) ((((reg)&3)) + 8 * ((reg) >> 2) + 4 * ((lane) >> 5))
#define MFMA(a, b, c) __builtin_amdgcn_mfma_f32_32x32x16_bf16((a), (b), (c), 0, 0, 0)

__device__ __forceinline__ int opaque_tid() {
  int t = threadIdx.x;
  asm volatile("" : "+v"(t));
  return t;
}

__device__ __forceinline__ unsigned long long opaque_u64(unsigned long long v) {
  unsigned lo = (unsigned)v, hi = (unsigned)(v >> 32);
  asm volatile("" : "+v"(lo), "+v"(hi));
  lo = __builtin_amdgcn_readfirstlane(lo);
  hi = __builtin_amdgcn_readfirstlane(hi);
  return ((unsigned long long)hi << 32) | lo;
}

__device__ __forceinline__ f32x16 zero16() {
  f32x16 z;
#pragma unroll
  for (int i = 0; i < 16; ++i) z[i] = 0.f;
  return z;
}

constexpr int G_STAGE_B = 40960;

__device__ __forceinline__ void glds16(const bf16_t* g, const char* l) {
  __builtin_amdgcn_global_load_lds((const unsigned*)g, (unsigned*)const_cast<char*>(l), 16, 0, 0);
}

#define RDFRAGS(F, stg, ok)                                                              \
  do {                                                                                   \
    const char* sa_ = lds + (stg) * G_STAGE_B + wm * 4096 + (ok);                         \
    const char* sb_ = lds + (stg) * G_STAGE_B + 8192 + wn * 8192 + (ok);                  \
    F[0] = *(const bfrag*)(sa_);                                                         \
    F[1] = *(const bfrag*)(sa_ + 2048);                                                  \
    F[2] = *(const bfrag*)(sb_);                                                         \
    F[3] = *(const bfrag*)(sb_ + 2048);                                                  \
    F[4] = *(const bfrag*)(sb_ + 4096);                                                  \
    F[5] = *(const bfrag*)(sb_ + 6144);                                                  \
  } while (0)
#define DOMFMA(F)                                                                        \
  do {                                                                                   \
    _Pragma("unroll") for (int ni_ = 0; ni_ < 4; ++ni_) {                                \
      acc[0][ni_] = MFMA(F[0], F[2 + ni_], acc[0][ni_]);                                 \
      acc[1][ni_] = MFMA(F[1], F[2 + ni_], acc[1][ni_]);                                 \
    }                                                                                    \
  } while (0)
#define ISSUE_SLAB(stg, ntv, krv)                                                        \
  do {                                                                                   \
    const char* st_ = lds + (stg) * G_STAGE_B + w * 1024;                                    \
    glds16(a_src + (krv) * 4096, st_);                                                   \
    const bf16_t* bs_ = b_src + (size_t)((ntv) * nk + (krv)) * 16384;                    \
    _Pragma("unroll") for (int i_ = 0; i_ < 4; ++i_) glds16(bs_ + i_ * 4096, st_ + 8192 + i_ * 8192); \
  } while (0)

#define ISSUE_SLAB_LO(stg, ntv, krv)    \
  do {                                                                                   \
    const char* st_ = lds + (stg) * G_STAGE_B + w * 1024;                                \
    glds16(a_src + (krv) * 4096, st_);                                                   \
    const bf16_t* bs_ = b_src + (size_t)((ntv) * nk + (krv)) * 16384;                    \
    glds16(bs_, st_ + 8192);                                                             \
    glds16(bs_ + 4096, st_ + 8192 + 8192);                                               \
  } while (0)
#define ISSUE_SLAB_HI(stg, ntv, krv)                        \
  do {                                                                                   \
    const char* st_ = lds + (stg) * G_STAGE_B + w * 1024;                                \
    const bf16_t* bs_ = b_src + (size_t)((ntv) * nk + (krv)) * 16384;                    \
    glds16(bs_ + 2 * 4096, st_ + 8192 + 2 * 8192);                                       \
    glds16(bs_ + 3 * 4096, st_ + 8192 + 3 * 8192);                                       \
  } while (0)

template <class Epi>
__device__ __forceinline__ void gemm_panel(const bf16_t* __restrict__ A, const int lda, const bf16_t* __restrict__ Wb,
                                           const int K, const int nN, const Epi epi, bf16_t* smem) {
  const int tid = opaque_tid(), lane = tid & 63;
  const int w = __builtin_amdgcn_readfirstlane(tid >> 6);
  const int wm = w & 1, wn = w >> 1;
  const int nk = K >> 5;
  const int total = nN * nk;
  const int l31 = lane & 31, h = lane >> 5;
  const int grow = lane >> 2;
  const int gch = (lane & 3) ^ ((lane >> 4) & 3);
  const bf16_t* a_src = A + (size_t)(w * 16 + grow) * 32 + gch * 8;
  const bf16_t* b_src = Wb + (size_t)(w * 16 + grow) * 32 + gch * 8;
  const char* lds = (const char*)smem;
  const int pos0 = h ^ ((l31 >> 2) & 3);
  const int offk0 = l31 * 64 + pos0 * 16;
  const int offk1 = l31 * 64 + (pos0 ^ 2) * 16;
  f32x16 acc[2][4];
#pragma unroll
  for (int i = 0; i < 2; ++i)
#pragma unroll
    for (int j = 0; j < 4; ++j) acc[i][j] = zero16();
  const int rot = (int)(((blockIdx.x >> 3) & 31) * nk) >> 5;
  int kr3 = rot, nt3 = 0, cnt3 = 0;
  __syncthreads();
#pragma unroll
  for (int s3 = 0; s3 < 3; ++s3) {
    ISSUE_SLAB(s3, nt3, kr3);
    ++kr3; if (kr3 == nk) kr3 = 0;
    ++cnt3; if (cnt3 == nk) { cnt3 = 0; ++nt3; }
  }
  asm volatile("s_waitcnt vmcnt(10)" ::: "memory");
  asm volatile("s_waitcnt lgkmcnt(0)" ::: "memory");
  __builtin_amdgcn_s_barrier();
  asm volatile("" ::: "memory");
  bfrag F0[6], F1[6];
  RDFRAGS(F0, 0, offk0);
  int ks = 0, nt = 0, stage = 0, stage_n = 1, stage_p = 2;
  int kr3p = 0, nt3p = 0;
  for (int it = 0; it < total; ++it) {
#define SB() __builtin_amdgcn_sched_barrier(0)
#define MM(F, mi_, ni_) acc[mi_][ni_] = MFMA(F[mi_], F[2 + (ni_)], acc[mi_][ni_])
    {
      const char* sa_ = lds + stage * G_STAGE_B + wm * 4096 + offk1;
      const char* sb_ = lds + stage * G_STAGE_B + 8192 + wn * 8192 + offk1;
      const char* stp_ = lds + stage_p * G_STAGE_B + w * 1024;
      const bf16_t* bsp_ = b_src + (size_t)(nt3p * nk + kr3p) * 16384;
      MM(F0, 0, 0); SB();
      F1[0] = *(const bfrag*)(sa_); F1[1] = *(const bfrag*)(sa_ + 2048); SB();
      MM(F0, 1, 0); SB();
      if (it > 0) glds16(bsp_ + 2 * 4096, stp_ + 8192 + 2 * 8192);
      SB();
      MM(F0, 0, 1); SB();
      F1[2] = *(const bfrag*)(sb_); F1[3] = *(const bfrag*)(sb_ + 2048); SB();
      MM(F0, 1, 1); SB();
      if (it > 0) glds16(bsp_ + 3 * 4096, stp_ + 8192 + 3 * 8192);
      SB();
      MM(F0, 0, 2); SB();
      F1[4] = *(const bfrag*)(sb_ + 4096); F1[5] = *(const bfrag*)(sb_ + 6144); SB();
      MM(F0, 1, 2); MM(F0, 0, 3); MM(F0, 1, 3); SB();
    }
    asm volatile("s_waitcnt vmcnt(5)" ::: "memory");
    asm volatile("s_waitcnt lgkmcnt(0)" ::: "memory");
    __builtin_amdgcn_s_barrier();
    asm volatile("" ::: "memory");
    SB();
    {
      const char* sa_ = lds + stage_n * G_STAGE_B + wm * 4096 + offk0;
      const char* sb_ = lds + stage_n * G_STAGE_B + 8192 + wn * 8192 + offk0;
      const char* st_ = lds + stage * G_STAGE_B + w * 1024;
      const bf16_t* bs_ = b_src + (size_t)(nt3 * nk + kr3) * 16384;
      MM(F1, 0, 0); SB();
      glds16(a_src + kr3 * 4096, st_); SB();
      MM(F1, 1, 0); SB();
      F0[0] = *(const bfrag*)(sa_); F0[1] = *(const bfrag*)(sa_ + 2048); SB();
      MM(F1, 0, 1); SB();
      glds16(bs_, st_ + 8192); SB();
      MM(F1, 1, 1); SB();
      F0[2] = *(const bfrag*)(sb_); F0[3] = *(const bfrag*)(sb_ + 2048); SB();
      MM(F1, 0, 2); SB();
      glds16(bs_ + 4096, st_ + 8192 + 8192); SB();
      MM(F1, 1, 2); SB();
      F0[4] = *(const bfrag*)(sb_ + 4096); F0[5] = *(const bfrag*)(sb_ + 6144); SB();
      MM(F1, 0, 3); MM(F1, 1, 3); SB();
    }
    kr3p = kr3; nt3p = nt3;
    ++kr3; if (kr3 == nk) kr3 = 0;
    ++cnt3; if (cnt3 == nk) { cnt3 = 0; ++nt3; }
    if (ks == nk - 1) {
      epi(acc, nt, wm, wn, lane);
#pragma unroll
      for (int i = 0; i < 2; ++i)
#pragma unroll
        for (int j = 0; j < 4; ++j) acc[i][j] = zero16();
      ++nt;
      asm volatile("s_waitcnt vmcnt(0)" ::: "memory");
      RDFRAGS(F0, stage_n, offk0);
    }
    ++ks; if (ks == nk) ks = 0;
    stage_p = stage;
    stage = stage_n;
    ++stage_n; if (stage_n == 3) stage_n = 0;
  }
  asm volatile("s_waitcnt vmcnt(0)" ::: "memory");
  __syncthreads();
}

struct EpiSwiglu {
  bf16_t* act;
  __device__ __forceinline__ void operator()(f32x16 (&acc)[2][4], int nt, int wm, int wn, int lane_in) const {
    int lane = lane_in;
    asm volatile("" : "+v"(lane));
    const int l31 = lane & 31;
#pragma unroll
    for (int mi = 0; mi < 2; ++mi)
#pragma unroll
      for (int n2 = 0; n2 < 2; ++n2)
#pragma unroll
        for (int r = 0; r < 16; ++r) {
          const int row = wm * 64 + mi * 32 + ROWMAP(r, lane);
          const int col = (nt * 4 + wn) * 64 + n2 * 32 + l31;
          const float g = acc[mi][n2][r], u = acc[mi][n2 + 2][r];
          act[ablk(row, col)] = f2bf(silu_f(g) * u);
        }
  }
};
struct EpiResLN {
  float* Hp;
  const float2* st;
  const float* gp;
  const float* bp;
  float alpha, c;
  const float* bias;
  __device__ __forceinline__ void operator()(f32x16 (&acc)[2][4], int nt, int wm, int wn, int lane_in) const {
    int lane = lane_in;
    asm volatile("" : "+v"(lane));
    const int l31 = lane & 31;
    const int rb = wm * 64 + 4 * (lane >> 5);
    float* base = Hp + (size_t)rb * 1024 + nt * 512 + wn * 128 + l31;
#pragma unroll
    for (int ni = 0; ni < 4; ++ni) {
      const int col = nt * 512 + wn * 128 + ni * 32 + l31;
      float ag = alpha, ab = bias ? c * bias[col] : 0.f;
      if (st) { ag = alpha * gp[col]; ab += alpha * bp[col]; }
#pragma unroll
      for (int mi = 0; mi < 2; ++mi) {
        float hv[16];
#pragma unroll
        for (int r = 0; r < 16; ++r) hv[r] = base[(size_t)(mi * 32 + (r & 3) + 8 * (r >> 2)) * 1024 + ni * 32];
#pragma unroll
        for (int r = 0; r < 16; ++r) {
          float mu = 0.f, rs = 1.f;
          if (st) { const float2 ms = st[rb + mi * 32 + (r & 3) + 8 * (r >> 2)]; mu = ms.x; rs = ms.y; }
          base[(size_t)(mi * 32 + (r & 3) + 8 * (r >> 2)) * 1024 + ni * 32] = (hv[r] - mu) * rs * ag + ab + c * acc[mi][ni][r];
        }
        __builtin_amdgcn_sched_barrier(0);
      }
    }
  }
};
struct EpiGelu {
  bf16_t* Z;
  __device__ __forceinline__ void operator()(f32x16 (&acc)[2][4], int nt, int wm, int wn, int lane_in) const {
    int lane = lane_in;
    asm volatile("" : "+v"(lane));
    const int l31 = lane & 31;
#pragma unroll
    for (int ni = 0; ni < 4; ++ni) {
      const int col = nt * 512 + wn * 128 + ni * 32 + l31;
#pragma unroll
      for (int mi = 0; mi < 2; ++mi)
#pragma unroll
        for (int r = 0; r < 16; ++r) {
          const int row = wm * 64 + mi * 32 + ROWMAP(r, lane);
          const float x = acc[mi][ni][r];
          Z[(size_t)row * 2048 + col] = f2bf(0.5f * x * (1.f + erff(x * 0.70710678118654752f)));
        }
    }
  }
};
struct EpiHgrn {
  bf16_t* Qp;
  bf16_t* Vp;
  float* LFp;
  bf16_t* SGp;
  const float* lb;
  __device__ __forceinline__ void operator()(f32x16 (&acc)[2][4], int nt, int wm, int wn, int lane_in) const {
    int lane = lane_in;
    asm volatile("" : "+v"(lane));
    const int l31 = lane & 31;
    const int sec = nt >> 1;
    const int cb = (nt & 1) * 512 + wn * 128 + l31;
    const int rb = wm * 64 + 4 * (lane >> 5);
    if (sec == 0 || sec == 3) {
      bf16_t* dst = (sec == 0) ? Qp : SGp;
#pragma unroll
      for (int ni = 0; ni < 4; ++ni)
#pragma unroll
        for (int mi = 0; mi < 2; ++mi)
#pragma unroll
          for (int r = 0; r < 16; ++r) {
            const int row = rb + mi * 32 + (r & 3) + 8 * (r >> 2);
            dst[(size_t)row * 1024 + cb + ni * 32] = f2bf(silu_f(acc[mi][ni][r]));
          }
    } else if (sec == 1) {
#pragma unroll
      for (int ni = 0; ni < 4; ++ni) {
        const float lbv = lb[cb + ni * 32];
#pragma unroll
        for (int mi = 0; mi < 2; ++mi)
#pragma unroll
          for (int r = 0; r < 16; ++r) {
            const int row = rb + mi * 32 + (r & 3) + 8 * (r >> 2);
            const float f = lbv + (1.f - lbv) * __builtin_amdgcn_rcpf(1.f + __expf(-acc[mi][ni][r]));
            LFp[(size_t)row * 1024 + cb + ni * 32] = __logf(f);
          }
      }
    } else {
#pragma unroll
      for (int ni = 0; ni < 4; ++ni)
#pragma unroll
        for (int mi = 0; mi < 2; ++mi)
#pragma unroll
          for (int r = 0; r < 16; ++r) {
            const int row = rb + mi * 32 + (r & 3) + 8 * (r >> 2);
            Vp[(size_t)row * 1024 + cb + ni * 32] = f2bf(acc[mi][ni][r]);
          }
    }
  }
};
struct EpiQkv {
  bf16_t* Qp;
  bf16_t* Kp;
  bf16_t* Vp;
  const float* bias;
  __device__ __forceinline__ void operator()(f32x16 (&acc)[2][4], int nt, int wm, int wn, int lane_in) const {
    int lane = lane_in;
    asm volatile("" : "+v"(lane));
    const int l31 = lane & 31;
#pragma unroll
    for (int ni = 0; ni < 4; ++ni) {
      const int col = nt * 512 + wn * 128 + ni * 32 + l31;
      if (col < 1280) {
        const float bv = bias[col];
#pragma unroll
        for (int mi = 0; mi < 2; ++mi)
#pragma unroll
          for (int r = 0; r < 16; ++r) {
            const int row = wm * 64 + mi * 32 + ROWMAP(r, lane);
            const float x = acc[mi][ni][r] + bv;
            if (col < 1024) Qp[(size_t)row * 1024 + col] = f2bf(x * 0.125f);
            else if (col < 1152) Kp[(size_t)row * 128 + (col - 1024)] = f2bf(x);
            else Vp[(size_t)row * 128 + (col - 1152)] = f2bf(x);
          }
      }
    }
  }
};

__device__ __forceinline__ void ln_panel(const float* Hp, float* outp, bf16_t* HBp, const float* g, const float* b,
                                         float2* stg, float2* stl) {
  const int tid = opaque_tid(), lane = tid & 63;
  const int w = __builtin_amdgcn_readfirstlane(tid >> 6);
  float4 gv[4], bv[4];
#pragma unroll
  for (int j = 0; j < 4; ++j) {
    gv[j] = *(const float4*)(g + j * 256 + lane * 4);
    bv[j] = *(const float4*)(b + j * 256 + lane * 4);
  }
  for (int r0 = w; r0 < 128; r0 += 32) {
    float4 x[4][4];
#pragma unroll
    for (int u = 0; u < 4; ++u)
#pragma unroll
      for (int j = 0; j < 4; ++j) x[u][j] = *(const float4*)(Hp + (size_t)(r0 + 8 * u) * 1024 + j * 256 + lane * 4);
#pragma unroll
    for (int u = 0; u < 4; ++u) {
      const int r = r0 + 8 * u;
      float s = 0.f;
#pragma unroll
      for (int j = 0; j < 4; ++j) s += x[u][j].x + x[u][j].y + x[u][j].z + x[u][j].w;
      s = wave_sum(s);
      const float mean = s * (1.f / 1024.f);
      float v = 0.f;
#pragma unroll
      for (int j = 0; j < 4; ++j) {
        x[u][j].x -= mean; x[u][j].y -= mean; x[u][j].z -= mean; x[u][j].w -= mean;
        v += x[u][j].x * x[u][j].x + x[u][j].y * x[u][j].y + x[u][j].z * x[u][j].z + x[u][j].w * x[u][j].w;
      }
      v = wave_sum(v);
      const float rstd = 1.0f / sqrtf(v * (1.f / 1024.f) + 1e-5f);
      if (lane == 0) { stg[r] = make_float2(mean, rstd); stl[r] = make_float2(mean, rstd); }
#pragma unroll
      for (int j = 0; j < 4; ++j) {
        float4 y;
        y.x = x[u][j].x * rstd * gv[j].x + bv[j].x;
        y.y = x[u][j].y * rstd * gv[j].y + bv[j].y;
        y.z = x[u][j].z * rstd * gv[j].z + bv[j].z;
        y.w = x[u][j].w * rstd * gv[j].w + bv[j].w;
        if (outp) *(float4*)(outp + (size_t)r * 1024 + j * 256 + lane * 4) = y;
        uint2 pk;
        pk.x = pack2(y.x, y.y);
        pk.y = pack2(y.z, y.w);
        *(uint2*)(HBp + ablk(r, j * 256 + lane * 4)) = pk;
      }
    }
  }
  __syncthreads();
}

__device__ __forceinline__ void ffn_panel(const Ctx& C, int p, int layer, int j, bool final_out, int sub, bf16_t* smem) {
  const int wi = layer * 2 + j;
  bf16_t* HBp = C.HB() + (size_t)p * 128 * 1024;
  bf16_t* ACTp = C.ACT() + (size_t)p * 128 * 2816;
  float* Hp = C.H() + (size_t)p * 128 * 1024;
  EpiSwiglu e1{ACTp};
  gemm_panel(HBp, 1024, C.WGU() + (size_t)wi * 5632 * 1024, 1024, 11, e1, smem);
  float2* stl = (float2*)((char*)smem + LDS_STATS_OFF);
  float2* stg = C.STATS() + (size_t)p * 128;
  EpiResLN e2{Hp, sub > 0 ? stl : nullptr, C.in[3] + (sub > 0 ? sub - 1 : 0) * 1024, C.in[4] + (sub > 0 ? sub - 1 : 0) * 1024, ALPHA, 0.5f, nullptr};
  gemm_panel(ACTp, 2816, C.WD() + (size_t)wi * 1024 * 2816, 2816, 2, e2, smem);
  const int li = (layer * 3 + (j == 0 ? 0 : 2)) * 1024;
  float* outp = final_out ? (C.out + (size_t)p * 128 * 1024) : nullptr;
  ln_panel(Hp, outp, HBp, C.in[3] + li, C.in[4] + li, stg, stl);
}

__device__ __forceinline__ void gmlp_panel(const Ctx& C, int p, int layer, int slot, int sub, bf16_t* smem) {
  const int tid = opaque_tid(), lane = tid & 63;
  const int w = __builtin_amdgcn_readfirstlane(tid >> 6);
  const int l31 = lane & 31, h8 = (lane >> 5) * 8;
  bf16_t* HBp = C.HB() + (size_t)p * 128 * 1024;
  bf16_t* Zp = C.ACT() + (size_t)p * 128 * 2816;
  float* Hp = C.H() + (size_t)p * 128 * 1024;
  {
    EpiGelu e{Zp};
    gemm_panel(HBp, 1024, C.WGI() + (size_t)slot * 2048 * 1024, 1024, 4, e, smem);
  }
  bf16_t* As = smem;
  bf16_t* Bs = smem + 128 * 136;
  float* st = (float*)(smem + 2 * 128 * 136);
  for (int r = w; r < 128; r += 8) {
    const uint4 q0 = *(const uint4*)(Zp + (size_t)r * 2048 + 1024 + lane * 16);
    const uint4 q1 = *(const uint4*)(Zp + (size_t)r * 2048 + 1024 + lane * 16 + 8);
    const uint32_t u[8] = {q0.x, q0.y, q0.z, q0.w, q1.x, q1.y, q1.z, q1.w};
    float x[16];
    float s = 0.f;
#pragma unroll
    for (int e = 0; e < 8; ++e) {
      x[2 * e] = __uint_as_float(u[e] << 16);
      x[2 * e + 1] = __uint_as_float(u[e] & 0xffff0000u);
      s += x[2 * e] + x[2 * e + 1];
    }
    s = wave_sum(s);
    const float mean = s * (1.f / 1024.f);
    float v = 0.f;
#pragma unroll
    for (int e = 0; e < 16; ++e) { const float d = x[e] - mean; v += d * d; }
    v = wave_sum(v);
    if (lane == 0) { st[r * 2] = mean; st[r * 2 + 1] = 1.0f / sqrtf(v * (1.f / 1024.f) + 1e-5f); }
  }
  __syncthreads();
  const float* lng = C.in[6] + slot * 1024;
  const float* lnb = C.in[7] + slot * 1024;
  const float* bsp = C.in[9] + slot * 1024;
  const bf16_t* Wsp = C.WSP() + (size_t)slot * 8 * 16384;
  const int nd = w & 3, mt0 = (w >> 2) * 2;
  for (int g = 0; g < 8; ++g) {
#pragma unroll
    for (int i = 0; i < 4; ++i) {
      const int c = tid + 512 * i;
      *(uint4*)(As + (c >> 4) * 136 + (c & 15) * 8) = *(const uint4*)(Wsp + (size_t)g * 16384 + c * 8);
    }
    {
      const int s = tid >> 2, dq = tid & 3;
      const float mean = st[s * 2], rstd = st[s * 2 + 1];
      const bf16_t* src = Zp + (size_t)s * 2048 + 1024 + g * 128 + dq * 32;
#pragma unroll
      for (int q = 0; q < 4; ++q) {
        const uint4 v4 = *(const uint4*)(src + q * 8);
        const uint32_t u[4] = {v4.x, v4.y, v4.z, v4.w};
#pragma unroll
        for (int e = 0; e < 4; ++e) {
          const int d0 = dq * 32 + q * 8 + e * 2;
          const int ch = g * 128 + d0;
          const float x0 = __uint_as_float(u[e] << 16), x1 = __uint_as_float(u[e] & 0xffff0000u);
          Bs[d0 * 136 + s] = f2bf((x0 - mean) * rstd * lng[ch] + lnb[ch]);
          Bs[(d0 + 1) * 136 + s] = f2bf((x1 - mean) * rstd * lng[ch + 1] + lnb[ch + 1]);
        }
      }
    }
    __syncthreads();
    f32x16 acc[2];
    acc[0] = zero16(); acc[1] = zero16();
#pragma unroll
    for (int k16 = 0; k16 < 8; ++k16) {
      const bfrag b = *(const bfrag*)(Bs + (nd * 32 + l31) * 136 + k16 * 16 + h8);
#pragma unroll
      for (int mi = 0; mi < 2; ++mi) {
        const bfrag a = *(const bfrag*)(As + ((mt0 + mi) * 32 + l31) * 136 + k16 * 16 + h8);
        acc[mi] = MFMA(a, b, acc[mi]);
      }
    }
#pragma unroll
    for (int mi = 0; mi < 2; ++mi)
#pragma unroll
      for (int r = 0; r < 16; ++r) {
        const int t = (mt0 + mi) * 32 + ROWMAP(r, lane);
        const int ch = g * 128 + nd * 32 + l31;
        const float mixed = acc[mi][r] + bsp[g * 128 + t];
        const float u = bf2f(Zp[(size_t)t * 2048 + ch]);
        HBp[ablk(t, ch)] = f2bf(u * mixed);
      }
    __syncthreads();
  }
  {
    EpiResLN e2{Hp, (float2*)((char*)smem + LDS_STATS_OFF), C.in[3] + (sub - 1) * 1024, C.in[4] + (sub - 1) * 1024, ALPHA, 1.0f, nullptr};
    gemm_panel(HBp, 1024, C.WGO() + (size_t)slot * 1024 * 1024, 1024, 2, e2, smem);
  }
  const int li = (layer * 3 + 1) * 1024;
  ln_panel(Hp, nullptr, HBp, C.in[3] + li, C.in[4] + li, C.STATS() + (size_t)p * 128, (float2*)((char*)smem + LDS_STATS_OFF));
}

template <bool OUT>
__device__ __forceinline__ void hgrn_rec(const Ctx& C, int p, bf16_t* smem) {
  const int tid = opaque_tid(), lane = tid & 63;
  const int w = __builtin_amdgcn_readfirstlane(tid >> 6);
  const int l31 = lane & 31, h8 = (lane >> 5) * 8;
  bf16_t* ST = smem;
  bf16_t* Qh = smem + 17408;
  bf16_t* Kh = smem + 21760;
  bf16_t* KhT = smem + 26112;
  bf16_t* vT = smem + 31232;
  bf16_t* Ps = smem + 36352;
  float* seg = (float*)(smem + 37632);
  float* dec = seg + 512;
  float* oF = dec + 128;
  const size_t row0 = (size_t)p * 128;
  const bf16_t* Qp = C.ACT() + (size_t)p * 128 * 2816;
  const bf16_t* Vp = Qp + 128 * 1024;
  const float* LFp = C.out + row0 * 1024;
  const bf16_t* SGp = C.SG() + row0 * 1024;
  bf16_t* HBp = C.HB() + row0 * 1024;
  const float* ng = C.in[13];
  const int jt = w >> 1, kt0 = (w & 1) * 2;
  const int kq = tid & 127, tq = tid >> 7;
  for (int h = 0; h < 8; ++h) {
    f32x16 accS[2];
    bf16_t* SBh = C.DS() + ((size_t)(p * 8 + h)) * 16384;
    if (OUT) {
      __syncthreads();
#pragma unroll
      for (int i = 0; i < 4; ++i) {
        const int c = tid + 512 * i;
        *(uint4*)(ST + (c >> 4) * 136 + (c & 15) * 8) = *(const uint4*)(SBh + c * 8);
      }
      __syncthreads();
#pragma unroll
      for (int c2 = 0; c2 < 2; ++c2)
#pragma unroll
        for (int r = 0; r < 16; ++r)
          accS[c2][r] = bf2f(ST[(jt * 32 + ROWMAP(r, lane)) * 136 + (kt0 + c2) * 32 + l31]);
    } else {
      accS[0] = zero16(); accS[1] = zero16();
    }
    float dsum = 0.f;
    float ln_[8];
    bf16_t vn_[8], qn_[8];
    {
      const size_t g0 = (size_t)(tq * 8) * 1024 + h * 128 + kq;
#pragma unroll
      for (int e = 0; e < 8; ++e) {
        ln_[e] = LFp[g0 + (size_t)e * 1024];
        vn_[e] = Vp[g0 + (size_t)e * 1024];
        qn_[e] = OUT ? Qp[g0 + (size_t)e * 1024] : (bf16_t)0;
      }
    }
    for (int i = 0; i < 4; ++i) {
      float l[8], cs[8];
      bf16_t vcur[8], qcur[8];
      const size_t gbase = (size_t)(i * 32 + tq * 8) * 1024 + h * 128 + kq;
#pragma unroll
      for (int e = 0; e < 8; ++e) { l[e] = ln_[e]; vcur[e] = vn_[e]; qcur[e] = qn_[e]; }
      if (i < 3) {
        const size_t gn = gbase + (size_t)32 * 1024;
#pragma unroll
        for (int e = 0; e < 8; ++e) {
          ln_[e] = LFp[gn + (size_t)e * 1024];
          vn_[e] = Vp[gn + (size_t)e * 1024];
          if (OUT) qn_[e] = Qp[gn + (size_t)e * 1024];
        }
      }
      cs[0] = l[0];
#pragma unroll
      for (int e = 1; e < 8; ++e) cs[e] = cs[e - 1] + l[e];
      seg[tq * 128 + kq] = cs[7];
#pragma unroll
      for (int e = 0; e < 8; ++e) vT[kq * 40 + tq * 8 + e] = vcur[e];
      __syncthreads();
      float off = 0.f, tot = 0.f;
#pragma unroll
      for (int q = 0; q < 4; ++q) {
        const float s = seg[q * 128 + kq];
        if (q < tq) off += s;
        tot += s;
      }
#pragma unroll
      for (int e = 0; e < 8; ++e) {
        const float gc = cs[e] + off;
        const float f = __expf(l[e]);
        const float kh = (1.f - f) * __expf(-gc);
        const bf16_t khb = f2bf(kh);
        const int t = tq * 8 + e;
        KhT[kq * 40 + t] = khb;
        if (OUT) {
          Kh[t * 136 + kq] = khb;
          const float qv = bf2f(qcur[e]);
          Qh[t * 136 + kq] = f2bf(qv * __expf(gc));
        }
      }
      if (tq == 0) { dec[kq] = __expf(tot); dsum += tot; }
      __syncthreads();
      f32x16 accO = zero16();
      if (OUT) {
        if (w == 0) {
          f32x16 accP = zero16();
#pragma unroll
          for (int k16 = 0; k16 < 8; ++k16) {
            const bfrag a = *(const bfrag*)(Qh + l31 * 136 + k16 * 16 + h8);
            const bfrag b = *(const bfrag*)(Kh + l31 * 136 + k16 * 16 + h8);
            accP = MFMA(a, b, accP);
          }
#pragma unroll
          for (int r = 0; r < 16; ++r) {
            const int t = ROWMAP(r, lane);
            Ps[t * 40 + l31] = (l31 <= t) ? f2bf(accP[r]) : (bf16_t)0;
          }
        } else if (w <= 4) {
          const int nt = w - 1;
#pragma unroll
          for (int k16 = 0; k16 < 8; ++k16) {
            const bfrag a = *(const bfrag*)(Qh + l31 * 136 + k16 * 16 + h8);
            const bfrag b = *(const bfrag*)(ST + (nt * 32 + l31) * 136 + k16 * 16 + h8);
            accO = MFMA(a, b, accO);
          }
        }
        __syncthreads();
        if (w >= 1 && w <= 4) {
          const int nt = w - 1;
#pragma unroll
          for (int k16 = 0; k16 < 2; ++k16) {
            const bfrag a = *(const bfrag*)(Ps + l31 * 40 + k16 * 16 + h8);
            const bfrag b = *(const bfrag*)(vT + (nt * 32 + l31) * 40 + k16 * 16 + h8);
            accO = MFMA(a, b, accO);
          }
#pragma unroll
          for (int r = 0; r < 16; ++r) oF[ROWMAP(r, lane) * 132 + nt * 32 + l31] = accO[r];
        }
      }
#pragma unroll
      for (int c2 = 0; c2 < 2; ++c2) {
#pragma unroll
        for (int k16 = 0; k16 < 2; ++k16) {
          const bfrag a = *(const bfrag*)(vT + (jt * 32 + l31) * 40 + k16 * 16 + h8);
          const bfrag b = *(const bfrag*)(KhT + ((kt0 + c2) * 32 + l31) * 40 + k16 * 16 + h8);
          accS[c2] = MFMA(a, b, accS[c2]);
        }
        const float dk = dec[(kt0 + c2) * 32 + l31];
#pragma unroll
        for (int r = 0; r < 16; ++r) accS[c2][r] *= dk;
        if (OUT) {
#pragma unroll
          for (int r = 0; r < 16; ++r)
            ST[(jt * 32 + ROWMAP(r, lane)) * 136 + (kt0 + c2) * 32 + l31] = f2bf(accS[c2][r]);
        }
      }
      __syncthreads();
      if (OUT) {
        const int t = tid >> 4, part = tid & 15;
        float x[8];
        float ss = 0.f;
#pragma unroll
        for (int e = 0; e < 8; ++e) { x[e] = oF[t * 132 + part * 8 + e]; ss += x[e] * x[e]; }
        ss += __shfl_xor(ss, 1, 64); ss += __shfl_xor(ss, 2, 64); ss += __shfl_xor(ss, 4, 64); ss += __shfl_xor(ss, 8, 64);
        const float rr = 1.0f / sqrtf(ss * (1.f / 128.f) + 1e-6f);
        const size_t gro = (size_t)(i * 32 + t) * 1024 + h * 128 + part * 8;
        const uint4 sg4 = *(const uint4*)(SGp + gro);
        const uint32_t su[4] = {sg4.x, sg4.y, sg4.z, sg4.w};
        uint32_t ov[4];
#pragma unroll
        for (int e = 0; e < 4; ++e) {
          const float g0 = ng[part * 8 + 2 * e], g1 = ng[part * 8 + 2 * e + 1];
          const float s0 = __uint_as_float(su[e] << 16), s1 = __uint_as_float(su[e] & 0xffff0000u);
          ov[e] = pack2(x[2 * e] * rr * g0 * s0, x[2 * e + 1] * rr * g1 * s1);
        }
        uint4 o4; o4.x = ov[0]; o4.y = ov[1]; o4.z = ov[2]; o4.w = ov[3];
        *(uint4*)(HBp + ablk(i * 32 + t, h * 128 + part * 8)) = o4;
      }
    }
    if (!OUT) {
#pragma unroll
      for (int c2 = 0; c2 < 2; ++c2)
#pragma unroll
        for (int r = 0; r < 16; ++r)
          SBh[(jt * 32 + ROWMAP(r, lane)) * 128 + (kt0 + c2) * 32 + l31] = f2bf(accS[c2][r]);
      if (tq == 0) C.DEC()[(size_t)(p * 8 + h) * 128 + kq] = __expf(dsum);
    }
  }
  __syncthreads();
}

__device__ __forceinline__ void hgrn_scan(const Ctx& C) {
  for (int gid = blockIdx.x * 512 + threadIdx.x; gid < 131072; gid += gridDim.x * 512) {
    const int kp = gid & 63, j = (gid >> 6) & 127, h = (gid >> 13) & 7, b = gid >> 16;
    float s0 = 0.f, s1 = 0.f;
    for (int c0 = 0; c0 < 128; c0 += 8) {
      uint32_t d[8];
      float2 dc[8];
#pragma unroll
      for (int e = 0; e < 8; ++e) {
        const size_t ph = (size_t)((b * 128 + c0 + e) * 8 + h);
        d[e] = *(const uint32_t*)(C.DS() + ph * 16384 + j * 128 + kp * 2);
        dc[e] = *(const float2*)(C.DEC() + ph * 128 + kp * 2);
      }
#pragma unroll
      for (int e = 0; e < 8; ++e) {
        const size_t ph = (size_t)((b * 128 + c0 + e) * 8 + h);
        *(uint32_t*)(C.DS() + ph * 16384 + j * 128 + kp * 2) = pack2(s0, s1);
        s0 = dc[e].x * s0 + __uint_as_float(d[e] << 16);
        s1 = dc[e].y * s1 + __uint_as_float(d[e] & 0xffff0000u);
      }
    }
  }
}

__device__ __forceinline__ void attn_panel(const Ctx& C, int p, bf16_t* smem) {
  const int tid = opaque_tid(), lane = tid & 63;
  const int w = __builtin_amdgcn_readfirstlane(tid >> 6);
  const int l31 = lane & 31, h8 = (lane >> 5) * 8;
  bf16_t* K2 = smem;
  bf16_t* VT = smem + 18432;
  bf16_t* Pw = smem + 35328 + w * 1280;
  const int blk = p & 127;
  const size_t row0 = (size_t)p * 128;
  const bf16_t* Qp = C.ACT() + (size_t)p * 128 * 2816;
  bf16_t* HBp = C.HB() + row0 * 1024;
  const int qt = w & 3;
  for (int hk = 0; hk < 2; ++hk) {
    __syncthreads();
#pragma unroll
    for (int i = 0; i < 4; ++i) {
      const int c = tid + 512 * i;
      const int r = c >> 3, ch = c & 7;
      uint4 kv = make_uint4(0, 0, 0, 0), vv = make_uint4(0, 0, 0, 0);
      if (blk > 0 || r >= 128) {
        const size_t tok = row0 + r - 128;
        kv = *(const uint4*)(C.KB() + tok * 128 + hk * 64 + ch * 8);
        vv = *(const uint4*)(C.VB() + tok * 128 + hk * 64 + ch * 8);
      }
      *(uint4*)(K2 + r * 72 + ch * 8) = kv;
      const uint32_t vu[4] = {vv.x, vv.y, vv.z, vv.w};
#pragma unroll
      for (int e = 0; e < 4; ++e) {
        VT[(ch * 8 + 2 * e) * 264 + r] = (bf16_t)(vu[e] & 0xffffu);
        VT[(ch * 8 + 2 * e + 1) * 264 + r] = (bf16_t)(vu[e] >> 16);
      }
    }
    __syncthreads();
    for (int u = 0; u < 4; ++u) {
      const int hq = hk * 8 + (w >> 2) * 4 + u;
      const float sink = C.in[17][hq];
      bfrag aq[4];
#pragma unroll
      for (int k16 = 0; k16 < 4; ++k16)
        aq[k16] = *(const bfrag*)(Qp + (size_t)(qt * 32 + l31) * 1024 + hq * 64 + k16 * 16 + h8);
      f32x16 s[5];
#pragma unroll
      for (int c = 0; c < 5; ++c) {
        s[c] = zero16();
#pragma unroll
        for (int k16 = 0; k16 < 4; ++k16) {
          const bfrag b = *(const bfrag*)(K2 + ((qt + c) * 32 + l31) * 72 + k16 * 16 + h8);
          s[c] = MFMA(aq[k16], b, s[c]);
        }
      }
      float linv[16];
#pragma unroll
      for (int r = 0; r < 16; ++r) {
        const int qi = qt * 32 + ROWMAP(r, lane);
        float m = -1e30f;
#pragma unroll
        for (int c = 0; c < 5; ++c) {
          const int kp = (qt + c) * 32 + l31;
          const bool valid = (kp > qi) && (kp <= qi + 128) && (blk > 0 || kp >= 128);
          const float v = valid ? s[c][r] : -1e30f;
          s[c][r] = v;
          m = fmaxf(m, v);
        }
        m = fmaxf(m, __shfl_xor(m, 16, 64)); m = fmaxf(m, __shfl_xor(m, 8, 64)); m = fmaxf(m, __shfl_xor(m, 4, 64));
        m = fmaxf(m, __shfl_xor(m, 2, 64)); m = fmaxf(m, __shfl_xor(m, 1, 64));
        m = fmaxf(m, sink);
        float sum = 0.f;
#pragma unroll
        for (int c = 0; c < 5; ++c) {
          const float pv = (s[c][r] > -1e29f) ? __expf(s[c][r] - m) : 0.f;
          s[c][r] = pv;
          sum += pv;
        }
        sum += __shfl_xor(sum, 16, 64); sum += __shfl_xor(sum, 8, 64); sum += __shfl_xor(sum, 4, 64);
        sum += __shfl_xor(sum, 2, 64); sum += __shfl_xor(sum, 1, 64);
        sum += __expf(sink - m);
        linv[r] = __builtin_amdgcn_rcpf(sum);
      }
      f32x16 o[2];
      o[0] = zero16(); o[1] = zero16();
#pragma unroll
      for (int c = 0; c < 5; ++c) {
#pragma unroll
        for (int r = 0; r < 16; ++r) Pw[ROWMAP(r, lane) * 40 + l31] = f2bf(s[c][r]);
        __syncthreads();
#pragma unroll
        for (int k16 = 0; k16 < 2; ++k16) {
          const bfrag a = *(const bfrag*)(Pw + l31 * 40 + k16 * 16 + h8);
#pragma unroll
          for (int dt = 0; dt < 2; ++dt) {
            const bfrag b = *(const bfrag*)(VT + (dt * 32 + l31) * 264 + (qt + c) * 32 + k16 * 16 + h8);
            o[dt] = MFMA(a, b, o[dt]);
          }
        }
        __syncthreads();
      }
#pragma unroll
      for (int dt = 0; dt < 2; ++dt)
#pragma unroll
        for (int r = 0; r < 16; ++r)
          HBp[ablk(qt * 32 + ROWMAP(r, lane), hq * 64 + dt * 32 + l31)] = f2bf(o[dt][r] * linv[r]);
    }
  }
  __syncthreads();
}

__device__ __forceinline__ void conv_weights(const float* __restrict__ src, bf16_t* __restrict__ dst, int nmat, int K,
                                             int Nsrc, int Ndst, int mode) {
  const int nk = K >> 5, nNt = Ndst >> 9;
  const int upm = nk * nNt;
  const int tid = threadIdx.x;
  for (int u = blockIdx.x; u < nmat * upm; u += gridDim.x) {
    const int m = u / upm, r = u - m * upm;
    const int nt = r / nk, ks = r - nt * nk;
    const int np = nt * 512 + tid;
    int sc;
    if (mode == 1) {
      const int b = np >> 7, rr = np & 127;
      sc = (rr < 64) ? (b * 64 + rr) : (2816 + b * 64 + rr - 64);
    } else {
      sc = (np < Nsrc) ? np : -1;
    }
    const float* s = src + (size_t)m * K * Nsrc + (size_t)(ks * 32) * Nsrc + (sc < 0 ? 0 : sc);
    uint32_t pk[16];
#pragma unroll
    for (int kk = 0; kk < 16; ++kk) {
      float v0 = s[(size_t)(2 * kk) * Nsrc], v1 = s[(size_t)(2 * kk + 1) * Nsrc];
      if (sc < 0) { v0 = 0.f; v1 = 0.f; }
      pk[kk] = pack2(v0, v1);
    }
    uint4* d = (uint4*)(dst + (size_t)m * K * Ndst + (size_t)(nt * nk + ks) * 16384 + tid * 32);
    d[0] = make_uint4(pk[0], pk[1], pk[2], pk[3]);
    d[1] = make_uint4(pk[4], pk[5], pk[6], pk[7]);
    d[2] = make_uint4(pk[8], pk[9], pk[10], pk[11]);
    d[3] = make_uint4(pk[12], pk[13], pk[14], pk[15]);
  }
}

__device__ __forceinline__ void phase0(const Ctx& C) {
  conv_weights(C.in[1], C.WGU(), 8, 1024, 5632, 5632, 1);
  conv_weights(C.in[2], C.WD(), 8, 2816, 1024, 1024, 0);
  conv_weights(C.in[5], C.WGI(), 2, 1024, 2048, 2048, 0);
  conv_weights(C.in[10], C.WGO(), 2, 1024, 1024, 1024, 0);
  conv_weights(C.in[11], C.WHI(), 1, 1024, 4096, 4096, 0);
  conv_weights(C.in[14], C.WHO(), 1, 1024, 1024, 1024, 0);
  conv_weights(C.in[15], C.WQKV(), 1, 1024, 1280, 1536, 0);
  conv_weights(C.in[18], C.WAO(), 1, 1024, 1024, 1024, 0);
  const size_t gtid = (size_t)blockIdx.x * 512 + threadIdx.x;
  const size_t gsz = (size_t)gridDim.x * 512;
  for (size_t i = gtid; i < (size_t)T_TOK * 1024 / 4; i += gsz) {
    const float4 v = ((const float4*)C.in[0])[i];
    ((float4*)C.H())[i] = v;
    uint2 pk;
    pk.x = pack2(v.x, v.y);
    pk.y = pack2(v.z, v.w);
    {
      const int row = (int)(i >> 8), col = (int)(i & 255) * 4;
      *(uint2*)(C.HB() + (size_t)(row >> 7) * 131072 + ablk(row & 127, col)) = pk;
    }
  }
  for (size_t i = gtid; i < (size_t)2 * 8 * 128 * 128; i += gsz) {
    const int s = (int)(i & 127), t = (int)((i >> 7) & 127);
    C.WSP()[i] = (s <= t) ? f2bf(C.in[8][i]) : (bf16_t)0;
  }
  for (size_t i = gtid; i < 1024; i += gsz) {
    const float* lp = C.in[12];
    const float a0 = lp[i], a1 = lp[1024 + i], a2 = lp[2048 + i], a3 = lp[3072 + i];
    const float m = fmaxf(fmaxf(a0, a1), fmaxf(a2, a3));
    const float e0 = expf(a0 - m), e1 = expf(a1 - m), e2 = expf(a2 - m), e3 = expf(a3 - m);
    C.LB()[i] = e1 / (e0 + e1 + e2 + e3);
  }
}

enum { OP_FFN = 0, OP_GMLP = 1, OP_HIN = 2, OP_HOUT = 3, OP_QKV = 4, OP_ATTN = 5 };

__device__ __forceinline__ void run_ops(const Ctx& C0, int op_lo, int op_hi, bf16_t* smem) {
  for (int p0 = blockIdx.x; p0 < NPANEL; p0 += gridDim.x) {
    for (int op = op_lo; op < op_hi; ++op) {
      const Ctx& C = C0;
      const int p = p0;
      bf16_t* HBp = C.HB() + (size_t)p * 128 * 1024;
      float* Hp = C.H() + (size_t)p * 128 * 1024;
      bf16_t* ACTp = C.ACT() + (size_t)p * 128 * 2816;
      int kind = OP_FFN, layer = 0, j = 0, sub = 0;
      switch (op) {
        case 0: kind = OP_FFN; layer = 0; j = 0; sub = 0; break;
        case 1: kind = OP_GMLP; layer = 0; j = 0; sub = 1; break;
        case 2: kind = OP_FFN; layer = 0; j = 1; sub = 2; break;
        case 3: kind = OP_FFN; layer = 1; j = 0; sub = 3; break;
        case 4: kind = OP_HIN; layer = 1; break;
        case 5: kind = OP_HOUT; layer = 1; sub = 4; break;
        case 6: kind = OP_FFN; layer = 1; j = 1; sub = 5; break;
        case 7: kind = OP_FFN; layer = 2; j = 0; sub = 6; break;
        case 8: kind = OP_QKV; layer = 2; break;
        case 9: kind = OP_ATTN; layer = 2; sub = 7; break;
        case 10: kind = OP_FFN; layer = 2; j = 1; sub = 8; break;
        case 11: kind = OP_FFN; layer = 3; j = 0; sub = 9; break;
        case 12: kind = OP_GMLP; layer = 3; j = 1; sub = 10; break;
        default: kind = OP_FFN; layer = 3; j = 1; sub = 11; break;
      }
      float2* stl = (float2*)((char*)smem + LDS_STATS_OFF);
      float2* stg = C.STATS() + (size_t)p * 128;
      if (threadIdx.x < 128) stl[threadIdx.x] = stg[threadIdx.x];
      if (kind == OP_FFN) {
        ffn_panel(C, p, layer, j, op == 13, sub, smem);
      } else if (kind == OP_GMLP) {
        gmlp_panel(C, p, layer, j, sub, smem);
      } else if (kind == OP_HIN) {
        EpiHgrn e{ACTp, ACTp + 128 * 1024, C.out + (size_t)p * 128 * 1024, C.SG() + (size_t)p * 128 * 1024, C.LB()};
        gemm_panel(HBp, 1024, C.WHI(), 1024, 8, e, smem);
        hgrn_rec<false>(C, p, smem);
      } else if (kind == OP_HOUT) {
        hgrn_rec<true>(C, p, smem);
        EpiResLN e2{Hp, stl, C.in[3] + (sub - 1) * 1024, C.in[4] + (sub - 1) * 1024, ALPHA, 1.0f, nullptr};
        gemm_panel(HBp, 1024, C.WHO(), 1024, 2, e2, smem);
        const int li = (1 * 3 + 1) * 1024;
        ln_panel(Hp, nullptr, HBp, C.in[3] + li, C.in[4] + li, stg, stl);
      } else if (kind == OP_QKV) {
        EpiQkv e{ACTp, C.KB() + (size_t)p * 128 * 128, C.VB() + (size_t)p * 128 * 128, C.in[16]};
        gemm_panel(HBp, 1024, C.WQKV(), 1024, 3, e, smem);
      } else {
        attn_panel(C, p, smem);
        EpiResLN e2{Hp, stl, C.in[3] + (sub - 1) * 1024, C.in[4] + (sub - 1) * 1024, ALPHA, 1.0f, C.in[19]};
        gemm_panel(HBp, 1024, C.WAO(), 1024, 2, e2, smem);
        const int li = (2 * 3 + 1) * 1024;
        ln_panel(Hp, nullptr, HBp, C.in[3] + li, C.in[4] + li, stg, stl);
      }
    }
  }
}

#if COOP
__device__ __forceinline__ void grid_barrier(unsigned* bar, unsigned target) {
  __syncthreads();
  if (threadIdx.x == 0) {
    __threadfence();
    __hip_atomic_fetch_add(bar, 1u, __ATOMIC_RELEASE, __HIP_MEMORY_SCOPE_AGENT);
    while (__hip_atomic_load(bar, __ATOMIC_ACQUIRE, __HIP_MEMORY_SCOPE_AGENT) < target) __builtin_amdgcn_s_sleep(8);
    __threadfence();
  }
  __syncthreads();
}

__global__ void __launch_bounds__(512) mega(Params P) {
  extern __shared__ __attribute__((aligned(16))) unsigned char lds_raw[];
  bf16_t* smem = (bf16_t*)lds_raw;
  Ctx C;
  C.in = P.in;
  C.out = P.out;
  C.ws = P.ws;
  const int lo = P.ph_lo, hi = P.ph_hi;
#if COOP
  if (lo < 0) cg::this_grid().sync();
  unsigned* bar = (unsigned*)(P.ws + OFF_BAR);
#define GSYNC(k) do { if (lo <= (k) && (k) + 1 < hi) grid_barrier(bar, (unsigned)((k) + 1) * gridDim.x); } while (0)
#else
#define GSYNC(k) do { } while (0)
#endif
  if (lo <= 0 && 0 < hi) phase0(C);
  GSYNC(0);
  if (lo <= 1 && 1 < hi) run_ops(C, 0, 5, smem);
  GSYNC(1);
  if (lo <= 2 && 2 < hi) hgrn_scan(C);
  GSYNC(2);
  if (lo <= 3 && 3 < hi) run_ops(C, 5, 9, smem);
  GSYNC(3);
  if (lo <= 4 && 4 < hi) run_ops(C, 9, 14, smem);
}

#endif

extern "C" void kernel_launch(void* const* d_in, const int* in_sizes, int n_in, void* d_out, int out_size, void* d_ws,
                              size_t ws_size, hipStream_t stream) {
  static int grid_blocks = 0;
  if (grid_blocks == 0) {
    if (n_in != 20 || ws_size < WS_END) {
      fprintf(stderr, "kernel_launch: unexpected n_in %d or ws_size %zu (need %zu)\n", n_in, ws_size, (size_t)WS_END);
      grid_blocks = -1;
      return;
    }
    int dev = 0, cus = 0, per_cu = 0;
    hipGetDevice(&dev);
    hipDeviceGetAttribute(&cus, hipDeviceAttributeMultiprocessorCount, dev);
#if COOP
    if (hipFuncSetAttribute((const void*)mega, hipFuncAttributeMaxDynamicSharedMemorySize, LDS_BYTES) != hipSuccess)
      fprintf(stderr, "kernel_launch: hipFuncSetAttribute failed\n");
    hipOccupancyMaxActiveBlocksPerMultiprocessor(&per_cu, (const void*)mega, 512, LDS_BYTES);
#endif
    (void)hipGetLastError();
    if (per_cu < 1) per_cu = 1;
    grid_blocks = cus * per_cu;
    if (grid_blocks > NPANEL) grid_blocks = NPANEL;
    if (grid_blocks < 1) grid_blocks = NPANEL;
  }
  if (grid_blocks < 0) return;
  Params P{};
  for (int i = 0; i < 20; ++i) P.in[i] = (const float*)d_in[i];
  P.out = (float*)d_out;
  P.ws = (unsigned char*)d_ws;
#if COOP
  P.ph_lo = 0; P.ph_hi = 5;
  (void)hipMemsetAsync((unsigned char*)d_ws + OFF_BAR, 0, 256, stream);
  void* args[] = {&P};
  hipError_t e = hipLaunchCooperativeKernel((const void*)mega, dim3(grid_blocks), dim3(512), args, LDS_BYTES, stream);
  if (e != hipSuccess) fprintf(stderr, "cooperative launch failed: %s (grid %d)\n", hipGetErrorString(e), grid_blocks);
#endif
}
```

```cpp
#include <hip/hip_runtime.h>
#include <hip/hip_cooperative_groups.h>
#include <stdint.h>
#include <stdio.h>
namespace cg = cooperative_groups;

#ifndef COOP
#define COOP 1
#endif

typedef unsigned short bf16_t;
typedef __attribute__((ext_vector_type(8))) __bf16 bfrag;
typedef __attribute__((ext_vector_type(16))) float f32x16;

constexpr int T_TOK = 32768;
constexpr int NPANEL = 256;
constexpr float ALPHA = 1.6817928305074290f;
constexpr int LDS_BYTES = 123904;
constexpr int LDS_STATS_OFF = 122880;

constexpr size_t SZ_WGU = (size_t)8 * 5632 * 1024 * 2;
constexpr size_t SZ_WD = (size_t)8 * 1024 * 2816 * 2;
constexpr size_t SZ_WGI = (size_t)2 * 2048 * 1024 * 2;
constexpr size_t SZ_WGO = (size_t)2 * 1024 * 1024 * 2;
constexpr size_t SZ_WSP = (size_t)2 * 8 * 128 * 128 * 2;
constexpr size_t SZ_WHI = (size_t)4096 * 1024 * 2;
constexpr size_t SZ_WHO = (size_t)1024 * 1024 * 2;
constexpr size_t SZ_WQKV = (size_t)1536 * 1024 * 2;
constexpr size_t SZ_WAO = (size_t)1024 * 1024 * 2;
constexpr size_t SZ_LB = 4096;
constexpr size_t SZ_H = (size_t)T_TOK * 1024 * 4;
constexpr size_t SZ_HB = (size_t)T_TOK * 1024 * 2;
constexpr size_t SZ_ACT = (size_t)T_TOK * 2816 * 2;
constexpr size_t SZ_SG = (size_t)T_TOK * 1024 * 2;
constexpr size_t SZ_DS = (size_t)NPANEL * 8 * 128 * 128 * 2;
constexpr size_t SZ_DEC = (size_t)NPANEL * 8 * 128 * 4;
constexpr size_t SZ_KB = (size_t)T_TOK * 128 * 2;

constexpr size_t OFF_WGU = 0;
constexpr size_t OFF_WD = OFF_WGU + SZ_WGU;
constexpr size_t OFF_WGI = OFF_WD + SZ_WD;
constexpr size_t OFF_WGO = OFF_WGI + SZ_WGI;
constexpr size_t OFF_WSP = OFF_WGO + SZ_WGO;
constexpr size_t OFF_WHI = OFF_WSP + SZ_WSP;
constexpr size_t OFF_WHO = OFF_WHI + SZ_WHI;
constexpr size_t OFF_WQKV = OFF_WHO + SZ_WHO;
constexpr size_t OFF_WAO = OFF_WQKV + SZ_WQKV;
constexpr size_t OFF_LB = OFF_WAO + SZ_WAO;
constexpr size_t OFF_H = OFF_LB + SZ_LB;
constexpr size_t OFF_HB = OFF_H + SZ_H;
constexpr size_t OFF_ACT = OFF_HB + SZ_HB;
constexpr size_t OFF_SG = OFF_ACT + SZ_ACT;
constexpr size_t OFF_DS = OFF_SG + SZ_SG;
constexpr size_t OFF_DEC = OFF_DS + SZ_DS;
constexpr size_t OFF_KB = OFF_DEC + SZ_DEC;
constexpr size_t OFF_VB = OFF_KB + SZ_KB;
constexpr size_t OFF_BAR = OFF_VB + SZ_KB;
constexpr size_t OFF_STATS = OFF_BAR + 256;
constexpr size_t WS_END = OFF_STATS + (size_t)T_TOK * 8;

struct Params {
  const float* in[20];
  float* out;
  unsigned char* ws;
  int ph_lo, ph_hi;
};

struct Ctx {
  const float* const* in;
  float* out;
  unsigned char* ws;
  __device__ __forceinline__ bf16_t* WGU() const { return (bf16_t*)(ws + OFF_WGU); }
  __device__ __forceinline__ bf16_t* WD() const { return (bf16_t*)(ws + OFF_WD); }
  __device__ __forceinline__ bf16_t* WGI() const { return (bf16_t*)(ws + OFF_WGI); }
  __device__ __forceinline__ bf16_t* WGO() const { return (bf16_t*)(ws + OFF_WGO); }
  __device__ __forceinline__ bf16_t* WSP() const { return (bf16_t*)(ws + OFF_WSP); }
  __device__ __forceinline__ bf16_t* WHI() const { return (bf16_t*)(ws + OFF_WHI); }
  __device__ __forceinline__ bf16_t* WHO() const { return (bf16_t*)(ws + OFF_WHO); }
  __device__ __forceinline__ bf16_t* WQKV() const { return (bf16_t*)(ws + OFF_WQKV); }
  __device__ __forceinline__ bf16_t* WAO() const { return (bf16_t*)(ws + OFF_WAO); }
  __device__ __forceinline__ float* LB() const { return (float*)(ws + OFF_LB); }
  __device__ __forceinline__ float* H() const { return (float*)(ws + OFF_H); }
  __device__ __forceinline__ bf16_t* HB() const { return (bf16_t*)(ws + OFF_HB); }
  __device__ __forceinline__ bf16_t* ACT() const { return (bf16_t*)(ws + OFF_ACT); }
  __device__ __forceinline__ bf16_t* SG() const { return (bf16_t*)(ws + OFF_SG); }
  __device__ __forceinline__ bf16_t* DS() const { return (bf16_t*)(ws + OFF_DS); }
  __device__ __forceinline__ float* DEC() const { return (float*)(ws + OFF_DEC); }
  __device__ __forceinline__ bf16_t* KB() const { return (bf16_t*)(ws + OFF_KB); }
  __device__ __forceinline__ bf16_t* VB() const { return (bf16_t*)(ws + OFF_VB); }
  __device__ __forceinline__ float2* STATS() const { return (float2*)(ws + OFF_STATS); }
};

typedef __attribute__((ext_vector_type(2))) float f32x2_t;
typedef __attribute__((ext_vector_type(2))) __bf16 bf16x2_t;
__device__ __forceinline__ uint32_t pack2(float a, float b) {
  f32x2_t v = {a, b};
  bf16x2_t r = __builtin_convertvector(v, bf16x2_t);
  return __builtin_bit_cast(uint32_t, r);
}
__device__ __forceinline__ bf16_t f2bf(float f) { return (bf16_t)(pack2(f, 0.f) & 0xffffu); }
__device__ __forceinline__ float bf2f(bf16_t b) { return __uint_as_float(((uint32_t)b) << 16); }
__device__ __forceinline__ float dpp_add(float v, const int ctrl_quad_perm_b1, const int which) {
  int x = __builtin_bit_cast(int, v), y;
  if (which == 0) y = __builtin_amdgcn_update_dpp(0, x, 0xB1, 0xF, 0xF, true);
  else if (which == 1) y = __builtin_amdgcn_update_dpp(0, x, 0x4E, 0xF, 0xF, true);
  else if (which == 2) y = __builtin_amdgcn_update_dpp(0, x, 0x141, 0xF, 0xF, true);
  else y = __builtin_amdgcn_update_dpp(0, x, 0x140, 0xF, 0xF, true);
  (void)ctrl_quad_perm_b1;
  return v + __builtin_bit_cast(float, y);
}
__device__ __forceinline__ float wave_sum(float v) {
  v = dpp_add(v, 0, 0);
  v = dpp_add(v, 0, 1);
  v = dpp_add(v, 0, 2);
  v = dpp_add(v, 0, 3);
  const int x = __builtin_bit_cast(int, v);
  const float s0 = __builtin_bit_cast(float, __builtin_amdgcn_readlane(x, 0));
  const float s1 = __builtin_bit_cast(float, __builtin_amdgcn_readlane(x, 16));
  const float s2 = __builtin_bit_cast(float, __builtin_amdgcn_readlane(x, 32));
  const float s3 = __builtin_bit_cast(float, __builtin_amdgcn_readlane(x, 48));
  return (s0 + s1) + (s2 + s3);
}
__device__ __forceinline__ size_t ablk(int row, int col) { return (size_t)(col >> 5) * 4096 + row * 32 + (col & 31); }
__device__ __forceinline__ float silu_f(float x) { return x * __builtin_amdgcn_rcpf(1.f + __expf(-x)); }
#define ROWMAP(reg, lane) ((((reg)&3)) + 8 * ((reg) >> 2) + 4 * ((lane) >> 5))
#define MFMA(a, b, c) __builtin_amdgcn_mfma_f32_32x32x16_bf16((a), (b), (c), 0, 0, 0)

__device__ __forceinline__ int opaque_tid() {
  int t = threadIdx.x;
  asm volatile("" : "+v"(t));
  return t;
}

__device__ __forceinline__ unsigned long long opaque_u64(unsigned long long v) {
  unsigned lo = (unsigned)v, hi = (unsigned)(v >> 32);
  asm volatile("" : "+v"(lo), "+v"(hi));
  lo = __builtin_amdgcn_readfirstlane(lo);
  hi = __builtin_amdgcn_readfirstlane(hi);
  return ((unsigned long long)hi << 32) | lo;
}

__device__ __forceinline__ f32x16 zero16() {
  f32x16 z;
#pragma unroll
  for (int i = 0; i < 16; ++i) z[i] = 0.f;
  return z;
}

constexpr int G_STAGE_B = 40960;

__device__ __forceinline__ void glds16(const bf16_t* g, const char* l) {
  __builtin_amdgcn_global_load_lds((const unsigned*)g, (unsigned*)const_cast<char*>(l), 16, 0, 0);
}

#define RDFRAGS(F, stg, ok)                                                              \
  do {                                                                                   \
    const char* sa_ = lds + (stg) * G_STAGE_B + wm * 4096 + (ok);                         \
    const char* sb_ = lds + (stg) * G_STAGE_B + 8192 + wn * 8192 + (ok);                  \
    F[0] = *(const bfrag*)(sa_);                                                         \
    F[1] = *(const bfrag*)(sa_ + 2048);                                                  \
    F[2] = *(const bfrag*)(sb_);                                                         \
    F[3] = *(const bfrag*)(sb_ + 2048);                                                  \
    F[4] = *(const bfrag*)(sb_ + 4096);                                                  \
    F[5] = *(const bfrag*)(sb_ + 6144);                                                  \
  } while (0)
#define DOMFMA(F)                                                                        \
  do {                                                                                   \
    _Pragma("unroll") for (int ni_ = 0; ni_ < 4; ++ni_) {                                \
      acc[0][ni_] = MFMA(F[0], F[2 + ni_], acc[0][ni_]);                                 \
      acc[1][ni_] = MFMA(F[1], F[2 + ni_], acc[1][ni_]);                                 \
    }                                                                                    \
  } while (0)
#define ISSUE_SLAB(stg, ntv, krv)                                                        \
  do {                                                                                   \
    const char* st_ = lds + (stg) * G_STAGE_B + w * 1024;                                    \
    glds16(a_src + (krv) * 4096, st_);                                                   \
    const bf16_t* bs_ = b_src + (size_t)((ntv) * nk + (krv)) * 16384;                    \
    _Pragma("unroll") for (int i_ = 0; i_ < 4; ++i_) glds16(bs_ + i_ * 4096, st_ + 8192 + i_ * 8192); \
  } while (0)

#define ISSUE_SLAB_LO(stg, ntv, krv)    \
  do {                                                                                   \
    const char* st_ = lds + (stg) * G_STAGE_B + w * 1024;                                \
    glds16(a_src + (krv) * 4096, st_);                                                   \
    const bf16_t* bs_ = b_src + (size_t)((ntv) * nk + (krv)) * 16384;                    \
    glds16(bs_, st_ + 8192);                                                             \
    glds16(bs_ + 4096, st_ + 8192 + 8192);                                               \
  } while (0)
#define ISSUE_SLAB_HI(stg, ntv, krv)                        \
  do {                                                                                   \
    const char* st_ = lds + (stg) * G_STAGE_B + w * 1024;                                \
    const bf16_t* bs_ = b_src + (size_t)((ntv) * nk + (krv)) * 16384;                    \
    glds16(bs_ + 2 * 4096, st_ + 8192 + 2 * 8192);                                       \
    glds16(bs_ + 3 * 4096, st_ + 8192 + 3 * 8192);                                       \
  } while (0)

template <class Epi>
__device__ __forceinline__ void gemm_panel(const bf16_t* __restrict__ A, const int lda, const bf16_t* __restrict__ Wb,
                                           const int K, const int nN, const Epi epi, bf16_t* smem) {
  const int tid = opaque_tid(), lane = tid & 63;
  const int w = __builtin_amdgcn_readfirstlane(tid >> 6);
  const int wm = w & 1, wn = w >> 1;
  const int nk = K >> 5;
  const int total = nN * nk;
  const int l31 = lane & 31, h = lane >> 5;
  const int grow = lane >> 2;
  const int gch = (lane & 3) ^ ((lane >> 4) & 3);
  const bf16_t* a_src = A + (size_t)(w * 16 + grow) * 32 + gch * 8;
  const bf16_t* b_src = Wb + (size_t)(w * 16 + grow) * 32 + gch * 8;
  const char* lds = (const char*)smem;
  const int pos0 = h ^ ((l31 >> 2) & 3);
  const int offk0 = l31 * 64 + pos0 * 16;
  const int offk1 = l31 * 64 + (pos0 ^ 2) * 16;
  f32x16 acc[2][4];
#pragma unroll
  for (int i = 0; i < 2; ++i)
#pragma unroll
    for (int j = 0; j < 4; ++j) acc[i][j] = zero16();
  const int rot = (int)(((blockIdx.x >> 3) & 31) * nk) >> 5;
  int kr3 = rot, nt3 = 0, cnt3 = 0;
  __syncthreads();
#pragma unroll
  for (int s3 = 0; s3 < 3; ++s3) {
    ISSUE_SLAB(s3, nt3, kr3);
    ++kr3; if (kr3 == nk) kr3 = 0;
    ++cnt3; if (cnt3 == nk) { cnt3 = 0; ++nt3; }
  }
  asm volatile("s_waitcnt vmcnt(10)" ::: "memory");
  asm volatile("s_waitcnt lgkmcnt(0)" ::: "memory");
  __builtin_amdgcn_s_barrier();
  asm volatile("" ::: "memory");
  bfrag F0[6], F1[6];
  RDFRAGS(F0, 0, offk0);
  int ks = 0, nt = 0, stage = 0, stage_n = 1, stage_p = 2;
  int kr3p = 0, nt3p = 0;
  for (int it = 0; it < total; ++it) {
#define SB() __builtin_amdgcn_sched_barrier(0)
#define MM(F, mi_, ni_) acc[mi_][ni_] = MFMA(F[mi_], F[2 + (ni_)], acc[mi_][ni_])
    {
      const char* sa_ = lds + stage * G_STAGE_B + wm * 4096 + offk1;
      const char* sb_ = lds + stage * G_STAGE_B + 8192 + wn * 8192 + offk1;
      const char* stp_ = lds + stage_p * G_STAGE_B + w * 1024;
      const bf16_t* bsp_ = b_src + (size_t)(nt3p * nk + kr3p) * 16384;
      MM(F0, 0, 0); SB();
      F1[0] = *(const bfrag*)(sa_); F1[1] = *(const bfrag*)(sa_ + 2048); SB();
      MM(F0, 1, 0); SB();
      if (it > 0) glds16(bsp_ + 2 * 4096, stp_ + 8192 + 2 * 8192);
      SB();
      MM(F0, 0, 1); SB();
      F1[2] = *(const bfrag*)(sb_); F1[3] = *(const bfrag*)(sb_ + 2048); SB();
      MM(F0, 1, 1); SB();
      if (it > 0) glds16(bsp_ + 3 * 4096, stp_ + 8192 + 3 * 8192);
      SB();
      MM(F0, 0, 2); SB();
      F1[4] = *(const bfrag*)(sb_ + 4096); F1[5] = *(const bfrag*)(sb_ + 6144); SB();
      MM(F0, 1, 2); MM(F0, 0, 3); MM(F0, 1, 3); SB();
    }
    asm volatile("s_waitcnt vmcnt(5)" ::: "memory");
    asm volatile("s_waitcnt lgkmcnt(0)" ::: "memory");
    __builtin_amdgcn_s_barrier();
    asm volatile("" ::: "memory");
    SB();
    {
      const char* sa_ = lds + stage_n * G_STAGE_B + wm * 4096 + offk0;
      const char* sb_ = lds + stage_n * G_STAGE_B + 8192 + wn * 8192 + offk0;
      const char* st_ = lds + stage * G_STAGE_B + w * 1024;
      const bf16_t* bs_ = b_src + (size_t)(nt3 * nk + kr3) * 16384;
      MM(F1, 0, 0); SB();
      glds16(a_src + kr3 * 4096, st_); SB();
      MM(F1, 1, 0); SB();
      F0[0] = *(const bfrag*)(sa_); F0[1] = *(const bfrag*)(sa_ + 2048); SB();
      MM(F1, 0, 1); SB();
      glds16(bs_, st_ + 8192); SB();
      MM(F1, 1, 1); SB();
      F0[2] = *(const bfrag*)(sb_); F0[3] = *(const bfrag*)(sb_ + 2048); SB();
      MM(F1, 0, 2); SB();
      glds16(bs_ + 4096, st_ + 8192 + 8192); SB();
      MM(F1, 1, 2); SB();
      F0[4] = *(const bfrag*)(sb_ + 4096); F0[5] = *(const bfrag*)(sb_ + 6144); SB();
      MM(F1, 0, 3); MM(F1, 1, 3); SB();
    }
    kr3p = kr3; nt3p = nt3;
    ++kr3; if (kr3 == nk) kr3 = 0;
    ++cnt3; if (cnt3 == nk) { cnt3 = 0; ++nt3; }
    if (ks == nk - 1) {
      epi(acc, nt, wm, wn, lane);
#pragma unroll
      for (int i = 0; i < 2; ++i)
#pragma unroll
        for (int j = 0; j < 4; ++j) acc[i][j] = zero16();
      ++nt;
      asm volatile("s_waitcnt vmcnt(0)" ::: "memory");
      RDFRAGS(F0, stage_n, offk0);
    }
    ++ks; if (ks == nk) ks = 0;
    stage_p = stage;
    stage = stage_n;
    ++stage_n; if (stage_n == 3) stage_n = 0;
  }
  asm volatile("s_waitcnt vmcnt(0)" ::: "memory");
  __syncthreads();
}

struct EpiSwiglu {
  bf16_t* act;
  __device__ __forceinline__ void operator()(f32x16 (&acc)[2][4], int nt, int wm, int wn, int lane_in) const {
    int lane = lane_in;
    asm volatile("" : "+v"(lane));
    const int l31 = lane & 31;
#pragma unroll
    for (int mi = 0; mi < 2; ++mi)
#pragma unroll
      for (int n2 = 0; n2 < 2; ++n2)
#pragma unroll
        for (int r = 0; r < 16; ++r) {
          const int row = wm * 64 + mi * 32 + ROWMAP(r, lane);
          const int col = (nt * 4 + wn) * 64 + n2 * 32 + l31;
          const float g = acc[mi][n2][r], u = acc[mi][n2 + 2][r];
          act[ablk(row, col)] = f2bf(silu_f(g) * u);
        }
  }
};
struct EpiResLN {
  const float* Hin;
  float* Hp;
  const float2* st;
  const float* gp;
  const float* bp;
  float alpha, c;
  const float* bias;
  __device__ __forceinline__ void operator()(f32x16 (&acc)[2][4], int nt, int wm, int wn, int lane_in) const {
    int lane = lane_in;
    asm volatile("" : "+v"(lane));
    const int l31 = lane & 31;
    const int rb = wm * 64 + 4 * (lane >> 5);
    const size_t off0 = (size_t)rb * 1024 + nt * 512 + wn * 128 + l31;
    const float* bin = Hin + off0;
    float* base = Hp + off0;
#pragma unroll
    for (int ni = 0; ni < 4; ++ni) {
      const int col = nt * 512 + wn * 128 + ni * 32 + l31;
      float ag = alpha, ab = bias ? c * bias[col] : 0.f;
      if (st) { ag = alpha * gp[col]; ab += alpha * bp[col]; }
#pragma unroll
      for (int mi = 0; mi < 2; ++mi) {
        float hv[16];
#pragma unroll
        for (int r = 0; r < 16; ++r) hv[r] = bin[(size_t)(mi * 32 + (r & 3) + 8 * (r >> 2)) * 1024 + ni * 32];
#pragma unroll
        for (int r = 0; r < 16; ++r) {
          float A = 1.f, B = 0.f;
          if (st) { const float2 ms = st[rb + mi * 32 + (r & 3) + 8 * (r >> 2)]; A = ms.x; B = ms.y; }
          base[(size_t)(mi * 32 + (r & 3) + 8 * (r >> 2)) * 1024 + ni * 32] = fmaf(fmaf(hv[r], A, B), ag, fmaf(c, acc[mi][ni][r], ab));
        }
        __builtin_amdgcn_sched_barrier(0);
      }
    }
  }
};
struct EpiGelu {
  bf16_t* Z;
  __device__ __forceinline__ void operator()(f32x16 (&acc)[2][4], int nt, int wm, int wn, int lane_in) const {
    int lane = lane_in;
    asm volatile("" : "+v"(lane));
    const int l31 = lane & 31;
#pragma unroll
    for (int ni = 0; ni < 4; ++ni) {
      const int col = nt * 512 + wn * 128 + ni * 32 + l31;
#pragma unroll
      for (int mi = 0; mi < 2; ++mi)
#pragma unroll
        for (int r = 0; r < 16; ++r) {
          const int row = wm * 64 + mi * 32 + ROWMAP(r, lane);
          const float x = acc[mi][ni][r];
          Z[(size_t)row * 2048 + col] = f2bf(0.5f * x * (1.f + erff(x * 0.70710678118654752f)));
        }
    }
  }
};
struct EpiHgrn {
  bf16_t* Qp;
  bf16_t* Vp;
  float* LFp;
  bf16_t* SGp;
  const float* lb;
  __device__ __forceinline__ void operator()(f32x16 (&acc)[2][4], int nt, int wm, int wn, int lane_in) const {
    int lane = lane_in;
    asm volatile("" : "+v"(lane));
    const int l31 = lane & 31;
    const int sec = nt >> 1;
    const int cb = (nt & 1) * 512 + wn * 128 + l31;
    const int rb = wm * 64 + 4 * (lane >> 5);
    if (sec == 0 || sec == 3) {
      bf16_t* dst = (sec == 0) ? Qp : SGp;
#pragma unroll
      for (int ni = 0; ni < 4; ++ni)
#pragma unroll
        for (int mi = 0; mi < 2; ++mi)
#pragma unroll
          for (int r = 0; r < 16; ++r) {
            const int row = rb + mi * 32 + (r & 3) + 8 * (r >> 2);
            dst[(size_t)row * 1024 + cb + ni * 32] = f2bf(silu_f(acc[mi][ni][r]));
          }
    } else if (sec == 1) {
#pragma unroll
      for (int ni = 0; ni < 4; ++ni) {
        const float lbv = lb[cb + ni * 32];
#pragma unroll
        for (int mi = 0; mi < 2; ++mi)
#pragma unroll
          for (int r = 0; r < 16; ++r) {
            const int row = rb + mi * 32 + (r & 3) + 8 * (r >> 2);
            const float f = lbv + (1.f - lbv) * __builtin_amdgcn_rcpf(1.f + __expf(-acc[mi][ni][r]));
            LFp[(size_t)row * 1024 + cb + ni * 32] = __logf(f);
          }
      }
    } else {
#pragma unroll
      for (int ni = 0; ni < 4; ++ni)
#pragma unroll
        for (int mi = 0; mi < 2; ++mi)
#pragma unroll
          for (int r = 0; r < 16; ++r) {
            const int row = rb + mi * 32 + (r & 3) + 8 * (r >> 2);
            Vp[(size_t)row * 1024 + cb + ni * 32] = f2bf(acc[mi][ni][r]);
          }
    }
  }
};
struct EpiQkv {
  bf16_t* Qp;
  bf16_t* Kp;
  bf16_t* Vp;
  const float* bias;
  __device__ __forceinline__ void operator()(f32x16 (&acc)[2][4], int nt, int wm, int wn, int lane_in) const {
    int lane = lane_in;
    asm volatile("" : "+v"(lane));
    const int l31 = lane & 31;
#pragma unroll
    for (int ni = 0; ni < 4; ++ni) {
      const int col = nt * 512 + wn * 128 + ni * 32 + l31;
      if (col < 1280) {
        const float bv = bias[col];
#pragma unroll
        for (int mi = 0; mi < 2; ++mi)
#pragma unroll
          for (int r = 0; r < 16; ++r) {
            const int row = wm * 64 + mi * 32 + ROWMAP(r, lane);
            const float x = acc[mi][ni][r] + bv;
            if (col < 1024) Qp[(size_t)row * 1024 + col] = f2bf(x * 0.125f);
            else if (col < 1152) Kp[(size_t)row * 128 + (col - 1024)] = f2bf(x);
            else Vp[(size_t)row * 128 + (col - 1152)] = f2bf(x);
          }
      }
    }
  }
};

__device__ __forceinline__ void ln_panel(const float* Hp, float* outp, bf16_t* HBp, const float* g, const float* b,
                                         float2* stg, float2* stl) {
  const int tid = opaque_tid(), lane = tid & 63;
  const int w = __builtin_amdgcn_readfirstlane(tid >> 6);
  float4 gv[4], bv[4];
#pragma unroll
  for (int j = 0; j < 4; ++j) {
    gv[j] = *(const float4*)(g + j * 256 + lane * 4);
    bv[j] = *(const float4*)(b + j * 256 + lane * 4);
  }
  for (int r0 = w; r0 < 128; r0 += 32) {
    float4 x[4][4];
#pragma unroll
    for (int u = 0; u < 4; ++u)
#pragma unroll
      for (int j = 0; j < 4; ++j) x[u][j] = *(const float4*)(Hp + (size_t)(r0 + 8 * u) * 1024 + j * 256 + lane * 4);
#pragma unroll
    for (int u = 0; u < 4; ++u) {
      const int r = r0 + 8 * u;
      float s = 0.f;
#pragma unroll
      for (int j = 0; j < 4; ++j) s += x[u][j].x + x[u][j].y + x[u][j].z + x[u][j].w;
      s = wave_sum(s);
      const float mean = s * (1.f / 1024.f);
      float v = 0.f;
#pragma unroll
      for (int j = 0; j < 4; ++j) {
        x[u][j].x -= mean; x[u][j].y -= mean; x[u][j].z -= mean; x[u][j].w -= mean;
        v += x[u][j].x * x[u][j].x + x[u][j].y * x[u][j].y + x[u][j].z * x[u][j].z + x[u][j].w * x[u][j].w;
      }
      v = wave_sum(v);
      const float rstd = 1.0f / sqrtf(v * (1.f / 1024.f) + 1e-5f);
        if (lane == 0) { stg[r] = make_float2(rstd, -mean * rstd); stl[r] = make_float2(rstd, -mean * rstd); }
#pragma unroll
      for (int j = 0; j < 4; ++j) {
        float4 y;
        y.x = x[u][j].x * rstd * gv[j].x + bv[j].x;
        y.y = x[u][j].y * rstd * gv[j].y + bv[j].y;
        y.z = x[u][j].z * rstd * gv[j].z + bv[j].z;
        y.w = x[u][j].w * rstd * gv[j].w + bv[j].w;
        if (outp) *(float4*)(outp + (size_t)r * 1024 + j * 256 + lane * 4) = y;
        uint2 pk;
        pk.x = pack2(y.x, y.y);
        pk.y = pack2(y.z, y.w);
        *(uint2*)(HBp + ablk(r, j * 256 + lane * 4)) = pk;
      }
    }
  }
  __syncthreads();
}

__device__ __forceinline__ void ffn_panel(const Ctx& C, int p, int layer, int j, bool final_out, int sub, bf16_t* smem) {
  const int wi = layer * 2 + j;
  bf16_t* HBp = C.HB() + (size_t)p * 128 * 1024;
  bf16_t* ACTp = C.ACT() + (size_t)p * 128 * 2816;
  float* Hp = C.H() + (size_t)p * 128 * 1024;
  EpiSwiglu e1{ACTp};
  gemm_panel(HBp, 1024, C.WGU() + (size_t)wi * 5632 * 1024, 1024, 11, e1, smem);
  float2* stl = (float2*)((char*)smem + LDS_STATS_OFF);
  float2* stg = C.STATS() + (size_t)p * 128;
  EpiResLN e2{sub > 0 ? (const float*)Hp : C.in[0] + (size_t)p * 128 * 1024, Hp, sub > 0 ? stl : nullptr, C.in[3] + (sub > 0 ? sub - 1 : 0) * 1024, C.in[4] + (sub > 0 ? sub - 1 : 0) * 1024, ALPHA, 0.5f, nullptr};
  gemm_panel(ACTp, 2816, C.WD() + (size_t)wi * 1024 * 2816, 2816, 2, e2, smem);
  const int li = (layer * 3 + (j == 0 ? 0 : 2)) * 1024;
  float* outp = final_out ? (C.out + (size_t)p * 128 * 1024) : nullptr;
  ln_panel(Hp, outp, HBp, C.in[3] + li, C.in[4] + li, stg, stl);
}

__device__ __forceinline__ void gmlp_panel(const Ctx& C, int p, int layer, int slot, int sub, bf16_t* smem) {
  const int tid = opaque_tid(), lane = tid & 63;
  const int w = __builtin_amdgcn_readfirstlane(tid >> 6);
  const int l31 = lane & 31, h8 = (lane >> 5) * 8;
  bf16_t* HBp = C.HB() + (size_t)p * 128 * 1024;
  bf16_t* Zp = C.ACT() + (size_t)p * 128 * 2816;
  float* Hp = C.H() + (size_t)p * 128 * 1024;
  {
    EpiGelu e{Zp};
    gemm_panel(HBp, 1024, C.WGI() + (size_t)slot * 2048 * 1024, 1024, 4, e, smem);
  }
  bf16_t* As = smem;
  bf16_t* Bs = smem + 128 * 136;
  float* st = (float*)(smem + 2 * 128 * 136);
  for (int r = w; r < 128; r += 8) {
    const uint4 q0 = *(const uint4*)(Zp + (size_t)r * 2048 + 1024 + lane * 16);
    const uint4 q1 = *(const uint4*)(Zp + (size_t)r * 2048 + 1024 + lane * 16 + 8);
    const uint32_t u[8] = {q0.x, q0.y, q0.z, q0.w, q1.x, q1.y, q1.z, q1.w};
    float x[16];
    float s = 0.f;
#pragma unroll
    for (int e = 0; e < 8; ++e) {
      x[2 * e] = __uint_as_float(u[e] << 16);
      x[2 * e + 1] = __uint_as_float(u[e] & 0xffff0000u);
      s += x[2 * e] + x[2 * e + 1];
    }
    s = wave_sum(s);
    const float mean = s * (1.f / 1024.f);
    float v = 0.f;
#pragma unroll
    for (int e = 0; e < 16; ++e) { const float d = x[e] - mean; v += d * d; }
    v = wave_sum(v);
    if (lane == 0) { st[r * 2] = mean; st[r * 2 + 1] = 1.0f / sqrtf(v * (1.f / 1024.f) + 1e-5f); }
  }
  __syncthreads();
  const float* lng = C.in[6] + slot * 1024;
  const float* lnb = C.in[7] + slot * 1024;
  const float* bsp = C.in[9] + slot * 1024;
  const bf16_t* Wsp = C.WSP() + (size_t)slot * 8 * 16384;
  const int nd = w & 3, mt0 = (w >> 2) * 2;
  for (int g = 0; g < 8; ++g) {
#pragma unroll
    for (int i = 0; i < 4; ++i) {
      const int c = tid + 512 * i;
      *(uint4*)(As + (c >> 4) * 136 + (c & 15) * 8) = *(const uint4*)(Wsp + (size_t)g * 16384 + c * 8);
    }
    {
      const int s = tid >> 2, dq = tid & 3;
      const float mean = st[s * 2], rstd = st[s * 2 + 1];
      const bf16_t* src = Zp + (size_t)s * 2048 + 1024 + g * 128 + dq * 32;
#pragma unroll
      for (int q = 0; q < 4; ++q) {
        const uint4 v4 = *(const uint4*)(src + q * 8);
        const uint32_t u[4] = {v4.x, v4.y, v4.z, v4.w};
#pragma unroll
        for (int e = 0; e < 4; ++e) {
          const int d0 = dq * 32 + q * 8 + e * 2;
          const int ch = g * 128 + d0;
          const float x0 = __uint_as_float(u[e] << 16), x1 = __uint_as_float(u[e] & 0xffff0000u);
          Bs[d0 * 136 + s] = f2bf((x0 - mean) * rstd * lng[ch] + lnb[ch]);
          Bs[(d0 + 1) * 136 + s] = f2bf((x1 - mean) * rstd * lng[ch + 1] + lnb[ch + 1]);
        }
      }
    }
    __syncthreads();
    f32x16 acc[2];
    acc[0] = zero16(); acc[1] = zero16();
#pragma unroll
    for (int k16 = 0; k16 < 8; ++k16) {
      const bfrag b = *(const bfrag*)(Bs + (nd * 32 + l31) * 136 + k16 * 16 + h8);
#pragma unroll
      for (int mi = 0; mi < 2; ++mi) {
        const bfrag a = *(const bfrag*)(As + ((mt0 + mi) * 32 + l31) * 136 + k16 * 16 + h8);
        acc[mi] = MFMA(a, b, acc[mi]);
      }
    }
#pragma unroll
    for (int mi = 0; mi < 2; ++mi)
#pragma unroll
      for (int r = 0; r < 16; ++r) {
        const int t = (mt0 + mi) * 32 + ROWMAP(r, lane);
        const int ch = g * 128 + nd * 32 + l31;
        const float mixed = acc[mi][r] + bsp[g * 128 + t];
        const float u = bf2f(Zp[(size_t)t * 2048 + ch]);
        HBp[ablk(t, ch)] = f2bf(u * mixed);
      }
    __syncthreads();
  }
  {
    EpiResLN e2{Hp, Hp, (float2*)((char*)smem + LDS_STATS_OFF), C.in[3] + (sub - 1) * 1024, C.in[4] + (sub - 1) * 1024, ALPHA, 1.0f, nullptr};
    gemm_panel(HBp, 1024, C.WGO() + (size_t)slot * 1024 * 1024, 1024, 2, e2, smem);
  }
  const int li = (layer * 3 + 1) * 1024;
  ln_panel(Hp, nullptr, HBp, C.in[3] + li, C.in[4] + li, C.STATS() + (size_t)p * 128, (float2*)((char*)smem + LDS_STATS_OFF));
}

template <bool OUT>
__device__ __forceinline__ void hgrn_rec(const Ctx& C, int p, bf16_t* smem) {
  const int tid = opaque_tid(), lane = tid & 63;
  const int w = __builtin_amdgcn_readfirstlane(tid >> 6);
  const int l31 = lane & 31, h8 = (lane >> 5) * 8;
  bf16_t* ST = smem;
  bf16_t* Qh = smem + 17408;
  bf16_t* Kh = smem + 21760;
  bf16_t* KhT = smem + 26112;
  bf16_t* vT = smem + 31232;
  bf16_t* Ps = smem + 36352;
  float* seg = (float*)(smem + 37632);
  float* dec = seg + 512;
  float* oF = dec + 128;
  const size_t row0 = (size_t)p * 128;
  const bf16_t* Qp = C.ACT() + (size_t)p * 128 * 2816;
  const bf16_t* Vp = Qp + 128 * 1024;
  const float* LFp = C.out + row0 * 1024;
  const bf16_t* SGp = C.SG() + row0 * 1024;
  bf16_t* HBp = C.HB() + row0 * 1024;
  const float* ng = C.in[13];
  const int jt = w >> 1, kt0 = (w & 1) * 2;
  const int kq = tid & 127, tq = tid >> 7;
  for (int h = 0; h < 8; ++h) {
    f32x16 accS[2];
    bf16_t* SBh = C.DS() + ((size_t)(p * 8 + h)) * 16384;
    if (OUT) {
      __syncthreads();
#pragma unroll
      for (int i = 0; i < 4; ++i) {
        const int c = tid + 512 * i;
        *(uint4*)(ST + (c >> 4) * 136 + (c & 15) * 8) = *(const uint4*)(SBh + c * 8);
      }
      __syncthreads();
#pragma unroll
      for (int c2 = 0; c2 < 2; ++c2)
#pragma unroll
        for (int r = 0; r < 16; ++r)
          accS[c2][r] = bf2f(ST[(jt * 32 + ROWMAP(r, lane)) * 136 + (kt0 + c2) * 32 + l31]);
    } else {
      accS[0] = zero16(); accS[1] = zero16();
    }
    float dsum = 0.f;
    float ln_[8];
    bf16_t vn_[8], qn_[8];
    {
      const size_t g0 = (size_t)(tq * 8) * 1024 + h * 128 + kq;
#pragma unroll
      for (int e = 0; e < 8; ++e) {
        ln_[e] = LFp[g0 + (size_t)e * 1024];
        vn_[e] = Vp[g0 + (size_t)e * 1024];
        qn_[e] = OUT ? Qp[g0 + (size_t)e * 1024] : (bf16_t)0;
      }
    }
    for (int i = 0; i < 4; ++i) {
      float l[8], cs[8];
      bf16_t vcur[8], qcur[8];
      const size_t gbase = (size_t)(i * 32 + tq * 8) * 1024 + h * 128 + kq;
#pragma unroll
      for (int e = 0; e < 8; ++e) { l[e] = ln_[e]; vcur[e] = vn_[e]; qcur[e] = qn_[e]; }
      if (i < 3) {
        const size_t gn = gbase + (size_t)32 * 1024;
#pragma unroll
        for (int e = 0; e < 8; ++e) {
          ln_[e] = LFp[gn + (size_t)e * 1024];
          vn_[e] = Vp[gn + (size_t)e * 1024];
          if (OUT) qn_[e] = Qp[gn + (size_t)e * 1024];
        }
      }
      cs[0] = l[0];
#pragma unroll
      for (int e = 1; e < 8; ++e) cs[e] = cs[e - 1] + l[e];
      seg[tq * 128 + kq] = cs[7];
#pragma unroll
      for (int e = 0; e < 8; ++e) vT[kq * 40 + tq * 8 + e] = vcur[e];
      __syncthreads();
      float off = 0.f, tot = 0.f;
#pragma unroll
      for (int q = 0; q < 4; ++q) {
        const float s = seg[q * 128 + kq];
        if (q < tq) off += s;
        tot += s;
      }
#pragma unroll
      for (int e = 0; e < 8; ++e) {
        const float gc = cs[e] + off;
        const float f = __expf(l[e]);
        const float kh = (1.f - f) * __expf(-gc);
        const bf16_t khb = f2bf(kh);
        const int t = tq * 8 + e;
        KhT[kq * 40 + t] = khb;
        if (OUT) {
          Kh[t * 136 + kq] = khb;
          const float qv = bf2f(qcur[e]);
          Qh[t * 136 + kq] = f2bf(qv * __expf(gc));
        }
      }
      if (tq == 0) { dec[kq] = __expf(tot); dsum += tot; }
      __syncthreads();
      f32x16 accO = zero16();
      if (OUT) {
        if (w == 0) {
          f32x16 accP = zero16();
#pragma unroll
          for (int k16 = 0; k16 < 8; ++k16) {
            const bfrag a = *(const bfrag*)(Qh + l31 * 136 + k16 * 16 + h8);
            const bfrag b = *(const bfrag*)(Kh + l31 * 136 + k16 * 16 + h8);
            accP = MFMA(a, b, accP);
          }
#pragma unroll
          for (int r = 0; r < 16; ++r) {
            const int t = ROWMAP(r, lane);
            Ps[t * 40 + l31] = (l31 <= t) ? f2bf(accP[r]) : (bf16_t)0;
          }
        } else if (w <= 4) {
          const int nt = w - 1;
#pragma unroll
          for (int k16 = 0; k16 < 8; ++k16) {
            const bfrag a = *(const bfrag*)(Qh + l31 * 136 + k16 * 16 + h8);
            const bfrag b = *(const bfrag*)(ST + (nt * 32 + l31) * 136 + k16 * 16 + h8);
            accO = MFMA(a, b, accO);
          }
        }
        __syncthreads();
        if (w >= 1 && w <= 4) {
          const int nt = w - 1;
#pragma unroll
          for (int k16 = 0; k16 < 2; ++k16) {
            const bfrag a = *(const bfrag*)(Ps + l31 * 40 + k16 * 16 + h8);
            const bfrag b = *(const bfrag*)(vT + (nt * 32 + l31) * 40 + k16 * 16 + h8);
            accO = MFMA(a, b, accO);
          }
#pragma unroll
          for (int r = 0; r < 16; ++r) oF[ROWMAP(r, lane) * 132 + nt * 32 + l31] = accO[r];
        }
      }
#pragma unroll
      for (int c2 = 0; c2 < 2; ++c2) {
#pragma unroll
        for (int k16 = 0; k16 < 2; ++k16) {
          const bfrag a = *(const bfrag*)(vT + (jt * 32 + l31) * 40 + k16 * 16 + h8);
          const bfrag b = *(const bfrag*)(KhT + ((kt0 + c2) * 32 + l31) * 40 + k16 * 16 + h8);
          accS[c2] = MFMA(a, b, accS[c2]);
        }
        const float dk = dec[(kt0 + c2) * 32 + l31];
#pragma unroll
        for (int r = 0; r < 16; ++r) accS[c2][r] *= dk;
        if (OUT) {
#pragma unroll
          for (int r = 0; r < 16; ++r)
            ST[(jt * 32 + ROWMAP(r, lane)) * 136 + (kt0 + c2) * 32 + l31] = f2bf(accS[c2][r]);
        }
      }
      __syncthreads();
      if (OUT) {
        const int t = tid >> 4, part = tid & 15;
        float x[8];
        float ss = 0.f;
#pragma unroll
        for (int e = 0; e < 8; ++e) { x[e] = oF[t * 132 + part * 8 + e]; ss += x[e] * x[e]; }
        ss += __shfl_xor(ss, 1, 64); ss += __shfl_xor(ss, 2, 64); ss += __shfl_xor(ss, 4, 64); ss += __shfl_xor(ss, 8, 64);
        const float rr = 1.0f / sqrtf(ss * (1.f / 128.f) + 1e-6f);
        const size_t gro = (size_t)(i * 32 + t) * 1024 + h * 128 + part * 8;
        const uint4 sg4 = *(const uint4*)(SGp + gro);
        const uint32_t su[4] = {sg4.x, sg4.y, sg4.z, sg4.w};
        uint32_t ov[4];
#pragma unroll
        for (int e = 0; e < 4; ++e) {
          const float g0 = ng[part * 8 + 2 * e], g1 = ng[part * 8 + 2 * e + 1];
          const float s0 = __uint_as_float(su[e] << 16), s1 = __uint_as_float(su[e] & 0xffff0000u);
          ov[e] = pack2(x[2 * e] * rr * g0 * s0, x[2 * e + 1] * rr * g1 * s1);
        }
        uint4 o4; o4.x = ov[0]; o4.y = ov[1]; o4.z = ov[2]; o4.w = ov[3];
        *(uint4*)(HBp + ablk(i * 32 + t, h * 128 + part * 8)) = o4;
      }
    }
    if (!OUT) {
#pragma unroll
      for (int c2 = 0; c2 < 2; ++c2)
#pragma unroll
        for (int r = 0; r < 16; ++r)
          SBh[(jt * 32 + ROWMAP(r, lane)) * 128 + (kt0 + c2) * 32 + l31] = f2bf(accS[c2][r]);
      if (tq == 0) C.DEC()[(size_t)(p * 8 + h) * 128 + kq] = __expf(dsum);
    }
  }
  __syncthreads();
}

__device__ __forceinline__ void hgrn_scan(const Ctx& C) {
  for (int gid = blockIdx.x * 512 + threadIdx.x; gid < 131072; gid += gridDim.x * 512) {
    const int kp = gid & 63, j = (gid >> 6) & 127, h = (gid >> 13) & 7, b = gid >> 16;
    float s0 = 0.f, s1 = 0.f;
    for (int c0 = 0; c0 < 128; c0 += 8) {
      uint32_t d[8];
      float2 dc[8];
#pragma unroll
      for (int e = 0; e < 8; ++e) {
        const size_t ph = (size_t)((b * 128 + c0 + e) * 8 + h);
        d[e] = *(const uint32_t*)(C.DS() + ph * 16384 + j * 128 + kp * 2);
        dc[e] = *(const float2*)(C.DEC() + ph * 128 + kp * 2);
      }
#pragma unroll
      for (int e = 0; e < 8; ++e) {
        const size_t ph = (size_t)((b * 128 + c0 + e) * 8 + h);
        *(uint32_t*)(C.DS() + ph * 16384 + j * 128 + kp * 2) = pack2(s0, s1);
        s0 = dc[e].x * s0 + __uint_as_float(d[e] << 16);
        s1 = dc[e].y * s1 + __uint_as_float(d[e] & 0xffff0000u);
      }
    }
  }
}

__device__ __forceinline__ void attn_panel(const Ctx& C, int p, bf16_t* smem) {
  const int tid = opaque_tid(), lane = tid & 63;
  const int w = __builtin_amdgcn_readfirstlane(tid >> 6);
  const int l31 = lane & 31, h8 = (lane >> 5) * 8;
  bf16_t* K2 = smem;
  bf16_t* VT = smem + 18432;
  bf16_t* Pw = smem + 35328 + w * 1280;
  const int blk = p & 127;
  const size_t row0 = (size_t)p * 128;
  const bf16_t* Qp = C.ACT() + (size_t)p * 128 * 2816;
  bf16_t* HBp = C.HB() + row0 * 1024;
  const int qt = w & 3;
  for (int hk = 0; hk < 2; ++hk) {
    __syncthreads();
#pragma unroll
    for (int i = 0; i < 4; ++i) {
      const int c = tid + 512 * i;
      const int r = c >> 3, ch = c & 7;
      uint4 kv = make_uint4(0, 0, 0, 0), vv = make_uint4(0, 0, 0, 0);
      if (blk > 0 || r >= 128) {
        const size_t tok = row0 + r - 128;
        kv = *(const uint4*)(C.KB() + tok * 128 + hk * 64 + ch * 8);
        vv = *(const uint4*)(C.VB() + tok * 128 + hk * 64 + ch * 8);
      }
      *(uint4*)(K2 + r * 72 + ch * 8) = kv;
      const uint32_t vu[4] = {vv.x, vv.y, vv.z, vv.w};
#pragma unroll
      for (int e = 0; e < 4; ++e) {
        VT[(ch * 8 + 2 * e) * 264 + r] = (bf16_t)(vu[e] & 0xffffu);
        VT[(ch * 8 + 2 * e + 1) * 264 + r] = (bf16_t)(vu[e] >> 16);
      }
    }
    __syncthreads();
    for (int u = 0; u < 4; ++u) {
      const int hq = hk * 8 + (w >> 2) * 4 + u;
      const float sink = C.in[17][hq];
      bfrag aq[4];
#pragma unroll
      for (int k16 = 0; k16 < 4; ++k16)
        aq[k16] = *(const bfrag*)(Qp + (size_t)(qt * 32 + l31) * 1024 + hq * 64 + k16 * 16 + h8);
      f32x16 s[5];
#pragma unroll
      for (int c = 0; c < 5; ++c) {
        s[c] = zero16();
#pragma unroll
        for (int k16 = 0; k16 < 4; ++k16) {
          const bfrag b = *(const bfrag*)(K2 + ((qt + c) * 32 + l31) * 72 + k16 * 16 + h8);
          s[c] = MFMA(aq[k16], b, s[c]);
        }
      }
      float linv[16];
#pragma unroll
      for (int r = 0; r < 16; ++r) {
        const int qi = qt * 32 + ROWMAP(r, lane);
        float m = -1e30f;
#pragma unroll
        for (int c = 0; c < 5; ++c) {
          const int kp = (qt + c) * 32 + l31;
          const bool valid = (kp > qi) && (kp <= qi + 128) && (blk > 0 || kp >= 128);
          const float v = valid ? s[c][r] : -1e30f;
          s[c][r] = v;
          m = fmaxf(m, v);
        }
        m = fmaxf(m, __shfl_xor(m, 16, 64)); m = fmaxf(m, __shfl_xor(m, 8, 64)); m = fmaxf(m, __shfl_xor(m, 4, 64));
        m = fmaxf(m, __shfl_xor(m, 2, 64)); m = fmaxf(m, __shfl_xor(m, 1, 64));
        m = fmaxf(m, sink);
        float sum = 0.f;
#pragma unroll
        for (int c = 0; c < 5; ++c) {
          const float pv = (s[c][r] > -1e29f) ? __expf(s[c][r] - m) : 0.f;
          s[c][r] = pv;
          sum += pv;
        }
        sum += __shfl_xor(sum, 16, 64); sum += __shfl_xor(sum, 8, 64); sum += __shfl_xor(sum, 4, 64);
        sum += __shfl_xor(sum, 2, 64); sum += __shfl_xor(sum, 1, 64);
        sum += __expf(sink - m);
        linv[r] = __builtin_amdgcn_rcpf(sum);
      }
      f32x16 o[2];
      o[0] = zero16(); o[1] = zero16();
#pragma unroll
      for (int c = 0; c < 5; ++c) {
#pragma unroll
        for (int r = 0; r < 16; ++r) Pw[ROWMAP(r, lane) * 40 + l31] = f2bf(s[c][r]);
        __syncthreads();
#pragma unroll
        for (int k16 = 0; k16 < 2; ++k16) {
          const bfrag a = *(const bfrag*)(Pw + l31 * 40 + k16 * 16 + h8);
#pragma unroll
          for (int dt = 0; dt < 2; ++dt) {
            const bfrag b = *(const bfrag*)(VT + (dt * 32 + l31) * 264 + (qt + c) * 32 + k16 * 16 + h8);
            o[dt] = MFMA(a, b, o[dt]);
          }
        }
        __syncthreads();
      }
#pragma unroll
      for (int dt = 0; dt < 2; ++dt)
#pragma unroll
        for (int r = 0; r < 16; ++r)
          HBp[ablk(qt * 32 + ROWMAP(r, lane), hq * 64 + dt * 32 + l31)] = f2bf(o[dt][r] * linv[r]);
    }
  }
  __syncthreads();
}

__device__ __forceinline__ void conv_weights(const float* __restrict__ src, bf16_t* __restrict__ dst, int nmat, int K,
                                             int Nsrc, int Ndst, int mode) {
  const int nk = K >> 5, nNt = Ndst >> 9;
  const int upm = nk * nNt;
  const int tid = threadIdx.x;
  for (int u = blockIdx.x; u < nmat * upm; u += gridDim.x) {
    const int m = u / upm, r = u - m * upm;
    const int nt = r / nk, ks = r - nt * nk;
    const int np = nt * 512 + tid;
    int sc;
    if (mode == 1) {
      const int b = np >> 7, rr = np & 127;
      sc = (rr < 64) ? (b * 64 + rr) : (2816 + b * 64 + rr - 64);
    } else {
      sc = (np < Nsrc) ? np : -1;
    }
    const float* s = src + (size_t)m * K * Nsrc + (size_t)(ks * 32) * Nsrc + (sc < 0 ? 0 : sc);
    uint32_t pk[16];
#pragma unroll
    for (int kk = 0; kk < 16; ++kk) {
      float v0 = s[(size_t)(2 * kk) * Nsrc], v1 = s[(size_t)(2 * kk + 1) * Nsrc];
      if (sc < 0) { v0 = 0.f; v1 = 0.f; }
      pk[kk] = pack2(v0, v1);
    }
    uint4* d = (uint4*)(dst + (size_t)m * K * Ndst + (size_t)(nt * nk + ks) * 16384 + tid * 32);
    d[0] = make_uint4(pk[0], pk[1], pk[2], pk[3]);
    d[1] = make_uint4(pk[4], pk[5], pk[6], pk[7]);
    d[2] = make_uint4(pk[8], pk[9], pk[10], pk[11]);
    d[3] = make_uint4(pk[12], pk[13], pk[14], pk[15]);
  }
}

__device__ __forceinline__ void phase0(const Ctx& C) {
  conv_weights(C.in[1], C.WGU(), 8, 1024, 5632, 5632, 1);
  conv_weights(C.in[2], C.WD(), 8, 2816, 1024, 1024, 0);
  conv_weights(C.in[5], C.WGI(), 2, 1024, 2048, 2048, 0);
  conv_weights(C.in[10], C.WGO(), 2, 1024, 1024, 1024, 0);
  conv_weights(C.in[11], C.WHI(), 1, 1024, 4096, 4096, 0);
  conv_weights(C.in[14], C.WHO(), 1, 1024, 1024, 1024, 0);
  conv_weights(C.in[15], C.WQKV(), 1, 1024, 1280, 1536, 0);
  conv_weights(C.in[18], C.WAO(), 1, 1024, 1024, 1024, 0);
  const size_t gtid = (size_t)blockIdx.x * 512 + threadIdx.x;
  const size_t gsz = (size_t)gridDim.x * 512;
  for (size_t i = gtid; i < (size_t)T_TOK * 1024 / 4; i += gsz) {
    const float4 v = ((const float4*)C.in[0])[i];
    uint2 pk;
    pk.x = pack2(v.x, v.y);
    pk.y = pack2(v.z, v.w);
    {
      const int row = (int)(i >> 8), col = (int)(i & 255) * 4;
      *(uint2*)(C.HB() + (size_t)(row >> 7) * 131072 + ablk(row & 127, col)) = pk;
    }
  }
  for (size_t i = gtid; i < (size_t)2 * 8 * 128 * 128; i += gsz) {
    const int s = (int)(i & 127), t = (int)((i >> 7) & 127);
    C.WSP()[i] = (s <= t) ? f2bf(C.in[8][i]) : (bf16_t)0;
  }
  for (size_t i = gtid; i < 1024; i += gsz) {
    const float* lp = C.in[12];
    const float a0 = lp[i], a1 = lp[1024 + i], a2 = lp[2048 + i], a3 = lp[3072 + i];
    const float m = fmaxf(fmaxf(a0, a1), fmaxf(a2, a3));
    const float e0 = expf(a0 - m), e1 = expf(a1 - m), e2 = expf(a2 - m), e3 = expf(a3 - m);
    C.LB()[i] = e1 / (e0 + e1 + e2 + e3);
  }
}

enum { OP_FFN = 0, OP_GMLP = 1, OP_HIN = 2, OP_HOUT = 3, OP_QKV = 4, OP_ATTN = 5 };

__device__ __forceinline__ void run_ops(const Ctx& C0, int op_lo, int op_hi, bf16_t* smem) {
  for (int p0 = blockIdx.x; p0 < NPANEL; p0 += gridDim.x) {
    for (int op = op_lo; op < op_hi; ++op) {
      const Ctx& C = C0;
      const int p = p0;
      bf16_t* HBp = C.HB() + (size_t)p * 128 * 1024;
      float* Hp = C.H() + (size_t)p * 128 * 1024;
      bf16_t* ACTp = C.ACT() + (size_t)p * 128 * 2816;
      int kind = OP_FFN, layer = 0, j = 0, sub = 0;
      switch (op) {
        case 0: kind = OP_FFN; layer = 0; j = 0; sub = 0; break;
        case 1: kind = OP_GMLP; layer = 0; j = 0; sub = 1; break;
        case 2: kind = OP_FFN; layer = 0; j = 1; sub = 2; break;
        case 3: kind = OP_FFN; layer = 1; j = 0; sub = 3; break;
        case 4: kind = OP_HIN; layer = 1; break;
        case 5: kind = OP_HOUT; layer = 1; sub = 4; break;
        case 6: kind = OP_FFN; layer = 1; j = 1; sub = 5; break;
        case 7: kind = OP_FFN; layer = 2; j = 0; sub = 6; break;
        case 8: kind = OP_QKV; layer = 2; break;
        case 9: kind = OP_ATTN; layer = 2; sub = 7; break;
        case 10: kind = OP_FFN; layer = 2; j = 1; sub = 8; break;
        case 11: kind = OP_FFN; layer = 3; j = 0; sub = 9; break;
        case 12: kind = OP_GMLP; layer = 3; j = 1; sub = 10; break;
        default: kind = OP_FFN; layer = 3; j = 1; sub = 11; break;
      }
      float2* stl = (float2*)((char*)smem + LDS_STATS_OFF);
      float2* stg = C.STATS() + (size_t)p * 128;
      if (threadIdx.x < 128) stl[threadIdx.x] = stg[threadIdx.x];
      if (kind == OP_FFN) {
        ffn_panel(C, p, layer, j, op == 13, sub, smem);
      } else if (kind == OP_GMLP) {
        gmlp_panel(C, p, layer, j, sub, smem);
      } else if (kind == OP_HIN) {
        EpiHgrn e{ACTp, ACTp + 128 * 1024, C.out + (size_t)p * 128 * 1024, C.SG() + (size_t)p * 128 * 1024, C.LB()};
        gemm_panel(HBp, 1024, C.WHI(), 1024, 8, e, smem);
        hgrn_rec<false>(C, p, smem);
      } else if (kind == OP_HOUT) {
        hgrn_rec<true>(C, p, smem);
        EpiResLN e2{Hp, Hp, stl, C.in[3] + (sub - 1) * 1024, C.in[4] + (sub - 1) * 1024, ALPHA, 1.0f, nullptr};
        gemm_panel(HBp, 1024, C.WHO(), 1024, 2, e2, smem);
        const int li = (1 * 3 + 1) * 1024;
        ln_panel(Hp, nullptr, HBp, C.in[3] + li, C.in[4] + li, stg, stl);
      } else if (kind == OP_QKV) {
        EpiQkv e{ACTp, C.KB() + (size_t)p * 128 * 128, C.VB() + (size_t)p * 128 * 128, C.in[16]};
        gemm_panel(HBp, 1024, C.WQKV(), 1024, 3, e, smem);
      } else {
        attn_panel(C, p, smem);
        EpiResLN e2{Hp, Hp, stl, C.in[3] + (sub - 1) * 1024, C.in[4] + (sub - 1) * 1024, ALPHA, 1.0f, C.in[19]};
        gemm_panel(HBp, 1024, C.WAO(), 1024, 2, e2, smem);
        const int li = (2 * 3 + 1) * 1024;
        ln_panel(Hp, nullptr, HBp, C.in[3] + li, C.in[4] + li, stg, stl);
      }
    }
  }
}

#if COOP
__device__ __forceinline__ void grid_barrier(unsigned* bar, unsigned target) {
  __syncthreads();
  if (threadIdx.x == 0) {
    __threadfence();
    __hip_atomic_fetch_add(bar, 1u, __ATOMIC_RELEASE, __HIP_MEMORY_SCOPE_AGENT);
    while (__hip_atomic_load(bar, __ATOMIC_ACQUIRE, __HIP_MEMORY_SCOPE_AGENT) < target) __builtin_amdgcn_s_sleep(8);
    __threadfence();
  }
  __syncthreads();
}

__global__ void __launch_bounds__(512) mega(Params P) {
  extern __shared__ __attribute__((aligned(16))) unsigned char lds_raw[];
  bf16_t* smem = (bf16_t*)lds_raw;
  Ctx C;
  C.in = P.in;
  C.out = P.out;
  C.ws = P.ws;
  const int lo = P.ph_lo, hi = P.ph_hi;
#if COOP
  if (lo < 0) cg::this_grid().sync();
  unsigned* bar = (unsigned*)(P.ws + OFF_BAR);
#define GSYNC(k) do { if (lo <= (k) && (k) + 1 < hi) grid_barrier(bar, (unsigned)((k) + 1) * gridDim.x); } while (0)
#else
#define GSYNC(k) do { } while (0)
#endif
  if (lo <= 0 && 0 < hi) phase0(C);
  GSYNC(0);
  if (lo <= 1 && 1 < hi) run_ops(C, 0, 5, smem);
  GSYNC(1);
  if (lo <= 2 && 2 < hi) hgrn_scan(C);
  GSYNC(2);
  if (lo <= 3 && 3 < hi) run_ops(C, 5, 9, smem);
  GSYNC(3);
  if (lo <= 4 && 4 < hi) run_ops(C, 9, 14, smem);
}

#endif

extern "C" void kernel_launch(void* const* d_in, const int* in_sizes, int n_in, void* d_out, int out_size, void* d_ws,
                              size_t ws_size, hipStream_t stream) {
  static int grid_blocks = 0;
  if (grid_blocks == 0) {
    if (n_in != 20 || ws_size < WS_END) {
      fprintf(stderr, "kernel_launch: unexpected n_in %d or ws_size %zu (need %zu)\n", n_in, ws_size, (size_t)WS_END);
      grid_blocks = -1;
      return;
    }
    int dev = 0, cus = 0, per_cu = 0;
    hipGetDevice(&dev);
    hipDeviceGetAttribute(&cus, hipDeviceAttributeMultiprocessorCount, dev);
#if COOP
    if (hipFuncSetAttribute((const void*)mega, hipFuncAttributeMaxDynamicSharedMemorySize, LDS_BYTES) != hipSuccess)
      fprintf(stderr, "kernel_launch: hipFuncSetAttribute failed\n");
    hipOccupancyMaxActiveBlocksPerMultiprocessor(&per_cu, (const void*)mega, 512, LDS_BYTES);
#endif
    (void)hipGetLastError();
    if (per_cu < 1) per_cu = 1;
    grid_blocks = cus * per_cu;
    if (grid_blocks > NPANEL) grid_blocks = NPANEL;
    if (grid_blocks < 1) grid_blocks = NPANEL;
  }
  if (grid_blocks < 0) return;
  Params P{};
  for (int i = 0; i < 20; ++i) P.in[i] = (const float*)d_in[i];
  P.out = (float*)d_out;
  P.ws = (unsigned char*)d_ws;
#if COOP
  P.ph_lo = 0; P.ph_hi = 5;
  (void)hipMemsetAsync((unsigned char*)d_ws + OFF_BAR, 0, 256, stream);
  void* args[] = {&P};
  hipError_t e = hipLaunchCooperativeKernel((const void*)mega, dim3(grid_blocks), dim3(512), args, LDS_BYTES, stream);
  if (e != hipSuccess) fprintf(stderr, "cooperative launch failed: %s (grid %d)\n", hipGetErrorString(e), grid_blocks);
#endif
}
```

```cpp
#include <hip/hip_runtime.h>
#include <hip/hip_cooperative_groups.h>
#include <stdint.h>
#include <stdio.h>
namespace cg = cooperative_groups;

#ifndef COOP
#define COOP 1
#endif

typedef unsigned short bf16_t;
typedef __attribute__((ext_vector_type(8))) __bf16 bfrag;
typedef __attribute__((ext_vector_type(16))) float f32x16;

constexpr int T_TOK = 32768;
constexpr int NPANEL = 256;
constexpr float ALPHA = 1.6817928305074290f;
constexpr int LDS_BYTES = 123904;
constexpr int LDS_STATS_OFF = 122880;

constexpr size_t SZ_WGU = (size_t)8 * 5632 * 1024 * 2;
constexpr size_t SZ_WD = (size_t)8 * 1024 * 2816 * 2;
constexpr size_t SZ_WGI = (size_t)2 * 2048 * 1024 * 2;
constexpr size_t SZ_WGO = (size_t)2 * 1024 * 1024 * 2;
constexpr size_t SZ_WSP = (size_t)2 * 8 * 128 * 128 * 2;
constexpr size_t SZ_WHI = (size_t)4096 * 1024 * 2;
constexpr size_t SZ_WHO = (size_t)1024 * 1024 * 2;
constexpr size_t SZ_WQKV = (size_t)1536 * 1024 * 2;
constexpr size_t SZ_WAO = (size_t)1024 * 1024 * 2;
constexpr size_t SZ_LB = 4096;
constexpr size_t SZ_H = (size_t)T_TOK * 1024 * 4;
constexpr size_t SZ_HB = (size_t)T_TOK * 1024 * 2;
constexpr size_t SZ_ACT = (size_t)T_TOK * 2816 * 2;
constexpr size_t SZ_SG = (size_t)T_TOK * 1024 * 2;
constexpr size_t SZ_DS = (size_t)NPANEL * 8 * 128 * 128 * 2;
constexpr size_t SZ_DEC = (size_t)NPANEL * 8 * 128 * 4;
constexpr size_t SZ_KB = (size_t)T_TOK * 128 * 2;

constexpr size_t OFF_WGU = 0;
constexpr size_t OFF_WD = OFF_WGU + SZ_WGU;
constexpr size_t OFF_WGI = OFF_WD + SZ_WD;
constexpr size_t OFF_WGO = OFF_WGI + SZ_WGI;
constexpr size_t OFF_WSP = OFF_WGO + SZ_WGO;
constexpr size_t OFF_WHI = OFF_WSP + SZ_WSP;
constexpr size_t OFF_WHO = OFF_WHI + SZ_WHI;
constexpr size_t OFF_WQKV = OFF_WHO + SZ_WHO;
constexpr size_t OFF_WAO = OFF_WQKV + SZ_WQKV;
constexpr size_t OFF_LB = OFF_WAO + SZ_WAO;
constexpr size_t OFF_H = OFF_LB + SZ_LB;
constexpr size_t OFF_HB = OFF_H + SZ_H;
constexpr size_t OFF_ACT = OFF_HB + SZ_HB;
constexpr size_t OFF_SG = OFF_ACT + SZ_ACT;
constexpr size_t OFF_DS = OFF_SG + SZ_SG;
constexpr size_t OFF_DEC = OFF_DS + SZ_DS;
constexpr size_t OFF_KB = OFF_DEC + SZ_DEC;
constexpr size_t OFF_VB = OFF_KB + SZ_KB;
constexpr size_t OFF_BAR = OFF_VB + SZ_KB;
constexpr size_t OFF_STATS = OFF_BAR + 256;
constexpr size_t WS_END = OFF_STATS + (size_t)T_TOK * 8;

struct Params {
  const float* in[20];
  float* out;
  unsigned char* ws;
  int ph_lo, ph_hi;
};

struct Ctx {
  const float* const* in;
  float* out;
  unsigned char* ws;
  __device__ __forceinline__ bf16_t* WGU() const { return (bf16_t*)(ws + OFF_WGU); }
  __device__ __forceinline__ bf16_t* WD() const { return (bf16_t*)(ws + OFF_WD); }
  __device__ __forceinline__ bf16_t* WGI() const { return (bf16_t*)(ws + OFF_WGI); }
  __device__ __forceinline__ bf16_t* WGO() const { return (bf16_t*)(ws + OFF_WGO); }
  __device__ __forceinline__ bf16_t* WSP() const { return (bf16_t*)(ws + OFF_WSP); }
  __device__ __forceinline__ bf16_t* WHI() const { return (bf16_t*)(ws + OFF_WHI); }
  __device__ __forceinline__ bf16_t* WHO() const { return (bf16_t*)(ws + OFF_WHO); }
  __device__ __forceinline__ bf16_t* WQKV() const { return (bf16_t*)(ws + OFF_WQKV); }
  __device__ __forceinline__ bf16_t* WAO() const { return (bf16_t*)(ws + OFF_WAO); }
  __device__ __forceinline__ float* LB() const { return (float*)(ws + OFF_LB); }
  __device__ __forceinline__ float* H() const { return (float*)(ws + OFF_H); }
  __device__ __forceinline__ bf16_t* HB() const { return (bf16_t*)(ws + OFF_HB); }
  __device__ __forceinline__ bf16_t* ACT() const { return (bf16_t*)(ws + OFF_ACT); }
  __device__ __forceinline__ bf16_t* SG() const { return (bf16_t*)(ws + OFF_SG); }
  __device__ __forceinline__ bf16_t* DS() const { return (bf16_t*)(ws + OFF_DS); }
  __device__ __forceinline__ float* DEC() const { return (float*)(ws + OFF_DEC); }
  __device__ __forceinline__ bf16_t* KB() const { return (bf16_t*)(ws + OFF_KB); }
  __device__ __forceinline__ bf16_t* VB() const { return (bf16_t*)(ws + OFF_VB); }
  __device__ __forceinline__ float2* STATS() const { return (float2*)(ws + OFF_STATS); }
};

typedef __attribute__((ext_vector_type(2))) float f32x2_t;
typedef __attribute__((ext_vector_type(2))) __bf16 bf16x2_t;
__device__ __forceinline__ uint32_t pack2(float a, float b) {
  f32x2_t v = {a, b};
  bf16x2_t r = __builtin_convertvector(v, bf16x2_t);
  return __builtin_bit_cast(uint32_t, r);
}
__device__ __forceinline__ bf16_t f2bf(float f) { return (bf16_t)(pack2(f, 0.f) & 0xffffu); }
__device__ __forceinline__ float bf2f(bf16_t b) { return __uint_as_float(((uint32_t)b) << 16); }
__device__ __forceinline__ float dpp_add(float v, const int ctrl_quad_perm_b1, const int which) {
  int x = __builtin_bit_cast(int, v), y;
  if (which == 0) y = __builtin_amdgcn_update_dpp(0, x, 0xB1, 0xF, 0xF, true);
  else if (which == 1) y = __builtin_amdgcn_update_dpp(0, x, 0x4E, 0xF, 0xF, true);
  else if (which == 2) y = __builtin_amdgcn_update_dpp(0, x, 0x141, 0xF, 0xF, true);
  else y = __builtin_amdgcn_update_dpp(0, x, 0x140, 0xF, 0xF, true);
  (void)ctrl_quad_perm_b1;
  return v + __builtin_bit_cast(float, y);
}
__device__ __forceinline__ float wave_sum(float v) {
  v = dpp_add(v, 0, 0);
  v = dpp_add(v, 0, 1);
  v = dpp_add(v, 0, 2);
  v = dpp_add(v, 0, 3);
  const int x = __builtin_bit_cast(int, v);
  const float s0 = __builtin_bit_cast(float, __builtin_amdgcn_readlane(x, 0));
  const float s1 = __builtin_bit_cast(float, __builtin_amdgcn_readlane(x, 16));
  const float s2 = __builtin_bit_cast(float, __builtin_amdgcn_readlane(x, 32));
  const float s3 = __builtin_bit_cast(float, __builtin_amdgcn_readlane(x, 48));
  return (s0 + s1) + (s2 + s3);
}
__device__ __forceinline__ size_t ablk(int row, int col) { return (size_t)(col >> 5) * 4096 + row * 32 + (col & 31); }
__device__ __forceinline__ float silu_f(float x) { return x * __builtin_amdgcn_rcpf(1.f + __expf(-x)); }
#define ROWMAP(reg, lane) ((((reg)&3)) + 8 * ((reg) >> 2) + 4 * ((lane) >> 5))
#define MFMA(a, b, c) __builtin_amdgcn_mfma_f32_32x32x16_bf16((a), (b), (c), 0, 0, 0)

__device__ __forceinline__ int opaque_tid() {
  int t = threadIdx.x;
  asm volatile("" : "+v"(t));
  return t;
}

__device__ __forceinline__ unsigned long long opaque_u64(unsigned long long v) {
  unsigned lo = (unsigned)v, hi = (unsigned)(v >> 32);
  asm volatile("" : "+v"(lo), "+v"(hi));
  lo = __builtin_amdgcn_readfirstlane(lo);
  hi = __builtin_amdgcn_readfirstlane(hi);
  return ((unsigned long long)hi << 32) | lo;
}

__device__ __forceinline__ f32x16 zero16() {
  f32x16 z;
#pragma unroll
  for (int i = 0; i < 16; ++i) z[i] = 0.f;
  return z;
}

constexpr int G_STAGE_B = 40960;

__device__ __forceinline__ void glds16(const bf16_t* g, const char* l) {
  __builtin_amdgcn_global_load_lds((const unsigned*)g, (unsigned*)const_cast<char*>(l), 16, 0, 0);
}

#define RDFRAGS(F, stg, ok)                                                              \
  do {                                                                                   \
    const char* sa_ = lds + (stg) * G_STAGE_B + wm * 4096 + (ok);                         \
    const char* sb_ = lds + (stg) * G_STAGE_B + 8192 + wn * 8192 + (ok);                  \
    F[0] = *(const bfrag*)(sa_);                                                         \
    F[1] = *(const bfrag*)(sa_ + 2048);                                                  \
    F[2] = *(const bfrag*)(sb_);                                                         \
    F[3] = *(const bfrag*)(sb_ + 2048);                                                  \
    F[4] = *(const bfrag*)(sb_ + 4096);                                                  \
    F[5] = *(const bfrag*)(sb_ + 6144);                                                  \
  } while (0)
#define DOMFMA(F)                                                                        \
  do {                                                                                   \
    _Pragma("unroll") for (int ni_ = 0; ni_ < 4; ++ni_) {                                \
      acc[0][ni_] = MFMA(F[0], F[2 + ni_], acc[0][ni_]);                                 \
      acc[1][ni_] = MFMA(F[1], F[2 + ni_], acc[1][ni_]);                                 \
    }                                                                                    \
  } while (0)
#define ISSUE_SLAB(stg, ntv, krv)                                                        \
  do {                                                                                   \
    const char* st_ = lds + (stg) * G_STAGE_B + w * 1024;                                    \
    glds16(a_src + (krv) * 4096, st_);                                                   \
    const bf16_t* bs_ = b_src + (size_t)((ntv) * nk + (krv)) * 16384;                    \
    _Pragma("unroll") for (int i_ = 0; i_ < 4; ++i_) glds16(bs_ + i_ * 4096, st_ + 8192 + i_ * 8192); \
  } while (0)

#define ISSUE_SLAB_LO(stg, ntv, krv)    \
  do {                                                                                   \
    const char* st_ = lds + (stg) * G_STAGE_B + w * 1024;                                \
    glds16(a_src + (krv) * 4096, st_);                                                   \
    const bf16_t* bs_ = b_src + (size_t)((ntv) * nk + (krv)) * 16384;                    \
    glds16(bs_, st_ + 8192);                                                             \
    glds16(bs_ + 4096, st_ + 8192 + 8192);                                               \
  } while (0)
#define ISSUE_SLAB_HI(stg, ntv, krv)                        \
  do {                                                                                   \
    const char* st_ = lds + (stg) * G_STAGE_B + w * 1024;                                \
    const bf16_t* bs_ = b_src + (size_t)((ntv) * nk + (krv)) * 16384;                    \
    glds16(bs_ + 2 * 4096, st_ + 8192 + 2 * 8192);                                       \
    glds16(bs_ + 3 * 4096, st_ + 8192 + 3 * 8192);                                       \
  } while (0)

template <class Epi>
__device__ __forceinline__ void gemm_panel(const bf16_t* __restrict__ A, const int lda, const bf16_t* __restrict__ Wb,
                                           const int K, const int nN, const Epi epi, bf16_t* smem) {
  const int tid = opaque_tid(), lane = tid & 63;
  const int w = __builtin_amdgcn_readfirstlane(tid >> 6);
  const int wm = w & 1, wn = w >> 1;
  const int nk = K >> 5;
  const int total = nN * nk;
  const int l31 = lane & 31, h = lane >> 5;
  const int grow = lane >> 2;
  const int gch = (lane & 3) ^ ((lane >> 4) & 3);
  const bf16_t* a_src = A + (size_t)(w * 16 + grow) * 32 + gch * 8;
  const bf16_t* b_src = Wb + (size_t)(w * 16 + grow) * 32 + gch * 8;
  const char* lds = (const char*)smem;
  const int pos0 = h ^ ((l31 >> 2) & 3);
  const int offk0 = l31 * 64 + pos0 * 16;
  const int offk1 = l31 * 64 + (pos0 ^ 2) * 16;
  f32x16 acc[2][4];
#pragma unroll
  for (int i = 0; i < 2; ++i)
#pragma unroll
    for (int j = 0; j < 4; ++j) acc[i][j] = zero16();
  const int rot = (int)(((blockIdx.x >> 3) & 31) * nk) >> 5;
  int kr3 = rot, nt3 = 0, cnt3 = 0;
  __syncthreads();
#pragma unroll
  for (int s3 = 0; s3 < 3; ++s3) {
    ISSUE_SLAB(s3, nt3, kr3);
    ++kr3; if (kr3 == nk) kr3 = 0;
    ++cnt3; if (cnt3 == nk) { cnt3 = 0; ++nt3; }
  }
  asm volatile("s_waitcnt vmcnt(10)" ::: "memory");
  asm volatile("s_waitcnt lgkmcnt(0)" ::: "memory");
  __builtin_amdgcn_s_barrier();
  asm volatile("" ::: "memory");
  bfrag F0[6], F1[6];
  RDFRAGS(F0, 0, offk0);
  int ks = 0, nt = 0, stage = 0, stage_n = 1, stage_p = 2;
  int kr3p = 0, nt3p = 0;
  for (int it = 0; it < total; ++it) {
#define SB() __builtin_amdgcn_sched_barrier(0)
#define MM(F, mi_, ni_) acc[mi_][ni_] = MFMA(F[mi_], F[2 + (ni_)], acc[mi_][ni_])
    {
      const char* sa_ = lds + stage * G_STAGE_B + wm * 4096 + offk1;
      const char* sb_ = lds + stage * G_STAGE_B + 8192 + wn * 8192 + offk1;
      const char* stp_ = lds + stage_p * G_STAGE_B + w * 1024;
      const bf16_t* bsp_ = b_src + (size_t)(nt3p * nk + kr3p) * 16384;
      MM(F0, 0, 0); SB();
      F1[0] = *(const bfrag*)(sa_); F1[1] = *(const bfrag*)(sa_ + 2048); SB();
      MM(F0, 1, 0); SB();
      if (it > 0) glds16(bsp_ + 2 * 4096, stp_ + 8192 + 2 * 8192);
      SB();
      MM(F0, 0, 1); SB();
      F1[2] = *(const bfrag*)(sb_); F1[3] = *(const bfrag*)(sb_ + 2048); SB();
      MM(F0, 1, 1); SB();
      if (it > 0) glds16(bsp_ + 3 * 4096, stp_ + 8192 + 3 * 8192);
      SB();
      MM(F0, 0, 2); SB();
      F1[4] = *(const bfrag*)(sb_ + 4096); F1[5] = *(const bfrag*)(sb_ + 6144); SB();
      MM(F0, 1, 2); MM(F0, 0, 3); MM(F0, 1, 3); SB();
    }
    asm volatile("s_waitcnt vmcnt(5)" ::: "memory");
    asm volatile("s_waitcnt lgkmcnt(0)" ::: "memory");
    __builtin_amdgcn_s_barrier();
    asm volatile("" ::: "memory");
    SB();
    {
      const char* sa_ = lds + stage_n * G_STAGE_B + wm * 4096 + offk0;
      const char* sb_ = lds + stage_n * G_STAGE_B + 8192 + wn * 8192 + offk0;
      const char* st_ = lds + stage * G_STAGE_B + w * 1024;
      const bf16_t* bs_ = b_src + (size_t)(nt3 * nk + kr3) * 16384;
      MM(F1, 0, 0); SB();
      glds16(a_src + kr3 * 4096, st_); SB();
      MM(F1, 1, 0); SB();
      F0[0] = *(const bfrag*)(sa_); F0[1] = *(const bfrag*)(sa_ + 2048); SB();
      MM(F1, 0, 1); SB();
      glds16(bs_, st_ + 8192); SB();
      MM(F1, 1, 1); SB();
      F0[2] = *(const bfrag*)(sb_); F0[3] = *(const bfrag*)(sb_ + 2048); SB();
      MM(F1, 0, 2); SB();
      glds16(bs_ + 4096, st_ + 8192 + 8192); SB();
      MM(F1, 1, 2); SB();
      F0[4] = *(const bfrag*)(sb_ + 4096); F0[5] = *(const bfrag*)(sb_ + 6144); SB();
      MM(F1, 0, 3); MM(F1, 1, 3); SB();
    }
    kr3p = kr3; nt3p = nt3;
    ++kr3; if (kr3 == nk) kr3 = 0;
    ++cnt3; if (cnt3 == nk) { cnt3 = 0; ++nt3; }
    if (ks == nk - 1) {
      epi(acc, nt, wm, wn, lane);
#pragma unroll
      for (int i = 0; i < 2; ++i)
#pragma unroll
        for (int j = 0; j < 4; ++j) acc[i][j] = zero16();
      ++nt;
      asm volatile("s_waitcnt vmcnt(0)" ::: "memory");
      RDFRAGS(F0, stage_n, offk0);
    }
    ++ks; if (ks == nk) ks = 0;
    stage_p = stage;
    stage = stage_n;
    ++stage_n; if (stage_n == 3) stage_n = 0;
  }
  asm volatile("s_waitcnt vmcnt(0)" ::: "memory");
  __syncthreads();
}

struct EpiSwiglu {
  bf16_t* act;
  __device__ __forceinline__ void operator()(f32x16 (&acc)[2][4], int nt, int wm, int wn, int lane_in) const {
    int lane = lane_in;
    asm volatile("" : "+v"(lane));
    const int l31 = lane & 31;
    bf16_t* base = act + (size_t)((nt * 4 + wn) * 2) * 4096 + (wm * 64 + 4 * (lane >> 5)) * 32 + l31;
#pragma unroll
    for (int mi = 0; mi < 2; ++mi)
#pragma unroll
      for (int n2 = 0; n2 < 2; ++n2)
#pragma unroll
        for (int r0 = 0; r0 < 16; r0 += 4) {
          float e[4], d[4], o[4];
#pragma unroll
          for (int k = 0; k < 4; ++k) e[k] = __expf(-acc[mi][n2][r0 + k]);
#pragma unroll
          for (int k = 0; k < 4; ++k) d[k] = __builtin_amdgcn_rcpf(1.f + e[k]);
#pragma unroll
          for (int k = 0; k < 4; ++k) o[k] = acc[mi][n2][r0 + k] * acc[mi][n2 + 2][r0 + k] * d[k];
#pragma unroll
          for (int k = 0; k < 4; ++k)
            base[n2 * 4096 + (mi * 32 + k + 2 * r0) * 32] = f2bf(o[k]);
        }
  }
};
struct EpiResLN {
  const float* Hin;
  float* Hp;
  const float2* st;
  const float* gp;
  const float* bp;
  float alpha, c;
  const float* bias;
  __device__ __forceinline__ void operator()(f32x16 (&acc)[2][4], int nt, int wm, int wn, int lane_in) const {
    int lane = lane_in;
    asm volatile("" : "+v"(lane));
    const int l31 = lane & 31;
    const int rb = wm * 64 + 4 * (lane >> 5);
    const size_t off0 = (size_t)rb * 1024 + nt * 512 + wn * 128 + l31;
    const float* bin = Hin + off0;
    float* base = Hp + off0;
#pragma unroll
    for (int ni = 0; ni < 4; ++ni) {
      const int col = nt * 512 + wn * 128 + ni * 32 + l31;
      float ag = alpha, ab = bias ? c * bias[col] : 0.f;
      if (st) { ag = alpha * gp[col]; ab += alpha * bp[col]; }
#pragma unroll
      for (int mi = 0; mi < 2; ++mi) {
        float hv[16];
#pragma unroll
        for (int r = 0; r < 16; ++r) hv[r] = bin[(size_t)(mi * 32 + (r & 3) + 8 * (r >> 2)) * 1024 + ni * 32];
#pragma unroll
        for (int r = 0; r < 16; ++r) {
          float A = 1.f, B = 0.f;
          if (st) { const float2 ms = st[rb + mi * 32 + (r & 3) + 8 * (r >> 2)]; A = ms.x; B = ms.y; }
          base[(size_t)(mi * 32 + (r & 3) + 8 * (r >> 2)) * 1024 + ni * 32] = fmaf(fmaf(hv[r], A, B), ag, fmaf(c, acc[mi][ni][r], ab));
        }
        __builtin_amdgcn_sched_barrier(0);
      }
    }
  }
};
struct EpiGelu {
  bf16_t* Z;
  __device__ __forceinline__ void operator()(f32x16 (&acc)[2][4], int nt, int wm, int wn, int lane_in) const {
    int lane = lane_in;
    asm volatile("" : "+v"(lane));
    const int l31 = lane & 31;
#pragma unroll
    for (int ni = 0; ni < 4; ++ni) {
      const int col = nt * 512 + wn * 128 + ni * 32 + l31;
#pragma unroll
      for (int mi = 0; mi < 2; ++mi)
#pragma unroll
        for (int r = 0; r < 16; ++r) {
          const int row = wm * 64 + mi * 32 + ROWMAP(r, lane);
          const float x = acc[mi][ni][r];
          Z[(size_t)row * 2048 + col] = f2bf(0.5f * x * (1.f + erff(x * 0.70710678118654752f)));
        }
    }
  }
};
struct EpiHgrn {
  bf16_t* Qp;
  bf16_t* Vp;
  float* LFp;
  bf16_t* SGp;
  const float* lb;
  __device__ __forceinline__ void operator()(f32x16 (&acc)[2][4], int nt, int wm, int wn, int lane_in) const {
    int lane = lane_in;
    asm volatile("" : "+v"(lane));
    const int l31 = lane & 31;
    const int sec = nt >> 1;
    const int cb = (nt & 1) * 512 + wn * 128 + l31;
    const int rb = wm * 64 + 4 * (lane >> 5);
    if (sec == 0 || sec == 3) {
      bf16_t* dst = (sec == 0) ? Qp : SGp;
#pragma unroll
      for (int ni = 0; ni < 4; ++ni)
#pragma unroll
        for (int mi = 0; mi < 2; ++mi)
#pragma unroll
          for (int r = 0; r < 16; ++r) {
            const int row = rb + mi * 32 + (r & 3) + 8 * (r >> 2);
            dst[(size_t)row * 1024 + cb + ni * 32] = f2bf(silu_f(acc[mi][ni][r]));
          }
    } else if (sec == 1) {
#pragma unroll
      for (int ni = 0; ni < 4; ++ni) {
        const float lbv = lb[cb + ni * 32];
#pragma unroll
        for (int mi = 0; mi < 2; ++mi)
#pragma unroll
          for (int r = 0; r < 16; ++r) {
            const int row = rb + mi * 32 + (r & 3) + 8 * (r >> 2);
            const float f = lbv + (1.f - lbv) * __builtin_amdgcn_rcpf(1.f + __expf(-acc[mi][ni][r]));
            LFp[(size_t)row * 1024 + cb + ni * 32] = __logf(f);
          }
      }
    } else {
#pragma unroll
      for (int ni = 0; ni < 4; ++ni)
#pragma unroll
        for (int mi = 0; mi < 2; ++mi)
#pragma unroll
          for (int r = 0; r < 16; ++r) {
            const int row = rb + mi * 32 + (r & 3) + 8 * (r >> 2);
            Vp[(size_t)row * 1024 + cb + ni * 32] = f2bf(acc[mi][ni][r]);
          }
    }
  }
};
struct EpiQkv {
  bf16_t* Qp;
  bf16_t* Kp;
  bf16_t* Vp;
  const float* bias;
  __device__ __forceinline__ void operator()(f32x16 (&acc)[2][4], int nt, int wm, int wn, int lane_in) const {
    int lane = lane_in;
    asm volatile("" : "+v"(lane));
    const int l31 = lane & 31;
#pragma unroll
    for (int ni = 0; ni < 4; ++ni) {
      const int col = nt * 512 + wn * 128 + ni * 32 + l31;
      if (col < 1280) {
        const float bv = bias[col];
#pragma unroll
        for (int mi = 0; mi < 2; ++mi)
#pragma unroll
          for (int r = 0; r < 16; ++r) {
            const int row = wm * 64 + mi * 32 + ROWMAP(r, lane);
            const float x = acc[mi][ni][r] + bv;
            if (col < 1024) Qp[(size_t)row * 1024 + col] = f2bf(x * 0.125f);
            else if (col < 1152) Kp[(size_t)row * 128 + (col - 1024)] = f2bf(x);
            else Vp[(size_t)row * 128 + (col - 1152)] = f2bf(x);
          }
      }
    }
  }
};

__device__ __forceinline__ void ln_panel(const float* Hp, float* outp, bf16_t* HBp, const float* g, const float* b,
                                         float2* stg, float2* stl) {
  const int tid = opaque_tid(), lane = tid & 63;
  const int w = __builtin_amdgcn_readfirstlane(tid >> 6);
  float4 gv[4], bv[4];
#pragma unroll
  for (int j = 0; j < 4; ++j) {
    gv[j] = *(const float4*)(g + j * 256 + lane * 4);
    bv[j] = *(const float4*)(b + j * 256 + lane * 4);
  }
  for (int r0 = w; r0 < 128; r0 += 32) {
    float4 x[4][4];
#pragma unroll
    for (int u = 0; u < 4; ++u)
#pragma unroll
      for (int j = 0; j < 4; ++j) x[u][j] = *(const float4*)(Hp + (size_t)(r0 + 8 * u) * 1024 + j * 256 + lane * 4);
#pragma unroll
    for (int u = 0; u < 4; ++u) {
      const int r = r0 + 8 * u;
      float s = 0.f;
#pragma unroll
      for (int j = 0; j < 4; ++j) s += x[u][j].x + x[u][j].y + x[u][j].z + x[u][j].w;
      s = wave_sum(s);
      const float mean = s * (1.f / 1024.f);
      float v = 0.f;
#pragma unroll
      for (int j = 0; j < 4; ++j) {
        x[u][j].x -= mean; x[u][j].y -= mean; x[u][j].z -= mean; x[u][j].w -= mean;
        v += x[u][j].x * x[u][j].x + x[u][j].y * x[u][j].y + x[u][j].z * x[u][j].z + x[u][j].w * x[u][j].w;
      }
      v = wave_sum(v);
      const float rstd = 1.0f / sqrtf(v * (1.f / 1024.f) + 1e-5f);
        if (lane == 0) { stg[r] = make_float2(rstd, -mean * rstd); stl[r] = make_float2(rstd, -mean * rstd); }
#pragma unroll
      for (int j = 0; j < 4; ++j) {
        float4 y;
        y.x = x[u][j].x * rstd * gv[j].x + bv[j].x;
        y.y = x[u][j].y * rstd * gv[j].y + bv[j].y;
        y.z = x[u][j].z * rstd * gv[j].z + bv[j].z;
        y.w = x[u][j].w * rstd * gv[j].w + bv[j].w;
        if (outp) *(float4*)(outp + (size_t)r * 1024 + j * 256 + lane * 4) = y;
        uint2 pk;
        pk.x = pack2(y.x, y.y);
        pk.y = pack2(y.z, y.w);
        *(uint2*)(HBp + ablk(r, j * 256 + lane * 4)) = pk;
      }
    }
  }
  __syncthreads();
}

__device__ __forceinline__ void ffn_panel(const Ctx& C, int p, int layer, int j, bool final_out, int sub, bf16_t* smem) {
  const int wi = layer * 2 + j;
  bf16_t* HBp = C.HB() + (size_t)p * 128 * 1024;
  bf16_t* ACTp = C.ACT() + (size_t)p * 128 * 2816;
  float* Hp = C.H() + (size_t)p * 128 * 1024;
  EpiSwiglu e1{ACTp};
  gemm_panel(HBp, 1024, C.WGU() + (size_t)wi * 5632 * 1024, 1024, 11, e1, smem);
  float2* stl = (float2*)((char*)smem + LDS_STATS_OFF);
  float2* stg = C.STATS() + (size_t)p * 128;
  EpiResLN e2{sub > 0 ? (const float*)Hp : C.in[0] + (size_t)p * 128 * 1024, Hp, sub > 0 ? stl : nullptr, C.in[3] + (sub > 0 ? sub - 1 : 0) * 1024, C.in[4] + (sub > 0 ? sub - 1 : 0) * 1024, ALPHA, 0.5f, nullptr};
  gemm_panel(ACTp, 2816, C.WD() + (size_t)wi * 1024 * 2816, 2816, 2, e2, smem);
  const int li = (layer * 3 + (j == 0 ? 0 : 2)) * 1024;
  float* outp = final_out ? (C.out + (size_t)p * 128 * 1024) : nullptr;
  ln_panel(Hp, outp, HBp, C.in[3] + li, C.in[4] + li, stg, stl);
}

__device__ __forceinline__ void gmlp_panel(const Ctx& C, int p, int layer, int slot, int sub, bf16_t* smem) {
  const int tid = opaque_tid(), lane = tid & 63;
  const int w = __builtin_amdgcn_readfirstlane(tid >> 6);
  const int l31 = lane & 31, h8 = (lane >> 5) * 8;
  bf16_t* HBp = C.HB() + (size_t)p * 128 * 1024;
  bf16_t* Zp = C.ACT() + (size_t)p * 128 * 2816;
  float* Hp = C.H() + (size_t)p * 128 * 1024;
  {
    EpiGelu e{Zp};
    gemm_panel(HBp, 1024, C.WGI() + (size_t)slot * 2048 * 1024, 1024, 4, e, smem);
  }
  bf16_t* As = smem;
  bf16_t* Bs = smem + 128 * 136;
  float* st = (float*)(smem + 2 * 128 * 136);
  for (int r = w; r < 128; r += 8) {
    const uint4 q0 = *(const uint4*)(Zp + (size_t)r * 2048 + 1024 + lane * 16);
    const uint4 q1 = *(const uint4*)(Zp + (size_t)r * 2048 + 1024 + lane * 16 + 8);
    const uint32_t u[8] = {q0.x, q0.y, q0.z, q0.w, q1.x, q1.y, q1.z, q1.w};
    float x[16];
    float s = 0.f;
#pragma unroll
    for (int e = 0; e < 8; ++e) {
      x[2 * e] = __uint_as_float(u[e] << 16);
      x[2 * e + 1] = __uint_as_float(u[e] & 0xffff0000u);
      s += x[2 * e] + x[2 * e + 1];
    }
    s = wave_sum(s);
    const float mean = s * (1.f / 1024.f);
    float v = 0.f;
#pragma unroll
    for (int e = 0; e < 16; ++e) { const float d = x[e] - mean; v += d * d; }
    v = wave_sum(v);
    if (lane == 0) { st[r * 2] = mean; st[r * 2 + 1] = 1.0f / sqrtf(v * (1.f / 1024.f) + 1e-5f); }
  }
  __syncthreads();
  const float* lng = C.in[6] + slot * 1024;
  const float* lnb = C.in[7] + slot * 1024;
  const float* bsp = C.in[9] + slot * 1024;
  const bf16_t* Wsp = C.WSP() + (size_t)slot * 8 * 16384;
  const int nd = w & 3, mt0 = (w >> 2) * 2;
  for (int g = 0; g < 8; ++g) {
#pragma unroll
    for (int i = 0; i < 4; ++i) {
      const int c = tid + 512 * i;
      *(uint4*)(As + (c >> 4) * 136 + (c & 15) * 8) = *(const uint4*)(Wsp + (size_t)g * 16384 + c * 8);
    }
    {
      const int s = tid >> 2, dq = tid & 3;
      const float mean = st[s * 2], rstd = st[s * 2 + 1];
      const bf16_t* src = Zp + (size_t)s * 2048 + 1024 + g * 128 + dq * 32;
#pragma unroll
      for (int q = 0; q < 4; ++q) {
        const uint4 v4 = *(const uint4*)(src + q * 8);
        const uint32_t u[4] = {v4.x, v4.y, v4.z, v4.w};
#pragma unroll
        for (int e = 0; e < 4; ++e) {
          const int d0 = dq * 32 + q * 8 + e * 2;
          const int ch = g * 128 + d0;
          const float x0 = __uint_as_float(u[e] << 16), x1 = __uint_as_float(u[e] & 0xffff0000u);
          Bs[d0 * 136 + s] = f2bf((x0 - mean) * rstd * lng[ch] + lnb[ch]);
          Bs[(d0 + 1) * 136 + s] = f2bf((x1 - mean) * rstd * lng[ch + 1] + lnb[ch + 1]);
        }
      }
    }
    __syncthreads();
    f32x16 acc[2];
    acc[0] = zero16(); acc[1] = zero16();
#pragma unroll
    for (int k16 = 0; k16 < 8; ++k16) {
      const bfrag b = *(const bfrag*)(Bs + (nd * 32 + l31) * 136 + k16 * 16 + h8);
#pragma unroll
      for (int mi = 0; mi < 2; ++mi) {
        const bfrag a = *(const bfrag*)(As + ((mt0 + mi) * 32 + l31) * 136 + k16 * 16 + h8);
        acc[mi] = MFMA(a, b, acc[mi]);
      }
    }
#pragma unroll
    for (int mi = 0; mi < 2; ++mi)
#pragma unroll
      for (int r = 0; r < 16; ++r) {
        const int t = (mt0 + mi) * 32 + ROWMAP(r, lane);
        const int ch = g * 128 + nd * 32 + l31;
        const float mixed = acc[mi][r] + bsp[g * 128 + t];
        const float u = bf2f(Zp[(size_t)t * 2048 + ch]);
        HBp[ablk(t, ch)] = f2bf(u * mixed);
      }
    __syncthreads();
  }
  {
    EpiResLN e2{Hp, Hp, (float2*)((char*)smem + LDS_STATS_OFF), C.in[3] + (sub - 1) * 1024, C.in[4] + (sub - 1) * 1024, ALPHA, 1.0f, nullptr};
    gemm_panel(HBp, 1024, C.WGO() + (size_t)slot * 1024 * 1024, 1024, 2, e2, smem);
  }
  const int li = (layer * 3 + 1) * 1024;
  ln_panel(Hp, nullptr, HBp, C.in[3] + li, C.in[4] + li, C.STATS() + (size_t)p * 128, (float2*)((char*)smem + LDS_STATS_OFF));
}

template <bool OUT>
__device__ __forceinline__ void hgrn_rec(const Ctx& C, int p, bf16_t* smem) {
  const int tid = opaque_tid(), lane = tid & 63;
  const int w = __builtin_amdgcn_readfirstlane(tid >> 6);
  const int l31 = lane & 31, h8 = (lane >> 5) * 8;
  bf16_t* ST = smem;
  bf16_t* Qh = smem + 17408;
  bf16_t* Kh = smem + 21760;
  bf16_t* KhT = smem + 26112;
  bf16_t* vT = smem + 31232;
  bf16_t* Ps = smem + 36352;
  float* seg = (float*)(smem + 37632);
  float* dec = seg + 512;
  float* oF = dec + 128;
  const size_t row0 = (size_t)p * 128;
  const bf16_t* Qp = C.ACT() + (size_t)p * 128 * 2816;
  const bf16_t* Vp = Qp + 128 * 1024;
  const float* LFp = C.out + row0 * 1024;
  const bf16_t* SGp = C.SG() + row0 * 1024;
  bf16_t* HBp = C.HB() + row0 * 1024;
  const float* ng = C.in[13];
  const int jt = w >> 1, kt0 = (w & 1) * 2;
  const int kq = tid & 127, tq = tid >> 7;
  for (int h = 0; h < 8; ++h) {
    f32x16 accS[2];
    bf16_t* SBh = C.DS() + ((size_t)(p * 8 + h)) * 16384;
    if (OUT) {
      __syncthreads();
#pragma unroll
      for (int i = 0; i < 4; ++i) {
        const int c = tid + 512 * i;
        *(uint4*)(ST + (c >> 4) * 136 + (c & 15) * 8) = *(const uint4*)(SBh + c * 8);
      }
      __syncthreads();
#pragma unroll
      for (int c2 = 0; c2 < 2; ++c2)
#pragma unroll
        for (int r = 0; r < 16; ++r)
          accS[c2][r] = bf2f(ST[(jt * 32 + ROWMAP(r, lane)) * 136 + (kt0 + c2) * 32 + l31]);
    } else {
      accS[0] = zero16(); accS[1] = zero16();
    }
    float dsum = 0.f;
    float ln_[8];
    bf16_t vn_[8], qn_[8];
    {
      const size_t g0 = (size_t)(tq * 8) * 1024 + h * 128 + kq;
#pragma unroll
      for (int e = 0; e < 8; ++e) {
        ln_[e] = LFp[g0 + (size_t)e * 1024];
        vn_[e] = Vp[g0 + (size_t)e * 1024];
        qn_[e] = OUT ? Qp[g0 + (size_t)e * 1024] : (bf16_t)0;
      }
    }
    for (int i = 0; i < 4; ++i) {
      float l[8], cs[8];
      bf16_t vcur[8], qcur[8];
      const size_t gbase = (size_t)(i * 32 + tq * 8) * 1024 + h * 128 + kq;
#pragma unroll
      for (int e = 0; e < 8; ++e) { l[e] = ln_[e]; vcur[e] = vn_[e]; qcur[e] = qn_[e]; }
      if (i < 3) {
        const size_t gn = gbase + (size_t)32 * 1024;
#pragma unroll
        for (int e = 0; e < 8; ++e) {
          ln_[e] = LFp[gn + (size_t)e * 1024];
          vn_[e] = Vp[gn + (size_t)e * 1024];
          if (OUT) qn_[e] = Qp[gn + (size_t)e * 1024];
        }
      }
      cs[0] = l[0];
#pragma unroll
      for (int e = 1; e < 8; ++e) cs[e] = cs[e - 1] + l[e];
      seg[tq * 128 + kq] = cs[7];
#pragma unroll
      for (int e = 0; e < 8; ++e) vT[kq * 40 + tq * 8 + e] = vcur[e];
      __syncthreads();
      float off = 0.f, tot = 0.f;
#pragma unroll
      for (int q = 0; q < 4; ++q) {
        const float s = seg[q * 128 + kq];
        if (q < tq) off += s;
        tot += s;
      }
#pragma unroll
      for (int e = 0; e < 8; ++e) {
        const float gc = cs[e] + off;
        const float f = __expf(l[e]);
        const float kh = (1.f - f) * __expf(-gc);
        const bf16_t khb = f2bf(kh);
        const int t = tq * 8 + e;
        KhT[kq * 40 + t] = khb;
        if (OUT) {
          Kh[t * 136 + kq] = khb;
          const float qv = bf2f(qcur[e]);
          Qh[t * 136 + kq] = f2bf(qv * __expf(gc));
        }
      }
      if (tq == 0) { dec[kq] = __expf(tot); dsum += tot; }
      __syncthreads();
      f32x16 accO = zero16();
      if (OUT) {
        if (w == 0) {
          f32x16 accP = zero16();
#pragma unroll
          for (int k16 = 0; k16 < 8; ++k16) {
            const bfrag a = *(const bfrag*)(Qh + l31 * 136 + k16 * 16 + h8);
            const bfrag b = *(const bfrag*)(Kh + l31 * 136 + k16 * 16 + h8);
            accP = MFMA(a, b, accP);
          }
#pragma unroll
          for (int r = 0; r < 16; ++r) {
            const int t = ROWMAP(r, lane);
            Ps[t * 40 + l31] = (l31 <= t) ? f2bf(accP[r]) : (bf16_t)0;
          }
        } else if (w <= 4) {
          const int nt = w - 1;
#pragma unroll
          for (int k16 = 0; k16 < 8; ++k16) {
            const bfrag a = *(const bfrag*)(Qh + l31 * 136 + k16 * 16 + h8);
            const bfrag b = *(const bfrag*)(ST + (nt * 32 + l31) * 136 + k16 * 16 + h8);
            accO = MFMA(a, b, accO);
          }
        }
        __syncthreads();
        if (w >= 1 && w <= 4) {
          const int nt = w - 1;
#pragma unroll
          for (int k16 = 0; k16 < 2; ++k16) {
            const bfrag a = *(const bfrag*)(Ps + l31 * 40 + k16 * 16 + h8);
            const bfrag b = *(const bfrag*)(vT + (nt * 32 + l31) * 40 + k16 * 16 + h8);
            accO = MFMA(a, b, accO);
          }
#pragma unroll
          for (int r = 0; r < 16; ++r) oF[ROWMAP(r, lane) * 132 + nt * 32 + l31] = accO[r];
        }
      }
#pragma unroll
      for (int c2 = 0; c2 < 2; ++c2) {
#pragma unroll
        for (int k16 = 0; k16 < 2; ++k16) {
          const bfrag a = *(const bfrag*)(vT + (jt * 32 + l31) * 40 + k16 * 16 + h8);
          const bfrag b = *(const bfrag*)(KhT + ((kt0 + c2) * 32 + l31) * 40 + k16 * 16 + h8);
          accS[c2] = MFMA(a, b, accS[c2]);
        }
        const float dk = dec[(kt0 + c2) * 32 + l31];
#pragma unroll
        for (int r = 0; r < 16; ++r) accS[c2][r] *= dk;
        if (OUT) {
#pragma unroll
          for (int r = 0; r < 16; ++r)
            ST[(jt * 32 + ROWMAP(r, lane)) * 136 + (kt0 + c2) * 32 + l31] = f2bf(accS[c2][r]);
        }
      }
      __syncthreads();
      if (OUT) {
        const int t = tid >> 4, part = tid & 15;
        float x[8];
        float ss = 0.f;
#pragma unroll
        for (int e = 0; e < 8; ++e) { x[e] = oF[t * 132 + part * 8 + e]; ss += x[e] * x[e]; }
        ss += __shfl_xor(ss, 1, 64); ss += __shfl_xor(ss, 2, 64); ss += __shfl_xor(ss, 4, 64); ss += __shfl_xor(ss, 8, 64);
        const float rr = 1.0f / sqrtf(ss * (1.f / 128.f) + 1e-6f);
        const size_t gro = (size_t)(i * 32 + t) * 1024 + h * 128 + part * 8;
        const uint4 sg4 = *(const uint4*)(SGp + gro);
        const uint32_t su[4] = {sg4.x, sg4.y, sg4.z, sg4.w};
        uint32_t ov[4];
#pragma unroll
        for (int e = 0; e < 4; ++e) {
          const float g0 = ng[part * 8 + 2 * e], g1 = ng[part * 8 + 2 * e + 1];
          const float s0 = __uint_as_float(su[e] << 16), s1 = __uint_as_float(su[e] & 0xffff0000u);
          ov[e] = pack2(x[2 * e] * rr * g0 * s0, x[2 * e + 1] * rr * g1 * s1);
        }
        uint4 o4; o4.x = ov[0]; o4.y = ov[1]; o4.z = ov[2]; o4.w = ov[3];
        *(uint4*)(HBp + ablk(i * 32 + t, h * 128 + part * 8)) = o4;
      }
    }
    if (!OUT) {
#pragma unroll
      for (int c2 = 0; c2 < 2; ++c2)
#pragma unroll
        for (int r = 0; r < 16; ++r)
          SBh[(jt * 32 + ROWMAP(r, lane)) * 128 + (kt0 + c2) * 32 + l31] = f2bf(accS[c2][r]);
      if (tq == 0) C.DEC()[(size_t)(p * 8 + h) * 128 + kq] = __expf(dsum);
    }
  }
  __syncthreads();
}

__device__ __forceinline__ void hgrn_scan(const Ctx& C) {
  for (int gid = blockIdx.x * 512 + threadIdx.x; gid < 131072; gid += gridDim.x * 512) {
    const int kp = gid & 63, j = (gid >> 6) & 127, h = (gid >> 13) & 7, b = gid >> 16;
    float s0 = 0.f, s1 = 0.f;
    for (int c0 = 0; c0 < 128; c0 += 8) {
      uint32_t d[8];
      float2 dc[8];
#pragma unroll
      for (int e = 0; e < 8; ++e) {
        const size_t ph = (size_t)((b * 128 + c0 + e) * 8 + h);
        d[e] = *(const uint32_t*)(C.DS() + ph * 16384 + j * 128 + kp * 2);
        dc[e] = *(const float2*)(C.DEC() + ph * 128 + kp * 2);
      }
#pragma unroll
      for (int e = 0; e < 8; ++e) {
        const size_t ph = (size_t)((b * 128 + c0 + e) * 8 + h);
        *(uint32_t*)(C.DS() + ph * 16384 + j * 128 + kp * 2) = pack2(s0, s1);
        s0 = dc[e].x * s0 + __uint_as_float(d[e] << 16);
        s1 = dc[e].y * s1 + __uint_as_float(d[e] & 0xffff0000u);
      }
    }
  }
}

__device__ __forceinline__ void attn_panel(const Ctx& C, int p, bf16_t* smem) {
  const int tid = opaque_tid(), lane = tid & 63;
  const int w = __builtin_amdgcn_readfirstlane(tid >> 6);
  const int l31 = lane & 31, h8 = (lane >> 5) * 8;
  bf16_t* K2 = smem;
  bf16_t* VT = smem + 18432;
  bf16_t* Pw = smem + 35328 + w * 1280;
  const int blk = p & 127;
  const size_t row0 = (size_t)p * 128;
  const bf16_t* Qp = C.ACT() + (size_t)p * 128 * 2816;
  bf16_t* HBp = C.HB() + row0 * 1024;
  const int qt = w & 3;
  for (int hk = 0; hk < 2; ++hk) {
    __syncthreads();
#pragma unroll
    for (int i = 0; i < 4; ++i) {
      const int c = tid + 512 * i;
      const int r = c >> 3, ch = c & 7;
      uint4 kv = make_uint4(0, 0, 0, 0), vv = make_uint4(0, 0, 0, 0);
      if (blk > 0 || r >= 128) {
        const size_t tok = row0 + r - 128;
        kv = *(const uint4*)(C.KB() + tok * 128 + hk * 64 + ch * 8);
        vv = *(const uint4*)(C.VB() + tok * 128 + hk * 64 + ch * 8);
      }
      *(uint4*)(K2 + r * 72 + ch * 8) = kv;
      const uint32_t vu[4] = {vv.x, vv.y, vv.z, vv.w};
#pragma unroll
      for (int e = 0; e < 4; ++e) {
        VT[(ch * 8 + 2 * e) * 264 + r] = (bf16_t)(vu[e] & 0xffffu);
        VT[(ch * 8 + 2 * e + 1) * 264 + r] = (bf16_t)(vu[e] >> 16);
      }
    }
    __syncthreads();
    for (int u = 0; u < 4; ++u) {
      const int hq = hk * 8 + (w >> 2) * 4 + u;
      const float sink = C.in[17][hq];
      bfrag aq[4];
#pragma unroll
      for (int k16 = 0; k16 < 4; ++k16)
        aq[k16] = *(const bfrag*)(Qp + (size_t)(qt * 32 + l31) * 1024 + hq * 64 + k16 * 16 + h8);
      f32x16 s[5];
#pragma unroll
      for (int c = 0; c < 5; ++c) {
        s[c] = zero16();
#pragma unroll
        for (int k16 = 0; k16 < 4; ++k16) {
          const bfrag b = *(const bfrag*)(K2 + ((qt + c) * 32 + l31) * 72 + k16 * 16 + h8);
          s[c] = MFMA(aq[k16], b, s[c]);
        }
      }
      float linv[16];
#pragma unroll
      for (int r = 0; r < 16; ++r) {
        const int qi = qt * 32 + ROWMAP(r, lane);
        float m = -1e30f;
#pragma unroll
        for (int c = 0; c < 5; ++c) {
          const int kp = (qt + c) * 32 + l31;
          const bool valid = (kp > qi) && (kp <= qi + 128) && (blk > 0 || kp >= 128);
          const float v = valid ? s[c][r] : -1e30f;
          s[c][r] = v;
          m = fmaxf(m, v);
        }
        m = fmaxf(m, __shfl_xor(m, 16, 64)); m = fmaxf(m, __shfl_xor(m, 8, 64)); m = fmaxf(m, __shfl_xor(m, 4, 64));
        m = fmaxf(m, __shfl_xor(m, 2, 64)); m = fmaxf(m, __shfl_xor(m, 1, 64));
        m = fmaxf(m, sink);
        float sum = 0.f;
#pragma unroll
        for (int c = 0; c < 5; ++c) {
          const float pv = (s[c][r] > -1e29f) ? __expf(s[c][r] - m) : 0.f;
          s[c][r] = pv;
          sum += pv;
        }
        sum += __shfl_xor(sum, 16, 64); sum += __shfl_xor(sum, 8, 64); sum += __shfl_xor(sum, 4, 64);
        sum += __shfl_xor(sum, 2, 64); sum += __shfl_xor(sum, 1, 64);
        sum += __expf(sink - m);
        linv[r] = __builtin_amdgcn_rcpf(sum);
      }
      f32x16 o[2];
      o[0] = zero16(); o[1] = zero16();
#pragma unroll
      for (int c = 0; c < 5; ++c) {
#pragma unroll
        for (int r = 0; r < 16; ++r) Pw[ROWMAP(r, lane) * 40 + l31] = f2bf(s[c][r]);
        __syncthreads();
#pragma unroll
        for (int k16 = 0; k16 < 2; ++k16) {
          const bfrag a = *(const bfrag*)(Pw + l31 * 40 + k16 * 16 + h8);
#pragma unroll
          for (int dt = 0; dt < 2; ++dt) {
            const bfrag b = *(const bfrag*)(VT + (dt * 32 + l31) * 264 + (qt + c) * 32 + k16 * 16 + h8);
            o[dt] = MFMA(a, b, o[dt]);
          }
        }
        __syncthreads();
      }
#pragma unroll
      for (int dt = 0; dt < 2; ++dt)
#pragma unroll
        for (int r = 0; r < 16; ++r)
          HBp[ablk(qt * 32 + ROWMAP(r, lane), hq * 64 + dt * 32 + l31)] = f2bf(o[dt][r] * linv[r]);
    }
  }
  __syncthreads();
}

__device__ __forceinline__ void conv_weights(const float* __restrict__ src, bf16_t* __restrict__ dst, int nmat, int K,
                                             int Nsrc, int Ndst, int mode) {
  const int nk = K >> 5, nNt = Ndst >> 9;
  const int upm = nk * nNt;
  const int tid = threadIdx.x;
  for (int u = blockIdx.x; u < nmat * upm; u += gridDim.x) {
    const int m = u / upm, r = u - m * upm;
    const int nt = r / nk, ks = r - nt * nk;
    const int np = nt * 512 + tid;
    int sc;
    if (mode == 1) {
      const int b = np >> 7, rr = np & 127;
      sc = (rr < 64) ? (b * 64 + rr) : (2816 + b * 64 + rr - 64);
    } else {
      sc = (np < Nsrc) ? np : -1;
    }
    const float* s = src + (size_t)m * K * Nsrc + (size_t)(ks * 32) * Nsrc + (sc < 0 ? 0 : sc);
    uint32_t pk[16];
#pragma unroll
    for (int kk = 0; kk < 16; ++kk) {
      float v0 = s[(size_t)(2 * kk) * Nsrc], v1 = s[(size_t)(2 * kk + 1) * Nsrc];
      if (sc < 0) { v0 = 0.f; v1 = 0.f; }
      pk[kk] = pack2(v0, v1);
    }
    uint4* d = (uint4*)(dst + (size_t)m * K * Ndst + (size_t)(nt * nk + ks) * 16384 + tid * 32);
    d[0] = make_uint4(pk[0], pk[1], pk[2], pk[3]);
    d[1] = make_uint4(pk[4], pk[5], pk[6], pk[7]);
    d[2] = make_uint4(pk[8], pk[9], pk[10], pk[11]);
    d[3] = make_uint4(pk[12], pk[13], pk[14], pk[15]);
  }
}

__device__ __forceinline__ void phase0(const Ctx& C) {
  conv_weights(C.in[1], C.WGU(), 8, 1024, 5632, 5632, 1);
  conv_weights(C.in[2], C.WD(), 8, 2816, 1024, 1024, 0);
  conv_weights(C.in[5], C.WGI(), 2, 1024, 2048, 2048, 0);
  conv_weights(C.in[10], C.WGO(), 2, 1024, 1024, 1024, 0);
  conv_weights(C.in[11], C.WHI(), 1, 1024, 4096, 4096, 0);
  conv_weights(C.in[14], C.WHO(), 1, 1024, 1024, 1024, 0);
  conv_weights(C.in[15], C.WQKV(), 1, 1024, 1280, 1536, 0);
  conv_weights(C.in[18], C.WAO(), 1, 1024, 1024, 1024, 0);
  const size_t gtid = (size_t)blockIdx.x * 512 + threadIdx.x;
  const size_t gsz = (size_t)gridDim.x * 512;
  for (size_t i = gtid; i < (size_t)T_TOK * 1024 / 4; i += gsz) {
    const float4 v = ((const float4*)C.in[0])[i];
    uint2 pk;
    pk.x = pack2(v.x, v.y);
    pk.y = pack2(v.z, v.w);
    {
      const int row = (int)(i >> 8), col = (int)(i & 255) * 4;
      *(uint2*)(C.HB() + (size_t)(row >> 7) * 131072 + ablk(row & 127, col)) = pk;
    }
  }
  for (size_t i = gtid; i < (size_t)2 * 8 * 128 * 128; i += gsz) {
    const int s = (int)(i & 127), t = (int)((i >> 7) & 127);
    C.WSP()[i] = (s <= t) ? f2bf(C.in[8][i]) : (bf16_t)0;
  }
  for (size_t i = gtid; i < 1024; i += gsz) {
    const float* lp = C.in[12];
    const float a0 = lp[i], a1 = lp[1024 + i], a2 = lp[2048 + i], a3 = lp[3072 + i];
    const float m = fmaxf(fmaxf(a0, a1), fmaxf(a2, a3));
    const float e0 = expf(a0 - m), e1 = expf(a1 - m), e2 = expf(a2 - m), e3 = expf(a3 - m);
    C.LB()[i] = e1 / (e0 + e1 + e2 + e3);
  }
}

enum { OP_FFN = 0, OP_GMLP = 1, OP_HIN = 2, OP_HOUT = 3, OP_QKV = 4, OP_ATTN = 5 };

__device__ __forceinline__ void run_ops(const Ctx& C0, int op_lo, int op_hi, bf16_t* smem) {
  for (int p0 = blockIdx.x; p0 < NPANEL; p0 += gridDim.x) {
    for (int op = op_lo; op < op_hi; ++op) {
      const Ctx& C = C0;
      const int p = p0;
      bf16_t* HBp = C.HB() + (size_t)p * 128 * 1024;
      float* Hp = C.H() + (size_t)p * 128 * 1024;
      bf16_t* ACTp = C.ACT() + (size_t)p * 128 * 2816;
      int kind = OP_FFN, layer = 0, j = 0, sub = 0;
      switch (op) {
        case 0: kind = OP_FFN; layer = 0; j = 0; sub = 0; break;
        case 1: kind = OP_GMLP; layer = 0; j = 0; sub = 1; break;
        case 2: kind = OP_FFN; layer = 0; j = 1; sub = 2; break;
        case 3: kind = OP_FFN; layer = 1; j = 0; sub = 3; break;
        case 4: kind = OP_HIN; layer = 1; break;
        case 5: kind = OP_HOUT; layer = 1; sub = 4; break;
        case 6: kind = OP_FFN; layer = 1; j = 1; sub = 5; break;
        case 7: kind = OP_FFN; layer = 2; j = 0; sub = 6; break;
        case 8: kind = OP_QKV; layer = 2; break;
        case 9: kind = OP_ATTN; layer = 2; sub = 7; break;
        case 10: kind = OP_FFN; layer = 2; j = 1; sub = 8; break;
        case 11: kind = OP_FFN; layer = 3; j = 0; sub = 9; break;
        case 12: kind = OP_GMLP; layer = 3; j = 1; sub = 10; break;
        default: kind = OP_FFN; layer = 3; j = 1; sub = 11; break;
      }
      float2* stl = (float2*)((char*)smem + LDS_STATS_OFF);
      float2* stg = C.STATS() + (size_t)p * 128;
      if (threadIdx.x < 128) stl[threadIdx.x] = stg[threadIdx.x];
      if (kind == OP_FFN) {
        ffn_panel(C, p, layer, j, op == 13, sub, smem);
      } else if (kind == OP_GMLP) {
        gmlp_panel(C, p, layer, j, sub, smem);
      } else if (kind == OP_HIN) {
        EpiHgrn e{ACTp, ACTp + 128 * 1024, C.out + (size_t)p * 128 * 1024, C.SG() + (size_t)p * 128 * 1024, C.LB()};
        gemm_panel(HBp, 1024, C.WHI(), 1024, 8, e, smem);
        hgrn_rec<false>(C, p, smem);
      } else if (kind == OP_HOUT) {
        hgrn_rec<true>(C, p, smem);
        EpiResLN e2{Hp, Hp, stl, C.in[3] + (sub - 1) * 1024, C.in[4] + (sub - 1) * 1024, ALPHA, 1.0f, nullptr};
        gemm_panel(HBp, 1024, C.WHO(), 1024, 2, e2, smem);
        const int li = (1 * 3 + 1) * 1024;
        ln_panel(Hp, nullptr, HBp, C.in[3] + li, C.in[4] + li, stg, stl);
      } else if (kind == OP_QKV) {
        EpiQkv e{ACTp, C.KB() + (size_t)p * 128 * 128, C.VB() + (size_t)p * 128 * 128, C.in[16]};
        gemm_panel(HBp, 1024, C.WQKV(), 1024, 3, e, smem);
      } else {
        attn_panel(C, p, smem);
        EpiResLN e2{Hp, Hp, stl, C.in[3] + (sub - 1) * 1024, C.in[4] + (sub - 1) * 1024, ALPHA, 1.0f, C.in[19]};
        gemm_panel(HBp, 1024, C.WAO(), 1024, 2, e2, smem);
        const int li = (2 * 3 + 1) * 1024;
        ln_panel(Hp, nullptr, HBp, C.in[3] + li, C.in[4] + li, stg, stl);
      }
    }
  }
}

#if COOP
__device__ __forceinline__ void grid_barrier(unsigned* bar, unsigned target) {
  __syncthreads();
  if (threadIdx.x == 0) {
    __threadfence();
    __hip_atomic_fetch_add(bar, 1u, __ATOMIC_RELEASE, __HIP_MEMORY_SCOPE_AGENT);
    while (__hip_atomic_load(bar, __ATOMIC_ACQUIRE, __HIP_MEMORY_SCOPE_AGENT) < target) __builtin_amdgcn_s_sleep(8);
    __threadfence();
  }
  __syncthreads();
}

__global__ void __launch_bounds__(512) mega(Params P) {
  extern __shared__ __attribute__((aligned(16))) unsigned char lds_raw[];
  bf16_t* smem = (bf16_t*)lds_raw;
  Ctx C;
  C.in = P.in;
  C.out = P.out;
  C.ws = P.ws;
  const int lo = P.ph_lo, hi = P.ph_hi;
#if COOP
  if (lo < 0) cg::this_grid().sync();
  unsigned* bar = (unsigned*)(P.ws + OFF_BAR);
#define GSYNC(k) do { if (lo <= (k) && (k) + 1 < hi) grid_barrier(bar, (unsigned)((k) + 1) * gridDim.x); } while (0)
#else
#define GSYNC(k) do { } while (0)
#endif
  if (lo <= 0 && 0 < hi) phase0(C);
  GSYNC(0);
  if (lo <= 1 && 1 < hi) run_ops(C, 0, 5, smem);
  GSYNC(1);
  if (lo <= 2 && 2 < hi) hgrn_scan(C);
  GSYNC(2);
  if (lo <= 3 && 3 < hi) run_ops(C, 5, 9, smem);
  GSYNC(3);
  if (lo <= 4 && 4 < hi) run_ops(C, 9, 14, smem);
}

#endif

extern "C" void kernel_launch(void* const* d_in, const int* in_sizes, int n_in, void* d_out, int out_size, void* d_ws,
                              size_t ws_size, hipStream_t stream) {
  static int grid_blocks = 0;
  if (grid_blocks == 0) {
    if (n_in != 20 || ws_size < WS_END) {
      fprintf(stderr, "kernel_launch: unexpected n_in %d or ws_size %zu (need %zu)\n", n_in, ws_size, (size_t)WS_END);
      grid_blocks = -1;
      return;
    }
    int dev = 0, cus = 0, per_cu = 0;
    hipGetDevice(&dev);
    hipDeviceGetAttribute(&cus, hipDeviceAttributeMultiprocessorCount, dev);
#if COOP
    if (hipFuncSetAttribute((const void*)mega, hipFuncAttributeMaxDynamicSharedMemorySize, LDS_BYTES) != hipSuccess)
      fprintf(stderr, "kernel_launch: hipFuncSetAttribute failed\n");
    hipOccupancyMaxActiveBlocksPerMultiprocessor(&per_cu, (const void*)mega, 512, LDS_BYTES);
#endif
    (void)hipGetLastError();
    if (per_cu < 1) per_cu = 1;
    grid_blocks = cus * per_cu;
    if (grid_blocks > NPANEL) grid_blocks = NPANEL;
    if (grid_blocks < 1) grid_blocks = NPANEL;
  }
  if (grid_blocks < 0) return;
  Params P{};
  for (int i = 0; i < 20; ++i) P.in[i] = (const float*)d_in[i];
  P.out = (float*)d_out;
  P.ws = (unsigned char*)d_ws;
#if COOP
  P.ph_lo = 0; P.ph_hi = 5;
  (void)hipMemsetAsync((unsigned char*)d_ws + OFF_BAR, 0, 256, stream);
  void* args[] = {&P};
  hipError_t e = hipLaunchCooperativeKernel((const void*)mega, dim3(grid_blocks), dim3(512), args, LDS_BYTES, stream);
  if (e != hipSuccess) fprintf(stderr, "cooperative launch failed: %s (grid %d)\n", hipGetErrorString(e), grid_blocks);
#endif
}
```

```cpp
#include <hip/hip_runtime.h>
#include <hip/hip_cooperative_groups.h>
#include <stdint.h>
#include <stdio.h>
namespace cg = cooperative_groups;

#ifndef COOP
#define COOP 1
#endif

typedef unsigned short bf16_t;
typedef __attribute__((ext_vector_type(8))) __bf16 bfrag;
typedef __attribute__((ext_vector_type(16))) float f32x16;

constexpr int T_TOK = 32768;
constexpr int NPANEL = 256;
constexpr float ALPHA = 1.6817928305074290f;
constexpr int LDS_BYTES = 123904;
constexpr int LDS_STATS_OFF = 122880;

constexpr size_t SZ_WGU = (size_t)8 * 5632 * 1024 * 2;
constexpr size_t SZ_WD = (size_t)8 * 1024 * 2816 * 2;
constexpr size_t SZ_WGI = (size_t)2 * 2048 * 1024 * 2;
constexpr size_t SZ_WGO = (size_t)2 * 1024 * 1024 * 2;
constexpr size_t SZ_WSP = (size_t)2 * 8 * 128 * 128 * 2;
constexpr size_t SZ_WHI = (size_t)4096 * 1024 * 2;
constexpr size_t SZ_WHO = (size_t)1024 * 1024 * 2;
constexpr size_t SZ_WQKV = (size_t)1536 * 1024 * 2;
constexpr size_t SZ_WAO = (size_t)1024 * 1024 * 2;
constexpr size_t SZ_LB = 4096;
constexpr size_t SZ_H = (size_t)T_TOK * 1024 * 4;
constexpr size_t SZ_HB = (size_t)T_TOK * 1024 * 2;
constexpr size_t SZ_ACT = (size_t)T_TOK * 2816 * 2;
constexpr size_t SZ_SG = (size_t)T_TOK * 1024 * 2;
constexpr size_t SZ_DS = (size_t)NPANEL * 8 * 128 * 128 * 2;
constexpr size_t SZ_DEC = (size_t)NPANEL * 8 * 128 * 4;
constexpr size_t SZ_KB = (size_t)T_TOK * 128 * 2;

constexpr size_t OFF_WGU = 0;
constexpr size_t OFF_WD = OFF_WGU + SZ_WGU;
constexpr size_t OFF_WGI = OFF_WD + SZ_WD;
constexpr size_t OFF_WGO = OFF_WGI + SZ_WGI;
constexpr size_t OFF_WSP = OFF_WGO + SZ_WGO;
constexpr size_t OFF_WHI = OFF_WSP + SZ_WSP;
constexpr size_t OFF_WHO = OFF_WHI + SZ_WHI;
constexpr size_t OFF_WQKV = OFF_WHO + SZ_WHO;
constexpr size_t OFF_WAO = OFF_WQKV + SZ_WQKV;
constexpr size_t OFF_LB = OFF_WAO + SZ_WAO;
constexpr size_t OFF_H = OFF_LB + SZ_LB;
constexpr size_t OFF_HB = OFF_H + SZ_H;
constexpr size_t OFF_ACT = OFF_HB + SZ_HB;
constexpr size_t OFF_SG = OFF_ACT + SZ_ACT;
constexpr size_t OFF_DS = OFF_SG + SZ_SG;
constexpr size_t OFF_DEC = OFF_DS + SZ_DS;
constexpr size_t OFF_KB = OFF_DEC + SZ_DEC;
constexpr size_t OFF_VB = OFF_KB + SZ_KB;
constexpr size_t OFF_BAR = OFF_VB + SZ_KB;
constexpr size_t OFF_STATS = OFF_BAR + 256;
constexpr size_t WS_END = OFF_STATS + (size_t)T_TOK * 8;

struct Params {
  const float* in[20];
  float* out;
  unsigned char* ws;
  int ph_lo, ph_hi;
};

struct Ctx {
  const float* const* in;
  float* out;
  unsigned char* ws;
  __device__ __forceinline__ bf16_t* WGU() const { return (bf16_t*)(ws + OFF_WGU); }
  __device__ __forceinline__ bf16_t* WD() const { return (bf16_t*)(ws + OFF_WD); }
  __device__ __forceinline__ bf16_t* WGI() const { return (bf16_t*)(ws + OFF_WGI); }
  __device__ __forceinline__ bf16_t* WGO() const { return (bf16_t*)(ws + OFF_WGO); }
  __device__ __forceinline__ bf16_t* WSP() const { return (bf16_t*)(ws + OFF_WSP); }
  __device__ __forceinline__ bf16_t* WHI() const { return (bf16_t*)(ws + OFF_WHI); }
  __device__ __forceinline__ bf16_t* WHO() const { return (bf16_t*)(ws + OFF_WHO); }
  __device__ __forceinline__ bf16_t* WQKV() const { return (bf16_t*)(ws + OFF_WQKV); }
  __device__ __forceinline__ bf16_t* WAO() const { return (bf16_t*)(ws + OFF_WAO); }
  __device__ __forceinline__ float* LB() const { return (float*)(ws + OFF_LB); }
  __device__ __forceinline__ float* H() const { return (float*)(ws + OFF_H); }
  __device__ __forceinline__ bf16_t* HB() const { return (bf16_t*)(ws + OFF_HB); }
  __device__ __forceinline__ bf16_t* ACT() const { return (bf16_t*)(ws + OFF_ACT); }
  __device__ __forceinline__ bf16_t* SG() const { return (bf16_t*)(ws + OFF_SG); }
  __device__ __forceinline__ bf16_t* DS() const { return (bf16_t*)(ws + OFF_DS); }
  __device__ __forceinline__ float* DEC() const { return (float*)(ws + OFF_DEC); }
  __device__ __forceinline__ bf16_t* KB() const { return (bf16_t*)(ws + OFF_KB); }
  __device__ __forceinline__ bf16_t* VB() const { return (bf16_t*)(ws + OFF_VB); }
  __device__ __forceinline__ float2* STATS() const { return (float2*)(ws + OFF_STATS); }
};

typedef __attribute__((ext_vector_type(2))) float f32x2_t;
typedef __attribute__((ext_vector_type(2))) __bf16 bf16x2_t;
__device__ __forceinline__ uint32_t pack2(float a, float b) {
  f32x2_t v = {a, b};
  bf16x2_t r = __builtin_convertvector(v, bf16x2_t);
  return __builtin_bit_cast(uint32_t, r);
}
__device__ __forceinline__ bf16_t f2bf(float f) { return (bf16_t)(pack2(f, 0.f) & 0xffffu); }
__device__ __forceinline__ float bf2f(bf16_t b) { return __uint_as_float(((uint32_t)b) << 16); }
__device__ __forceinline__ float dpp_add(float v, const int ctrl_quad_perm_b1, const int which) {
  int x = __builtin_bit_cast(int, v), y;
  if (which == 0) y = __builtin_amdgcn_update_dpp(0, x, 0xB1, 0xF, 0xF, true);
  else if (which == 1) y = __builtin_amdgcn_update_dpp(0, x, 0x4E, 0xF, 0xF, true);
  else if (which == 2) y = __builtin_amdgcn_update_dpp(0, x, 0x141, 0xF, 0xF, true);
  else y = __builtin_amdgcn_update_dpp(0, x, 0x140, 0xF, 0xF, true);
  (void)ctrl_quad_perm_b1;
  return v + __builtin_bit_cast(float, y);
}
__device__ __forceinline__ float wave_sum(float v) {
  v = dpp_add(v, 0, 0);
  v = dpp_add(v, 0, 1);
  v = dpp_add(v, 0, 2);
  v = dpp_add(v, 0, 3);
  const int x = __builtin_bit_cast(int, v);
  const float s0 = __builtin_bit_cast(float, __builtin_amdgcn_readlane(x, 0));
  const float s1 = __builtin_bit_cast(float, __builtin_amdgcn_readlane(x, 16));
  const float s2 = __builtin_bit_cast(float, __builtin_amdgcn_readlane(x, 32));
  const float s3 = __builtin_bit_cast(float, __builtin_amdgcn_readlane(x, 48));
  return (s0 + s1) + (s2 + s3);
}
__device__ __forceinline__ size_t ablk(int row, int col) { return (size_t)(col >> 5) * 4096 + row * 32 + (col & 31); }
__device__ __forceinline__ float silu_f(float x) { return x * __builtin_amdgcn_rcpf(1.f + __expf(-x)); }
#define ROWMAP(reg, lane) ((((reg)&3)) + 8 * ((reg) >> 2) + 4 * ((lane) >> 5))
#define MFMA(a, b, c) __builtin_amdgcn_mfma_f32_32x32x16_bf16((a), (b), (c), 0, 0, 0)

__device__ __forceinline__ int opaque_tid() {
  int t = threadIdx.x;
  asm volatile("" : "+v"(t));
  return t;
}

__device__ __forceinline__ unsigned long long opaque_u64(unsigned long long v) {
  unsigned lo = (unsigned)v, hi = (unsigned)(v >> 32);
  asm volatile("" : "+v"(lo), "+v"(hi));
  lo = __builtin_amdgcn_readfirstlane(lo);
  hi = __builtin_amdgcn_readfirstlane(hi);
  return ((unsigned long long)hi << 32) | lo;
}

__device__ __forceinline__ f32x16 zero16() {
  f32x16 z;
#pragma unroll
  for (int i = 0; i < 16; ++i) z[i] = 0.f;
  return z;
}

constexpr int G_STAGE_B = 40960;

__device__ __forceinline__ void glds16(const bf16_t* g, const char* l) {
  __builtin_amdgcn_global_load_lds((const unsigned*)g, (unsigned*)const_cast<char*>(l), 16, 0, 0);
}

#define RDFRAGS(F, stg, ok)                                                              \
  do {                                                                                   \
    const char* sa_ = lds + (stg) * G_STAGE_B + wm * 4096 + (ok);                         \
    const char* sb_ = lds + (stg) * G_STAGE_B + 8192 + wn * 8192 + (ok);                  \
    F[0] = *(const bfrag*)(sa_);                                                         \
    F[1] = *(const bfrag*)(sa_ + 2048);                                                  \
    F[2] = *(const bfrag*)(sb_);                                                         \
    F[3] = *(const bfrag*)(sb_ + 2048);                                                  \
    F[4] = *(const bfrag*)(sb_ + 4096);                                                  \
    F[5] = *(const bfrag*)(sb_ + 6144);                                                  \
  } while (0)
#define DOMFMA(F)                                                                        \
  do {                                                                                   \
    _Pragma("unroll") for (int ni_ = 0; ni_ < 4; ++ni_) {                                \
      acc[0][ni_] = MFMA(F[0], F[2 + ni_], acc[0][ni_]);                                 \
      acc[1][ni_] = MFMA(F[1], F[2 + ni_], acc[1][ni_]);                                 \
    }                                                                                    \
  } while (0)
#define ISSUE_SLAB(stg, ntv, krv)                                                        \
  do {                                                                                   \
    const char* st_ = lds + (stg) * G_STAGE_B + w * 1024;                                    \
    glds16(a_src + (krv) * 4096, st_);                                                   \
    const bf16_t* bs_ = b_src + (size_t)((ntv) * nk + (krv)) * 16384;                    \
    _Pragma("unroll") for (int i_ = 0; i_ < 4; ++i_) glds16(bs_ + i_ * 4096, st_ + 8192 + i_ * 8192); \
  } while (0)

#define ISSUE_SLAB_LO(stg, ntv, krv)    \
  do {                                                                                   \
    const char* st_ = lds + (stg) * G_STAGE_B + w * 1024;                                \
    glds16(a_src + (krv) * 4096, st_);                                                   \
    const bf16_t* bs_ = b_src + (size_t)((ntv) * nk + (krv)) * 16384;                    \
    glds16(bs_, st_ + 8192);                                                             \
    glds16(bs_ + 4096, st_ + 8192 + 8192);                                               \
  } while (0)
#define ISSUE_SLAB_HI(stg, ntv, krv)                        \
  do {                                                                                   \
    const char* st_ = lds + (stg) * G_STAGE_B + w * 1024;                                \
    const bf16_t* bs_ = b_src + (size_t)((ntv) * nk + (krv)) * 16384;                    \
    glds16(bs_ + 2 * 4096, st_ + 8192 + 2 * 8192);                                       \
    glds16(bs_ + 3 * 4096, st_ + 8192 + 3 * 8192);                                       \
  } while (0)

template <class Epi>
__device__ __forceinline__ void gemm_panel(const bf16_t* __restrict__ A, const int lda, const bf16_t* __restrict__ Wb,
                                           const int K, const int nN, const Epi epi, bf16_t* smem) {
  const int tid = opaque_tid(), lane = tid & 63;
  const int w = __builtin_amdgcn_readfirstlane(tid >> 6);
  const int wm = w & 1, wn = w >> 1;
  const int nk = K >> 5;
  const int total = nN * nk;
  const int l31 = lane & 31, h = lane >> 5;
  const int grow = lane >> 2;
  const int gch = (lane & 3) ^ ((lane >> 4) & 3);
  const bf16_t* a_src = A + (size_t)(w * 16 + grow) * 32 + gch * 8;
  const bf16_t* b_src = Wb + (size_t)(w * 16 + grow) * 32 + gch * 8;
  const char* lds = (const char*)smem;
  const int pos0 = h ^ ((l31 >> 2) & 3);
  const int offk0 = l31 * 64 + pos0 * 16;
  const int offk1 = l31 * 64 + (pos0 ^ 2) * 16;
  f32x16 acc[2][4];
#pragma unroll
  for (int i = 0; i < 2; ++i)
#pragma unroll
    for (int j = 0; j < 4; ++j) acc[i][j] = zero16();
  const int rot = (int)(((blockIdx.x >> 3) & 31) * nk) >> 5;
  int kr3 = rot, nt3 = 0, cnt3 = 0;
  __syncthreads();
#pragma unroll
  for (int s3 = 0; s3 < 3; ++s3) {
    ISSUE_SLAB(s3, nt3, kr3);
    ++kr3; if (kr3 == nk) kr3 = 0;
    ++cnt3; if (cnt3 == nk) { cnt3 = 0; ++nt3; }
  }
  asm volatile("s_waitcnt vmcnt(10)" ::: "memory");
  asm volatile("s_waitcnt lgkmcnt(0)" ::: "memory");
  __builtin_amdgcn_s_barrier();
  asm volatile("" ::: "memory");
  bfrag F0[6], F1[6];
  RDFRAGS(F0, 0, offk0);
  int ks = 0, nt = 0, stage = 0, stage_n = 1, stage_p = 2;
  int kr3p = 0, nt3p = 0;
  for (int it = 0; it < total; ++it) {
#define SB() __builtin_amdgcn_sched_barrier(0)
#define MM(F, mi_, ni_) acc[mi_][ni_] = MFMA(F[mi_], F[2 + (ni_)], acc[mi_][ni_])
    {
      const char* sa_ = lds + stage * G_STAGE_B + wm * 4096 + offk1;
      const char* sb_ = lds + stage * G_STAGE_B + 8192 + wn * 8192 + offk1;
      const char* stp_ = lds + stage_p * G_STAGE_B + w * 1024;
      const bf16_t* bsp_ = b_src + (size_t)(nt3p * nk + kr3p) * 16384;
      MM(F0, 0, 0); SB();
      F1[0] = *(const bfrag*)(sa_); F1[1] = *(const bfrag*)(sa_ + 2048); SB();
      MM(F0, 1, 0); SB();
      if (it > 0) glds16(bsp_ + 2 * 4096, stp_ + 8192 + 2 * 8192);
      SB();
      MM(F0, 0, 1); SB();
      F1[2] = *(const bfrag*)(sb_); F1[3] = *(const bfrag*)(sb_ + 2048); SB();
      MM(F0, 1, 1); SB();
      if (it > 0) glds16(bsp_ + 3 * 4096, stp_ + 8192 + 3 * 8192);
      SB();
      MM(F0, 0, 2); SB();
      F1[4] = *(const bfrag*)(sb_ + 4096); F1[5] = *(const bfrag*)(sb_ + 6144); SB();
      MM(F0, 1, 2); MM(F0, 0, 3); MM(F0, 1, 3); SB();
    }
    asm volatile("s_waitcnt vmcnt(5)" ::: "memory");
    asm volatile("s_waitcnt lgkmcnt(0)" ::: "memory");
    __builtin_amdgcn_s_barrier();
    asm volatile("" ::: "memory");
    SB();
    {
      const char* sa_ = lds + stage_n * G_STAGE_B + wm * 4096 + offk0;
      const char* sb_ = lds + stage_n * G_STAGE_B + 8192 + wn * 8192 + offk0;
      const char* st_ = lds + stage * G_STAGE_B + w * 1024;
      const bf16_t* bs_ = b_src + (size_t)(nt3 * nk + kr3) * 16384;
      MM(F1, 0, 0); SB();
      glds16(a_src + kr3 * 4096, st_); SB();
      MM(F1, 1, 0); SB();
      F0[0] = *(const bfrag*)(sa_); F0[1] = *(const bfrag*)(sa_ + 2048); SB();
      MM(F1, 0, 1); SB();
      glds16(bs_, st_ + 8192); SB();
      MM(F1, 1, 1); SB();
      F0[2] = *(const bfrag*)(sb_); F0[3] = *(const bfrag*)(sb_ + 2048); SB();
      MM(F1, 0, 2); SB();
      glds16(bs_ + 4096, st_ + 8192 + 8192); SB();
      MM(F1, 1, 2); SB();
      F0[4] = *(const bfrag*)(sb_ + 4096); F0[5] = *(const bfrag*)(sb_ + 6144); SB();
      MM(F1, 0, 3); MM(F1, 1, 3); SB();
    }
    kr3p = kr3; nt3p = nt3;
    ++kr3; if (kr3 == nk) kr3 = 0;
    ++cnt3; if (cnt3 == nk) { cnt3 = 0; ++nt3; }
    if (ks == nk - 1) {
      epi(acc, nt, wm, wn, lane);
#pragma unroll
      for (int i = 0; i < 2; ++i)
#pragma unroll
        for (int j = 0; j < 4; ++j) acc[i][j] = zero16();
      ++nt;
      asm volatile("s_waitcnt vmcnt(0)" ::: "memory");
      RDFRAGS(F0, stage_n, offk0);
    }
    ++ks; if (ks == nk) ks = 0;
    stage_p = stage;
    stage = stage_n;
    ++stage_n; if (stage_n == 3) stage_n = 0;
  }
  asm volatile("s_waitcnt vmcnt(0)" ::: "memory");
  __syncthreads();
}

struct EpiSwiglu {
  bf16_t* act;
  __device__ __forceinline__ void operator()(f32x16 (&acc)[2][4], int nt, int wm, int wn, int lane_in) const {
    int lane = lane_in;
    asm volatile("" : "+v"(lane));
    const int l31 = lane & 31;
    bf16_t* base = act + (size_t)((nt * 4 + wn) * 2) * 4096 + (wm * 64 + 4 * (lane >> 5)) * 32 + l31;
#pragma unroll
    for (int mi = 0; mi < 2; ++mi)
#pragma unroll
      for (int n2 = 0; n2 < 2; ++n2)
#pragma unroll
        for (int r0 = 0; r0 < 16; r0 += 4) {
          float e[4], d[4], o[4];
#pragma unroll
          for (int k = 0; k < 4; ++k) e[k] = __expf(-acc[mi][n2][r0 + k]);
#pragma unroll
          for (int k = 0; k < 4; ++k) d[k] = __builtin_amdgcn_rcpf(1.f + e[k]);
#pragma unroll
          for (int k = 0; k < 4; ++k) o[k] = acc[mi][n2][r0 + k] * acc[mi][n2 + 2][r0 + k] * d[k];
          const uint32_t p01 = pack2(o[0], o[1]), p23 = pack2(o[2], o[3]);
          bf16_t* q = base + n2 * 4096 + (mi * 32 + 2 * r0) * 32;
          q[0] = (bf16_t)(p01 & 0xffffu);
          q[32] = (bf16_t)(p01 >> 16);
          q[64] = (bf16_t)(p23 & 0xffffu);
          q[96] = (bf16_t)(p23 >> 16);
        }
  }
};
struct EpiResLN {
  const float* Hin;
  float* Hp;
  const float2* st;
  const float* gp;
  const float* bp;
  float alpha, c;
  const float* bias;
  __device__ __forceinline__ void operator()(f32x16 (&acc)[2][4], int nt, int wm, int wn, int lane_in) const {
    int lane = lane_in;
    asm volatile("" : "+v"(lane));
    const int l31 = lane & 31;
    const int rb = wm * 64 + 4 * (lane >> 5);
    const size_t off0 = (size_t)rb * 1024 + nt * 512 + wn * 128 + l31;
    const float* bin = Hin + off0;
    float* base = Hp + off0;
#pragma unroll
    for (int ni = 0; ni < 4; ++ni) {
      const int col = nt * 512 + wn * 128 + ni * 32 + l31;
      float ag = alpha, ab = bias ? c * bias[col] : 0.f;
      if (st) { ag = alpha * gp[col]; ab += alpha * bp[col]; }
#pragma unroll
      for (int mi = 0; mi < 2; ++mi) {
        float hv[16];
#pragma unroll
        for (int r = 0; r < 16; ++r) hv[r] = bin[(size_t)(mi * 32 + (r & 3) + 8 * (r >> 2)) * 1024 + ni * 32];
#pragma unroll
        for (int r = 0; r < 16; ++r) {
          float A = 1.f, B = 0.f;
          if (st) { const float2 ms = st[rb + mi * 32 + (r & 3) + 8 * (r >> 2)]; A = ms.x; B = ms.y; }
          base[(size_t)(mi * 32 + (r & 3) + 8 * (r >> 2)) * 1024 + ni * 32] = fmaf(fmaf(hv[r], A, B), ag, fmaf(c, acc[mi][ni][r], ab));
        }
        __builtin_amdgcn_sched_barrier(0);
      }
    }
  }
};
struct EpiGelu {
  bf16_t* Z;
  __device__ __forceinline__ void operator()(f32x16 (&acc)[2][4], int nt, int wm, int wn, int lane_in) const {
    int lane = lane_in;
    asm volatile("" : "+v"(lane));
    const int l31 = lane & 31;
#pragma unroll
    for (int ni = 0; ni < 4; ++ni) {
      const int col = nt * 512 + wn * 128 + ni * 32 + l31;
#pragma unroll
      for (int mi = 0; mi < 2; ++mi)
#pragma unroll
        for (int r = 0; r < 16; ++r) {
          const int row = wm * 64 + mi * 32 + ROWMAP(r, lane);
          const float x = acc[mi][ni][r];
          Z[(size_t)row * 2048 + col] = f2bf(0.5f * x * (1.f + erff(x * 0.70710678118654752f)));
        }
    }
  }
};
struct EpiHgrn {
  bf16_t* Qp;
  bf16_t* Vp;
  float* LFp;
  bf16_t* SGp;
  const float* lb;
  __device__ __forceinline__ void operator()(f32x16 (&acc)[2][4], int nt, int wm, int wn, int lane_in) const {
    int lane = lane_in;
    asm volatile("" : "+v"(lane));
    const int l31 = lane & 31;
    const int sec = nt >> 1;
    const int cb = (nt & 1) * 512 + wn * 128 + l31;
    const int rb = wm * 64 + 4 * (lane >> 5);
    if (sec == 0 || sec == 3) {
      bf16_t* dst = (sec == 0) ? Qp : SGp;
#pragma unroll
      for (int ni = 0; ni < 4; ++ni)
#pragma unroll
        for (int mi = 0; mi < 2; ++mi)
#pragma unroll
          for (int r = 0; r < 16; ++r) {
            const int row = rb + mi * 32 + (r & 3) + 8 * (r >> 2);
            dst[(size_t)row * 1024 + cb + ni * 32] = f2bf(silu_f(acc[mi][ni][r]));
          }
    } else if (sec == 1) {
#pragma unroll
      for (int ni = 0; ni < 4; ++ni) {
        const float lbv = lb[cb + ni * 32];
#pragma unroll
        for (int mi = 0; mi < 2; ++mi)
#pragma unroll
          for (int r = 0; r < 16; ++r) {
            const int row = rb + mi * 32 + (r & 3) + 8 * (r >> 2);
            const float f = lbv + (1.f - lbv) * __builtin_amdgcn_rcpf(1.f + __expf(-acc[mi][ni][r]));
            LFp[(size_t)row * 1024 + cb + ni * 32] = __logf(f);
          }
      }
    } else {
#pragma unroll
      for (int ni = 0; ni < 4; ++ni)
#pragma unroll
        for (int mi = 0; mi < 2; ++mi)
#pragma unroll
          for (int r = 0; r < 16; ++r) {
            const int row = rb + mi * 32 + (r & 3) + 8 * (r >> 2);
            Vp[(size_t)row * 1024 + cb + ni * 32] = f2bf(acc[mi][ni][r]);
          }
    }
  }
};
struct EpiQkv {
  bf16_t* Qp;
  bf16_t* Kp;
  bf16_t* Vp;
  const float* bias;
  __device__ __forceinline__ void operator()(f32x16 (&acc)[2][4], int nt, int wm, int wn, int lane_in) const {
    int lane = lane_in;
    asm volatile("" : "+v"(lane));
    const int l31 = lane & 31;
#pragma unroll
    for (int ni = 0; ni < 4; ++ni) {
      const int col = nt * 512 + wn * 128 + ni * 32 + l31;
      if (col < 1280) {
        const float bv = bias[col];
#pragma unroll
        for (int mi = 0; mi < 2; ++mi)
#pragma unroll
          for (int r = 0; r < 16; ++r) {
            const int row = wm * 64 + mi * 32 + ROWMAP(r, lane);
            const float x = acc[mi][ni][r] + bv;
            if (col < 1024) Qp[(size_t)row * 1024 + col] = f2bf(x * 0.125f);
            else if (col < 1152) Kp[(size_t)row * 128 + (col - 1024)] = f2bf(x);
            else Vp[(size_t)row * 128 + (col - 1152)] = f2bf(x);
          }
      }
    }
  }
};

__device__ __forceinline__ void ln_panel(const float* Hp, float* outp, bf16_t* HBp, const float* g, const float* b,
                                         float2* stg, float2* stl) {
  const int tid = opaque_tid(), lane = tid & 63;
  const int w = __builtin_amdgcn_readfirstlane(tid >> 6);
  float4 gv[4], bv[4];
#pragma unroll
  for (int j = 0; j < 4; ++j) {
    gv[j] = *(const float4*)(g + j * 256 + lane * 4);
    bv[j] = *(const float4*)(b + j * 256 + lane * 4);
  }
  for (int r0 = w; r0 < 128; r0 += 32) {
    float4 x[4][4];
#pragma unroll
    for (int u = 0; u < 4; ++u)
#pragma unroll
      for (int j = 0; j < 4; ++j) x[u][j] = *(const float4*)(Hp + (size_t)(r0 + 8 * u) * 1024 + j * 256 + lane * 4);
#pragma unroll
    for (int u = 0; u < 4; ++u) {
      const int r = r0 + 8 * u;
      float s = 0.f;
#pragma unroll
      for (int j = 0; j < 4; ++j) s += x[u][j].x + x[u][j].y + x[u][j].z + x[u][j].w;
      s = wave_sum(s);
      const float mean = s * (1.f / 1024.f);
      float v = 0.f;
#pragma unroll
      for (int j = 0; j < 4; ++j) {
        x[u][j].x -= mean; x[u][j].y -= mean; x[u][j].z -= mean; x[u][j].w -= mean;
        v += x[u][j].x * x[u][j].x + x[u][j].y * x[u][j].y + x[u][j].z * x[u][j].z + x[u][j].w * x[u][j].w;
      }
      v = wave_sum(v);
      const float rstd = 1.0f / sqrtf(v * (1.f / 1024.f) + 1e-5f);
        if (lane == 0) { stg[r] = make_float2(rstd, -mean * rstd); stl[r] = make_float2(rstd, -mean * rstd); }
#pragma unroll
      for (int j = 0; j < 4; ++j) {
        float4 y;
        y.x = x[u][j].x * rstd * gv[j].x + bv[j].x;
        y.y = x[u][j].y * rstd * gv[j].y + bv[j].y;
        y.z = x[u][j].z * rstd * gv[j].z + bv[j].z;
        y.w = x[u][j].w * rstd * gv[j].w + bv[j].w;
        if (outp) *(float4*)(outp + (size_t)r * 1024 + j * 256 + lane * 4) = y;
        uint2 pk;
        pk.x = pack2(y.x, y.y);
        pk.y = pack2(y.z, y.w);
        *(uint2*)(HBp + ablk(r, j * 256 + lane * 4)) = pk;
      }
    }
  }
  __syncthreads();
}

__device__ __forceinline__ void ffn_panel(const Ctx& C, int p, int layer, int j, bool final_out, int sub, bf16_t* smem) {
  const int wi = layer * 2 + j;
  bf16_t* HBp = C.HB() + (size_t)p * 128 * 1024;
  bf16_t* ACTp = C.ACT() + (size_t)p * 128 * 2816;
  float* Hp = C.H() + (size_t)p * 128 * 1024;
  EpiSwiglu e1{ACTp};
  gemm_panel(HBp, 1024, C.WGU() + (size_t)wi * 5632 * 1024, 1024, 11, e1, smem);
  float2* stl = (float2*)((char*)smem + LDS_STATS_OFF);
  float2* stg = C.STATS() + (size_t)p * 128;
  EpiResLN e2{sub > 0 ? (const float*)Hp : C.in[0] + (size_t)p * 128 * 1024, Hp, sub > 0 ? stl : nullptr, C.in[3] + (sub > 0 ? sub - 1 : 0) * 1024, C.in[4] + (sub > 0 ? sub - 1 : 0) * 1024, ALPHA, 0.5f, nullptr};
  gemm_panel(ACTp, 2816, C.WD() + (size_t)wi * 1024 * 2816, 2816, 2, e2, smem);
  const int li = (layer * 3 + (j == 0 ? 0 : 2)) * 1024;
  float* outp = final_out ? (C.out + (size_t)p * 128 * 1024) : nullptr;
  ln_panel(Hp, outp, HBp, C.in[3] + li, C.in[4] + li, stg, stl);
}

__device__ __forceinline__ void gmlp_panel(const Ctx& C, int p, int layer, int slot, int sub, bf16_t* smem) {
  const int tid = opaque_tid(), lane = tid & 63;
  const int w = __builtin_amdgcn_readfirstlane(tid >> 6);
  const int l31 = lane & 31, h8 = (lane >> 5) * 8;
  bf16_t* HBp = C.HB() + (size_t)p * 128 * 1024;
  bf16_t* Zp = C.ACT() + (size_t)p * 128 * 2816;
  float* Hp = C.H() + (size_t)p * 128 * 1024;
  {
    EpiGelu e{Zp};
    gemm_panel(HBp, 1024, C.WGI() + (size_t)slot * 2048 * 1024, 1024, 4, e, smem);
  }
  bf16_t* As = smem;
  bf16_t* Bs = smem + 128 * 136;
  float* st = (float*)(smem + 2 * 128 * 136);
  for (int r = w; r < 128; r += 8) {
    const uint4 q0 = *(const uint4*)(Zp + (size_t)r * 2048 + 1024 + lane * 16);
    const uint4 q1 = *(const uint4*)(Zp + (size_t)r * 2048 + 1024 + lane * 16 + 8);
    const uint32_t u[8] = {q0.x, q0.y, q0.z, q0.w, q1.x, q1.y, q1.z, q1.w};
    float x[16];
    float s = 0.f;
#pragma unroll
    for (int e = 0; e < 8; ++e) {
      x[2 * e] = __uint_as_float(u[e] << 16);
      x[2 * e + 1] = __uint_as_float(u[e] & 0xffff0000u);
      s += x[2 * e] + x[2 * e + 1];
    }
    s = wave_sum(s);
    const float mean = s * (1.f / 1024.f);
    float v = 0.f;
#pragma unroll
    for (int e = 0; e < 16; ++e) { const float d = x[e] - mean; v += d * d; }
    v = wave_sum(v);
    if (lane == 0) { st[r * 2] = mean; st[r * 2 + 1] = 1.0f / sqrtf(v * (1.f / 1024.f) + 1e-5f); }
  }
  __syncthreads();
  const float* lng = C.in[6] + slot * 1024;
  const float* lnb = C.in[7] + slot * 1024;
  const float* bsp = C.in[9] + slot * 1024;
  const bf16_t* Wsp = C.WSP() + (size_t)slot * 8 * 16384;
  const int nd = w & 3, mt0 = (w >> 2) * 2;
  for (int g = 0; g < 8; ++g) {
#pragma unroll
    for (int i = 0; i < 4; ++i) {
      const int c = tid + 512 * i;
      *(uint4*)(As + (c >> 4) * 136 + (c & 15) * 8) = *(const uint4*)(Wsp + (size_t)g * 16384 + c * 8);
    }
    {
      const int s = tid >> 2, dq = tid & 3;
      const float mean = st[s * 2], rstd = st[s * 2 + 1];
      const bf16_t* src = Zp + (size_t)s * 2048 + 1024 + g * 128 + dq * 32;
#pragma unroll
      for (int q = 0; q < 4; ++q) {
        const uint4 v4 = *(const uint4*)(src + q * 8);
        const uint32_t u[4] = {v4.x, v4.y, v4.z, v4.w};
#pragma unroll
        for (int e = 0; e < 4; ++e) {
          const int d0 = dq * 32 + q * 8 + e * 2;
          const int ch = g * 128 + d0;
          const float x0 = __uint_as_float(u[e] << 16), x1 = __uint_as_float(u[e] & 0xffff0000u);
          Bs[d0 * 136 + s] = f2bf((x0 - mean) * rstd * lng[ch] + lnb[ch]);
          Bs[(d0 + 1) * 136 + s] = f2bf((x1 - mean) * rstd * lng[ch + 1] + lnb[ch + 1]);
        }
      }
    }
    __syncthreads();
    f32x16 acc[2];
    acc[0] = zero16(); acc[1] = zero16();
#pragma unroll
    for (int k16 = 0; k16 < 8; ++k16) {
      const bfrag b = *(const bfrag*)(Bs + (nd * 32 + l31) * 136 + k16 * 16 + h8);
#pragma unroll
      for (int mi = 0; mi < 2; ++mi) {
        const bfrag a = *(const bfrag*)(As + ((mt0 + mi) * 32 + l31) * 136 + k16 * 16 + h8);
        acc[mi] = MFMA(a, b, acc[mi]);
      }
    }
#pragma unroll
    for (int mi = 0; mi < 2; ++mi)
#pragma unroll
      for (int r = 0; r < 16; ++r) {
        const int t = (mt0 + mi) * 32 + ROWMAP(r, lane);
        const int ch = g * 128 + nd * 32 + l31;
        const float mixed = acc[mi][r] + bsp[g * 128 + t];
        const float u = bf2f(Zp[(size_t)t * 2048 + ch]);
        HBp[ablk(t, ch)] = f2bf(u * mixed);
      }
    __syncthreads();
  }
  {
    EpiResLN e2{Hp, Hp, (float2*)((char*)smem + LDS_STATS_OFF), C.in[3] + (sub - 1) * 1024, C.in[4] + (sub - 1) * 1024, ALPHA, 1.0f, nullptr};
    gemm_panel(HBp, 1024, C.WGO() + (size_t)slot * 1024 * 1024, 1024, 2, e2, smem);
  }
  const int li = (layer * 3 + 1) * 1024;
  ln_panel(Hp, nullptr, HBp, C.in[3] + li, C.in[4] + li, C.STATS() + (size_t)p * 128, (float2*)((char*)smem + LDS_STATS_OFF));
}

template <bool OUT>
__device__ __forceinline__ void hgrn_rec(const Ctx& C, int p, bf16_t* smem) {
  const int tid = opaque_tid(), lane = tid & 63;
  const int w = __builtin_amdgcn_readfirstlane(tid >> 6);
  const int l31 = lane & 31, h8 = (lane >> 5) * 8;
  bf16_t* ST = smem;
  bf16_t* Qh = smem + 17408;
  bf16_t* Kh = smem + 21760;
  bf16_t* KhT = smem + 26112;
  bf16_t* vT = smem + 31232;
  bf16_t* Ps = smem + 36352;
  float* seg = (float*)(smem + 37632);
  float* dec = seg + 512;
  float* oF = dec + 128;
  const size_t row0 = (size_t)p * 128;
  const bf16_t* Qp = C.ACT() + (size_t)p * 128 * 2816;
  const bf16_t* Vp = Qp + 128 * 1024;
  const float* LFp = C.out + row0 * 1024;
  const bf16_t* SGp = C.SG() + row0 * 1024;
  bf16_t* HBp = C.HB() + row0 * 1024;
  const float* ng = C.in[13];
  const int jt = w >> 1, kt0 = (w & 1) * 2;
  const int kq = tid & 127, tq = tid >> 7;
  for (int h = 0; h < 8; ++h) {
    f32x16 accS[2];
    bf16_t* SBh = C.DS() + ((size_t)(p * 8 + h)) * 16384;
    if (OUT) {
      __syncthreads();
#pragma unroll
      for (int i = 0; i < 4; ++i) {
        const int c = tid + 512 * i;
        *(uint4*)(ST + (c >> 4) * 136 + (c & 15) * 8) = *(const uint4*)(SBh + c * 8);
      }
      __syncthreads();
#pragma unroll
      for (int c2 = 0; c2 < 2; ++c2)
#pragma unroll
        for (int r = 0; r < 16; ++r)
          accS[c2][r] = bf2f(ST[(jt * 32 + ROWMAP(r, lane)) * 136 + (kt0 + c2) * 32 + l31]);
    } else {
      accS[0] = zero16(); accS[1] = zero16();
    }
    float dsum = 0.f;
    float ln_[8];
    bf16_t vn_[8], qn_[8];
    {
      const size_t g0 = (size_t)(tq * 8) * 1024 + h * 128 + kq;
#pragma unroll
      for (int e = 0; e < 8; ++e) {
        ln_[e] = LFp[g0 + (size_t)e * 1024];
        vn_[e] = Vp[g0 + (size_t)e * 1024];
        qn_[e] = OUT ? Qp[g0 + (size_t)e * 1024] : (bf16_t)0;
      }
    }
    for (int i = 0; i < 4; ++i) {
      float l[8], cs[8];
      bf16_t vcur[8], qcur[8];
      const size_t gbase = (size_t)(i * 32 + tq * 8) * 1024 + h * 128 + kq;
#pragma unroll
      for (int e = 0; e < 8; ++e) { l[e] = ln_[e]; vcur[e] = vn_[e]; qcur[e] = qn_[e]; }
      if (i < 3) {
        const size_t gn = gbase + (size_t)32 * 1024;
#pragma unroll
        for (int e = 0; e < 8; ++e) {
          ln_[e] = LFp[gn + (size_t)e * 1024];
          vn_[e] = Vp[gn + (size_t)e * 1024];
          if (OUT) qn_[e] = Qp[gn + (size_t)e * 1024];
        }
      }
      cs[0] = l[0];
#pragma unroll
      for (int e = 1; e < 8; ++e) cs[e] = cs[e - 1] + l[e];
      seg[tq * 128 + kq] = cs[7];
#pragma unroll
      for (int e = 0; e < 8; ++e) vT[kq * 40 + tq * 8 + e] = vcur[e];
      __syncthreads();
      float off = 0.f, tot = 0.f;
#pragma unroll
      for (int q = 0; q < 4; ++q) {
        const float s = seg[q * 128 + kq];
        if (q < tq) off += s;
        tot += s;
      }
#pragma unroll
      for (int e = 0; e < 8; ++e) {
        const float gc = cs[e] + off;
        const float f = __expf(l[e]);
        const float kh = (1.f - f) * __expf(-gc);
        const bf16_t khb = f2bf(kh);
        const int t = tq * 8 + e;
        KhT[kq * 40 + t] = khb;
        if (OUT) {
          Kh[t * 136 + kq] = khb;
          const float qv = bf2f(qcur[e]);
          Qh[t * 136 + kq] = f2bf(qv * __expf(gc));
        }
      }
      if (tq == 0) { dec[kq] = __expf(tot); dsum += tot; }
      __syncthreads();
      f32x16 accO = zero16();
      if (OUT) {
        if (w == 0) {
          f32x16 accP = zero16();
#pragma unroll
          for (int k16 = 0; k16 < 8; ++k16) {
            const bfrag a = *(const bfrag*)(Qh + l31 * 136 + k16 * 16 + h8);
            const bfrag b = *(const bfrag*)(Kh + l31 * 136 + k16 * 16 + h8);
            accP = MFMA(a, b, accP);
          }
#pragma unroll
          for (int r = 0; r < 16; ++r) {
            const int t = ROWMAP(r, lane);
            Ps[t * 40 + l31] = (l31 <= t) ? f2bf(accP[r]) : (bf16_t)0;
          }
        } else if (w <= 4) {
          const int nt = w - 1;
#pragma unroll
          for (int k16 = 0; k16 < 8; ++k16) {
            const bfrag a = *(const bfrag*)(Qh + l31 * 136 + k16 * 16 + h8);
            const bfrag b = *(const bfrag*)(ST + (nt * 32 + l31) * 136 + k16 * 16 + h8);
            accO = MFMA(a, b, accO);
          }
        }
        __syncthreads();
        if (w >= 1 && w <= 4) {
          const int nt = w - 1;
#pragma unroll
          for (int k16 = 0; k16 < 2; ++k16) {
            const bfrag a = *(const bfrag*)(Ps + l31 * 40 + k16 * 16 + h8);
            const bfrag b = *(const bfrag*)(vT + (nt * 32 + l31) * 40 + k16 * 16 + h8);
            accO = MFMA(a, b, accO);
          }
#pragma unroll
          for (int r = 0; r < 16; ++r) oF[ROWMAP(r, lane) * 132 + nt * 32 + l31] = accO[r];
        }
      }
#pragma unroll
      for (int c2 = 0; c2 < 2; ++c2) {
#pragma unroll
        for (int k16 = 0; k16 < 2; ++k16) {
          const bfrag a = *(const bfrag*)(vT + (jt * 32 + l31) * 40 + k16 * 16 + h8);
          const bfrag b = *(const bfrag*)(KhT + ((kt0 + c2) * 32 + l31) * 40 + k16 * 16 + h8);
          accS[c2] = MFMA(a, b, accS[c2]);
        }
        const float dk = dec[(kt0 + c2) * 32 + l31];
#pragma unroll
        for (int r = 0; r < 16; ++r) accS[c2][r] *= dk;
        if (OUT) {
#pragma unroll
          for (int r = 0; r < 16; ++r)
            ST[(jt * 32 + ROWMAP(r, lane)) * 136 + (kt0 + c2) * 32 + l31] = f2bf(accS[c2][r]);
        }
      }
      __syncthreads();
      if (OUT) {
        const int t = tid >> 4, part = tid & 15;
        float x[8];
        float ss = 0.f;
#pragma unroll
        for (int e = 0; e < 8; ++e) { x[e] = oF[t * 132 + part * 8 + e]; ss += x[e] * x[e]; }
        ss += __shfl_xor(ss, 1, 64); ss += __shfl_xor(ss, 2, 64); ss += __shfl_xor(ss, 4, 64); ss += __shfl_xor(ss, 8, 64);
        const float rr = 1.0f / sqrtf(ss * (1.f / 128.f) + 1e-6f);
        const size_t gro = (size_t)(i * 32 + t) * 1024 + h * 128 + part * 8;
        const uint4 sg4 = *(const uint4*)(SGp + gro);
        const uint32_t su[4] = {sg4.x, sg4.y, sg4.z, sg4.w};
        uint32_t ov[4];
#pragma unroll
        for (int e = 0; e < 4; ++e) {
          const float g0 = ng[part * 8 + 2 * e], g1 = ng[part * 8 + 2 * e + 1];
          const float s0 = __uint_as_float(su[e] << 16), s1 = __uint_as_float(su[e] & 0xffff0000u);
          ov[e] = pack2(x[2 * e] * rr * g0 * s0, x[2 * e + 1] * rr * g1 * s1);
        }
        uint4 o4; o4.x = ov[0]; o4.y = ov[1]; o4.z = ov[2]; o4.w = ov[3];
        *(uint4*)(HBp + ablk(i * 32 + t, h * 128 + part * 8)) = o4;
      }
    }
    if (!OUT) {
#pragma unroll
      for (int c2 = 0; c2 < 2; ++c2)
#pragma unroll
        for (int r = 0; r < 16; ++r)
          SBh[(jt * 32 + ROWMAP(r, lane)) * 128 + (kt0 + c2) * 32 + l31] = f2bf(accS[c2][r]);
      if (tq == 0) C.DEC()[(size_t)(p * 8 + h) * 128 + kq] = __expf(dsum);
    }
  }
  __syncthreads();
}

__device__ __forceinline__ void hgrn_scan(const Ctx& C) {
  for (int gid = blockIdx.x * 512 + threadIdx.x; gid < 131072; gid += gridDim.x * 512) {
    const int kp = gid & 63, j = (gid >> 6) & 127, h = (gid >> 13) & 7, b = gid >> 16;
    float s0 = 0.f, s1 = 0.f;
    for (int c0 = 0; c0 < 128; c0 += 8) {
      uint32_t d[8];
      float2 dc[8];
#pragma unroll
      for (int e = 0; e < 8; ++e) {
        const size_t ph = (size_t)((b * 128 + c0 + e) * 8 + h);
        d[e] = *(const uint32_t*)(C.DS() + ph * 16384 + j * 128 + kp * 2);
        dc[e] = *(const float2*)(C.DEC() + ph * 128 + kp * 2);
      }
#pragma unroll
      for (int e = 0; e < 8; ++e) {
        const size_t ph = (size_t)((b * 128 + c0 + e) * 8 + h);
        *(uint32_t*)(C.DS() + ph * 16384 + j * 128 + kp * 2) = pack2(s0, s1);
        s0 = dc[e].x * s0 + __uint_as_float(d[e] << 16);
        s1 = dc[e].y * s1 + __uint_as_float(d[e] & 0xffff0000u);
      }
    }
  }
}

__device__ __forceinline__ void attn_panel(const Ctx& C, int p, bf16_t* smem) {
  const int tid = opaque_tid(), lane = tid & 63;
  const int w = __builtin_amdgcn_readfirstlane(tid >> 6);
  const int l31 = lane & 31, h8 = (lane >> 5) * 8;
  bf16_t* K2 = smem;
  bf16_t* VT = smem + 18432;
  bf16_t* Pw = smem + 35328 + w * 1280;
  const int blk = p & 127;
  const size_t row0 = (size_t)p * 128;
  const bf16_t* Qp = C.ACT() + (size_t)p * 128 * 2816;
  bf16_t* HBp = C.HB() + row0 * 1024;
  const int qt = w & 3;
  for (int hk = 0; hk < 2; ++hk) {
    __syncthreads();
#pragma unroll
    for (int i = 0; i < 4; ++i) {
      const int c = tid + 512 * i;
      const int r = c >> 3, ch = c & 7;
      uint4 kv = make_uint4(0, 0, 0, 0), vv = make_uint4(0, 0, 0, 0);
      if (blk > 0 || r >= 128) {
        const size_t tok = row0 + r - 128;
        kv = *(const uint4*)(C.KB() + tok * 128 + hk * 64 + ch * 8);
        vv = *(const uint4*)(C.VB() + tok * 128 + hk * 64 + ch * 8);
      }
      *(uint4*)(K2 + r * 72 + ch * 8) = kv;
      const uint32_t vu[4] = {vv.x, vv.y, vv.z, vv.w};
#pragma unroll
      for (int e = 0; e < 4; ++e) {
        VT[(ch * 8 + 2 * e) * 264 + r] = (bf16_t)(vu[e] & 0xffffu);
        VT[(ch * 8 + 2 * e + 1) * 264 + r] = (bf16_t)(vu[e] >> 16);
      }
    }
    __syncthreads();
    for (int u = 0; u < 4; ++u) {
      const int hq = hk * 8 + (w >> 2) * 4 + u;
      const float sink = C.in[17][hq];
      bfrag aq[4];
#pragma unroll
      for (int k16 = 0; k16 < 4; ++k16)
        aq[k16] = *(const bfrag*)(Qp + (size_t)(qt * 32 + l31) * 1024 + hq * 64 + k16 * 16 + h8);
      f32x16 s[5];
#pragma unroll
      for (int c = 0; c < 5; ++c) {
        s[c] = zero16();
#pragma unroll
        for (int k16 = 0; k16 < 4; ++k16) {
          const bfrag b = *(const bfrag*)(K2 + ((qt + c) * 32 + l31) * 72 + k16 * 16 + h8);
          s[c] = MFMA(aq[k16], b, s[c]);
        }
      }
      float linv[16];
#pragma unroll
      for (int r = 0; r < 16; ++r) {
        const int qi = qt * 32 + ROWMAP(r, lane);
        float m = -1e30f;
#pragma unroll
        for (int c = 0; c < 5; ++c) {
          const int kp = (qt + c) * 32 + l31;
          const bool valid = (kp > qi) && (kp <= qi + 128) && (blk > 0 || kp >= 128);
          const float v = valid ? s[c][r] : -1e30f;
          s[c][r] = v;
          m = fmaxf(m, v);
        }
        m = fmaxf(m, __shfl_xor(m, 16, 64)); m = fmaxf(m, __shfl_xor(m, 8, 64)); m = fmaxf(m, __shfl_xor(m, 4, 64));
        m = fmaxf(m, __shfl_xor(m, 2, 64)); m = fmaxf(m, __shfl_xor(m, 1, 64));
        m = fmaxf(m, sink);
        float sum = 0.f;
#pragma unroll
        for (int c = 0; c < 5; ++c) {
          const float pv = (s[c][r] > -1e29f) ? __expf(s[c][r] - m) : 0.f;
          s[c][r] = pv;
          sum += pv;
        }
        sum += __shfl_xor(sum, 16, 64); sum += __shfl_xor(sum, 8, 64); sum += __shfl_xor(sum, 4, 64);
        sum += __shfl_xor(sum, 2, 64); sum += __shfl_xor(sum, 1, 64);
        sum += __expf(sink - m);
        linv[r] = __builtin_amdgcn_rcpf(sum);
      }
      f32x16 o[2];
      o[0] = zero16(); o[1] = zero16();
#pragma unroll
      for (int c = 0; c < 5; ++c) {
#pragma unroll
        for (int r = 0; r < 16; ++r) Pw[ROWMAP(r, lane) * 40 + l31] = f2bf(s[c][r]);
        __syncthreads();
#pragma unroll
        for (int k16 = 0; k16 < 2; ++k16) {
          const bfrag a = *(const bfrag*)(Pw + l31 * 40 + k16 * 16 + h8);
#pragma unroll
          for (int dt = 0; dt < 2; ++dt) {
            const bfrag b = *(const bfrag*)(VT + (dt * 32 + l31) * 264 + (qt + c) * 32 + k16 * 16 + h8);
            o[dt] = MFMA(a, b, o[dt]);
          }
        }
        __syncthreads();
      }
#pragma unroll
      for (int dt = 0; dt < 2; ++dt)
#pragma unroll
        for (int r = 0; r < 16; ++r)
          HBp[ablk(qt * 32 + ROWMAP(r, lane), hq * 64 + dt * 32 + l31)] = f2bf(o[dt][r] * linv[r]);
    }
  }
  __syncthreads();
}

__device__ __forceinline__ void conv_weights(const float* __restrict__ src, bf16_t* __restrict__ dst, int nmat, int K,
                                             int Nsrc, int Ndst, int mode) {
  const int nk = K >> 5, nNt = Ndst >> 9;
  const int upm = nk * nNt;
  const int tid = threadIdx.x;
  for (int u = blockIdx.x; u < nmat * upm; u += gridDim.x) {
    const int m = u / upm, r = u - m * upm;
    const int nt = r / nk, ks = r - nt * nk;
    const int np = nt * 512 + tid;
    int sc;
    if (mode == 1) {
      const int b = np >> 7, rr = np & 127;
      sc = (rr < 64) ? (b * 64 + rr) : (2816 + b * 64 + rr - 64);
    } else {
      sc = (np < Nsrc) ? np : -1;
    }
    const float* s = src + (size_t)m * K * Nsrc + (size_t)(ks * 32) * Nsrc + (sc < 0 ? 0 : sc);
    uint32_t pk[16];
#pragma unroll
    for (int kk = 0; kk < 16; ++kk) {
      float v0 = s[(size_t)(2 * kk) * Nsrc], v1 = s[(size_t)(2 * kk + 1) * Nsrc];
      if (sc < 0) { v0 = 0.f; v1 = 0.f; }
      pk[kk] = pack2(v0, v1);
    }
    uint4* d = (uint4*)(dst + (size_t)m * K * Ndst + (size_t)(nt * nk + ks) * 16384 + tid * 32);
    d[0] = make_uint4(pk[0], pk[1], pk[2], pk[3]);
    d[1] = make_uint4(pk[4], pk[5], pk[6], pk[7]);
    d[2] = make_uint4(pk[8], pk[9], pk[10], pk[11]);
    d[3] = make_uint4(pk[12], pk[13], pk[14], pk[15]);
  }
}

__device__ __forceinline__ void phase0(const Ctx& C) {
  conv_weights(C.in[1], C.WGU(), 8, 1024, 5632, 5632, 1);
  conv_weights(C.in[2], C.WD(), 8, 2816, 1024, 1024, 0);
  conv_weights(C.in[5], C.WGI(), 2, 1024, 2048, 2048, 0);
  conv_weights(C.in[10], C.WGO(), 2, 1024, 1024, 1024, 0);
  conv_weights(C.in[11], C.WHI(), 1, 1024, 4096, 4096, 0);
  conv_weights(C.in[14], C.WHO(), 1, 1024, 1024, 1024, 0);
  conv_weights(C.in[15], C.WQKV(), 1, 1024, 1280, 1536, 0);
  conv_weights(C.in[18], C.WAO(), 1, 1024, 1024, 1024, 0);
  const size_t gtid = (size_t)blockIdx.x * 512 + threadIdx.x;
  const size_t gsz = (size_t)gridDim.x * 512;
  for (size_t i = gtid; i < (size_t)T_TOK * 1024 / 4; i += gsz) {
    const float4 v = ((const float4*)C.in[0])[i];
    uint2 pk;
    pk.x = pack2(v.x, v.y);
    pk.y = pack2(v.z, v.w);
    {
      const int row = (int)(i >> 8), col = (int)(i & 255) * 4;
      *(uint2*)(C.HB() + (size_t)(row >> 7) * 131072 + ablk(row & 127, col)) = pk;
    }
  }
  for (size_t i = gtid; i < (size_t)2 * 8 * 128 * 128; i += gsz) {
    const int s = (int)(i & 127), t = (int)((i >> 7) & 127);
    C.WSP()[i] = (s <= t) ? f2bf(C.in[8][i]) : (bf16_t)0;
  }
  for (size_t i = gtid; i < 1024; i += gsz) {
    const float* lp = C.in[12];
    const float a0 = lp[i], a1 = lp[1024 + i], a2 = lp[2048 + i], a3 = lp[3072 + i];
    const float m = fmaxf(fmaxf(a0, a1), fmaxf(a2, a3));
    const float e0 = expf(a0 - m), e1 = expf(a1 - m), e2 = expf(a2 - m), e3 = expf(a3 - m);
    C.LB()[i] = e1 / (e0 + e1 + e2 + e3);
  }
}

enum { OP_FFN = 0, OP_GMLP = 1, OP_HIN = 2, OP_HOUT = 3, OP_QKV = 4, OP_ATTN = 5 };

__device__ __forceinline__ void run_ops(const Ctx& C0, int op_lo, int op_hi, bf16_t* smem) {
  for (int p0 = blockIdx.x; p0 < NPANEL; p0 += gridDim.x) {
    for (int op = op_lo; op < op_hi; ++op) {
      const Ctx& C = C0;
      const int p = p0;
      bf16_t* HBp = C.HB() + (size_t)p * 128 * 1024;
      float* Hp = C.H() + (size_t)p * 128 * 1024;
      bf16_t* ACTp = C.ACT() + (size_t)p * 128 * 2816;
      int kind = OP_FFN, layer = 0, j = 0, sub = 0;
      switch (op) {
        case 0: kind = OP_FFN; layer = 0; j = 0; sub = 0; break;
        case 1: kind = OP_GMLP; layer = 0; j = 0; sub = 1; break;
        case 2: kind = OP_FFN; layer = 0; j = 1; sub = 2; break;
        case 3: kind = OP_FFN; layer = 1; j = 0; sub = 3; break;
        case 4: kind = OP_HIN; layer = 1; break;
        case 5: kind = OP_HOUT; layer = 1; sub = 4; break;
        case 6: kind = OP_FFN; layer = 1; j = 1; sub = 5; break;
        case 7: kind = OP_FFN; layer = 2; j = 0; sub = 6; break;
        case 8: kind = OP_QKV; layer = 2; break;
        case 9: kind = OP_ATTN; layer = 2; sub = 7; break;
        case 10: kind = OP_FFN; layer = 2; j = 1; sub = 8; break;
        case 11: kind = OP_FFN; layer = 3; j = 0; sub = 9; break;
        case 12: kind = OP_GMLP; layer = 3; j = 1; sub = 10; break;
        default: kind = OP_FFN; layer = 3; j = 1; sub = 11; break;
      }
      float2* stl = (float2*)((char*)smem + LDS_STATS_OFF);
      float2* stg = C.STATS() + (size_t)p * 128;
      if (threadIdx.x < 128) stl[threadIdx.x] = stg[threadIdx.x];
      if (kind == OP_FFN) {
        ffn_panel(C, p, layer, j, op == 13, sub, smem);
      } else if (kind == OP_GMLP) {
        gmlp_panel(C, p, layer, j, sub, smem);
      } else if (kind == OP_HIN) {
        EpiHgrn e{ACTp, ACTp + 128 * 1024, C.out + (size_t)p * 128 * 1024, C.SG() + (size_t)p * 128 * 1024, C.LB()};
        gemm_panel(HBp, 1024, C.WHI(), 1024, 8, e, smem);
        hgrn_rec<false>(C, p, smem);
      } else if (kind == OP_HOUT) {
        hgrn_rec<true>(C, p, smem);
        EpiResLN e2{Hp, Hp, stl, C.in[3] + (sub - 1) * 1024, C.in[4] + (sub - 1) * 1024, ALPHA, 1.0f, nullptr};
        gemm_panel(HBp, 1024, C.WHO(), 1024, 2, e2, smem);
        const int li = (1 * 3 + 1) * 1024;
        ln_panel(Hp, nullptr, HBp, C.in[3] + li, C.in[4] + li, stg, stl);
      } else if (kind == OP_QKV) {
        EpiQkv e{ACTp, C.KB() + (size_t)p * 128 * 128, C.VB() + (size_t)p * 128 * 128, C.in[16]};
        gemm_panel(HBp, 1024, C.WQKV(), 1024, 3, e, smem);
      } else {
        attn_panel(C, p, smem);
        EpiResLN e2{Hp, Hp, stl, C.in[3] + (sub - 1) * 1024, C.in[4] + (sub - 1) * 1024, ALPHA, 1.0f, C.in[19]};
        gemm_panel(HBp, 1024, C.WAO(), 1024, 2, e2, smem);
        const int li = (2 * 3 + 1) * 1024;
        ln_panel(Hp, nullptr, HBp, C.in[3] + li, C.in[4] + li, stg, stl);
      }
    }
  }
}

#if COOP
__device__ __forceinline__ void grid_barrier(unsigned* bar, unsigned target) {
  __syncthreads();
  if (threadIdx.x == 0) {
    __threadfence();
    __hip_atomic_fetch_add(bar, 1u, __ATOMIC_RELEASE, __HIP_MEMORY_SCOPE_AGENT);
    while (__hip_atomic_load(bar, __ATOMIC_ACQUIRE, __HIP_MEMORY_SCOPE_AGENT) < target) __builtin_amdgcn_s_sleep(8);
    __threadfence();
  }
  __syncthreads();
}

__global__ void __launch_bounds__(512) mega(Params P) {
  extern __shared__ __attribute__((aligned(16))) unsigned char lds_raw[];
  bf16_t* smem = (bf16_t*)lds_raw;
  Ctx C;
  C.in = P.in;
  C.out = P.out;
  C.ws = P.ws;
  const int lo = P.ph_lo, hi = P.ph_hi;
#if COOP
  if (lo < 0) cg::this_grid().sync();
  unsigned* bar = (unsigned*)(P.ws + OFF_BAR);
#define GSYNC(k) do { if (lo <= (k) && (k) + 1 < hi) grid_barrier(bar, (unsigned)((k) + 1) * gridDim.x); } while (0)
#else
#define GSYNC(k) do { } while (0)
#endif
  if (lo <= 0 && 0 < hi) phase0(C);
  GSYNC(0);
  if (lo <= 1 && 1 < hi) run_ops(C, 0, 5, smem);
  GSYNC(1);
  if (lo <= 2 && 2 < hi) hgrn_scan(C);
  GSYNC(2);
  if (lo <= 3 && 3 < hi) run_ops(C, 5, 9, smem);
  GSYNC(3);
  if (lo <= 4 && 4 < hi) run_ops(C, 9, 14, smem);
}

#endif

extern "C" void kernel_launch(void* const* d_in, const int* in_sizes, int n_in, void* d_out, int out_size, void* d_ws,
                              size_t ws_size, hipStream_t stream) {
  static int grid_blocks = 0;
  if (grid_blocks == 0) {
    if (n_in != 20 || ws_size < WS_END) {
      fprintf(stderr, "kernel_launch: unexpected n_in %d or ws_size %zu (need %zu)\n", n_in, ws_size, (size_t)WS_END);
      grid_blocks = -1;
      return;
    }
    int dev = 0, cus = 0, per_cu = 0;
    hipGetDevice(&dev);
    hipDeviceGetAttribute(&cus, hipDeviceAttributeMultiprocessorCount, dev);
#if COOP
    if (hipFuncSetAttribute((const void*)mega, hipFuncAttributeMaxDynamicSharedMemorySize, LDS_BYTES) != hipSuccess)
      fprintf(stderr, "kernel_launch: hipFuncSetAttribute failed\n");
    hipOccupancyMaxActiveBlocksPerMultiprocessor(&per_cu, (const void*)mega, 512, LDS_BYTES);
#endif
    (void)hipGetLastError();
    if (per_cu < 1) per_cu = 1;
    grid_blocks = cus * per_cu;
    if (grid_blocks > NPANEL) grid_blocks = NPANEL;
    if (grid_blocks < 1) grid_blocks = NPANEL;
  }
  if (grid_blocks < 0) return;
  Params P{};
  for (int i = 0; i < 20; ++i) P.in[i] = (const float*)d_in[i];
  P.out = (float*)d_out;
  P.ws = (unsigned char*)d_ws;
#if COOP
  P.ph_lo = 0; P.ph_hi = 5;
  (void)hipMemsetAsync((unsigned char*)d_ws + OFF_BAR, 0, 256, stream);
  void* args[] = {&P};
  hipError_t e = hipLaunchCooperativeKernel((const void*)mega, dim3(grid_blocks), dim3(512), args, LDS_BYTES, stream);
  if (e != hipSuccess) fprintf(stderr, "cooperative launch failed: %s (grid %d)\n", hipGetErrorString(e), grid_blocks);
#endif
}
```
